# Optimizing an MI355X kernel written in HIP

```python
import jax
import jax.numpy as jnp
from jax import lax
import numpy as np

D_MODEL = 1024
BATCH = 8
SEQ = 2048
DEPTH = 1

GRID_W = 64
MEM_LEN = 256
N_BRANCHES = 3
RET_HEADS = 4
RET_QK_DIM = 128
RET_V_DIM = 256
RET_CHUNK = 128
ROPE_BASE = 10000.0
NA_HEADS = 8
NA_HEAD_DIM = 64
NA_ROWS = 8
NA_COLS = 16
XA_HEADS = 4
XA_HEAD_DIM = 128
MOE_GROUPS = 4
MOE_EXPERTS_PER_GROUP = 4
MOE_TOP_K = 2
MOE_D_FF = 512
RMS_EPS = 1e-6
GN_EPS = 1e-5

RET_QK_WIDTH = RET_HEADS * RET_QK_DIM
RET_V_WIDTH = RET_HEADS * RET_V_DIM
NA_WIDTH = NA_HEADS * NA_HEAD_DIM
XA_WIDTH = XA_HEADS * XA_HEAD_DIM
IN_SPLITS = (RET_QK_WIDTH, RET_QK_WIDTH, RET_V_WIDTH, RET_V_WIDTH, NA_WIDTH, NA_WIDTH, NA_WIDTH, XA_WIDTH, N_BRANCHES * D_MODEL)
IN_WIDTH = 2 * RET_QK_WIDTH + 2 * RET_V_WIDTH + 3 * NA_WIDTH + XA_WIDTH + N_BRANCHES * D_MODEL

kernel_name = 'hybrid_retention_natten_memory_hmoe_encoder'


def _rmsnorm(x, g):
    xf = x.astype(jnp.float32)
    y = xf * lax.rsqrt(jnp.mean(xf * xf, axis=-1, keepdims=True) + RMS_EPS)
    return (y * g.astype(jnp.float32)).astype(x.dtype)


def _rope(a):
    seq, dh = a.shape[1], a.shape[-1]
    half = dh // 2
    inv_freq = ROPE_BASE ** (-jnp.arange(half, dtype=jnp.float32) / half)
    ang = jnp.arange(seq, dtype=jnp.float32)[:, None] * inv_freq[None, :]
    cos = jnp.cos(ang)[None, :, None, :]
    sin = jnp.sin(ang)[None, :, None, :]
    a1, a2 = a[..., :half], a[..., half:]
    return jnp.concatenate([a1 * cos - a2 * sin, a1 * sin + a2 * cos], axis=-1)


def _retention_one_direction(q, k, v, log_gamma, strict):
    b, h, s, dk = q.shape
    dv = v.shape[-1]
    c = RET_CHUNK
    n = s // c
    qc = q.reshape(b, h, n, c, dk)
    kc = k.reshape(b, h, n, c, dk)
    vc = v.reshape(b, h, n, c, dv)
    pos = jnp.arange(c, dtype=jnp.float32)
    diff = pos[:, None] - pos[None, :]
    mask = (diff > 0) if strict else (diff >= 0)
    decay = jnp.where(mask[None], jnp.exp(jnp.where(mask, diff, 0.0)[None] * log_gamma[:, None, None]), 0.0)
    scores = jnp.einsum('bhnid,bhnjd->bhnij', qc, kc) * decay[None, :, None]
    y_inner = jnp.einsum('bhnij,bhnje->bhnie', scores, vc)
    k_decay = jnp.exp((c - 1 - pos)[None, :] * log_gamma[:, None])
    q_decay = jnp.exp((pos + 1)[None, :] * log_gamma[:, None])
    chunk_decay = jnp.exp(c * log_gamma)[None, :, None, None]
    kv = jnp.einsum('bhnjd,hj,bhnje->bhnde', kc, k_decay, vc)

    def step(state, kv_chunk):
        return state * chunk_decay + kv_chunk, state

    _, prev = lax.scan(step, jnp.zeros((b, h, dk, dv), jnp.float32), jnp.moveaxis(kv, 2, 0))
    prev = jnp.moveaxis(prev, 0, 2)
    y_cross = jnp.einsum('bhnid,hi,bhnde->bhnie', qc, q_decay, prev)
    return (y_inner + y_cross).reshape(b, h, s, dv)


def _retention_branch(rq, rk, rv, rg, dec_f, dec_b, gn_gain, w_o):
    b, s, _ = rq.shape
    q = _rope(rq.reshape(b, s, RET_HEADS, RET_QK_DIM).astype(jnp.float32)) * (RET_QK_DIM ** -0.5)
    k = _rope(rk.reshape(b, s, RET_HEADS, RET_QK_DIM).astype(jnp.float32))
    v = rv.reshape(b, s, RET_HEADS, RET_V_DIM).astype(jnp.float32)
    q, k, v = q.transpose(0, 2, 1, 3), k.transpose(0, 2, 1, 3), v.transpose(0, 2, 1, 3)
    lg_f = jax.nn.log_sigmoid(dec_f.astype(jnp.float32))
    lg_b = jax.nn.log_sigmoid(dec_b.astype(jnp.float32))
    y_fwd = _retention_one_direction(q, k, v, lg_f, False)
    y_bwd = jnp.flip(_retention_one_direction(jnp.flip(q, 2), jnp.flip(k, 2), jnp.flip(v, 2), lg_b, True), 2)
    y = y_fwd + y_bwd
    mu = jnp.mean(y, axis=-1, keepdims=True)
    var = jnp.mean(jnp.square(y - mu), axis=-1, keepdims=True)
    y = (y - mu) * lax.rsqrt(var + GN_EPS)
    y = y.transpose(0, 2, 1, 3).reshape(b, s, RET_V_WIDTH) * gn_gain.astype(jnp.float32)
    return (jax.nn.silu(rg) * y.astype(rg.dtype)) @ w_o


def _neighbourhood_attention(nq, nk, nv, rpb):
    b, s, _ = nq.shape
    rows_n = s // GRID_W
    w = GRID_W
    kr = min(NA_ROWS, rows_n)
    kc = NA_COLS

    def to_grid(a):
        return a.reshape(b, rows_n, w, NA_HEADS, NA_HEAD_DIM).transpose(0, 3, 1, 2, 4)

    qg, kg, vg = to_grid(nq), to_grid(nk), to_grid(nv)
    rows = jnp.arange(rows_n)
    row_start = jnp.clip(rows - kr // 2, 0, rows_n - kr)
    row_idx = row_start[:, None] + jnp.arange(kr)[None, :]
    cols = jnp.arange(w)
    col_start = jnp.clip(cols - kc // 2, 0, w - kc)
    col_off = cols[None, :] - col_start[:, None]
    col_mask = (col_off >= 0) & (col_off < kc)
    k_rows = jnp.take(kg, row_idx, axis=2)
    v_rows = jnp.take(vg, row_idx, axis=2)
    sc = jnp.einsum('bhrqd,bhrwkd->bhrqwk', qg, k_rows).astype(jnp.float32) * (NA_HEAD_DIM ** -0.5)
    rel_r = row_idx - rows[:, None] + (NA_ROWS - 1)
    rel_c = jnp.clip(cols[None, :] - cols[:, None], -(kc - 1), kc - 1) + (kc - 1)
    bias = rpb[:, rel_r[:, None, :, None], rel_c[None, :, None, :]].astype(jnp.float32)
    sc = jnp.where(col_mask[:, None, :], sc + bias, -jnp.inf)
    p = jax.nn.softmax(sc, axis=(-2, -1)).astype(vg.dtype)
    o = jnp.einsum('bhrqwk,bhrwkd->bhrqd', p, v_rows)
    return o.transpose(0, 2, 3, 1, 4).reshape(b, s, NA_WIDTH)


def _memory_cross_attention(xq, mem_n, w_kv):
    b, s, _ = xq.shape
    m = mem_n.shape[1]
    mk, mv = jnp.split(mem_n @ w_kv, 2, axis=-1)
    q = xq.reshape(b, s, XA_HEADS, XA_HEAD_DIM)
    k = mk.reshape(b, m, XA_HEADS, XA_HEAD_DIM)
    v = mv.reshape(b, m, XA_HEADS, XA_HEAD_DIM)
    sc = jnp.einsum('bshd,bmhd->bhsm', q, k).astype(jnp.float32) * (XA_HEAD_DIM ** -0.5)
    p = jax.nn.softmax(sc, axis=-1).astype(v.dtype)
    return jnp.einsum('bhsm,bmhd->bshd', p, v).reshape(b, s, XA_WIDTH)


def _hierarchical_moe(h, w_rg, b_rg, w_re, b_re, w_gate, w_up, w_down):
    b, s, d = h.shape
    t = h.reshape(b * s, d)
    g_n, e_n = MOE_GROUPS, MOE_EXPERTS_PER_GROUP
    grp_p = jax.nn.softmax((t @ w_rg + b_rg).astype(jnp.float32), axis=-1)
    grp_w, grp_idx = lax.top_k(grp_p, 1)
    exp_logits = (t @ w_re + b_re).astype(jnp.float32).reshape(-1, g_n, e_n)
    in_grp = jnp.take_along_axis(exp_logits, grp_idx[:, :, None], axis=1)[:, 0]
    top_w, top_idx = lax.top_k(jax.nn.softmax(in_grp, axis=-1), MOE_TOP_K)
    top_w = top_w / jnp.sum(top_w, axis=-1, keepdims=True) * grp_w
    exp_w = jnp.sum(jax.nn.one_hot(top_idx, e_n, dtype=jnp.float32) * top_w[..., None], axis=1)
    combine = (jax.nn.one_hot(grp_idx[:, 0], g_n, dtype=jnp.float32)[:, :, None] * exp_w[:, None, :]).astype(t.dtype)
    out = jnp.zeros_like(t)
    for g in range(g_n):
        a = jnp.einsum('td,edf->tef', t, w_gate[g])
        u = jnp.einsum('td,edf->tef', t, w_up[g])
        hid = jax.nn.silu(a) * u * combine[:, g, :, None]
        out = out + jnp.einsum('tef,efd->td', hid, w_down[g])
    return out.reshape(b, s, d)


def setup_inputs(seed: int = 0) -> dict:
    key = jax.random.key(seed)
    ks = jax.random.split(key, 24)
    f32 = jnp.float32
    d = D_MODEL
    n_l = DEPTH
    g_n, e_n, f_n = MOE_GROUPS, MOE_EXPERTS_PER_GROUP, MOE_D_FF

    def nrm(k, shape, fan_in):
        return jax.random.normal(k, shape, f32) * (fan_in ** -0.5)

    def gain(k, shape):
        return 1.0 + 0.02 * jax.random.normal(k, shape, f32)

    base_gamma = 1.0 - 2.0 ** (-5.0 - jnp.arange(RET_HEADS, dtype=f32))
    base_logit = jnp.log(base_gamma) - jnp.log1p(-base_gamma)
    return {
        'x': jax.random.normal(ks[0], (BATCH, SEQ, d), f32),
        'mem': jax.random.normal(ks[1], (BATCH, MEM_LEN, d), f32),
        'g_mix': gain(ks[2], (n_l, d)),
        'w_in': nrm(ks[3], (n_l, d, IN_WIDTH), d),
        'ret_decay_fwd': base_logit[None] + 0.05 * jax.random.normal(ks[4], (n_l, RET_HEADS), f32),
        'ret_decay_bwd': base_logit[None] + 0.05 * jax.random.normal(ks[5], (n_l, RET_HEADS), f32),
        'ret_norm_gain': gain(ks[6], (n_l, RET_V_WIDTH)),
        'w_ret_o': nrm(ks[7], (n_l, RET_V_WIDTH, d), RET_V_WIDTH),
        'na_rpb': 0.1 * jax.random.normal(ks[8], (n_l, NA_HEADS, 2 * NA_ROWS - 1, 2 * NA_COLS - 1), f32),
        'w_na_o': nrm(ks[9], (n_l, NA_WIDTH, d), NA_WIDTH),
        'g_mem': gain(ks[10], (n_l, d)),
        'w_mem_kv': nrm(ks[11], (n_l, d, 2 * XA_WIDTH), d),
        'w_xa_o': nrm(ks[12], (n_l, XA_WIDTH, d), XA_WIDTH),
        'w_out': nrm(ks[13], (n_l, d, d), d),
        'g_ffn': gain(ks[14], (n_l, d)),
        'w_router_group': nrm(ks[15], (n_l, d, g_n), d),
        'b_router_group': 0.01 * jax.random.normal(ks[16], (n_l, g_n), f32),
        'w_router_expert': nrm(ks[17], (n_l, d, g_n * e_n), d),
        'b_router_expert': 0.01 * jax.random.normal(ks[18], (n_l, g_n * e_n), f32),
        'w_exp_gate': nrm(ks[19], (n_l, g_n, e_n, d, f_n), d),
        'w_exp_up': nrm(ks[20], (n_l, g_n, e_n, d, f_n), d),
        'w_exp_down': nrm(ks[21], (n_l, g_n, e_n, f_n, d), f_n),
        'g_final': gain(ks[22], (d,)),
    }


def reference(x, mem, g_mix, w_in, ret_decay_fwd, ret_decay_bwd, ret_norm_gain, w_ret_o, na_rpb, w_na_o, g_mem, w_mem_kv, w_xa_o, w_out, g_ffn, w_router_group, b_router_group, w_router_expert, b_router_expert, w_exp_gate, w_exp_up, w_exp_down, g_final):
    split_points = [int(p) for p in np.cumsum(np.array(IN_SPLITS))[:-1]]
    for l in range(DEPTH):
        h = _rmsnorm(x, g_mix[l])
        rq, rk, rv, rg, nq, nk, nv, xq, gate_logits = jnp.split(h @ w_in[l], split_points, axis=-1)
        y_ret = _retention_branch(rq, rk, rv, rg, ret_decay_fwd[l], ret_decay_bwd[l], ret_norm_gain[l], w_ret_o[l])
        y_na = _neighbourhood_attention(nq, nk, nv, na_rpb[l]) @ w_na_o[l]
        y_xa = _memory_cross_attention(xq, _rmsnorm(mem, g_mem[l]), w_mem_kv[l]) @ w_xa_o[l]
        g_ret, g_na, g_xa = jnp.split(jax.nn.sigmoid(gate_logits), N_BRANCHES, axis=-1)
        x = x + (g_ret * y_ret + g_na * y_na + g_xa * y_xa) @ w_out[l]
        x = x + _hierarchical_moe(_rmsnorm(x, g_ffn[l]), w_router_group[l], b_router_group[l], w_router_expert[l], b_router_expert[l], w_exp_gate[l], w_exp_up[l], w_exp_down[l])
    return _rmsnorm(x, g_final)
```

```cpp
#include <hip/hip_runtime.h>
#include <cstdio>
#include <cstdint>

#ifndef MK_PER_PHASE
#define MK_PER_PHASE 1
#endif

#define GAS __attribute__((address_space(1)))
#define LAS __attribute__((address_space(3)))
typedef unsigned short bf16;
typedef float f32x4 __attribute__((ext_vector_type(4)));
typedef unsigned u32x4 __attribute__((ext_vector_type(4)));
typedef unsigned u32x2 __attribute__((ext_vector_type(2)));
typedef short bf16x8 __attribute__((ext_vector_type(8)));

constexpr int NB = 8, SEQ = 2048, DM = 1024, T = NB * SEQ;
constexpr int MEML = 256, TM = NB * MEML;
constexpr int NWAVES = 8, NTHREADS = 512;
constexpr int NPA = 5120, NPG = 3072;
constexpr int NEXP = 16, DFF = 512;
constexpr float RMS_EPS = 1e-6f, GN_EPS = 1e-5f;
constexpr float QK_SCALE = 0.08838834764831845f;

constexpr size_t MiB = 1u << 20;
constexpr size_t WS_CTL = 0, CTL_ZERO_BYTES = 1 * MiB;
constexpr size_t WS_COS = 1 * MiB, WS_SIN = 1 * MiB + 512 * 1024;
constexpr size_t WS_ELIST = 2 * MiB;
constexpr size_t WS_EWL = 3 * MiB;
constexpr size_t WS_TMETA = 4 * MiB;
constexpr size_t WS_WA = 5 * MiB;
constexpr size_t WS_WG = 15 * MiB;
constexpr size_t WS_WKV = 21 * MiB;
constexpr size_t WS_WRO = 23 * MiB;
constexpr size_t WS_WNO = 25 * MiB;
constexpr size_t WS_WXO = 26 * MiB;
constexpr size_t WS_WOUT = 27 * MiB;
constexpr size_t WS_XN = 29 * MiB;
constexpr size_t WS_H2 = WS_XN;
constexpr size_t WS_RQ = 61 * MiB;
constexpr size_t WS_RK = 77 * MiB;
constexpr size_t WS_RV = 93 * MiB;
constexpr size_t WS_NK = 125 * MiB;
constexpr size_t WS_NV = 141 * MiB;
constexpr size_t WS_GATES = 61 * MiB;
constexpr size_t WS_HID = 61 * MiB;
constexpr size_t WS_DROWS = 97 * MiB;
constexpr size_t WS_RG = 157 * MiB;
constexpr size_t WS_NQ = 189 * MiB;
constexpr size_t WS_XQ = 205 * MiB;
constexpr size_t WS_WD = 205 * MiB;
constexpr size_t WS_MN = 221 * MiB;
constexpr size_t WS_MKV = 225 * MiB;
constexpr size_t WS_MIX = 221 * MiB;
constexpr size_t WS_WGU = 221 * MiB;
constexpr size_t WS_END = 256 * MiB;

constexpr int CW_ECNT = 64;
constexpr int CW_BAR = 4096;

constexpr int LDS_BYTES = 147456;
constexpr int MISC_OFF = 131072 + 320;

__device__ __forceinline__ float bf2f(unsigned v) { return __uint_as_float(v << 16); }
__device__ __forceinline__ unsigned f2bf(float f) { unsigned u = __float_as_uint(f); return (u + 0x7fffu + ((u >> 16) & 1u)) >> 16; }
__device__ __forceinline__ unsigned pk2(float lo, float hi) { return f2bf(lo) | (f2bf(hi) << 16); }
__device__ __forceinline__ void unpack8(const u32x4 v, float* o) {
    o[0] = __uint_as_float(v.x << 16); o[1] = __uint_as_float(v.x & 0xffff0000u);
    o[2] = __uint_as_float(v.y << 16); o[3] = __uint_as_float(v.y & 0xffff0000u);
    o[4] = __uint_as_float(v.z << 16); o[5] = __uint_as_float(v.z & 0xffff0000u);
    o[6] = __uint_as_float(v.w << 16); o[7] = __uint_as_float(v.w & 0xffff0000u);
}
__device__ __forceinline__ void store8(bf16* p, f32x4 a, f32x4 b) {
    u32x4 w; w.x = pk2(a[0], a[1]); w.y = pk2(a[2], a[3]); w.z = pk2(b[0], b[1]); w.w = pk2(b[2], b[3]);
    *(u32x4*)p = w;
}
__device__ __forceinline__ float wave_sum(float v) {
#pragma unroll
    for (int o = 1; o < 64; o <<= 1) v += __shfl_xor(v, o);
    return v;
}
__device__ __forceinline__ float wave_max(float v) {
#pragma unroll
    for (int o = 1; o < 64; o <<= 1) v = fmaxf(v, __shfl_xor(v, o));
    return v;
}
__device__ __forceinline__ float sigmoidf_(float x) { return 1.0f / (1.0f + __expf(-x)); }
__device__ __forceinline__ float siluf_(float x) { return x / (1.0f + __expf(-x)); }

#define XB_TMO      128
#define XB_XCNT(j)  (256  + 64 * (j))
#define XB_XSUB(j)  (1280 + 64 * (j))
#define XB_XGEN(j)  (2304 + 64 * (j))
#define XB_TOP      3328
#define XB_TOPGEN   3392
#define XCD_BAR_WORDS 3456
#define XB_SPIN_CAP (1u << 18)
__device__ __forceinline__ unsigned xb_ld(unsigned* p)              { return __hip_atomic_load(p, __ATOMIC_RELAXED, __HIP_MEMORY_SCOPE_AGENT); }
__device__ __forceinline__ unsigned xb_add(unsigned* p, unsigned v) { return __hip_atomic_fetch_add(p, v, __ATOMIC_RELAXED, __HIP_MEMORY_SCOPE_AGENT); }
__device__ __forceinline__ unsigned xb_xcc_id() { return (unsigned)__builtin_amdgcn_s_getreg((3 << 11) | 20) & 0xFu; }
#define XB_SPIN(cond, bar) do { unsigned _sp = 0; while (cond) { __builtin_amdgcn_s_sleep(1); \
    if ((++_sp & 255u) == 0u) { if (xb_ld(&(bar)[XB_TMO])) break; if (_sp > XB_SPIN_CAP) { atomicAdd(&(bar)[XB_TMO], 1u); break; } } } } while (0)
struct XcdBarrier { unsigned* bar; unsigned x; volatile LAS unsigned* st; };
__device__ __forceinline__ XcdBarrier xcd_barrier_post(unsigned* bar, volatile LAS unsigned* st) {
    XcdBarrier b; b.bar = bar; b.x = xb_xcc_id(); b.st = st;
    if (threadIdx.x == 0) (void)xb_add(&bar[XB_XCNT(b.x)], 1u);
    return b;
}
__device__ __forceinline__ void xcd_barrier_complete(unsigned* bar, unsigned x, unsigned& nloc, unsigned& nx) {
    const unsigned G = gridDim.x * gridDim.y * gridDim.z;
    unsigned sum, cnt, mine, sp = 0u;
    for (;;) {
        sum = 0u; cnt = 0u; mine = 0u;
#pragma unroll
        for (unsigned j = 0; j < 16; ++j) { const unsigned c = xb_ld(&bar[XB_XCNT(j)]); sum += c; cnt += (c > 0u) ? 1u : 0u; mine = (j == x) ? c : mine; }
        if (sum == G) break;
        __builtin_amdgcn_s_sleep(1);
        if ((++sp & 255u) == 0u) { if (xb_ld(&bar[XB_TMO])) break; if (sp > XB_SPIN_CAP) { atomicAdd(&bar[XB_TMO], 1u); break; } }
    }
    nloc = mine > 0u ? mine : 1u; nx = cnt > 0u ? cnt : 1u;
}
__device__ __forceinline__ void xcd_barrier(const XcdBarrier& b) {
    asm volatile("s_waitcnt vmcnt(0)" ::: "memory");
    __syncthreads();
    if (threadIdx.x == 0) {
        unsigned* bar = b.bar;
        __builtin_amdgcn_s_waitcnt(0);
        unsigned nloc = b.st[0], nx = b.st[1];
        if (nloc == 0u) { xcd_barrier_complete(bar, b.x, nloc, nx); b.st[0] = nloc; b.st[1] = nx; }
        const unsigned old = xb_add(&bar[XB_XSUB(b.x)], 1u);
        const unsigned gen = old / nloc;
        if (old + 1u == (gen + 1u) * nloc) {
            __builtin_amdgcn_fence(__ATOMIC_RELEASE, "agent");
            asm volatile("s_waitcnt vmcnt(0)" ::: "memory");
            const unsigned og = xb_add(&bar[XB_TOP], 1u);
            const unsigned tg = og / nx;
            if (og + 1u == (tg + 1u) * nx) xb_add(&bar[XB_TOPGEN], 1u);
            else XB_SPIN(xb_ld(&bar[XB_TOPGEN]) == tg, bar);
            __builtin_amdgcn_fence(__ATOMIC_ACQUIRE, "agent");
            xb_add(&bar[XB_XGEN(b.x)], 1u);
            asm volatile("s_waitcnt vmcnt(0)" ::: "memory");
        } else {
            XB_SPIN(xb_ld(&bar[XB_XGEN(b.x)]) == gen, bar);
            __builtin_amdgcn_fence(__ATOMIC_ACQUIRE, "agent");
            asm volatile("s_waitcnt vmcnt(0)" ::: "memory");
        }
    }
    __syncthreads();
}

struct Args { const float* in[23]; float* out; unsigned char* ws; int ph_lo, ph_hi; };
struct Ctx {
    int tid, lane, wave, gw, ngw;
    unsigned char* lds;
};

template <class ColPtr>
__device__ __forceinline__ void transpose_all(const Ctx& c, ColPtr cp, int ldw, int P, int K, bf16* WT) {
    float* scr = (float*)(c.lds + c.wave * 16384);
    const int nkb = K / 64, npb = P / 32, lane = c.lane;
    for (int it = c.gw; it < nkb * npb; it += c.ngw) {
        const int kb = it % nkb, pb = it / nkb, k0 = 64 * kb, p0 = 32 * pb;
        const float* colp = cp(p0 + (lane & 31));
#pragma unroll 8
        for (int i = 0; i < 32; ++i) { const int kk = 2 * i + (lane >> 5); scr[kk * 33 + (lane & 31)] = colp[(size_t)(k0 + kk) * ldw]; }
        __builtin_amdgcn_s_waitcnt(0xC07F); asm volatile("" ::: "memory");
        const int cc = lane & 7;
#pragma unroll
        for (int j = 0; j < 4; ++j) { const int n = (lane >> 3) + 8 * j; const float* s = scr + (8 * cc) * 33 + n;
            u32x4 o; o.x = pk2(s[0 * 33], s[1 * 33]); o.y = pk2(s[2 * 33], s[3 * 33]); o.z = pk2(s[4 * 33], s[5 * 33]); o.w = pk2(s[6 * 33], s[7 * 33]);
            *(u32x4*)(WT + (size_t)(p0 + n) * K + k0 + 8 * cc) = o; }
        __builtin_amdgcn_s_waitcnt(0xC07F); asm volatile("" ::: "memory");
    }
}
struct ColPlain { const float* W; __device__ const float* operator()(int p) const { return W + p; } };
struct ColOff { const float* W; int off; __device__ const float* operator()(int p) const { return W + off + p; } };
struct ColWA {
    const float* W;
    __device__ const float* operator()(int p) const {
        if (p < 1024) { const int pp = p & 127; const int d = ((pp & 4) ? 64 : 0) + 4 * (pp >> 3) + (pp & 3); return W + (p & ~127) + d; }
        return W + p;
    }
};
struct ColGU {
    const float* Wg; const float* Wu;
    __device__ const float* operator()(int p) const { const int f = 4 * (p >> 3) + (p & 3); return ((p >> 2) & 1) ? Wu + f : Wg + f; }
};
__device__ __forceinline__ void rms_row_to_bf16(const float* xrow, const float* g, bf16* orow, int lane) {
    const f32x4* xr = (const f32x4*)xrow + lane; const f32x4* gr = (const f32x4*)g + lane;
    f32x4 v[4]; float s = 0.f;
#pragma unroll
    for (int j = 0; j < 4; ++j) { v[j] = xr[64 * j]; s += (v[j].x * v[j].x + v[j].y * v[j].y) + (v[j].z * v[j].z + v[j].w * v[j].w); }
    const float r = 1.0f / sqrtf(wave_sum(s) * (1.f / 1024.f) + RMS_EPS);
    unsigned long long* o8 = (unsigned long long*)orow + lane;
#pragma unroll
    for (int j = 0; j < 4; ++j) { const f32x4 gg = gr[64 * j];
        o8[64 * j] = (unsigned long long)pk2(v[j].x * r * gg.x, v[j].y * r * gg.y) | ((unsigned long long)pk2(v[j].z * r * gg.z, v[j].w * r * gg.w) << 32); }
}

template <class RowPtr, class Epi>
__device__ __forceinline__ void naive_gemm(const Ctx& c, const RowPtr& rp, const bf16* Bt, int ldb, int M, int N, int K, const Epi& epi) {
    const int tilesN = N / 64, tilesM = (M + 7) / 8, lane = c.lane;
    for (int it = c.gw; it < tilesM * tilesN; it += c.ngw) {
        const int tm = it / tilesN, tn = it % tilesN;
        const int row = tm * 8 + (lane >> 3), col0 = tn * 64 + (lane & 7) * 8;
        const bool valid = row < M;
        const bf16* ap = rp(valid ? row : 0);
        float acc[8];
#pragma unroll
        for (int j = 0; j < 8; ++j) acc[j] = 0.f;
        for (int k = 0; k < K; k += 8) {
            float a[8]; unpack8(*(const u32x4*)(ap + k), a);
#pragma unroll
            for (int j = 0; j < 8; ++j) { float b[8]; unpack8(*(const u32x4*)(Bt + (size_t)(col0 + j) * ldb + k), b);
#pragma unroll
                for (int i = 0; i < 8; ++i) acc[j] += a[i] * b[i]; }
        }
        if (valid) epi(row, col0, (f32x4){acc[0], acc[1], acc[2], acc[3]}, (f32x4){acc[4], acc[5], acc[6], acc[7]});
    }
}
struct RowPlain { const bf16* A; int lda; __device__ const bf16* operator()(int r) const { return A + (size_t)r * lda; } };
struct RowGather { const bf16* A; int lda; const int* idx; __device__ const bf16* operator()(int r) const { return A + (size_t)idx[r] * lda; } };

struct EpiProjA {
    bf16 *RQ, *RK, *RV, *RG, *NQ, *NK, *NV, *XQ; const float *COS, *SIN;
    __device__ __forceinline__ void operator()(int row, int col0, f32x4 v0, f32x4 v1) const {
        if (col0 < 1024) {
            const int which = col0 >> 9, cc = col0 & 511, pos = row & (SEQ - 1), q = (cc & 127) >> 3;
            const f32x4 cs = *(const f32x4*)(COS + pos * 64 + 4 * q), sn = *(const f32x4*)(SIN + pos * 64 + 4 * q);
            f32x4 o1 = v0 * cs - v1 * sn, o2 = v0 * sn + v1 * cs;
            if (which == 0) { o1 = o1 * QK_SCALE; o2 = o2 * QK_SCALE; }
            store8((which ? RK : RQ) + (size_t)row * 512 + cc, o1, o2);
        } else if (col0 < 2048) { store8(RV + (size_t)row * 1024 + (col0 - 1024), v0, v1);
        } else if (col0 < 3072) {
            f32x4 a, b;
#pragma unroll
            for (int i = 0; i < 4; ++i) { a[i] = siluf_(v0[i]); b[i] = siluf_(v1[i]); }
            store8(RG + (size_t)row * 1024 + (col0 - 2048), a, b);
        } else if (col0 < 3584) { store8(NQ + (size_t)row * 512 + (col0 - 3072), v0 * 0.125f, v1 * 0.125f);
        } else if (col0 < 4096) { store8(NK + (size_t)row * 512 + (col0 - 3584), v0, v1);
        } else if (col0 < 4608) { store8(NV + (size_t)row * 512 + (col0 - 4096), v0, v1);
        } else { store8(XQ + (size_t)row * 512 + (col0 - 4608), v0 * QK_SCALE, v1 * QK_SCALE); }
    }
};
struct EpiBf16Plain { bf16* O; int ldc; __device__ __forceinline__ void operator()(int row, int col0, f32x4 v0, f32x4 v1) const { store8(O + (size_t)row * ldc + col0, v0, v1); } };
struct EpiSigmoid { bf16* O; int ldc;
    __device__ __forceinline__ void operator()(int row, int col0, f32x4 v0, f32x4 v1) const {
        f32x4 a, b;
#pragma unroll
        for (int i = 0; i < 4; ++i) { a[i] = sigmoidf_(v0[i]); b[i] = sigmoidf_(v1[i]); }
        store8(O + (size_t)row * ldc + col0, a, b); } };
template <int MODE> struct EpiMixNaive { float* TMP; bf16* MIX; const bf16* G;
    __device__ __forceinline__ void operator()(int row, int col0, f32x4 v0, f32x4 v1) const {
        float g[8]; unpack8(*(const u32x4*)(G + (size_t)row * NPG + col0), g);
        f32x4 a = {v0[0] * g[0], v0[1] * g[1], v0[2] * g[2], v0[3] * g[3]}, b = {v1[0] * g[4], v1[1] * g[5], v1[2] * g[6], v1[3] * g[7]};
        float* t = TMP + (size_t)row * DM + col0;
        if (MODE >= 1) { a = a + *(const f32x4*)t; b = b + *(const f32x4*)(t + 4); }
        if (MODE <= 1) { *(f32x4*)t = a; *(f32x4*)(t + 4) = b; } else store8(MIX + (size_t)row * DM + col0, a, b);
    } };
struct EpiResidF32 { const float* X; float* O;
    __device__ __forceinline__ void operator()(int row, int col0, f32x4 v0, f32x4 v1) const {
        const float* x = X + (size_t)row * DM + col0; float* o = O + (size_t)row * DM + col0;
        *(f32x4*)o = *(const f32x4*)x + v0; *(f32x4*)(o + 4) = *(const f32x4*)(x + 4) + v1; } };
struct EpiSwiGLU { bf16* HID; const float* wl; int rowbase;
    __device__ __forceinline__ void operator()(int row, int col0, f32x4 v0, f32x4 v1) const {
        const float w = wl[row]; f32x4 h;
#pragma unroll
        for (int i = 0; i < 4; ++i) h[i] = siluf_(v0[i]) * v1[i] * w;
        u32x2 o; o.x = pk2(h[0], h[1]); o.y = pk2(h[2], h[3]);
        *(u32x2*)(HID + (size_t)(rowbase + row) * DFF + (col0 >> 1)) = o; } };
struct EpiRowsBf16 { bf16* O; int ldc; int rowbase;
    __device__ __forceinline__ void operator()(int row, int col0, f32x4 v0, f32x4 v1) const { store8(O + (size_t)(rowbase + row) * ldc + col0, v0, v1); } };

struct Ptrs {
    const float* in[23]; float* out; unsigned char* ws;
    __device__ bf16* b(size_t off) const { return (bf16*)(ws + off); }
    __device__ float* f(size_t off) const { return (float*)(ws + off); }
};

__device__ __forceinline__ void phase0(const Ctx& c, const Ptrs& P) {
    transpose_all(c, ColWA{P.in[3]}, 8192, NPA, 1024, P.b(WS_WA));
    transpose_all(c, ColOff{P.in[3], NPA}, 8192, NPG, 1024, P.b(WS_WG));
    transpose_all(c, ColPlain{P.in[11]}, 1024, 1024, 1024, P.b(WS_WKV));
    transpose_all(c, ColPlain{P.in[7]}, 1024, 1024, 1024, P.b(WS_WRO));
    transpose_all(c, ColPlain{P.in[9]}, 1024, 1024, 512, P.b(WS_WNO));
    transpose_all(c, ColPlain{P.in[12]}, 1024, 1024, 512, P.b(WS_WXO));
    transpose_all(c, ColPlain{P.in[13]}, 1024, 1024, 1024, P.b(WS_WOUT));
    { float* COS = P.f(WS_COS); float* SIN = P.f(WS_SIN);
      for (int i = c.gw * 64 + c.lane; i < SEQ * 64; i += c.ngw * 64) { const int pos = i >> 6, fi = i & 63;
          const float inv = (float)pow(10000.0, -(double)fi / 64.0); const float ang = (float)pos * inv;
          COS[i] = (float)cos((double)ang); SIN[i] = (float)sin((double)ang); } }
    for (int m = c.gw; m < T; m += c.ngw) rms_row_to_bf16(P.in[0] + (size_t)m * DM, P.in[2], P.b(WS_XN) + (size_t)m * DM, c.lane);
    for (int m = c.gw; m < TM; m += c.ngw) rms_row_to_bf16(P.in[1] + (size_t)m * DM, P.in[10], P.b(WS_MN) + (size_t)m * DM, c.lane);
}

__device__ __forceinline__ void phase1_naive(const Ctx& c, const Ptrs& P) {
    EpiProjA E{P.b(WS_RQ), P.b(WS_RK), P.b(WS_RV), P.b(WS_RG), P.b(WS_NQ), P.b(WS_NK), P.b(WS_NV), P.b(WS_XQ), P.f(WS_COS), P.f(WS_SIN)};
    naive_gemm(c, RowPlain{P.b(WS_XN), DM}, P.b(WS_WA), DM, T, NPA, DM, E);
}

__device__ __forceinline__ float log_sigmoid_(float x) { return -log1pf(expf(-x)); }

__device__ __forceinline__ void phase2_states_naive(const Ctx& c, const Ptrs& P) {
    const bf16* RK = P.b(WS_RK); const bf16* RV = P.b(WS_RV); bf16* ST = (bf16*)P.out;
    const int nitems = NB * 4 * 2 * 128 * 4;
    for (int it = c.gw; it < nitems; it += c.ngw) {
        const int eb = it & 3, d = (it >> 2) & 127, dir = (it >> 9) & 1, h = (it >> 10) & 3, b = it >> 12;
        const int e = eb * 64 + c.lane;
        const float lg = log_sigmoid_(dir ? P.in[5][h] : P.in[4][h]); const float gam = expf(lg);
        float S = 0.f;
        bf16* stb = ST + (size_t)(((b * 4 + h) * 2 + dir) * 16) * 256 * 128 + (size_t)e * 128 + d;
        for (int jj = 0; jj < SEQ; ++jj) {
            const int j = dir ? (SEQ - 1 - jj) : jj;
            if ((jj & 127) == 0) { const int n = j >> 7; stb[(size_t)n * 256 * 128] = (bf16)f2bf(S); }
            const size_t tok = (size_t)b * SEQ + j;
            const float kv = bf2f(RK[tok * 512 + h * 128 + d]) * bf2f(RV[tok * 1024 + h * 256 + e]);
            S = S * gam + kv;
        }
    }
}
__device__ __forceinline__ void phase2_na_naive(const Ctx& c, const Ptrs& P) {
    bf16* NQ = P.b(WS_NQ); const bf16* NK = P.b(WS_NK); const bf16* NV = P.b(WS_NV); const float* rpb = P.in[8];
    float* scr = (float*)(c.lds + c.wave * 16384);
    const int lane = c.lane;
    for (int it = c.gw; it < T * 8; it += c.ngw) {
        const int h = it & 7, tok = it >> 3, b = tok >> 11, s = tok & 2047, r = s >> 6, cc = s & 63;
        int rs = r - 4; rs = rs < 0 ? 0 : (rs > 24 ? 24 : rs);
        int cs = cc - 8; cs = cs < 0 ? 0 : (cs > 48 ? 48 : cs);
        scr[128 + lane] = bf2f(NQ[(size_t)tok * 512 + h * 64 + lane]);
        __builtin_amdgcn_s_waitcnt(0xC07F); asm volatile("" ::: "memory");
        float sc[2];
#pragma unroll
        for (int t = 0; t < 2; ++t) { const int key = lane + 64 * t, kr = rs + (key >> 4), kc = cs + (key & 15);
            const size_t kt = (size_t)b * SEQ + kr * 64 + kc; const u32x4* kp = (const u32x4*)(NK + kt * 512 + h * 64);
            float a = 0.f;
#pragma unroll 2
            for (int i = 0; i < 8; ++i) { float kk[8]; unpack8(kp[i], kk);
#pragma unroll
                for (int u = 0; u < 8; ++u) a += scr[128 + 8 * i + u] * kk[u]; }
            int rc = kc - cc; rc = rc < -15 ? -15 : (rc > 15 ? 15 : rc);
            sc[t] = a + rpb[(h * 15 + (kr - r + 7)) * 31 + rc + 15]; }
        const float mx = wave_max(fmaxf(sc[0], sc[1]));
        const float e0 = __expf(sc[0] - mx), e1 = __expf(sc[1] - mx);
        const float inv = 1.0f / wave_sum(e0 + e1);
        scr[lane] = e0 * inv; scr[lane + 64] = e1 * inv;
        __builtin_amdgcn_s_waitcnt(0xC07F); asm volatile("" ::: "memory");
        float o = 0.f;
        for (int key = 0; key < 128; ++key) { const int kr = rs + (key >> 4), kc = cs + (key & 15);
            const size_t kt = (size_t)b * SEQ + kr * 64 + kc; o += scr[key] * bf2f(NV[kt * 512 + h * 64 + lane]); }
        NQ[(size_t)tok * 512 + h * 64 + lane] = (bf16)f2bf(o);
        __builtin_amdgcn_s_waitcnt(0xC07F); asm volatile("" ::: "memory");
    }
}
__device__ __forceinline__ void phase2_memkv_naive(const Ctx& c, const Ptrs& P) {
    naive_gemm(c, RowPlain{P.b(WS_MN), DM}, P.b(WS_WKV), DM, TM, 1024, DM, EpiBf16Plain{P.b(WS_MKV), 1024});
}
__device__ __forceinline__ void phase3_ret_naive(const Ctx& c, const Ptrs& P) {
    const bf16* RQ = P.b(WS_RQ); const bf16* RK = P.b(WS_RK); const bf16* RV = P.b(WS_RV); bf16* RG = P.b(WS_RG); const bf16* ST = (const bf16*)P.out;
    const float* gain = P.in[6];
    float* scr = (float*)(c.lds + c.wave * 16384);
    const int lane = c.lane;
    for (int it = c.gw; it < T * 4; it += c.ngw) {
        const int h = it & 3, tok = it >> 2, b = tok >> 11, s = tok & 2047, n = s >> 7, p = s & 127;
        const float lgf = log_sigmoid_(P.in[4][h]), lgb = log_sigmoid_(P.in[5][h]);
        { const bf16* qp = RQ + (size_t)tok * 512 + h * 128; scr[lane] = bf2f(qp[lane]); scr[lane + 64] = bf2f(qp[lane + 64]); }
        __builtin_amdgcn_s_waitcnt(0xC07F); asm volatile("" ::: "memory");
        float sv[2];
#pragma unroll
        for (int t = 0; t < 2; ++t) { const int pj = lane + 64 * t; const size_t kt = (size_t)b * SEQ + n * 128 + pj;
            const u32x4* kp = (const u32x4*)(RK + kt * 512 + h * 128); float a = 0.f;
#pragma unroll 2
            for (int i = 0; i < 16; ++i) { float kk[8]; unpack8(kp[i], kk);
#pragma unroll
                for (int u = 0; u < 8; ++u) a += scr[8 * i + u] * kk[u]; }
            const float w = (pj <= p) ? expf((float)(p - pj) * lgf) : expf((float)(pj - p) * lgb);
            sv[t] = a * w; }
        scr[128 + lane] = sv[0]; scr[128 + 64 + lane] = sv[1];
        __builtin_amdgcn_s_waitcnt(0xC07F); asm volatile("" ::: "memory");
        const float af = expf((float)(p + 1) * lgf), ab = expf((float)(128 - p) * lgb);
        const bf16* sf = ST + (size_t)(((b * 4 + h) * 2 + 0) * 16 + n) * 256 * 128;
        const bf16* sb = ST + (size_t)(((b * 4 + h) * 2 + 1) * 16 + n) * 256 * 128;
        float y[4];
#pragma unroll 1
        for (int eb = 0; eb < 4; ++eb) { const int e = eb * 64 + lane; float a = 0.f;
#pragma unroll 4
            for (int pj = 0; pj < 128; ++pj) { const size_t kt = (size_t)b * SEQ + n * 128 + pj; a += scr[128 + pj] * bf2f(RV[kt * 1024 + h * 256 + e]); }
            float cf = 0.f, cb = 0.f; const u32x4* fp = (const u32x4*)(sf + (size_t)e * 128); const u32x4* bp = (const u32x4*)(sb + (size_t)e * 128);
#pragma unroll 2
            for (int i = 0; i < 16; ++i) { float x1[8], x2[8]; unpack8(fp[i], x1); unpack8(bp[i], x2);
#pragma unroll
                for (int u = 0; u < 8; ++u) { cf += scr[8 * i + u] * x1[u]; cb += scr[8 * i + u] * x2[u]; } }
            y[eb] = a + af * cf + ab * cb; }
        const float mu = wave_sum((y[0] + y[1]) + (y[2] + y[3])) * (1.f / 256.f);
        float v = 0.f;
#pragma unroll
        for (int eb = 0; eb < 4; ++eb) { y[eb] -= mu; v += y[eb] * y[eb]; }
        const float rstd = 1.0f / sqrtf(wave_sum(v) * (1.f / 256.f) + GN_EPS);
#pragma unroll
        for (int eb = 0; eb < 4; ++eb) { const int col = h * 256 + eb * 64 + lane; bf16* g = RG + (size_t)tok * 1024 + col;
            *g = (bf16)f2bf(y[eb] * rstd * gain[col] * bf2f(*g)); }
        __builtin_amdgcn_s_waitcnt(0xC07F); asm volatile("" ::: "memory");
    }
}
__device__ __forceinline__ void phase3_xa_naive(const Ctx& c, const Ptrs& P) {
    bf16* XQ = P.b(WS_XQ); const bf16* MKV = P.b(WS_MKV);
    float* scr = (float*)(c.lds + c.wave * 16384);
    const int lane = c.lane;
    for (int it = c.gw; it < T * 4; it += c.ngw) {
        const int h = it & 3, tok = it >> 2, b = tok >> 11;
        { const bf16* qp = XQ + (size_t)tok * 512 + h * 128; scr[lane] = bf2f(qp[lane]); scr[lane + 64] = bf2f(qp[lane + 64]); }
        __builtin_amdgcn_s_waitcnt(0xC07F); asm volatile("" ::: "memory");
        float sc[4]; float mx = -3.0e38f;
#pragma unroll
        for (int t = 0; t < 4; ++t) { const int m = lane + 64 * t; const u32x4* kp = (const u32x4*)(MKV + (size_t)(b * MEML + m) * 1024 + h * 128); float a = 0.f;
#pragma unroll 2
            for (int i = 0; i < 16; ++i) { float kk[8]; unpack8(kp[i], kk);
#pragma unroll
                for (int u = 0; u < 8; ++u) a += scr[8 * i + u] * kk[u]; }
            sc[t] = a; mx = fmaxf(mx, a); }
        mx = wave_max(mx); float sum = 0.f;
#pragma unroll
        for (int t = 0; t < 4; ++t) { sc[t] = __expf(sc[t] - mx); sum += sc[t]; }
        const float inv = 1.0f / wave_sum(sum);
#pragma unroll
        for (int t = 0; t < 4; ++t) scr[128 + lane + 64 * t] = sc[t] * inv;
        __builtin_amdgcn_s_waitcnt(0xC07F); asm volatile("" ::: "memory");
        float o0 = 0.f, o1 = 0.f;
        for (int m = 0; m < MEML; ++m) { const bf16* vp = MKV + (size_t)(b * MEML + m) * 1024 + 512 + h * 128; const float pm = scr[128 + m];
            o0 += pm * bf2f(vp[lane]); o1 += pm * bf2f(vp[lane + 64]); }
        bf16* op = XQ + (size_t)tok * 512 + h * 128; op[lane] = (bf16)f2bf(o0); op[lane + 64] = (bf16)f2bf(o1);
        __builtin_amdgcn_s_waitcnt(0xC07F); asm volatile("" ::: "memory");
    }
}
__device__ __forceinline__ void phase4_naive(const Ctx& c, const Ptrs& P) {
    naive_gemm(c, RowPlain{P.b(WS_XN), DM}, P.b(WS_WG), DM, T, NPG, DM, EpiSigmoid{P.b(WS_GATES), NPG});
}
__device__ __forceinline__ void phase5_naive(const Ctx& c, const Ptrs& P) {
    float* TMP = P.out; bf16* MIX = P.b(WS_MIX); const bf16* G = P.b(WS_GATES);
    naive_gemm(c, RowPlain{P.b(WS_RG), 1024}, P.b(WS_WRO), 1024, T, DM, 1024, EpiMixNaive<0>{TMP, MIX, G});
    naive_gemm(c, RowPlain{P.b(WS_NQ), 512}, P.b(WS_WNO), 512, T, DM, 512, EpiMixNaive<1>{TMP, MIX, G + 1024});
    naive_gemm(c, RowPlain{P.b(WS_XQ), 512}, P.b(WS_WXO), 512, T, DM, 512, EpiMixNaive<2>{TMP, MIX, G + 2048});
}
__device__ __forceinline__ void phase6_naive(const Ctx& c, const Ptrs& P) {
    naive_gemm(c, RowPlain{P.b(WS_MIX), DM}, P.b(WS_WOUT), DM, T, DM, DM, EpiResidF32{P.in[0], P.out});
}
__device__ __forceinline__ void phase7(const Ctx& c, const Ptrs& P) {
    const float* X1 = P.out; const float* g = P.in[14]; const float* wrg = P.in[15]; const float* brg = P.in[16]; const float* wre = P.in[17]; const float* bre = P.in[18];
    bf16* H2 = P.b(WS_H2); unsigned* ctl = (unsigned*)(P.ws + WS_CTL); int* elist = (int*)(P.ws + WS_ELIST); float* ewl = P.f(WS_EWL); int* tmeta = (int*)(P.ws + WS_TMETA);
    const int lane = c.lane;
    for (int tok = c.gw; tok < T; tok += c.ngw) {
        const f32x4* xr = (const f32x4*)(X1 + (size_t)tok * DM) + lane; const f32x4* gr = (const f32x4*)g + lane;
        f32x4 v[4]; float s = 0.f;
#pragma unroll
        for (int j = 0; j < 4; ++j) { v[j] = xr[64 * j]; s += (v[j].x * v[j].x + v[j].y * v[j].y) + (v[j].z * v[j].z + v[j].w * v[j].w); }
        const float r = 1.0f / sqrtf(wave_sum(s) * (1.f / 1024.f) + RMS_EPS);
        float lg[20];
#pragma unroll
        for (int i = 0; i < 20; ++i) lg[i] = 0.f;
        unsigned long long* o8 = (unsigned long long*)(H2 + (size_t)tok * DM) + lane;
#pragma unroll
        for (int j = 0; j < 4; ++j) { const f32x4 gg = gr[64 * j]; const f32x4 hh = {v[j].x * r * gg.x, v[j].y * r * gg.y, v[j].z * r * gg.z, v[j].w * r * gg.w};
            o8[64 * j] = (unsigned long long)pk2(hh.x, hh.y) | ((unsigned long long)pk2(hh.z, hh.w) << 32);
            const int k0 = 4 * lane + 256 * j;
#pragma unroll
            for (int u = 0; u < 4; ++u) { const float hv = hh[u]; const f32x4 wg = *(const f32x4*)(wrg + (size_t)(k0 + u) * 4);
                lg[0] += hv * wg.x; lg[1] += hv * wg.y; lg[2] += hv * wg.z; lg[3] += hv * wg.w;
                const f32x4* we = (const f32x4*)(wre + (size_t)(k0 + u) * 16);
#pragma unroll
                for (int q = 0; q < 4; ++q) { const f32x4 w4 = we[q]; lg[4 + 4 * q] += hv * w4.x; lg[5 + 4 * q] += hv * w4.y; lg[6 + 4 * q] += hv * w4.z; lg[7 + 4 * q] += hv * w4.w; } } }
#pragma unroll
        for (int i = 0; i < 20; ++i) lg[i] = wave_sum(lg[i]);
        if (lane == 0) {
            float gl[4]; int gi = 0;
#pragma unroll
            for (int i = 0; i < 4; ++i) { gl[i] = lg[i] + brg[i]; }
#pragma unroll
            for (int i = 1; i < 4; ++i) if (gl[i] > gl[gi]) gi = i;
            float se = 0.f;
#pragma unroll
            for (int i = 0; i < 4; ++i) se += expf(gl[i] - gl[gi]);
            const float grp_w = 1.0f / se;
            float el[4];
#pragma unroll
            for (int i = 0; i < 4; ++i) { float a = 0.f;
#pragma unroll
                for (int g2 = 0; g2 < 4; ++g2) a = (g2 == gi) ? (lg[4 + 4 * g2 + i] + bre[4 * g2 + i]) : a;
                el[i] = a; }
            int ia = 0;
#pragma unroll
            for (int i = 1; i < 4; ++i) if (el[i] > el[ia]) ia = i;
            int ib = (ia == 0) ? 1 : 0;
#pragma unroll
            for (int i = 0; i < 4; ++i) if (i != ia && i != ib && el[i] > el[ib]) ib = i;
            const float t = expf(el[ib] - el[ia]); const float wa = grp_w / (1.0f + t), wb = grp_w * t / (1.0f + t);
            const int ea = gi * 4 + ia, eb = gi * 4 + ib;
            const int pa = (int)atomicAdd(ctl + CW_ECNT + 64 * ea, 1u), pb = (int)atomicAdd(ctl + CW_ECNT + 64 * eb, 1u);
            elist[ea * T + pa] = tok; ewl[ea * T + pa] = wa; elist[eb * T + pb] = tok; ewl[eb * T + pb] = wb;
            *(int4*)(tmeta + 4 * tok) = make_int4(ea, pa, eb, pb);
        }
    }
    for (int e = 0; e < NEXP; ++e) {
        transpose_all(c, ColGU{P.in[19] + (size_t)e * 1024 * 512, P.in[20] + (size_t)e * 1024 * 512}, 512, 1024, 1024, P.b(WS_WGU) + (size_t)e * 1024 * 1024);
        transpose_all(c, ColPlain{P.in[21] + (size_t)e * 512 * 1024}, 1024, 1024, 512, P.b(WS_WD) + (size_t)e * 1024 * 512);
    }
}
__device__ __forceinline__ int expert_rowbase(const unsigned* ctl, int e, int& cnt_e) {
    int base = 0; cnt_e = 0;
    for (int i = 0; i < NEXP; ++i) { const int ci = (int)ctl[CW_ECNT + 64 * i]; if (i < e) base += (ci + 255) & ~255; if (i == e) cnt_e = ci; }
    return base;
}
__device__ __forceinline__ void phase8_naive(const Ctx& c, const Ptrs& P) {
    const unsigned* ctl = (const unsigned*)(P.ws + WS_CTL);
    for (int e = 0; e < NEXP; ++e) { int cnt; const int base = expert_rowbase(ctl, e, cnt);
        naive_gemm(c, RowGather{P.b(WS_H2), DM, (const int*)(P.ws + WS_ELIST) + e * T}, P.b(WS_WGU) + (size_t)e * 1024 * 1024, 1024, cnt, 1024, 1024,
                   EpiSwiGLU{P.b(WS_HID), P.f(WS_EWL) + e * T, base}); }
}
__device__ __forceinline__ void phase9_naive(const Ctx& c, const Ptrs& P) {
    const unsigned* ctl = (const unsigned*)(P.ws + WS_CTL);
    for (int e = 0; e < NEXP; ++e) { int cnt; const int base = expert_rowbase(ctl, e, cnt);
        naive_gemm(c, RowPlain{P.b(WS_HID) + (size_t)base * DFF, DFF}, P.b(WS_WD) + (size_t)e * 1024 * 512, 512, cnt, 1024, 512, EpiRowsBf16{P.b(WS_DROWS), 1024, base}); }
}
__device__ __forceinline__ void phase10(const Ctx& c, const Ptrs& P) {
    const unsigned* ctl = (const unsigned*)(P.ws + WS_CTL); const int* tmeta = (const int*)(P.ws + WS_TMETA); const bf16* DR = P.b(WS_DROWS); const float* g = P.in[22];
    int rb[NEXP]; { int base = 0;
#pragma unroll
        for (int i = 0; i < NEXP; ++i) { rb[i] = base; base += ((int)ctl[CW_ECNT + 64 * i] + 255) & ~255; } }
    const int lane = c.lane;
    for (int tok = c.gw; tok < T; tok += c.ngw) {
        const int4 m = *(const int4*)(tmeta + 4 * tok);
        int ba = 0, bb = 0;
#pragma unroll
        for (int i = 0; i < NEXP; ++i) { ba = (i == m.x) ? rb[i] : ba; bb = (i == m.z) ? rb[i] : bb; }
        const unsigned long long* da = (const unsigned long long*)(DR + (size_t)(ba + m.y) * DM) + lane;
        const unsigned long long* db = (const unsigned long long*)(DR + (size_t)(bb + m.w) * DM) + lane;
        f32x4* xr = (f32x4*)(P.out + (size_t)tok * DM) + lane; const f32x4* gr = (const f32x4*)g + lane;
        f32x4 v[4]; float s = 0.f;
#pragma unroll
        for (int j = 0; j < 4; ++j) { const unsigned long long a = da[64 * j], b = db[64 * j]; f32x4 x = xr[64 * j];
            x.x += bf2f((unsigned)a & 0xffffu) + bf2f((unsigned)b & 0xffffu); x.y += bf2f(((unsigned)a >> 16)) + bf2f(((unsigned)b >> 16));
            x.z += bf2f((unsigned)(a >> 32) & 0xffffu) + bf2f((unsigned)(b >> 32) & 0xffffu); x.w += bf2f((unsigned)(a >> 48)) + bf2f((unsigned)(b >> 48));
            v[j] = x; s += (x.x * x.x + x.y * x.y) + (x.z * x.z + x.w * x.w); }
        const float r = 1.0f / sqrtf(wave_sum(s) * (1.f / 1024.f) + RMS_EPS);
#pragma unroll
        for (int j = 0; j < 4; ++j) { const f32x4 gg = gr[64 * j]; xr[64 * j] = (f32x4){v[j].x * r * gg.x, v[j].y * r * gg.y, v[j].z * r * gg.z, v[j].w * r * gg.w}; }
    }
}

constexpr int NPHASES = 11;
__global__ void __launch_bounds__(NTHREADS, 2) mk_fwd(Args args) {
    extern __shared__ __attribute__((aligned(16))) unsigned char lds[];
    Ctx c; c.tid = threadIdx.x; c.lane = c.tid & 63; c.wave = __builtin_amdgcn_readfirstlane(c.tid >> 6);
    c.gw = blockIdx.x * NWAVES + c.wave; c.ngw = gridDim.x * NWAVES; c.lds = lds;
    Ptrs P;
#pragma unroll
    for (int i = 0; i < 23; ++i) P.in[i] = args.in[i];
    P.out = args.out; P.ws = args.ws;
    volatile LAS unsigned* MISC = (volatile LAS unsigned*)((LAS unsigned char*)lds + MISC_OFF);
    if (c.tid < 32) MISC[c.tid] = 0u;
    __syncthreads();
    XcdBarrier bar; bar.bar = (unsigned*)(args.ws + WS_CTL) + CW_BAR; bar.x = 0; bar.st = nullptr;
    const int lo = args.ph_lo, hi = args.ph_hi;
    if (hi - lo > 1) bar = xcd_barrier_post((unsigned*)(args.ws + WS_CTL) + CW_BAR, MISC + 8);
#define IN(k) (lo <= (k) && (k) < hi)
#define SEAM(k) do { if (IN(k) && IN((k) + 1)) xcd_barrier(bar); } while (0)
    if (IN(0)) { phase0(c, P); } SEAM(0);
    if (IN(1)) { phase1_naive(c, P); } SEAM(1);
    if (IN(2)) { phase2_states_naive(c, P); phase2_na_naive(c, P); phase2_memkv_naive(c, P); } SEAM(2);
    if (IN(3)) { phase3_ret_naive(c, P); phase3_xa_naive(c, P); } SEAM(3);
    if (IN(4)) { phase4_naive(c, P); } SEAM(4);
    if (IN(5)) { phase5_naive(c, P); } SEAM(5);
    if (IN(6)) { phase6_naive(c, P); } SEAM(6);
    if (IN(7)) { phase7(c, P); } SEAM(7);
    if (IN(8)) { phase8_naive(c, P); } SEAM(8);
    if (IN(9)) { phase9_naive(c, P); } SEAM(9);
    if (IN(10)) { phase10(c, P); }
#undef IN
#undef SEAM
}

extern "C" void kernel_launch(void* const* d_in, const int* in_sizes, int n_in, void* d_out, int out_size, void* d_ws, size_t ws_size, hipStream_t stream) {
    static int grid = 0;
    if (grid == 0) {
        if (n_in != 23 || out_size != T * DM || ws_size < WS_END) { fprintf(stderr, "kernel_launch: unexpected shapes (n_in %d out %d ws %zu)\n", n_in, out_size, ws_size); grid = -1; return; }
        int dev = 0, cus = 0;
        if (hipGetDevice(&dev) != hipSuccess || hipDeviceGetAttribute(&cus, hipDeviceAttributeMultiprocessorCount, dev) != hipSuccess) { grid = -1; return; }
        if (hipFuncSetAttribute((const void*)mk_fwd, hipFuncAttributeMaxDynamicSharedMemorySize, LDS_BYTES) != hipSuccess) { fprintf(stderr, "kernel_launch: hipFuncSetAttribute failed\n"); grid = -1; return; }
        (void)hipGetLastError();
        grid = cus;
    }
    if (grid < 0) return;
    (void)hipMemsetAsync((char*)d_ws + WS_CTL, 0, CTL_ZERO_BYTES, stream);
    Args a{};
    for (int i = 0; i < 23; ++i) a.in[i] = (const float*)d_in[i];
    a.out = (float*)d_out; a.ws = (unsigned char*)d_ws;
#if MK_PER_PHASE
    for (int p = 0; p < NPHASES; ++p) { a.ph_lo = p; a.ph_hi = p + 1; hipLaunchKernelGGL(mk_fwd, dim3(grid), dim3(NTHREADS), LDS_BYTES, stream, a); }
#else
    a.ph_lo = 0; a.ph_hi = NPHASES; hipLaunchKernelGGL(mk_fwd, dim3(grid), dim3(NTHREADS), LDS_BYTES, stream, a);
#endif
}
```

```cpp
#include <hip/hip_runtime.h>
#include <cstdio>
#include <cstdint>

#ifndef MK_PER_PHASE
#define MK_PER_PHASE 0
#endif

#define GAS __attribute__((address_space(1)))
#define LAS __attribute__((address_space(3)))
typedef unsigned short bf16;
typedef float f32x4 __attribute__((ext_vector_type(4)));
typedef unsigned u32x4 __attribute__((ext_vector_type(4)));
typedef unsigned u32x2 __attribute__((ext_vector_type(2)));
typedef short bf16x8 __attribute__((ext_vector_type(8)));

constexpr int NB = 8, SEQ = 2048, DM = 1024, T = NB * SEQ;
constexpr int MEML = 256, TM = NB * MEML;
constexpr int NWAVES = 8, NTHREADS = 512;
constexpr int NPA = 5120, NPG = 3072;
constexpr int NEXP = 16, DFF = 512;
constexpr float RMS_EPS = 1e-6f, GN_EPS = 1e-5f;
constexpr float QK_SCALE = 0.08838834764831845f;

constexpr size_t MiB = 1u << 20;
constexpr size_t WS_CTL = 0, CTL_ZERO_BYTES = 1 * MiB;
constexpr size_t WS_COS = 1 * MiB, WS_SIN = 1 * MiB + 512 * 1024;
constexpr size_t WS_ELIST = 2 * MiB;
constexpr size_t WS_FT = 2 * MiB;
constexpr size_t WS_EWL = 3 * MiB;
constexpr size_t WS_TMETA = 4 * MiB;
constexpr size_t WS_WA = 5 * MiB;
constexpr size_t WS_WG = 15 * MiB;
constexpr size_t WS_WKV = 21 * MiB;
constexpr size_t WS_WRO = 23 * MiB;
constexpr size_t WS_WNO = 25 * MiB;
constexpr size_t WS_WXO = 26 * MiB;
constexpr size_t WS_WOUT = 27 * MiB;
constexpr size_t WS_XN = 29 * MiB;
constexpr size_t WS_H2 = WS_XN;
constexpr size_t WS_RQ = 61 * MiB;
constexpr size_t WS_RK = 77 * MiB;
constexpr size_t WS_RV = 93 * MiB;
constexpr size_t WS_NK = 125 * MiB;
constexpr size_t WS_NV = 141 * MiB;
constexpr size_t WS_GATES = 61 * MiB;
constexpr size_t WS_HID = 61 * MiB;
constexpr size_t WS_DROWS = 97 * MiB;
constexpr size_t WS_RG = 157 * MiB;
constexpr size_t WS_NQ = 189 * MiB;
constexpr size_t WS_XQ = 205 * MiB;
constexpr size_t WS_WD = 205 * MiB;
constexpr size_t WS_MN = 221 * MiB;
constexpr size_t WS_MKV = 225 * MiB;
constexpr size_t WS_MIX = 221 * MiB;
constexpr size_t WS_WGU = 221 * MiB;
constexpr size_t WS_END = 256 * MiB;

constexpr int CW_ECNT = 64;
constexpr int CW_BAR = 4096;

constexpr int LDS_BYTES = 163840;
constexpr int MISC_OFF = 163840 - 512;

__device__ __forceinline__ float bf2f(unsigned v) { return __uint_as_float(v << 16); }
__device__ __forceinline__ unsigned f2bf(float f) { unsigned u = __float_as_uint(f); return (u + 0x7fffu + ((u >> 16) & 1u)) >> 16; }
__device__ __forceinline__ unsigned pk2(float lo, float hi) { return f2bf(lo) | (f2bf(hi) << 16); }
__device__ __forceinline__ void unpack8(const u32x4 v, float* o) {
    o[0] = __uint_as_float(v.x << 16); o[1] = __uint_as_float(v.x & 0xffff0000u);
    o[2] = __uint_as_float(v.y << 16); o[3] = __uint_as_float(v.y & 0xffff0000u);
    o[4] = __uint_as_float(v.z << 16); o[5] = __uint_as_float(v.z & 0xffff0000u);
    o[6] = __uint_as_float(v.w << 16); o[7] = __uint_as_float(v.w & 0xffff0000u);
}
__device__ __forceinline__ void store8(bf16* p, f32x4 a, f32x4 b) {
    u32x4 w; w.x = pk2(a[0], a[1]); w.y = pk2(a[2], a[3]); w.z = pk2(b[0], b[1]); w.w = pk2(b[2], b[3]);
    *(u32x4*)p = w;
}
__device__ __forceinline__ float wave_sum(float v) {
#pragma unroll
    for (int o = 1; o < 64; o <<= 1) v += __shfl_xor(v, o);
    return v;
}
__device__ __forceinline__ float wave_max(float v) {
#pragma unroll
    for (int o = 1; o < 64; o <<= 1) v = fmaxf(v, __shfl_xor(v, o));
    return v;
}
__device__ __forceinline__ float sigmoidf_(float x) { return 1.0f / (1.0f + __expf(-x)); }
__device__ __forceinline__ float siluf_(float x) { return x / (1.0f + __expf(-x)); }

#define XB_TMO      128
#define XB_XCNT(j)  (256  + 64 * (j))
#define XB_XSUB(j)  (1280 + 64 * (j))
#define XB_XGEN(j)  (2304 + 64 * (j))
#define XB_TOP      3328
#define XB_TOPGEN   3392
#define XCD_BAR_WORDS 3456
#define XB_SPIN_CAP (1u << 18)
__device__ __forceinline__ unsigned xb_ld(unsigned* p)              { return __hip_atomic_load(p, __ATOMIC_RELAXED, __HIP_MEMORY_SCOPE_AGENT); }
__device__ __forceinline__ unsigned xb_add(unsigned* p, unsigned v) { return __hip_atomic_fetch_add(p, v, __ATOMIC_RELAXED, __HIP_MEMORY_SCOPE_AGENT); }
__device__ __forceinline__ unsigned xb_xcc_id() { return (unsigned)__builtin_amdgcn_s_getreg((3 << 11) | 20) & 0xFu; }
#define XB_SPIN(cond, bar) do { unsigned _sp = 0; while (cond) { __builtin_amdgcn_s_sleep(1); \
    if ((++_sp & 255u) == 0u) { if (xb_ld(&(bar)[XB_TMO])) break; if (_sp > XB_SPIN_CAP) { atomicAdd(&(bar)[XB_TMO], 1u); break; } } } } while (0)
struct XcdBarrier { unsigned* bar; unsigned x; volatile LAS unsigned* st; };
__device__ __forceinline__ XcdBarrier xcd_barrier_post(unsigned* bar, volatile LAS unsigned* st) {
    XcdBarrier b; b.bar = bar; b.x = xb_xcc_id(); b.st = st;
    if (threadIdx.x == 0) (void)xb_add(&bar[XB_XCNT(b.x)], 1u);
    return b;
}
__device__ __forceinline__ void xcd_barrier_complete(unsigned* bar, unsigned x, unsigned& nloc, unsigned& nx) {
    const unsigned G = gridDim.x * gridDim.y * gridDim.z;
    unsigned sum, cnt, mine, sp = 0u;
    for (;;) {
        sum = 0u; cnt = 0u; mine = 0u;
#pragma unroll
        for (unsigned j = 0; j < 16; ++j) { const unsigned c = xb_ld(&bar[XB_XCNT(j)]); sum += c; cnt += (c > 0u) ? 1u : 0u; mine = (j == x) ? c : mine; }
        if (sum == G) break;
        __builtin_amdgcn_s_sleep(1);
        if ((++sp & 255u) == 0u) { if (xb_ld(&bar[XB_TMO])) break; if (sp > XB_SPIN_CAP) { atomicAdd(&bar[XB_TMO], 1u); break; } }
    }
    nloc = mine > 0u ? mine : 1u; nx = cnt > 0u ? cnt : 1u;
}
__device__ __forceinline__ void xcd_barrier(const XcdBarrier& b) {
    asm volatile("s_waitcnt vmcnt(0)" ::: "memory");
    __syncthreads();
    if (threadIdx.x == 0) {
        unsigned* bar = b.bar;
        __builtin_amdgcn_s_waitcnt(0);
        unsigned nloc = b.st[0], nx = b.st[1];
        if (nloc == 0u) { xcd_barrier_complete(bar, b.x, nloc, nx); b.st[0] = nloc; b.st[1] = nx; }
        const unsigned old = xb_add(&bar[XB_XSUB(b.x)], 1u);
        const unsigned gen = old / nloc;
        if (old + 1u == (gen + 1u) * nloc) {
            __builtin_amdgcn_fence(__ATOMIC_RELEASE, "agent");
            asm volatile("s_waitcnt vmcnt(0)" ::: "memory");
            const unsigned og = xb_add(&bar[XB_TOP], 1u);
            const unsigned tg = og / nx;
            if (og + 1u == (tg + 1u) * nx) xb_add(&bar[XB_TOPGEN], 1u);
            else XB_SPIN(xb_ld(&bar[XB_TOPGEN]) == tg, bar);
            __builtin_amdgcn_fence(__ATOMIC_ACQUIRE, "agent");
            xb_add(&bar[XB_XGEN(b.x)], 1u);
            asm volatile("s_waitcnt vmcnt(0)" ::: "memory");
        } else {
            XB_SPIN(xb_ld(&bar[XB_XGEN(b.x)]) == gen, bar);
            __builtin_amdgcn_fence(__ATOMIC_ACQUIRE, "agent");
            asm volatile("s_waitcnt vmcnt(0)" ::: "memory");
        }
    }
    __syncthreads();
}

struct Args { const float* in[23]; float* out; unsigned char* ws; int ph_lo, ph_hi; };
struct Ctx {
    int tid, lane, wave, gw, ngw;
    unsigned char* lds;
};

template <class ColPtr>
__device__ __forceinline__ void transpose_all(const Ctx& c, ColPtr cp, int ldw, int P, int K, bf16* WT) {
    float* scr = (float*)(c.lds + c.wave * 16384);
    const int nkb = K / 64, npb = P / 32, lane = c.lane;
    for (int it = c.gw; it < nkb * npb; it += c.ngw) {
        const int kb = it % nkb, pb = it / nkb, k0 = 64 * kb, p0 = 32 * pb;
        const float* colp = cp(p0 + (lane & 31));
#pragma unroll 8
        for (int i = 0; i < 32; ++i) { const int kk = 2 * i + (lane >> 5); scr[kk * 33 + (lane & 31)] = colp[(size_t)(k0 + kk) * ldw]; }
        __builtin_amdgcn_s_waitcnt(0xC07F); asm volatile("" ::: "memory");
        const int cc = lane & 7;
#pragma unroll
        for (int j = 0; j < 4; ++j) { const int n = (lane >> 3) + 8 * j; const float* s = scr + (8 * cc) * 33 + n;
            u32x4 o; o.x = pk2(s[0 * 33], s[1 * 33]); o.y = pk2(s[2 * 33], s[3 * 33]); o.z = pk2(s[4 * 33], s[5 * 33]); o.w = pk2(s[6 * 33], s[7 * 33]);
            *(u32x4*)(WT + (size_t)(p0 + n) * K + k0 + 8 * cc) = o; }
        __builtin_amdgcn_s_waitcnt(0xC07F); asm volatile("" ::: "memory");
    }
}
struct ColPlain { const float* W; __device__ const float* operator()(int p) const { return W + p; } };
struct ColOff { const float* W; int off; __device__ const float* operator()(int p) const { return W + off + p; } };
struct ColWA {
    const float* W;
    __device__ const float* operator()(int p) const {
        if (p < 1024) { const int pp = p & 127; const int d = ((pp & 4) ? 64 : 0) + 4 * (pp >> 3) + (pp & 3); return W + (p & ~127) + d; }
        return W + p;
    }
};
struct ColGU {
    const float* Wg; const float* Wu;
    __device__ const float* operator()(int p) const { const int f = 4 * (p >> 3) + (p & 3); return ((p >> 2) & 1) ? Wu + f : Wg + f; }
};
__device__ __forceinline__ void rms_row_to_bf16(const float* xrow, const float* g, bf16* orow, int lane) {
    const f32x4* xr = (const f32x4*)xrow + lane; const f32x4* gr = (const f32x4*)g + lane;
    f32x4 v[4]; float s = 0.f;
#pragma unroll
    for (int j = 0; j < 4; ++j) { v[j] = xr[64 * j]; s += (v[j].x * v[j].x + v[j].y * v[j].y) + (v[j].z * v[j].z + v[j].w * v[j].w); }
    const float r = 1.0f / sqrtf(wave_sum(s) * (1.f / 1024.f) + RMS_EPS);
    unsigned long long* o8 = (unsigned long long*)orow + lane;
#pragma unroll
    for (int j = 0; j < 4; ++j) { const f32x4 gg = gr[64 * j];
        o8[64 * j] = (unsigned long long)pk2(v[j].x * r * gg.x, v[j].y * r * gg.y) | ((unsigned long long)pk2(v[j].z * r * gg.z, v[j].w * r * gg.w) << 32); }
}

template <class RowPtr, class Epi>
__device__ __forceinline__ void naive_gemm(const Ctx& c, const RowPtr& rp, const bf16* Bt, int ldb, int M, int N, int K, const Epi& epi) {
    const int tilesN = N / 64, tilesM = (M + 7) / 8, lane = c.lane;
    for (int it = c.gw; it < tilesM * tilesN; it += c.ngw) {
        const int tm = it / tilesN, tn = it % tilesN;
        const int row = tm * 8 + (lane >> 3), col0 = tn * 64 + (lane & 7) * 8;
        const bool valid = row < M;
        const bf16* ap = rp(valid ? row : 0);
        float acc[8];
#pragma unroll
        for (int j = 0; j < 8; ++j) acc[j] = 0.f;
        for (int k = 0; k < K; k += 8) {
            float a[8]; unpack8(*(const u32x4*)(ap + k), a);
#pragma unroll
            for (int j = 0; j < 8; ++j) { float b[8]; unpack8(*(const u32x4*)(Bt + (size_t)(col0 + j) * ldb + k), b);
#pragma unroll
                for (int i = 0; i < 8; ++i) acc[j] += a[i] * b[i]; }
        }
        if (valid) epi(row, col0, (f32x4){acc[0], acc[1], acc[2], acc[3]}, (f32x4){acc[4], acc[5], acc[6], acc[7]});
    }
}
struct RowPlain { const bf16* A; int lda; __device__ const bf16* operator()(int r) const { return A + (size_t)r * lda; } };
struct RowGather { const bf16* A; int lda; const int* idx; __device__ const bf16* operator()(int r) const { return A + (size_t)idx[r] * lda; } };

struct EpiProjA {
    bf16 *RQ, *RK, *RV, *RG, *NQ, *NK, *NV, *XQ; const float *COS, *SIN;
    __device__ __forceinline__ void operator()(int row, int col0, f32x4 v0, f32x4 v1) const {
        if (col0 < 1024) {
            const int which = col0 >> 9, cc = col0 & 511, pos = row & (SEQ - 1), q = (cc & 127) >> 3;
            const f32x4 cs = *(const f32x4*)(COS + pos * 64 + 4 * q), sn = *(const f32x4*)(SIN + pos * 64 + 4 * q);
            f32x4 o1 = v0 * cs - v1 * sn, o2 = v0 * sn + v1 * cs;
            if (which == 0) { o1 = o1 * QK_SCALE; o2 = o2 * QK_SCALE; }
            store8((which ? RK : RQ) + (size_t)row * 512 + cc, o1, o2);
        } else if (col0 < 2048) { store8(RV + (size_t)row * 1024 + (col0 - 1024), v0, v1);
        } else if (col0 < 3072) {
            f32x4 a, b;
#pragma unroll
            for (int i = 0; i < 4; ++i) { a[i] = siluf_(v0[i]); b[i] = siluf_(v1[i]); }
            store8(RG + (size_t)row * 1024 + (col0 - 2048), a, b);
        } else if (col0 < 3584) { store8(NQ + (size_t)row * 512 + (col0 - 3072), v0 * 0.125f, v1 * 0.125f);
        } else if (col0 < 4096) { store8(NK + (size_t)row * 512 + (col0 - 3584), v0, v1);
        } else if (col0 < 4608) { store8(NV + (size_t)row * 512 + (col0 - 4096), v0, v1);
        } else { store8(XQ + (size_t)row * 512 + (col0 - 4608), v0 * QK_SCALE, v1 * QK_SCALE); }
    }
};
struct EpiBf16Plain { bf16* O; int ldc; __device__ __forceinline__ void operator()(int row, int col0, f32x4 v0, f32x4 v1) const { store8(O + (size_t)row * ldc + col0, v0, v1); } };
struct EpiSigmoid { bf16* O; int ldc;
    __device__ __forceinline__ void operator()(int row, int col0, f32x4 v0, f32x4 v1) const {
        f32x4 a, b;
#pragma unroll
        for (int i = 0; i < 4; ++i) { a[i] = sigmoidf_(v0[i]); b[i] = sigmoidf_(v1[i]); }
        store8(O + (size_t)row * ldc + col0, a, b); } };
template <int MODE> struct EpiMixNaive { float* TMP; bf16* MIX; const bf16* G;
    __device__ __forceinline__ void operator()(int row, int col0, f32x4 v0, f32x4 v1) const {
        float g[8]; unpack8(*(const u32x4*)(G + (size_t)row * NPG + col0), g);
        f32x4 a = {v0[0] * g[0], v0[1] * g[1], v0[2] * g[2], v0[3] * g[3]}, b = {v1[0] * g[4], v1[1] * g[5], v1[2] * g[6], v1[3] * g[7]};
        float* t = TMP + (size_t)row * DM + col0;
        if (MODE >= 1) { a = a + *(const f32x4*)t; b = b + *(const f32x4*)(t + 4); }
        if (MODE <= 1) { *(f32x4*)t = a; *(f32x4*)(t + 4) = b; } else store8(MIX + (size_t)row * DM + col0, a, b);
    } };
struct EpiResidF32 { const float* X; float* O;
    __device__ __forceinline__ void operator()(int row, int col0, f32x4 v0, f32x4 v1) const {
        const float* x = X + (size_t)row * DM + col0; float* o = O + (size_t)row * DM + col0;
        *(f32x4*)o = *(const f32x4*)x + v0; *(f32x4*)(o + 4) = *(const f32x4*)(x + 4) + v1; } };
struct EpiSwiGLU { bf16* HID; const float* wl; int rowbase;
    __device__ __forceinline__ void operator()(int row, int col0, f32x4 v0, f32x4 v1) const {
        const float w = wl[row]; f32x4 h;
#pragma unroll
        for (int i = 0; i < 4; ++i) h[i] = siluf_(v0[i]) * v1[i] * w;
        u32x2 o; o.x = pk2(h[0], h[1]); o.y = pk2(h[2], h[3]);
        *(u32x2*)(HID + (size_t)(rowbase + row) * DFF + (col0 >> 1)) = o; } };
struct EpiRowsBf16 { bf16* O; int ldc; int rowbase;
    __device__ __forceinline__ void operator()(int row, int col0, f32x4 v0, f32x4 v1) const { store8(O + (size_t)(rowbase + row) * ldc + col0, v0, v1); } };

namespace pg8 {
constexpr int BM = 256, BK = 64, HALF = 128, HTB = HALF * BK * 2, STAGE_BYTES = 8 * HTB;
__device__ __forceinline__ int lds_byte(int r, int c) { const int st = (r >> 4) * 2 + (c >> 5), rr = r & 15, cc = c & 31, ob = rr * 64 + cc * 2; return st * 1024 + (ob ^ (((ob >> 9) & 1) << 5)); }
__device__ __forceinline__ void stage_rc(int b, int& R, int& C) { const int st = b / 1024, sb = b % 1024, swz = sb ^ (((sb >> 9) & 1) << 5); R = (st >> 1) * 16 + swz / 64; C = (st & 1) * 32 + (swz % 64) / 2; }
__device__ __forceinline__ int perm32(int rho) { const int n = rho >> 4, i = rho & 15; return 8 * (i >> 2) + 4 * n + (i & 3); }

struct UnitDesc {
    const char* A; const char* B;
    unsigned lda2, ldb2;
    int nt;
    int row0, col0;
    int aux, aux2;
    const int* gidx; int gcnt;
    int chain;
};
__device__ __forceinline__ unsigned cvt_pk_bf16(float lo, float hi) { unsigned r; asm volatile("v_cvt_pk_bf16_f32 %0, %1, %2" : "=v"(r) : "v"(lo), "v"(hi)); return r; }

template <class F> __device__ __forceinline__ void epi_apply(const f32x4 (&acc)[2][2][4][2], const UnitDesc& u, int wr, int wc, int fr, int fq, const F& f) {
#pragma unroll
    for (int ai = 0; ai < 2; ++ai)
#pragma unroll
        for (int m = 0; m < 4; ++m) { const int row = u.row0 + ai * HALF + wr * 64 + m * 16 + fr;
#pragma unroll
            for (int bj = 0; bj < 2; ++bj) f(row, u.col0 + bj * HALF + wc * 32 + 8 * fq, acc[ai][bj][m][0], acc[ai][bj][m][1]);
            asm volatile("" ::: "memory"); __builtin_amdgcn_sched_barrier(0); }
}

template <bool GATHER> __device__ __forceinline__ void unit_offs(const UnitDesc& u, int tid, unsigned (&oA0)[2], unsigned (&oA1)[2], unsigned (&oB)[2]) {
#pragma unroll
    for (int i = 0; i < 2; ++i) { int R, C; stage_rc(tid * 16 + i * 8192, R, C); const int Rb = (R & ~31) + perm32(R & 31);
        oB[i] = (unsigned)Rb * u.ldb2 + (unsigned)C * 2u;
        if (GATHER && u.gidx) { const int last = u.gcnt - 1; int r0 = u.row0 + R, r1 = r0 + HALF; r0 = r0 < last ? r0 : last; r1 = r1 < last ? r1 : last;
            oA0[i] = (unsigned)u.gidx[r0] * u.lda2 + (unsigned)C * 2u; oA1[i] = (unsigned)u.gidx[r1] * u.lda2 + (unsigned)C * 2u;
        } else { oA0[i] = (unsigned)R * u.lda2 + (unsigned)C * 2u; oA1[i] = oA0[i] + (unsigned)HALF * u.lda2; } }
}

template <bool GATHER, class Sched, class Epi>
__device__ __forceinline__ void gemm_phase(LAS unsigned char* lds, const Sched& S, const Epi& E) {
    const int tid = threadIdx.x, wid = __builtin_amdgcn_readfirstlane(tid >> 6), lane = tid & 63, wr = wid >> 2, wc = wid & 3, fr = lane & 15, fq = lane >> 4;
    const unsigned ldsw = (unsigned)wid * 1024u;
    const int aoff = lds_byte(wr * 64 + fr, fq * 8), boff = lds_byte(wc * 32 + fr, fq * 8);
    const size_t kstep = (size_t)(BK * 2);
#define PG8_SA(b, h) (((b) * 2 + (h)) * HTB)
#define PG8_SB(b, h) ((4 + (b) * 2 + (h)) * HTB)
#define PG8_STAGE(bufoff, gbase, voff) do { _Pragma("unroll") for (int _i = 0; _i < 2; ++_i) \
        __builtin_amdgcn_global_load_lds((const unsigned*)((const char*)(gbase) + (voff)[_i]), (LAS unsigned*)(lds + (bufoff) + ldsw + _i * 8192), 16, 0, 0); } while (0)
#define PG8_LDA(dst, b, h) do { _Pragma("unroll") for (int m = 0; m < 4; ++m) _Pragma("unroll") for (int k = 0; k < 2; ++k) dst[m][k] = *(const LAS bf16x8*)(lds + PG8_SA(b, h) + aoff + m * 2048 + k * 1024); } while (0)
#define PG8_LDB(dst, b, h) do { _Pragma("unroll") for (int n = 0; n < 2; ++n) _Pragma("unroll") for (int k = 0; k < 2; ++k) dst[n][k] = *(const LAS bf16x8*)(lds + PG8_SB(b, h) + boff + n * 2048 + k * 1024); } while (0)
#define PG8_MMA(ai, bj, At, Bt) do { __builtin_amdgcn_s_setprio(1); _Pragma("unroll") for (int m = 0; m < 4; ++m) _Pragma("unroll") for (int n = 0; n < 2; ++n) _Pragma("unroll") for (int k = 0; k < 2; ++k) \
        acc[ai][bj][m][n] = __builtin_amdgcn_mfma_f32_16x16x32_bf16(Bt[n][k], At[m][k], acc[ai][bj][m][n], 0, 0, 0); __builtin_amdgcn_s_setprio(0); } while (0)
#define PG8_WAIT_V(n) asm volatile("s_waitcnt vmcnt(" #n ")" ::: "memory")
#define PG8_WAIT_L(n) asm volatile("s_waitcnt lgkmcnt(" #n ")" ::: "memory")
#define PG8_BAR __builtin_amdgcn_s_barrier()
#define PG8_SCHED __builtin_amdgcn_sched_barrier(0)
    UnitDesc cur, nxt; int ui = 0;
    if (!S.next(0, cur)) return;
    f32x4 acc[2][2][4][2];
#pragma unroll
    for (int a = 0; a < 2; ++a)
#pragma unroll
        for (int b = 0; b < 2; ++b)
#pragma unroll
            for (int m = 0; m < 4; ++m)
#pragma unroll
                for (int n = 0; n < 2; ++n) acc[a][b][m][n] = (f32x4){0.f, 0.f, 0.f, 0.f};
    bf16x8 At[4][2], B0[2][2], B1[2][2];
    unsigned cA0[2], cA1[2], cB[2], nA0[2], nA1[2], nB[2];
    unit_offs<GATHER>(cur, tid, cA0, cA1, cB);
    const char* pA = cur.A; const char* pB = cur.B; size_t hB = (size_t)HALF * cur.ldb2;
    PG8_STAGE(PG8_SB(0, 0), pB, cB); PG8_STAGE(PG8_SB(0, 1), pB + hB, cB); PG8_STAGE(PG8_SA(0, 0), pA, cA0); PG8_STAGE(PG8_SA(0, 1), pA, cA1);
    if (wr == 1) PG8_BAR;
    PG8_WAIT_V(2); PG8_BAR;
    PG8_STAGE(PG8_SB(1, 0), pB + kstep, cB); PG8_STAGE(PG8_SA(1, 0), pA + kstep, cA0); PG8_STAGE(PG8_SB(1, 1), pB + hB + kstep, cB);
    PG8_WAIT_V(6); PG8_BAR;
    for (;;) {
        const bool has_next = S.next(ui + 1, nxt);
        const char* qA = pA; const char* qB = pB; size_t hBn = hB;
        if (has_next) { unit_offs<GATHER>(nxt, tid, nA0, nA1, nB); qA = nxt.A; qB = nxt.B; hBn = (size_t)HALF * nxt.ldb2; }
        else {
#pragma unroll
            for (int i = 0; i < 2; ++i) { nA0[i] = cA0[i]; nA1[i] = cA1[i]; nB[i] = cB[i]; } }
        const int nt = cur.nt;
        for (int t = 0; t < nt; t += 2) {
            const bool last = (t == nt - 2);
            const char* a1 = pA + (size_t)(t + 1) * kstep;
            const char* a2 = last ? qA : pA + (size_t)(t + 2) * kstep; const char* b2 = last ? qB : pB + (size_t)(t + 2) * kstep;
            const char* a3 = a2 + kstep; const char* b3 = b2 + kstep;
            unsigned sA0[2], sA1[2], sB[2];
#pragma unroll
            for (int i = 0; i < 2; ++i) { sA0[i] = last ? nA0[i] : cA0[i]; sA1[i] = last ? nA1[i] : cA1[i]; sB[i] = last ? nB[i] : cB[i]; }
            const size_t shB = last ? hBn : hB;
            PG8_LDB(B0, 0, 0); PG8_LDB(B1, 0, 1); PG8_SCHED; PG8_LDA(At, 0, 0); PG8_STAGE(PG8_SA(1, 1), a1, cA1);
            PG8_WAIT_V(8); PG8_WAIT_L(0); PG8_BAR; PG8_MMA(0, 0, At, B0); PG8_MMA(0, 1, At, B1); PG8_BAR; PG8_SCHED;
            PG8_LDA(At, 0, 1); PG8_STAGE(PG8_SB(0, 0), b2, sB); PG8_STAGE(PG8_SB(0, 1), b2 + shB, sB); PG8_STAGE(PG8_SA(0, 0), a2, sA0);
            PG8_WAIT_V(8); PG8_WAIT_L(0); PG8_BAR; PG8_MMA(1, 0, At, B0); PG8_MMA(1, 1, At, B1); PG8_BAR; PG8_SCHED;
            PG8_LDB(B0, 1, 0); PG8_LDB(B1, 1, 1); PG8_SCHED; PG8_LDA(At, 1, 0); PG8_STAGE(PG8_SA(0, 1), a2, sA1);
            PG8_WAIT_V(8); PG8_WAIT_L(0); PG8_BAR; PG8_MMA(0, 0, At, B0); PG8_MMA(0, 1, At, B1); PG8_BAR; PG8_SCHED;
            PG8_LDA(At, 1, 1); PG8_STAGE(PG8_SB(1, 0), b3, sB); PG8_STAGE(PG8_SB(1, 1), b3 + shB, sB); PG8_STAGE(PG8_SA(1, 0), a3, sA0);
            PG8_WAIT_V(8); PG8_WAIT_L(0); PG8_BAR; PG8_MMA(1, 0, At, B0); PG8_MMA(1, 1, At, B1); PG8_BAR; PG8_SCHED;
        }
        if (wr == 0) PG8_BAR;
        E.finish(acc, cur, wr, wc, fr, fq);
        if (!has_next) break;
        cur = nxt; pA = qA; pB = qB; hB = hBn; ++ui;
#pragma unroll
        for (int i = 0; i < 2; ++i) { cA0[i] = nA0[i]; cA1[i] = nA1[i]; cB[i] = nB[i]; }
        if (wr == 1) PG8_BAR;
    }
    PG8_WAIT_V(0);
    PG8_BAR;
#undef PG8_SA
#undef PG8_SB
#undef PG8_STAGE
#undef PG8_LDA
#undef PG8_LDB
#undef PG8_MMA
#undef PG8_WAIT_V
#undef PG8_WAIT_L
#undef PG8_BAR
#undef PG8_SCHED
}

__device__ __forceinline__ void zero_acc(f32x4 (&acc)[2][2][4][2]) {
#pragma unroll
    for (int a = 0; a < 2; ++a)
#pragma unroll
        for (int b = 0; b < 2; ++b)
#pragma unroll
            for (int m = 0; m < 4; ++m)
#pragma unroll
                for (int n = 0; n < 2; ++n) acc[a][b][m][n] = (f32x4){0.f, 0.f, 0.f, 0.f};
}
template <class F> struct EpiF { F f;
    __device__ __forceinline__ void finish(f32x4 (&acc)[2][2][4][2], const UnitDesc& u, int wr, int wc, int fr, int fq) const { epi_apply(acc, u, wr, wc, fr, fq, f); zero_acc(acc); } };

struct TileOrder {
    int nM, nN, nwg, G, c;
    __device__ __forceinline__ void init(int nM_, int nN_, int G_, int c_) { nM = nM_; nN = nN_; nwg = nM * nN; G = G_; c = c_; }
    __device__ __forceinline__ bool tile(int i, int& pm, int& pn) const {
        const long L = (long)i * G + c; if (L >= nwg) return false;
        int wgid = (int)L; { const int q = nwg / 8, r = nwg % 8, xcd = wgid % 8, off = wgid / 8; wgid = (xcd < r ? xcd * (q + 1) : r * (q + 1) + (xcd - r) * q) + off; }
        const int nig = 8 * nN, gid = wgid / nig, fm = gid * 8, gsz = (nM - fm) < 8 ? (nM - fm) : 8;
        pm = fm + ((wgid % nig) % gsz); pn = (wgid % nig) / gsz; return true;
    }
};
struct PlainSched { TileOrder o; const bf16* A; const bf16* Bt; int lda, ldb, K;
    __device__ __forceinline__ bool next(int i, UnitDesc& u) const { int pm, pn; if (!o.tile(i, pm, pn)) return false;
        u.A = (const char*)(A + (size_t)pm * BM * lda); u.B = (const char*)(Bt + (size_t)pn * BM * ldb); u.lda2 = lda * 2; u.ldb2 = ldb * 2; u.nt = K / BK;
        u.row0 = pm * BM; u.col0 = pn * BM; u.aux = 0; u.aux2 = 0; u.gidx = nullptr; u.gcnt = 0; u.chain = 0; return true; } };
}

namespace mx {
typedef short s16x4 __attribute__((ext_vector_type(4)));
typedef __bf16 bf16x8_t __attribute__((ext_vector_type(8)));
typedef __bf16 bf16x4_t __attribute__((ext_vector_type(4)));
typedef float f32x8 __attribute__((ext_vector_type(8)));
__device__ __forceinline__ f32x4 mma(bf16x8 a, bf16x8 b, f32x4 c) { return __builtin_amdgcn_mfma_f32_16x16x32_bf16(a, b, c, 0, 0, 0); }
__device__ __forceinline__ bf16x8 ldsf(LAS unsigned char* p) { return *(LAS bf16x8*)p; }
__device__ __forceinline__ bf16x8 glbf(const bf16* p) { return *(const bf16x8*)p; }
__device__ __forceinline__ bf16x8 trf(LAS unsigned char* p0, LAS unsigned char* p1) {
    const s16x4 a = __builtin_amdgcn_ds_read_tr16_b64_v4i16((LAS s16x4*)p0), b = __builtin_amdgcn_ds_read_tr16_b64_v4i16((LAS s16x4*)p1);
    return __builtin_shufflevector(a, b, 0, 1, 2, 3, 4, 5, 6, 7);
}
__device__ __forceinline__ bf16x8 pack8(f32x4 a, f32x4 b) { const f32x8 v = {a[0], a[1], a[2], a[3], b[0], b[1], b[2], b[3]}; return __builtin_bit_cast(bf16x8, __builtin_convertvector(v, bf16x8_t)); }
__device__ __forceinline__ u32x2 pack4(f32x4 a) { return __builtin_bit_cast(u32x2, __builtin_convertvector(a, bf16x4_t)); }
__device__ __forceinline__ float red_g_max(float v) { v = fmaxf(v, __shfl_xor(v, 16)); return fmaxf(v, __shfl_xor(v, 32)); }
__device__ __forceinline__ float red_g_sum(float v) { v += __shfl_xor(v, 16); return v + __shfl_xor(v, 32); }

constexpr int XA_KP = 272, XA_VP = 288, XA_VOFF = 256 * XA_KP;
__device__ __forceinline__ void xa_phase(LAS unsigned char* lds, bf16* XQ, const bf16* MKV) {
    const int tid = threadIdx.x, lane = tid & 63, wave = __builtin_amdgcn_readfirstlane(tid >> 6), g = lane >> 4, li = lane & 15, q4 = li >> 2, p4 = li & 3;
    for (int it = blockIdx.x; it < NB * 4 * 8; it += gridDim.x) {
        const int b = it >> 5, h = (it >> 3) & 3, qb = it & 7;
        __syncthreads();
#pragma unroll
        for (int i = 0; i < 8; ++i) { const int id = tid + 512 * i, row = id >> 4, ch = id & 15; const bf16* src = MKV + (size_t)(b * MEML + row) * 1024 + h * 128 + ch * 8;
            *(LAS u32x4*)(lds + row * XA_KP + ch * 16) = *(const u32x4*)src; *(LAS u32x4*)(lds + XA_VOFF + row * XA_VP + ch * 16) = *(const u32x4*)(src + 512); }
        __syncthreads();
#pragma unroll 1
        for (int qi = 0; qi < 2; ++qi) {
            bf16* qrow = XQ + (size_t)(b * SEQ + qb * 256 + wave * 32 + qi * 16 + li) * 512 + h * 128;
            bf16x8 qf[4];
#pragma unroll
            for (int s = 0; s < 4; ++s) qf[s] = glbf(qrow + 32 * s + 8 * g);
            f32x4 st[16]; float mx = -3.0e38f;
#pragma unroll
            for (int kf = 0; kf < 16; ++kf) { f32x4 a = {0.f, 0.f, 0.f, 0.f};
#pragma unroll
                for (int s = 0; s < 4; ++s) a = mma(ldsf(lds + (16 * kf + li) * XA_KP + (32 * s + 8 * g) * 2), qf[s], a);
                st[kf] = a; mx = fmaxf(mx, fmaxf(fmaxf(a[0], a[1]), fmaxf(a[2], a[3]))); __builtin_amdgcn_sched_barrier(0); }
            mx = red_g_max(mx); float sum = 0.f;
#pragma unroll
            for (int kf = 0; kf < 16; ++kf) {
#pragma unroll
                for (int r = 0; r < 4; ++r) { const float e = __expf(st[kf][r] - mx); st[kf][r] = e; sum += e; } }
            sum = red_g_sum(sum); const float inv = 1.0f / sum;
            f32x4 o[8];
#pragma unroll
            for (int df = 0; df < 8; ++df) o[df] = (f32x4){0.f, 0.f, 0.f, 0.f};
#pragma unroll
            for (int x = 0; x < 8; ++x) { const bf16x8 pf = pack8(st[2 * x], st[2 * x + 1]);
                LAS unsigned char* vb = lds + XA_VOFF + (32 * x + 4 * g + q4) * XA_VP + 8 * p4;
#pragma unroll
                for (int df = 0; df < 8; ++df) o[df] = mma(trf(vb + 32 * df, vb + 16 * XA_VP + 32 * df), pf, o[df]); __builtin_amdgcn_sched_barrier(0); }
#pragma unroll
            for (int df = 0; df < 8; ++df) *(u32x2*)(qrow + 16 * df + 4 * g) = pack4(o[df] * inv);
        }
    }
}

constexpr int NA_VP = 144;
__device__ __forceinline__ void na_phase(LAS unsigned char* lds, bf16* NQ, const bf16* NK, const bf16* NV, const bf16* FT) {
    const int tid = threadIdx.x, lane = tid & 63, wave = __builtin_amdgcn_readfirstlane(tid >> 6), g = lane >> 4, li = lane & 15, q4 = li >> 2, p4 = li & 3;
    const int ri = wave >> 2, qf = wave & 3, c0 = 16 * qf, w0 = qf == 0 ? 0 : (qf == 1 ? 8 : (qf == 2 ? 24 : 32));
    for (int it = blockIdx.x; it < NB * 8 * 16; it += gridDim.x) {
        const int b = it >> 7, h = (it >> 4) & 7, rp = it & 15;
        int krmin = 2 * rp - 4; krmin = krmin < 0 ? 0 : (krmin > 24 ? 24 : krmin);
        __syncthreads();
#pragma unroll
        for (int i = 0; i < 9; ++i) { const int id = tid + 512 * i, trow = id >> 3, ch = id & 7; int kr = krmin + (trow >> 6); kr = kr > 31 ? 31 : kr;
            *(LAS u32x4*)(lds + trow * NA_VP + ch * 16) = *(const u32x4*)(NV + (size_t)(b * SEQ + kr * 64 + (trow & 63)) * 512 + h * 64 + ch * 8); }
        __syncthreads();
        const int r = 2 * rp + ri; int rs = r - 4; rs = rs < 0 ? 0 : (rs > 24 ? 24 : rs);
        bf16* qrow = NQ + (size_t)(b * SEQ + r * 64 + c0 + li) * 512 + h * 64;
        const bf16x8 q0 = glbf(qrow + 8 * g), q1 = glbf(qrow + 32 + 8 * g);
        bf16x8 e0, e1;
#pragma unroll
        for (int j = 0; j < 8; ++j) { e0[j] = (8 * g + j == c0 + li) ? (short)0x3F80 : (short)0; e1[j] = (32 + 8 * g + j == c0 + li) ? (short)0x3F80 : (short)0; }
        f32x4 st[16]; float mx = -3.0e38f;
#pragma unroll
        for (int kri = 0; kri < 8; ++kri) { const int kr = rs + kri;
#pragma unroll
            for (int cf = 0; cf < 2; ++cf) { const int kc = w0 + 16 * cf + li;
                const bf16* kp = NK + (size_t)(b * SEQ + kr * 64 + kc) * 512 + h * 64 + 8 * g;
                const bf16* fp = FT + ((size_t)((h * 15 + (kr - r + 7)) * 64 + kc)) * 64 + 8 * g;
                f32x4 a = {0.f, 0.f, 0.f, 0.f};
                a = mma(glbf(kp), q0, a); a = mma(glbf(kp + 32), q1, a); a = mma(glbf(fp), e0, a); a = mma(glbf(fp + 32), e1, a);
                st[kri * 2 + cf] = a; mx = fmaxf(mx, fmaxf(fmaxf(a[0], a[1]), fmaxf(a[2], a[3]))); } __builtin_amdgcn_sched_barrier(0); }
        mx = red_g_max(mx); float sum = 0.f;
#pragma unroll
        for (int f = 0; f < 16; ++f) {
#pragma unroll
            for (int rr = 0; rr < 4; ++rr) { const float e = __expf(st[f][rr] - mx); st[f][rr] = e; sum += e; } }
        sum = red_g_sum(sum); const float inv = 1.0f / sum;
        f32x4 o[4];
#pragma unroll
        for (int df = 0; df < 4; ++df) o[df] = (f32x4){0.f, 0.f, 0.f, 0.f};
#pragma unroll
        for (int x = 0; x < 8; ++x) { const bf16x8 pf = pack8(st[2 * x], st[2 * x + 1]);
            LAS unsigned char* vb = lds + ((rs + x - krmin) * 64 + w0 + 4 * g + q4) * NA_VP + 8 * p4;
#pragma unroll
            for (int df = 0; df < 4; ++df) o[df] = mma(trf(vb + 32 * df, vb + 16 * NA_VP + 32 * df), pf, o[df]); __builtin_amdgcn_sched_barrier(0); }
#pragma unroll
        for (int df = 0; df < 4; ++df) *(u32x2*)(qrow + 16 * df + 4 * g) = pack4(o[df] * inv);
    }
}

constexpr int RT_P = 272, RT_VP = 544, RT_QOFF = 0, RT_KOFF = 128 * RT_P, RT_VOFF = 2 * 128 * RT_P, RT_RED = RT_VOFF + 128 * RT_VP, RT_STAT = RT_RED + 8 * 128 * 8;
__device__ __forceinline__ void ret_out_phase(LAS unsigned char* lds, const bf16* RQ, const bf16* RK, const bf16* RV, bf16* RG, const bf16* ST, const float* gain, const float* decf, const float* decb) {
    const int tid = threadIdx.x, lane = tid & 63, wave = __builtin_amdgcn_readfirstlane(tid >> 6), g = lane >> 4, li = lane & 15, q4 = li >> 2, p4 = li & 3;
    for (int it = blockIdx.x; it < NB * 4 * 16; it += gridDim.x) {
        const int b = it >> 6, h = (it >> 4) & 3, n = it & 15; const size_t tok0 = (size_t)b * SEQ + n * 128;
        const float lgf = -log1pf(expf(-decf[h])), lgb = -log1pf(expf(-decb[h]));
        __syncthreads();
#pragma unroll
        for (int i = 0; i < 4; ++i) { const int id = tid + 512 * i, row = id >> 4, ch = id & 15;
            *(LAS u32x4*)(lds + RT_QOFF + row * RT_P + ch * 16) = *(const u32x4*)(RQ + (tok0 + row) * 512 + h * 128 + ch * 8);
            *(LAS u32x4*)(lds + RT_KOFF + row * RT_P + ch * 16) = *(const u32x4*)(RK + (tok0 + row) * 512 + h * 128 + ch * 8); }
#pragma unroll
        for (int i = 0; i < 8; ++i) { const int id = tid + 512 * i, row = id >> 5, ch = id & 31;
            *(LAS u32x4*)(lds + RT_VOFF + row * RT_VP + ch * 16) = *(const u32x4*)(RV + (tok0 + row) * 1024 + h * 256 + ch * 8); }
        __syncthreads();
        { bf16x8 qf[4];
#pragma unroll
          for (int s = 0; s < 4; ++s) qf[s] = ldsf(lds + RT_QOFF + (16 * wave + li) * RT_P + (32 * s + 8 * g) * 2);
          f32x4 st[8]; const int pi = 16 * wave + li;
#pragma unroll
          for (int jf = 0; jf < 8; ++jf) { f32x4 a = {0.f, 0.f, 0.f, 0.f};
#pragma unroll
              for (int s = 0; s < 4; ++s) a = mma(ldsf(lds + RT_KOFF + (16 * jf + li) * RT_P + (32 * s + 8 * g) * 2), qf[s], a);
#pragma unroll
              for (int r = 0; r < 4; ++r) { const int pj = 16 * jf + 4 * g + r; a[r] *= (pj <= pi) ? __expf((float)(pi - pj) * lgf) : __expf((float)(pj - pi) * lgb); }
              st[jf] = a; __builtin_amdgcn_sched_barrier(0); }
          __syncthreads();
#pragma unroll
          for (int jf = 0; jf < 8; ++jf) *(LAS u32x2*)(lds + RT_KOFF + pi * RT_P + (16 * jf + 4 * g) * 2) = pack4(st[jf]);
        }
        __syncthreads();
        f32x4 y[2][8];
#pragma unroll
        for (int a = 0; a < 2; ++a)
#pragma unroll
            for (int i = 0; i < 8; ++i) y[a][i] = (f32x4){0.f, 0.f, 0.f, 0.f};
        const bf16* sfp = ST + ((size_t)(((b * 4 + h) * 2 + 0) * 16 + n) * 256 + 32 * wave + li) * 128 + 8 * g;
        const bf16* sbp = ST + ((size_t)(((b * 4 + h) * 2 + 1) * 16 + n) * 256 + 32 * wave + li) * 128 + 8 * g;
        { bf16x8 sf[2][4];
#pragma unroll
          for (int a = 0; a < 2; ++a)
#pragma unroll
              for (int s = 0; s < 4; ++s) sf[a][s] = glbf(sfp + a * 16 * 128 + 32 * s);
#pragma unroll
          for (int i = 0; i < 8; ++i) {
#pragma unroll
              for (int s = 0; s < 4; ++s) { const bf16x8 qfr = ldsf(lds + RT_QOFF + (16 * i + li) * RT_P + (32 * s + 8 * g) * 2); y[0][i] = mma(sf[0][s], qfr, y[0][i]); y[1][i] = mma(sf[1][s], qfr, y[1][i]); }
              const int pi = 16 * i + li; const float ratio = __expf((float)(pi + 1) * lgf - (float)(128 - pi) * lgb);
              y[0][i] = y[0][i] * ratio; y[1][i] = y[1][i] * ratio; __builtin_amdgcn_sched_barrier(0); } }
        { bf16x8 sf[2][4];
#pragma unroll
          for (int a = 0; a < 2; ++a)
#pragma unroll
              for (int s = 0; s < 4; ++s) sf[a][s] = glbf(sbp + a * 16 * 128 + 32 * s);
#pragma unroll
          for (int i = 0; i < 8; ++i) {
#pragma unroll
              for (int s = 0; s < 4; ++s) { const bf16x8 qfr = ldsf(lds + RT_QOFF + (16 * i + li) * RT_P + (32 * s + 8 * g) * 2); y[0][i] = mma(sf[0][s], qfr, y[0][i]); y[1][i] = mma(sf[1][s], qfr, y[1][i]); }
              const int pi = 16 * i + li; const float ab = __expf((float)(128 - pi) * lgb);
              y[0][i] = y[0][i] * ab; y[1][i] = y[1][i] * ab; __builtin_amdgcn_sched_barrier(0); } }
#pragma unroll
        for (int x = 0; x < 4; ++x) {
            LAS unsigned char* vb = lds + RT_VOFF + (32 * x + 8 * g + q4) * RT_VP + (32 * wave) * 2 + 8 * p4;
            const bf16x8 v0 = trf(vb, vb + 4 * RT_VP), v1 = trf(vb + 32, vb + 4 * RT_VP + 32);
#pragma unroll
            for (int i = 0; i < 8; ++i) { const bf16x8 pfr = ldsf(lds + RT_KOFF + (16 * i + li) * RT_P + (32 * x + 8 * g) * 2); y[0][i] = mma(v0, pfr, y[0][i]); y[1][i] = mma(v1, pfr, y[1][i]); } __builtin_amdgcn_sched_barrier(0); }
#pragma unroll
        for (int i = 0; i < 8; ++i) { float s1 = 0.f, s2 = 0.f;
#pragma unroll
            for (int a = 0; a < 2; ++a)
#pragma unroll
                for (int r = 0; r < 4; ++r) { const float v = y[a][i][r]; s1 += v; s2 += v * v; }
            s1 = red_g_sum(s1); s2 = red_g_sum(s2);
            if (g == 0) { LAS float* rp = (LAS float*)(lds + RT_RED) + (wave * 128 + 16 * i + li) * 2; rp[0] = s1; rp[1] = s2; } }
        __syncthreads();
        if (tid < 128) { float s1 = 0.f, s2 = 0.f;
#pragma unroll
            for (int w = 0; w < 8; ++w) { const LAS float* rp = (const LAS float*)(lds + RT_RED) + (w * 128 + tid) * 2; s1 += rp[0]; s2 += rp[1]; }
            const float mu = s1 * (1.f / 256.f); const float var = fmaxf(s2 * (1.f / 256.f) - mu * mu, 0.f);
            LAS float* sp = (LAS float*)(lds + RT_STAT) + tid * 2; sp[0] = mu; sp[1] = 1.0f / sqrtf(var + GN_EPS); }
        __syncthreads();
        const f32x4 gn0 = *(const f32x4*)(gain + h * 256 + 32 * wave + 4 * g), gn1 = *(const f32x4*)(gain + h * 256 + 32 * wave + 16 + 4 * g);
#pragma unroll
        for (int i = 0; i < 8; ++i) { const LAS float* sp = (const LAS float*)(lds + RT_STAT) + (16 * i + li) * 2; const float mu = sp[0], rstd = sp[1];
            bf16* gp = RG + (tok0 + 16 * i + li) * 1024 + h * 256 + 32 * wave + 4 * g;
#pragma unroll
            for (int a = 0; a < 2; ++a) { const u32x2 gv = *(const u32x2*)(gp + 16 * a); const f32x4 gg = a ? gn1 : gn0;
                f32x4 o; o[0] = (y[a][i][0] - mu) * rstd * gg[0] * bf2f(gv.x & 0xffffu); o[1] = (y[a][i][1] - mu) * rstd * gg[1] * bf2f(gv.x >> 16);
                o[2] = (y[a][i][2] - mu) * rstd * gg[2] * bf2f(gv.y & 0xffffu); o[3] = (y[a][i][3] - mu) * rstd * gg[3] * bf2f(gv.y >> 16);
                *(u32x2*)(gp + 16 * a) = pack4(o); } }
    }
}

constexpr int RS_KP = 272, RS_VP = 144, RS_VOFF = 128 * RS_KP;
__device__ __forceinline__ void ret_state_phase(LAS unsigned char* lds, const bf16* RK, const bf16* RV, bf16* ST, const float* decf, const float* decb) {
    const int tid = threadIdx.x, lane = tid & 63, wave = __builtin_amdgcn_readfirstlane(tid >> 6), g = lane >> 4, li = lane & 15, q4 = li >> 2, p4 = li & 3;
    for (int it = blockIdx.x; it < NB * 4 * 2 * 4; it += gridDim.x) {
        const int es = it & 3, dir = (it >> 2) & 1, h = (it >> 3) & 3, b = it >> 5;
        const float lg = -log1pf(expf(-(dir ? decb[h] : decf[h]))); const float cd = __expf(128.f * lg);
        f32x4 st[4];
#pragma unroll
        for (int ef = 0; ef < 4; ++ef) st[ef] = (f32x4){0.f, 0.f, 0.f, 0.f};
#pragma unroll 1
        for (int cc = 0; cc < 16; ++cc) { const int n = dir ? 15 - cc : cc; const size_t tok0 = (size_t)b * SEQ + n * 128;
            bf16* sp = ST + ((size_t)(((b * 4 + h) * 2 + dir) * 16 + n) * 256 + es * 64 + 4 * g) * 128 + 16 * wave + li;
#pragma unroll
            for (int ef = 0; ef < 4; ++ef)
#pragma unroll
                for (int r = 0; r < 4; ++r) sp[(16 * ef + r) * 128] = (bf16)f2bf(st[ef][r]);
            __syncthreads();
#pragma unroll
            for (int i = 0; i < 4; ++i) { const int id = tid + 512 * i, row = id >> 4, ch = id & 15;
                float v[8]; unpack8(*(const u32x4*)(RK + (tok0 + row) * 512 + h * 128 + ch * 8), v);
                const float w = __expf((float)(dir ? row : 127 - row) * lg);
                u32x4 o; o.x = pk2(v[0] * w, v[1] * w); o.y = pk2(v[2] * w, v[3] * w); o.z = pk2(v[4] * w, v[5] * w); o.w = pk2(v[6] * w, v[7] * w);
                *(LAS u32x4*)(lds + row * RS_KP + ch * 16) = o; }
#pragma unroll
            for (int i = 0; i < 2; ++i) { const int id = tid + 512 * i, row = id >> 3, ch = id & 7;
                *(LAS u32x4*)(lds + RS_VOFF + row * RS_VP + ch * 16) = *(const u32x4*)(RV + (tok0 + row) * 1024 + h * 256 + es * 64 + ch * 8); }
            __syncthreads();
#pragma unroll
            for (int ef = 0; ef < 4; ++ef) st[ef] = st[ef] * cd;
#pragma unroll
            for (int x = 0; x < 4; ++x) {
                LAS unsigned char* kb = lds + (32 * x + 8 * g + q4) * RS_KP + (16 * wave) * 2 + 8 * p4;
                const bf16x8 kfr = trf(kb, kb + 4 * RS_KP);
                LAS unsigned char* vb = lds + RS_VOFF + (32 * x + 8 * g + q4) * RS_VP + 8 * p4;
#pragma unroll
                for (int ef = 0; ef < 4; ++ef) st[ef] = mma(trf(vb + 32 * ef, vb + 4 * RS_VP + 32 * ef), kfr, st[ef]); __builtin_amdgcn_sched_barrier(0); }
        }
    }
}
}

struct Ptrs {
    const float* in[23]; float* out; unsigned char* ws;
    __device__ bf16* b(size_t off) const { return (bf16*)(ws + off); }
    __device__ float* f(size_t off) const { return (float*)(ws + off); }
};

__device__ __forceinline__ void phase0(const Ctx& c, const Ptrs& P) {
    transpose_all(c, ColWA{P.in[3]}, 8192, NPA, 1024, P.b(WS_WA));
    transpose_all(c, ColOff{P.in[3], NPA}, 8192, NPG, 1024, P.b(WS_WG));
    transpose_all(c, ColPlain{P.in[11]}, 1024, 1024, 1024, P.b(WS_WKV));
    transpose_all(c, ColPlain{P.in[7]}, 1024, 1024, 1024, P.b(WS_WRO));
    transpose_all(c, ColPlain{P.in[9]}, 1024, 1024, 512, P.b(WS_WNO));
    transpose_all(c, ColPlain{P.in[12]}, 1024, 1024, 512, P.b(WS_WXO));
    transpose_all(c, ColPlain{P.in[13]}, 1024, 1024, 1024, P.b(WS_WOUT));
    { float* COS = P.f(WS_COS); float* SIN = P.f(WS_SIN);
      for (int i = c.gw * 64 + c.lane; i < SEQ * 64; i += c.ngw * 64) { const int pos = i >> 6, fi = i & 63;
          const float inv = (float)pow(10000.0, -(double)fi / 64.0); const float ang = (float)pos * inv;
          COS[i] = (float)cos((double)ang); SIN[i] = (float)sin((double)ang); } }
    { bf16* FT = P.b(WS_FT); const float* rpb = P.in[8];
      for (int i = c.gw * 64 + c.lane; i < 8 * 15 * 64 * 64; i += c.ngw * 64) { const int qc = i & 63, kc = (i >> 6) & 63, hr = i >> 12;
          int cs = qc - 8; cs = cs < 0 ? 0 : (cs > 48 ? 48 : cs); int rc = kc - qc; rc = rc < -15 ? -15 : (rc > 15 ? 15 : rc);
          const float v = (kc >= cs && kc < cs + 16) ? rpb[hr * 31 + rc + 15] : -1.0e30f; FT[i] = (bf16)f2bf(v); } }
    for (int m = c.gw; m < T; m += c.ngw) rms_row_to_bf16(P.in[0] + (size_t)m * DM, P.in[2], P.b(WS_XN) + (size_t)m * DM, c.lane);
    for (int m = c.gw; m < TM; m += c.ngw) rms_row_to_bf16(P.in[1] + (size_t)m * DM, P.in[10], P.b(WS_MN) + (size_t)m * DM, c.lane);
}

__device__ __forceinline__ void phase1_naive(const Ctx& c, const Ptrs& P) {
    EpiProjA E{P.b(WS_RQ), P.b(WS_RK), P.b(WS_RV), P.b(WS_RG), P.b(WS_NQ), P.b(WS_NK), P.b(WS_NV), P.b(WS_XQ), P.f(WS_COS), P.f(WS_SIN)};
    naive_gemm(c, RowPlain{P.b(WS_XN), DM}, P.b(WS_WA), DM, T, NPA, DM, E);
}

__device__ __forceinline__ float log_sigmoid_(float x) { return -log1pf(expf(-x)); }

__device__ __forceinline__ void phase2_states_naive(const Ctx& c, const Ptrs& P) {
    const bf16* RK = P.b(WS_RK); const bf16* RV = P.b(WS_RV); bf16* ST = (bf16*)P.out;
    const int nitems = NB * 4 * 2 * 128 * 4;
    for (int it = c.gw; it < nitems; it += c.ngw) {
        const int eb = it & 3, d = (it >> 2) & 127, dir = (it >> 9) & 1, h = (it >> 10) & 3, b = it >> 12;
        const int e = eb * 64 + c.lane;
        const float lg = log_sigmoid_(dir ? P.in[5][h] : P.in[4][h]); const float gam = expf(lg);
        float S = 0.f;
        bf16* stb = ST + (size_t)(((b * 4 + h) * 2 + dir) * 16) * 256 * 128 + (size_t)e * 128 + d;
        for (int jj = 0; jj < SEQ; ++jj) {
            const int j = dir ? (SEQ - 1 - jj) : jj;
            if ((jj & 127) == 0) { const int n = j >> 7; stb[(size_t)n * 256 * 128] = (bf16)f2bf(S); }
            const size_t tok = (size_t)b * SEQ + j;
            const float kv = bf2f(RK[tok * 512 + h * 128 + d]) * bf2f(RV[tok * 1024 + h * 256 + e]);
            S = S * gam + kv;
        }
    }
}
__device__ __forceinline__ void phase2_na_naive(const Ctx& c, const Ptrs& P) {
    bf16* NQ = P.b(WS_NQ); const bf16* NK = P.b(WS_NK); const bf16* NV = P.b(WS_NV); const float* rpb = P.in[8];
    float* scr = (float*)(c.lds + c.wave * 16384);
    const int lane = c.lane;
    for (int it = c.gw; it < T * 8; it += c.ngw) {
        const int h = it & 7, tok = it >> 3, b = tok >> 11, s = tok & 2047, r = s >> 6, cc = s & 63;
        int rs = r - 4; rs = rs < 0 ? 0 : (rs > 24 ? 24 : rs);
        int cs = cc - 8; cs = cs < 0 ? 0 : (cs > 48 ? 48 : cs);
        scr[128 + lane] = bf2f(NQ[(size_t)tok * 512 + h * 64 + lane]);
        __builtin_amdgcn_s_waitcnt(0xC07F); asm volatile("" ::: "memory");
        float sc[2];
#pragma unroll
        for (int t = 0; t < 2; ++t) { const int key = lane + 64 * t, kr = rs + (key >> 4), kc = cs + (key & 15);
            const size_t kt = (size_t)b * SEQ + kr * 64 + kc; const u32x4* kp = (const u32x4*)(NK + kt * 512 + h * 64);
            float a = 0.f;
#pragma unroll 2
            for (int i = 0; i < 8; ++i) { float kk[8]; unpack8(kp[i], kk);
#pragma unroll
                for (int u = 0; u < 8; ++u) a += scr[128 + 8 * i + u] * kk[u]; }
            int rc = kc - cc; rc = rc < -15 ? -15 : (rc > 15 ? 15 : rc);
            sc[t] = a + rpb[(h * 15 + (kr - r + 7)) * 31 + rc + 15]; }
        const float mx = wave_max(fmaxf(sc[0], sc[1]));
        const float e0 = __expf(sc[0] - mx), e1 = __expf(sc[1] - mx);
        const float inv = 1.0f / wave_sum(e0 + e1);
        scr[lane] = e0 * inv; scr[lane + 64] = e1 * inv;
        __builtin_amdgcn_s_waitcnt(0xC07F); asm volatile("" ::: "memory");
        float o = 0.f;
        for (int key = 0; key < 128; ++key) { const int kr = rs + (key >> 4), kc = cs + (key & 15);
            const size_t kt = (size_t)b * SEQ + kr * 64 + kc; o += scr[key] * bf2f(NV[kt * 512 + h * 64 + lane]); }
        NQ[(size_t)tok * 512 + h * 64 + lane] = (bf16)f2bf(o);
        __builtin_amdgcn_s_waitcnt(0xC07F); asm volatile("" ::: "memory");
    }
}
__device__ __forceinline__ void phase2_memkv_naive(const Ctx& c, const Ptrs& P) {
    naive_gemm(c, RowPlain{P.b(WS_MN), DM}, P.b(WS_WKV), DM, TM, 1024, DM, EpiBf16Plain{P.b(WS_MKV), 1024});
}
__device__ __forceinline__ void phase3_ret_naive(const Ctx& c, const Ptrs& P) {
    const bf16* RQ = P.b(WS_RQ); const bf16* RK = P.b(WS_RK); const bf16* RV = P.b(WS_RV); bf16* RG = P.b(WS_RG); const bf16* ST = (const bf16*)P.out;
    const float* gain = P.in[6];
    float* scr = (float*)(c.lds + c.wave * 16384);
    const int lane = c.lane;
    for (int it = c.gw; it < T * 4; it += c.ngw) {
        const int h = it & 3, tok = it >> 2, b = tok >> 11, s = tok & 2047, n = s >> 7, p = s & 127;
        const float lgf = log_sigmoid_(P.in[4][h]), lgb = log_sigmoid_(P.in[5][h]);
        { const bf16* qp = RQ + (size_t)tok * 512 + h * 128; scr[lane] = bf2f(qp[lane]); scr[lane + 64] = bf2f(qp[lane + 64]); }
        __builtin_amdgcn_s_waitcnt(0xC07F); asm volatile("" ::: "memory");
        float sv[2];
#pragma unroll
        for (int t = 0; t < 2; ++t) { const int pj = lane + 64 * t; const size_t kt = (size_t)b * SEQ + n * 128 + pj;
            const u32x4* kp = (const u32x4*)(RK + kt * 512 + h * 128); float a = 0.f;
#pragma unroll 2
            for (int i = 0; i < 16; ++i) { float kk[8]; unpack8(kp[i], kk);
#pragma unroll
                for (int u = 0; u < 8; ++u) a += scr[8 * i + u] * kk[u]; }
            const float w = (pj <= p) ? expf((float)(p - pj) * lgf) : expf((float)(pj - p) * lgb);
            sv[t] = a * w; }
        scr[128 + lane] = sv[0]; scr[128 + 64 + lane] = sv[1];
        __builtin_amdgcn_s_waitcnt(0xC07F); asm volatile("" ::: "memory");
        const float af = expf((float)(p + 1) * lgf), ab = expf((float)(128 - p) * lgb);
        const bf16* sf = ST + (size_t)(((b * 4 + h) * 2 + 0) * 16 + n) * 256 * 128;
        const bf16* sb = ST + (size_t)(((b * 4 + h) * 2 + 1) * 16 + n) * 256 * 128;
        float y[4];
#pragma unroll 1
        for (int eb = 0; eb < 4; ++eb) { const int e = eb * 64 + lane; float a = 0.f;
#pragma unroll 4
            for (int pj = 0; pj < 128; ++pj) { const size_t kt = (size_t)b * SEQ + n * 128 + pj; a += scr[128 + pj] * bf2f(RV[kt * 1024 + h * 256 + e]); }
            float cf = 0.f, cb = 0.f; const u32x4* fp = (const u32x4*)(sf + (size_t)e * 128); const u32x4* bp = (const u32x4*)(sb + (size_t)e * 128);
#pragma unroll 2
            for (int i = 0; i < 16; ++i) { float x1[8], x2[8]; unpack8(fp[i], x1); unpack8(bp[i], x2);
#pragma unroll
                for (int u = 0; u < 8; ++u) { cf += scr[8 * i + u] * x1[u]; cb += scr[8 * i + u] * x2[u]; } }
            y[eb] = a + af * cf + ab * cb; }
        const float mu = wave_sum((y[0] + y[1]) + (y[2] + y[3])) * (1.f / 256.f);
        float v = 0.f;
#pragma unroll
        for (int eb = 0; eb < 4; ++eb) { y[eb] -= mu; v += y[eb] * y[eb]; }
        const float rstd = 1.0f / sqrtf(wave_sum(v) * (1.f / 256.f) + GN_EPS);
#pragma unroll
        for (int eb = 0; eb < 4; ++eb) { const int col = h * 256 + eb * 64 + lane; bf16* g = RG + (size_t)tok * 1024 + col;
            *g = (bf16)f2bf(y[eb] * rstd * gain[col] * bf2f(*g)); }
        __builtin_amdgcn_s_waitcnt(0xC07F); asm volatile("" ::: "memory");
    }
}
__device__ __forceinline__ void phase3_xa_naive(const Ctx& c, const Ptrs& P) {
    bf16* XQ = P.b(WS_XQ); const bf16* MKV = P.b(WS_MKV);
    float* scr = (float*)(c.lds + c.wave * 16384);
    const int lane = c.lane;
    for (int it = c.gw; it < T * 4; it += c.ngw) {
        const int h = it & 3, tok = it >> 2, b = tok >> 11;
        { const bf16* qp = XQ + (size_t)tok * 512 + h * 128; scr[lane] = bf2f(qp[lane]); scr[lane + 64] = bf2f(qp[lane + 64]); }
        __builtin_amdgcn_s_waitcnt(0xC07F); asm volatile("" ::: "memory");
        float sc[4]; float mx = -3.0e38f;
#pragma unroll
        for (int t = 0; t < 4; ++t) { const int m = lane + 64 * t; const u32x4* kp = (const u32x4*)(MKV + (size_t)(b * MEML + m) * 1024 + h * 128); float a = 0.f;
#pragma unroll 2
            for (int i = 0; i < 16; ++i) { float kk[8]; unpack8(kp[i], kk);
#pragma unroll
                for (int u = 0; u < 8; ++u) a += scr[8 * i + u] * kk[u]; }
            sc[t] = a; mx = fmaxf(mx, a); }
        mx = wave_max(mx); float sum = 0.f;
#pragma unroll
        for (int t = 0; t < 4; ++t) { sc[t] = __expf(sc[t] - mx); sum += sc[t]; }
        const float inv = 1.0f / wave_sum(sum);
#pragma unroll
        for (int t = 0; t < 4; ++t) scr[128 + lane + 64 * t] = sc[t] * inv;
        __builtin_amdgcn_s_waitcnt(0xC07F); asm volatile("" ::: "memory");
        float o0 = 0.f, o1 = 0.f;
        for (int m = 0; m < MEML; ++m) { const bf16* vp = MKV + (size_t)(b * MEML + m) * 1024 + 512 + h * 128; const float pm = scr[128 + m];
            o0 += pm * bf2f(vp[lane]); o1 += pm * bf2f(vp[lane + 64]); }
        bf16* op = XQ + (size_t)tok * 512 + h * 128; op[lane] = (bf16)f2bf(o0); op[lane + 64] = (bf16)f2bf(o1);
        __builtin_amdgcn_s_waitcnt(0xC07F); asm volatile("" ::: "memory");
    }
}
__device__ __forceinline__ void phase4_naive(const Ctx& c, const Ptrs& P) {
    naive_gemm(c, RowPlain{P.b(WS_XN), DM}, P.b(WS_WG), DM, T, NPG, DM, EpiSigmoid{P.b(WS_GATES), NPG});
}
__device__ __forceinline__ void phase5_naive(const Ctx& c, const Ptrs& P) {
    float* TMP = P.out; bf16* MIX = P.b(WS_MIX); const bf16* G = P.b(WS_GATES);
    naive_gemm(c, RowPlain{P.b(WS_RG), 1024}, P.b(WS_WRO), 1024, T, DM, 1024, EpiMixNaive<0>{TMP, MIX, G});
    naive_gemm(c, RowPlain{P.b(WS_NQ), 512}, P.b(WS_WNO), 512, T, DM, 512, EpiMixNaive<1>{TMP, MIX, G + 1024});
    naive_gemm(c, RowPlain{P.b(WS_XQ), 512}, P.b(WS_WXO), 512, T, DM, 512, EpiMixNaive<2>{TMP, MIX, G + 2048});
}
__device__ __forceinline__ void phase6_naive(const Ctx& c, const Ptrs& P) {
    naive_gemm(c, RowPlain{P.b(WS_MIX), DM}, P.b(WS_WOUT), DM, T, DM, DM, EpiResidF32{P.in[0], P.out});
}

__device__ __forceinline__ void phase1_mfma(const Ctx& c, const Ptrs& P) {
    EpiProjA E{P.b(WS_RQ), P.b(WS_RK), P.b(WS_RV), P.b(WS_RG), P.b(WS_NQ), P.b(WS_NK), P.b(WS_NV), P.b(WS_XQ), P.f(WS_COS), P.f(WS_SIN)};
    pg8::PlainSched S; S.o.init(T / 256, NPA / 256, gridDim.x, blockIdx.x); S.A = P.b(WS_XN); S.Bt = P.b(WS_WA); S.lda = DM; S.ldb = DM; S.K = DM;
    pg8::gemm_phase<false>((LAS unsigned char*)c.lds, S, pg8::EpiF<EpiProjA>{E});
}
__device__ __forceinline__ void phase4_mfma(const Ctx& c, const Ptrs& P) {
    pg8::PlainSched S; S.o.init(T / 256, NPG / 256, gridDim.x, blockIdx.x); S.A = P.b(WS_XN); S.Bt = P.b(WS_WG); S.lda = DM; S.ldb = DM; S.K = DM;
    pg8::gemm_phase<false>((LAS unsigned char*)c.lds, S, pg8::EpiF<EpiSigmoid>{EpiSigmoid{P.b(WS_GATES), NPG}});
}
__device__ __forceinline__ void phase6_mfma(const Ctx& c, const Ptrs& P) {
    pg8::PlainSched S; S.o.init(T / 256, DM / 256, gridDim.x, blockIdx.x); S.A = P.b(WS_MIX); S.Bt = P.b(WS_WOUT); S.lda = DM; S.ldb = DM; S.K = DM;
    pg8::gemm_phase<false>((LAS unsigned char*)c.lds, S, pg8::EpiF<EpiResidF32>{EpiResidF32{P.in[0], P.out}});
}

struct MixSched { pg8::TileOrder o; const unsigned char* ws;
    __device__ __forceinline__ bool next(int i, pg8::UnitDesc& u) const { int pm, pn; const int w = i % 3; if (!o.tile(i / 3, pm, pn)) return false;
        const size_t offA = w == 0 ? WS_RG : (w == 1 ? WS_NQ : WS_XQ), offB = w == 0 ? WS_WRO : (w == 1 ? WS_WNO : WS_WXO); const int K = w == 0 ? 1024 : 512;
        u.A = (const char*)(ws + offA) + (size_t)pm * 256 * K * 2; u.B = (const char*)(ws + offB) + (size_t)pn * 256 * K * 2; u.lda2 = K * 2; u.ldb2 = K * 2; u.nt = K / 64;
        u.row0 = pm * 256; u.col0 = pn * 256; u.aux = w; u.aux2 = 0; u.gidx = nullptr; u.gcnt = 0; u.chain = (w < 2); return true; } };
struct EpiMix { const bf16* G; bf16* MIX;
    __device__ __forceinline__ void finish(f32x4 (&acc)[2][2][4][2], const pg8::UnitDesc& u, int wr, int wc, int fr, int fq) const {
        const int w = u.aux; const bool fin = (w == 2);
        const bf16* gp = G + (size_t)(u.row0 + wr * 64 + fr) * NPG + u.col0 + wc * 32 + 8 * fq + 1024 * w;
        bf16* mp = MIX + (size_t)(u.row0 + wr * 64 + fr) * DM + u.col0 + wc * 32 + 8 * fq;
        const int doff = fin ? 0 : 1024;
#pragma unroll
        for (int ai = 0; ai < 2; ++ai) {
#pragma unroll
            for (int m = 0; m < 4; ++m) {
                asm volatile("" : "+v"(gp), "+v"(mp));
#pragma unroll
                for (int bj = 0; bj < 2; ++bj) {
                    const u32x4 a = *(const u32x4*)(gp + bj * 128), b = *(const u32x4*)(gp + bj * 128 + doff);
                    float gn[8], gd[8]; unpack8(a, gn); unpack8(b, gd);
                    f32x4 r0, r1;
#pragma unroll
                    for (int i = 0; i < 4; ++i) { const float d0 = fin ? 1.0f : fmaxf(gd[i], 1e-18f), d1 = fin ? 1.0f : fmaxf(gd[4 + i], 1e-18f);
                        r0[i] = fmaxf(gn[i], 1e-18f) * __builtin_amdgcn_rcpf(d0); r1[i] = fmaxf(gn[4 + i], 1e-18f) * __builtin_amdgcn_rcpf(d1); }
                    const f32x4 v0 = acc[ai][bj][m][0] * r0, v1 = acc[ai][bj][m][1] * r1;
                    if (fin) store8(mp + bj * 128, v0, v1);
                    acc[ai][bj][m][0] = fin ? (f32x4){0.f, 0.f, 0.f, 0.f} : v0; acc[ai][bj][m][1] = fin ? (f32x4){0.f, 0.f, 0.f, 0.f} : v1; }
                gp += 16 * NPG; mp += 16 * DM; asm volatile("" ::: "memory"); __builtin_amdgcn_sched_barrier(0); }
            gp += 64 * NPG; mp += 64 * DM; }
    }
};
__device__ __forceinline__ void phase5_mfma(const Ctx& c, const Ptrs& P) {
    MixSched S; S.o.init(T / 256, DM / 256, gridDim.x, blockIdx.x); S.ws = P.ws;
    pg8::gemm_phase<false>((LAS unsigned char*)c.lds, S, EpiMix{P.b(WS_GATES), P.b(WS_MIX)});
}
struct MoeSched { const unsigned* ctl; int G, c; int mode;
    const bf16 *H2, *WGU, *HID, *WD; const int* elist;
    __device__ __forceinline__ bool next(int i, pg8::UnitDesc& u) const {
        const int L = i * G + c; const int pn = L & 3; int mtg = L >> 2;
        int e = -1, base = 0, cnt = 0, mt = 0;
#pragma unroll 1
        for (int j = 0; j < NEXP; ++j) { const int cj = (int)__builtin_amdgcn_readfirstlane((int)ctl[CW_ECNT + 64 * j]); const int tj = (cj + 255) >> 8;
            if (mtg < tj) { e = j; cnt = cj; mt = mtg; break; } mtg -= tj; base += tj * 256; }
        if (e < 0) return false;
        u.row0 = mt * 256; u.col0 = pn * 256; u.aux = e; u.aux2 = base; u.gcnt = cnt; u.chain = 0;
        if (mode == 0) { u.A = (const char*)H2; u.gidx = elist + e * T; u.lda2 = DM * 2; u.B = (const char*)(WGU + (size_t)e * 1024 * 1024 + (size_t)pn * 256 * 1024); u.ldb2 = 2048; u.nt = 16; }
        else { u.A = (const char*)(HID + (size_t)(base + mt * 256) * DFF); u.gidx = nullptr; u.lda2 = DFF * 2; u.B = (const char*)(WD + (size_t)e * 1024 * 512 + (size_t)pn * 256 * 512); u.ldb2 = 1024; u.nt = 8; }
        return true; } };
struct EpiMoeUp { bf16* HID; const float* EWL;
    __device__ __forceinline__ void finish(f32x4 (&acc)[2][2][4][2], const pg8::UnitDesc& u, int wr, int wc, int fr, int fq) const {
        const float* wl = EWL + u.aux * T; bf16* H = HID; const int base = u.aux2, cnt = u.gcnt;
        pg8::epi_apply(acc, u, wr, wc, fr, fq, [=](int row, int col0, f32x4 v0, f32x4 v1) { if (row < cnt) { const float w = wl[row]; f32x4 h;
#pragma unroll
            for (int i = 0; i < 4; ++i) h[i] = siluf_(v0[i]) * v1[i] * w;
            u32x2 o; o.x = pk2(h[0], h[1]); o.y = pk2(h[2], h[3]); *(u32x2*)(H + (size_t)(base + row) * DFF + (col0 >> 1)) = o; } });
        pg8::zero_acc(acc);
    } };
struct EpiMoeDown { bf16* DR;
    __device__ __forceinline__ void finish(f32x4 (&acc)[2][2][4][2], const pg8::UnitDesc& u, int wr, int wc, int fr, int fq) const {
        bf16* D = DR; const int base = u.aux2;
        pg8::epi_apply(acc, u, wr, wc, fr, fq, [=](int row, int col0, f32x4 v0, f32x4 v1) { store8(D + (size_t)(base + row) * DM + col0, v0, v1); });
        pg8::zero_acc(acc);
    } };
__device__ __forceinline__ void phase8_mfma(const Ctx& c, const Ptrs& P) {
    MoeSched S; S.ctl = (const unsigned*)(P.ws + WS_CTL); S.G = gridDim.x; S.c = blockIdx.x; S.mode = 0; S.H2 = P.b(WS_H2); S.WGU = P.b(WS_WGU); S.HID = P.b(WS_HID); S.WD = P.b(WS_WD); S.elist = (const int*)(P.ws + WS_ELIST);
    pg8::gemm_phase<true>((LAS unsigned char*)c.lds, S, EpiMoeUp{P.b(WS_HID), P.f(WS_EWL)});
}
__device__ __forceinline__ void phase9_mfma(const Ctx& c, const Ptrs& P) {
    MoeSched S; S.ctl = (const unsigned*)(P.ws + WS_CTL); S.G = gridDim.x; S.c = blockIdx.x; S.mode = 1; S.H2 = P.b(WS_H2); S.WGU = P.b(WS_WGU); S.HID = P.b(WS_HID); S.WD = P.b(WS_WD); S.elist = (const int*)(P.ws + WS_ELIST);
    pg8::gemm_phase<false>((LAS unsigned char*)c.lds, S, EpiMoeDown{P.b(WS_DROWS)});
}
__device__ __forceinline__ void phase2_memkv_mfma(const Ctx& c, const Ptrs& P) {
    pg8::PlainSched S; S.o.init(TM / 256, 1024 / 256, gridDim.x, blockIdx.x); S.A = P.b(WS_MN); S.Bt = P.b(WS_WKV); S.lda = DM; S.ldb = DM; S.K = DM;
    pg8::gemm_phase<false>((LAS unsigned char*)c.lds, S, pg8::EpiF<EpiBf16Plain>{EpiBf16Plain{P.b(WS_MKV), 1024}});
}
__device__ __forceinline__ void phase7(const Ctx& c, const Ptrs& P) {
    const float* X1 = P.out; const float* g = P.in[14]; const float* wrg = P.in[15]; const float* brg = P.in[16]; const float* wre = P.in[17]; const float* bre = P.in[18];
    bf16* H2 = P.b(WS_H2); unsigned* ctl = (unsigned*)(P.ws + WS_CTL); int* elist = (int*)(P.ws + WS_ELIST); float* ewl = P.f(WS_EWL); int* tmeta = (int*)(P.ws + WS_TMETA);
    const int lane = c.lane;
    for (int tok = c.gw; tok < T; tok += c.ngw) {
        const f32x4* xr = (const f32x4*)(X1 + (size_t)tok * DM) + lane; const f32x4* gr = (const f32x4*)g + lane;
        f32x4 v[4]; float s = 0.f;
#pragma unroll
        for (int j = 0; j < 4; ++j) { v[j] = xr[64 * j]; s += (v[j].x * v[j].x + v[j].y * v[j].y) + (v[j].z * v[j].z + v[j].w * v[j].w); }
        const float r = 1.0f / sqrtf(wave_sum(s) * (1.f / 1024.f) + RMS_EPS);
        float lg[20];
#pragma unroll
        for (int i = 0; i < 20; ++i) lg[i] = 0.f;
        unsigned long long* o8 = (unsigned long long*)(H2 + (size_t)tok * DM) + lane;
#pragma unroll
        for (int j = 0; j < 4; ++j) { const f32x4 gg = gr[64 * j]; const f32x4 hh = {v[j].x * r * gg.x, v[j].y * r * gg.y, v[j].z * r * gg.z, v[j].w * r * gg.w};
            o8[64 * j] = (unsigned long long)pk2(hh.x, hh.y) | ((unsigned long long)pk2(hh.z, hh.w) << 32);
            const int k0 = 4 * lane + 256 * j;
#pragma unroll
            for (int u = 0; u < 4; ++u) { const float hv = hh[u]; const f32x4 wg = *(const f32x4*)(wrg + (size_t)(k0 + u) * 4);
                lg[0] += hv * wg.x; lg[1] += hv * wg.y; lg[2] += hv * wg.z; lg[3] += hv * wg.w;
                const f32x4* we = (const f32x4*)(wre + (size_t)(k0 + u) * 16);
#pragma unroll
                for (int q = 0; q < 4; ++q) { const f32x4 w4 = we[q]; lg[4 + 4 * q] += hv * w4.x; lg[5 + 4 * q] += hv * w4.y; lg[6 + 4 * q] += hv * w4.z; lg[7 + 4 * q] += hv * w4.w; } } }
#pragma unroll
        for (int i = 0; i < 20; ++i) lg[i] = wave_sum(lg[i]);
        if (lane == 0) {
            float gl[4]; int gi = 0;
#pragma unroll
            for (int i = 0; i < 4; ++i) { gl[i] = lg[i] + brg[i]; }
#pragma unroll
            for (int i = 1; i < 4; ++i) if (gl[i] > gl[gi]) gi = i;
            float se = 0.f;
#pragma unroll
            for (int i = 0; i < 4; ++i) se += expf(gl[i] - gl[gi]);
            const float grp_w = 1.0f / se;
            float el[4];
#pragma unroll
            for (int i = 0; i < 4; ++i) { float a = 0.f;
#pragma unroll
                for (int g2 = 0; g2 < 4; ++g2) a = (g2 == gi) ? (lg[4 + 4 * g2 + i] + bre[4 * g2 + i]) : a;
                el[i] = a; }
            int ia = 0;
#pragma unroll
            for (int i = 1; i < 4; ++i) if (el[i] > el[ia]) ia = i;
            int ib = (ia == 0) ? 1 : 0;
#pragma unroll
            for (int i = 0; i < 4; ++i) if (i != ia && i != ib && el[i] > el[ib]) ib = i;
            const float t = expf(el[ib] - el[ia]); const float wa = grp_w / (1.0f + t), wb = grp_w * t / (1.0f + t);
            const int ea = gi * 4 + ia, eb = gi * 4 + ib;
            const int pa = (int)atomicAdd(ctl + CW_ECNT + 64 * ea, 1u), pb = (int)atomicAdd(ctl + CW_ECNT + 64 * eb, 1u);
            elist[ea * T + pa] = tok; ewl[ea * T + pa] = wa; elist[eb * T + pb] = tok; ewl[eb * T + pb] = wb;
            *(int4*)(tmeta + 4 * tok) = make_int4(ea, pa, eb, pb);
        }
    }
    for (int e = 0; e < NEXP; ++e) {
        transpose_all(c, ColGU{P.in[19] + (size_t)e * 1024 * 512, P.in[20] + (size_t)e * 1024 * 512}, 512, 1024, 1024, P.b(WS_WGU) + (size_t)e * 1024 * 1024);
        transpose_all(c, ColPlain{P.in[21] + (size_t)e * 512 * 1024}, 1024, 1024, 512, P.b(WS_WD) + (size_t)e * 1024 * 512);
    }
}
__device__ __forceinline__ int expert_rowbase(const unsigned* ctl, int e, int& cnt_e) {
    int base = 0; cnt_e = 0;
    for (int i = 0; i < NEXP; ++i) { const int ci = (int)ctl[CW_ECNT + 64 * i]; if (i < e) base += (ci + 255) & ~255; if (i == e) cnt_e = ci; }
    return base;
}
__device__ __forceinline__ void phase8_naive(const Ctx& c, const Ptrs& P) {
    const unsigned* ctl = (const unsigned*)(P.ws + WS_CTL);
    for (int e = 0; e < NEXP; ++e) { int cnt; const int base = expert_rowbase(ctl, e, cnt);
        naive_gemm(c, RowGather{P.b(WS_H2), DM, (const int*)(P.ws + WS_ELIST) + e * T}, P.b(WS_WGU) + (size_t)e * 1024 * 1024, 1024, cnt, 1024, 1024,
                   EpiSwiGLU{P.b(WS_HID), P.f(WS_EWL) + e * T, base}); }
}
__device__ __forceinline__ void phase9_naive(const Ctx& c, const Ptrs& P) {
    const unsigned* ctl = (const unsigned*)(P.ws + WS_CTL);
    for (int e = 0; e < NEXP; ++e) { int cnt; const int base = expert_rowbase(ctl, e, cnt);
        naive_gemm(c, RowPlain{P.b(WS_HID) + (size_t)base * DFF, DFF}, P.b(WS_WD) + (size_t)e * 1024 * 512, 512, cnt, 1024, 512, EpiRowsBf16{P.b(WS_DROWS), 1024, base}); }
}
__device__ __forceinline__ void phase10(const Ctx& c, const Ptrs& P) {
    const unsigned* ctl = (const unsigned*)(P.ws + WS_CTL); const int* tmeta = (const int*)(P.ws + WS_TMETA); const bf16* DR = P.b(WS_DROWS); const float* g = P.in[22];
    int rb[NEXP]; { int base = 0;
#pragma unroll
        for (int i = 0; i < NEXP; ++i) { rb[i] = base; base += ((int)ctl[CW_ECNT + 64 * i] + 255) & ~255; } }
    const int lane = c.lane;
    for (int tok = c.gw; tok < T; tok += c.ngw) {
        const int4 m = *(const int4*)(tmeta + 4 * tok);
        int ba = 0, bb = 0;
#pragma unroll
        for (int i = 0; i < NEXP; ++i) { ba = (i == m.x) ? rb[i] : ba; bb = (i == m.z) ? rb[i] : bb; }
        const unsigned long long* da = (const unsigned long long*)(DR + (size_t)(ba + m.y) * DM) + lane;
        const unsigned long long* db = (const unsigned long long*)(DR + (size_t)(bb + m.w) * DM) + lane;
        f32x4* xr = (f32x4*)(P.out + (size_t)tok * DM) + lane; const f32x4* gr = (const f32x4*)g + lane;
        f32x4 v[4]; float s = 0.f;
#pragma unroll
        for (int j = 0; j < 4; ++j) { const unsigned long long a = da[64 * j], b = db[64 * j]; f32x4 x = xr[64 * j];
            x.x += bf2f((unsigned)a & 0xffffu) + bf2f((unsigned)b & 0xffffu); x.y += bf2f(((unsigned)a >> 16)) + bf2f(((unsigned)b >> 16));
            x.z += bf2f((unsigned)(a >> 32) & 0xffffu) + bf2f((unsigned)(b >> 32) & 0xffffu); x.w += bf2f((unsigned)(a >> 48)) + bf2f((unsigned)(b >> 48));
            v[j] = x; s += (x.x * x.x + x.y * x.y) + (x.z * x.z + x.w * x.w); }
        const float r = 1.0f / sqrtf(wave_sum(s) * (1.f / 1024.f) + RMS_EPS);
#pragma unroll
        for (int j = 0; j < 4; ++j) { const f32x4 gg = gr[64 * j]; xr[64 * j] = (f32x4){v[j].x * r * gg.x, v[j].y * r * gg.y, v[j].z * r * gg.z, v[j].w * r * gg.w}; }
    }
}

constexpr int NPHASES = 11;
__global__ void __launch_bounds__(NTHREADS, 2) mk_fwd(Args args) {
    extern __shared__ __attribute__((aligned(16))) unsigned char lds[];
    Ctx c; c.tid = threadIdx.x; c.lane = c.tid & 63; c.wave = __builtin_amdgcn_readfirstlane(c.tid >> 6);
    c.gw = blockIdx.x * NWAVES + c.wave; c.ngw = gridDim.x * NWAVES; c.lds = lds;
    Ptrs P;
#pragma unroll
    for (int i = 0; i < 23; ++i) P.in[i] = args.in[i];
    P.out = args.out; P.ws = args.ws;
    volatile LAS unsigned* MISC = (volatile LAS unsigned*)((LAS unsigned char*)lds + MISC_OFF);
    if (c.tid < 32) MISC[c.tid] = 0u;
    __syncthreads();
    XcdBarrier bar; bar.bar = (unsigned*)(args.ws + WS_CTL) + CW_BAR; bar.x = 0; bar.st = nullptr;
    const int lo = args.ph_lo, hi = args.ph_hi;
    if (hi - lo > 1) bar = xcd_barrier_post((unsigned*)(args.ws + WS_CTL) + CW_BAR, MISC + 8);
#define IN(k) (lo <= (k) && (k) < hi)
#define SEAM(k) do { if (IN(k) && IN((k) + 1)) xcd_barrier(bar); } while (0)
    if (IN(0)) { phase0(c, P); } SEAM(0);
    if (IN(1)) { phase1_mfma(c, P); } SEAM(1);
    if (IN(2)) { mx::ret_state_phase((LAS unsigned char*)lds, P.b(WS_RK), P.b(WS_RV), (bf16*)P.out, P.in[4], P.in[5]);
                 mx::na_phase((LAS unsigned char*)lds, P.b(WS_NQ), P.b(WS_NK), P.b(WS_NV), P.b(WS_FT)); __syncthreads(); phase2_memkv_mfma(c, P); } SEAM(2);
    if (IN(3)) { mx::ret_out_phase((LAS unsigned char*)lds, P.b(WS_RQ), P.b(WS_RK), P.b(WS_RV), P.b(WS_RG), (const bf16*)P.out, P.in[6], P.in[4], P.in[5]);
                 mx::xa_phase((LAS unsigned char*)lds, P.b(WS_XQ), P.b(WS_MKV)); } SEAM(3);
    if (IN(4)) { phase4_mfma(c, P); } SEAM(4);
    if (IN(5)) { phase5_mfma(c, P); } SEAM(5);
    if (IN(6)) { phase6_mfma(c, P); } SEAM(6);
    if (IN(7)) { phase7(c, P); } SEAM(7);
    if (IN(8)) { phase8_mfma(c, P); } SEAM(8);
    if (IN(9)) { phase9_mfma(c, P); } SEAM(9);
    if (IN(10)) { phase10(c, P); }
#undef IN
#undef SEAM
}

extern "C" void kernel_launch(void* const* d_in, const int* in_sizes, int n_in, void* d_out, int out_size, void* d_ws, size_t ws_size, hipStream_t stream) {
    static int grid = 0;
    if (grid == 0) {
        if (n_in != 23 || out_size != T * DM || ws_size < WS_END) { fprintf(stderr, "kernel_launch: unexpected shapes (n_in %d out %d ws %zu)\n", n_in, out_size, ws_size); grid = -1; return; }
        int dev = 0, cus = 0;
        if (hipGetDevice(&dev) != hipSuccess || hipDeviceGetAttribute(&cus, hipDeviceAttributeMultiprocessorCount, dev) != hipSuccess) { grid = -1; return; }
        if (hipFuncSetAttribute((const void*)mk_fwd, hipFuncAttributeMaxDynamicSharedMemorySize, LDS_BYTES) != hipSuccess) { fprintf(stderr, "kernel_launch: hipFuncSetAttribute failed\n"); grid = -1; return; }
        (void)hipGetLastError();
        grid = cus;
    }
    if (grid < 0) return;
    (void)hipMemsetAsync((char*)d_ws + WS_CTL, 0, CTL_ZERO_BYTES, stream);
    Args a{};
    for (int i = 0; i < 23; ++i) a.in[i] = (const float*)d_in[i];
    a.out = (float*)d_out; a.ws = (unsigned char*)d_ws;
#if MK_PER_PHASE
    for (int p = 0; p < NPHASES; ++p) { a.ph_lo = p; a.ph_hi = p + 1; hipLaunchKernelGGL(mk_fwd, dim3(grid), dim3(NTHREADS), LDS_BYTES, stream, a); }
#else
    a.ph_lo = 0; a.ph_hi = NPHASES; hipLaunchKernelGGL(mk_fwd, dim3(grid), dim3(NTHREADS), LDS_BYTES, stream, a);
#endif
}
```

```cpp
#include <hip/hip_runtime.h>
#include <cstdio>
#include <cstdint>

#ifndef PROBE_REP
#define PROBE_REP -1
#endif
#ifndef PROBE_END
#define PROBE_END -1
#endif
#ifndef PROBE_TS_A
#define PROBE_TS_A -1
#define PROBE_TS_B -1
#endif
#ifndef PROBE_TS_DIV
#define PROBE_TS_DIV 8.0f
#endif
#ifndef MK_PER_PHASE
#define MK_PER_PHASE 0
#endif

#define GAS __attribute__((address_space(1)))
#define LAS __attribute__((address_space(3)))
typedef unsigned short bf16;
typedef float f32x4 __attribute__((ext_vector_type(4)));
typedef unsigned u32x4 __attribute__((ext_vector_type(4)));
typedef unsigned u32x2 __attribute__((ext_vector_type(2)));
typedef short bf16x8 __attribute__((ext_vector_type(8)));

constexpr int NB = 8, SEQ = 2048, DM = 1024, T = NB * SEQ;
constexpr int MEML = 256, TM = NB * MEML;
constexpr int NWAVES = 8, NTHREADS = 512;
constexpr int NPA = 5120, NPG = 3072;
constexpr int NEXP = 16, DFF = 512;
constexpr float RMS_EPS = 1e-6f, GN_EPS = 1e-5f;
constexpr float QK_SCALE = 0.08838834764831845f;

constexpr size_t MiB = 1u << 20;
constexpr size_t WS_CTL = 0, CTL_ZERO_BYTES = 32768;
constexpr size_t WS_COS = 1 * MiB, WS_SIN = 1 * MiB + 512 * 1024;
constexpr size_t WS_ELIST = 2 * MiB;
constexpr size_t WS_FT = 2 * MiB;
constexpr size_t WS_EWL = 3 * MiB;
constexpr size_t WS_TMETA = 4 * MiB;
constexpr size_t WS_WA = 5 * MiB;
constexpr size_t WS_WG = 15 * MiB;
constexpr size_t WS_WKV = 21 * MiB;
constexpr size_t WS_WRO = 23 * MiB;
constexpr size_t WS_WNO = 25 * MiB;
constexpr size_t WS_WXO = 26 * MiB;
constexpr size_t WS_WOUT = 27 * MiB;
constexpr size_t WS_XN = 29 * MiB;
constexpr size_t WS_H2 = WS_XN;
constexpr size_t WS_RQ = 61 * MiB;
constexpr size_t WS_RK = 77 * MiB;
constexpr size_t WS_RV = 93 * MiB;
constexpr size_t WS_NK = 125 * MiB;
constexpr size_t WS_NV = 141 * MiB;
constexpr size_t WS_GATES = 61 * MiB;
constexpr size_t WS_HID = 61 * MiB;
constexpr size_t WS_DROWS = 97 * MiB;
constexpr size_t WS_RG = 157 * MiB;
constexpr size_t WS_NQ = 189 * MiB;
constexpr size_t WS_XQ = 205 * MiB;
constexpr size_t WS_WD = 205 * MiB;
constexpr size_t WS_MN = 221 * MiB;
constexpr size_t WS_MKV = 225 * MiB;
constexpr size_t WS_MIX = 221 * MiB;
constexpr size_t WS_WGU = 221 * MiB;
constexpr size_t WS_D = 169 * MiB;
constexpr size_t WS_END = 256 * MiB;

constexpr int CW_ECNT = 64;
constexpr int CW_BAR = 4096;

constexpr int LDS_BYTES = 163840;
constexpr int MISC_OFF = 163840 - 512;

__device__ __forceinline__ float bf2f(unsigned v) { return __uint_as_float(v << 16); }
__device__ __forceinline__ unsigned f2bf(float f) { unsigned u = __float_as_uint(f); return (u + 0x7fffu + ((u >> 16) & 1u)) >> 16; }
__device__ __forceinline__ unsigned pk2(float lo, float hi) { return f2bf(lo) | (f2bf(hi) << 16); }
__device__ __forceinline__ void unpack8(const u32x4 v, float* o) {
    o[0] = __uint_as_float(v.x << 16); o[1] = __uint_as_float(v.x & 0xffff0000u);
    o[2] = __uint_as_float(v.y << 16); o[3] = __uint_as_float(v.y & 0xffff0000u);
    o[4] = __uint_as_float(v.z << 16); o[5] = __uint_as_float(v.z & 0xffff0000u);
    o[6] = __uint_as_float(v.w << 16); o[7] = __uint_as_float(v.w & 0xffff0000u);
}
__device__ __forceinline__ void store8(bf16* p, f32x4 a, f32x4 b) {
    u32x4 w; w.x = pk2(a[0], a[1]); w.y = pk2(a[2], a[3]); w.z = pk2(b[0], b[1]); w.w = pk2(b[2], b[3]);
    *(u32x4*)p = w;
}
__device__ __forceinline__ float wave_sum(float v) {
#pragma unroll
    for (int o = 1; o < 64; o <<= 1) v += __shfl_xor(v, o);
    return v;
}
__device__ __forceinline__ float wave_max(float v) {
#pragma unroll
    for (int o = 1; o < 64; o <<= 1) v = fmaxf(v, __shfl_xor(v, o));
    return v;
}
__device__ __forceinline__ float sigmoidf_(float x) { return 1.0f / (1.0f + __expf(-x)); }
__device__ __forceinline__ float siluf_(float x) { return x / (1.0f + __expf(-x)); }

#define XB_TMO      128
#define XB_XCNT(j)  (256  + 64 * (j))
#define XB_XSUB(j)  (1280 + 64 * (j))
#define XB_XGEN(j)  (2304 + 64 * (j))
#define XB_TOP      3328
#define XB_TOPGEN   3392
#define XCD_BAR_WORDS 3456
#define XB_SPIN_CAP (1u << 18)
__device__ __forceinline__ unsigned xb_ld(unsigned* p)              { return __hip_atomic_load(p, __ATOMIC_RELAXED, __HIP_MEMORY_SCOPE_AGENT); }
__device__ __forceinline__ unsigned xb_add(unsigned* p, unsigned v) { return __hip_atomic_fetch_add(p, v, __ATOMIC_RELAXED, __HIP_MEMORY_SCOPE_AGENT); }
__device__ __forceinline__ unsigned xb_xcc_id() { return (unsigned)__builtin_amdgcn_s_getreg((3 << 11) | 20) & 0xFu; }
#define XB_SPIN(cond, bar) do { unsigned _sp = 0; while (cond) { __builtin_amdgcn_s_sleep(1); \
    if ((++_sp & 255u) == 0u) { if (xb_ld(&(bar)[XB_TMO])) break; if (_sp > XB_SPIN_CAP) { atomicAdd(&(bar)[XB_TMO], 1u); break; } } } } while (0)
struct XcdBarrier { unsigned* bar; unsigned x; volatile LAS unsigned* st; };
__device__ __forceinline__ XcdBarrier xcd_barrier_post(unsigned* bar, volatile LAS unsigned* st) {
    XcdBarrier b; b.bar = bar; b.x = xb_xcc_id(); b.st = st;
    if (threadIdx.x == 0) (void)xb_add(&bar[XB_XCNT(b.x)], 1u);
    return b;
}
__device__ __forceinline__ void xcd_barrier_complete(unsigned* bar, unsigned x, unsigned& nloc, unsigned& nx) {
    const unsigned G = gridDim.x * gridDim.y * gridDim.z;
    unsigned sum, cnt, mine, sp = 0u;
    for (;;) {
        sum = 0u; cnt = 0u; mine = 0u;
#pragma unroll
        for (unsigned j = 0; j < 16; ++j) { const unsigned c = xb_ld(&bar[XB_XCNT(j)]); sum += c; cnt += (c > 0u) ? 1u : 0u; mine = (j == x) ? c : mine; }
        if (sum == G) break;
        __builtin_amdgcn_s_sleep(1);
        if ((++sp & 255u) == 0u) { if (xb_ld(&bar[XB_TMO])) break; if (sp > XB_SPIN_CAP) { atomicAdd(&bar[XB_TMO], 1u); break; } }
    }
    nloc = mine > 0u ? mine : 1u; nx = cnt > 0u ? cnt : 1u;
}
__device__ __forceinline__ void xcd_barrier(const XcdBarrier& b) {
    asm volatile("s_waitcnt vmcnt(0)" ::: "memory");
    __syncthreads();
    if (threadIdx.x == 0) {
        unsigned* bar = b.bar;
        __builtin_amdgcn_s_waitcnt(0);
        unsigned nloc = b.st[0], nx = b.st[1];
        if (nloc == 0u) { xcd_barrier_complete(bar, b.x, nloc, nx); b.st[0] = nloc; b.st[1] = nx; }
        const unsigned old = xb_add(&bar[XB_XSUB(b.x)], 1u);
        const unsigned gen = old / nloc;
        if (old + 1u == (gen + 1u) * nloc) {
            __builtin_amdgcn_fence(__ATOMIC_RELEASE, "agent");
            asm volatile("s_waitcnt vmcnt(0)" ::: "memory");
            const unsigned og = xb_add(&bar[XB_TOP], 1u);
            const unsigned tg = og / nx;
            if (og + 1u == (tg + 1u) * nx) xb_add(&bar[XB_TOPGEN], 1u);
            else XB_SPIN(xb_ld(&bar[XB_TOPGEN]) == tg, bar);
            __builtin_amdgcn_fence(__ATOMIC_ACQUIRE, "agent");
            xb_add(&bar[XB_XGEN(b.x)], 1u);
            asm volatile("s_waitcnt vmcnt(0)" ::: "memory");
        } else {
            XB_SPIN(xb_ld(&bar[XB_XGEN(b.x)]) == gen, bar);
            __builtin_amdgcn_fence(__ATOMIC_ACQUIRE, "agent");
            asm volatile("s_waitcnt vmcnt(0)" ::: "memory");
        }
    }
    __syncthreads();
}

struct Args { const float* in[23]; float* out; unsigned char* ws; int ph_lo, ph_hi; int sub, rep; };
struct Ctx {
    int tid, lane, wave, gw, ngw;
    unsigned char* lds;
};

template <class ColPtr>
__device__ __forceinline__ void transpose_all(const Ctx& c, int& base, ColPtr cp, int ldw, int P, int K, bf16* WT) {
    float* scr = (float*)(c.lds + c.wave * 16384);
    const int nkb = K / 64, npb = P / 32, lane = c.lane, nit = nkb * npb;
    int it0 = (c.gw - base) % c.ngw; it0 = it0 < 0 ? it0 + c.ngw : it0; base += nit;
    for (int it = it0; it < nit; it += c.ngw) {
        const int kb = it % nkb, pb = it / nkb, k0 = 64 * kb, p0 = 32 * pb;
        const float* colp = cp(p0 + (lane & 31));
        float tv[32];
#pragma unroll
        for (int i = 0; i < 32; ++i) tv[i] = colp[(size_t)(k0 + 2 * i + (lane >> 5)) * ldw];
#pragma unroll
        for (int i = 0; i < 32; ++i) scr[(2 * i + (lane >> 5)) * 33 + (lane & 31)] = tv[i];
        __builtin_amdgcn_s_waitcnt(0xC07F); asm volatile("" ::: "memory");
        const int cc = lane & 7;
#pragma unroll
        for (int j = 0; j < 4; ++j) { const int n = (lane >> 3) + 8 * j; const float* s = scr + (8 * cc) * 33 + n;
            u32x4 o; o.x = pk2(s[0 * 33], s[1 * 33]); o.y = pk2(s[2 * 33], s[3 * 33]); o.z = pk2(s[4 * 33], s[5 * 33]); o.w = pk2(s[6 * 33], s[7 * 33]);
            *(u32x4*)(WT + (size_t)(p0 + n) * K + k0 + 8 * cc) = o; }
        __builtin_amdgcn_s_waitcnt(0xC07F); asm volatile("" ::: "memory");
    }
}
struct ColPlain { const float* W; __device__ const float* operator()(int p) const { return W + p; } };
struct ColOff { const float* W; int off; __device__ const float* operator()(int p) const { return W + off + p; } };
struct ColWA {
    const float* W;
    __device__ const float* operator()(int p) const {
        if (p < 1024) { const int pp = p & 127; const int d = ((pp & 4) ? 64 : 0) + 4 * (pp >> 3) + (pp & 3); return W + (p & ~127) + d; }
        return W + p;
    }
};
struct ColGU {
    const float* Wg; const float* Wu;
    __device__ const float* operator()(int p) const { const int f = 4 * (p >> 3) + (p & 3); return ((p >> 2) & 1) ? Wu + f : Wg + f; }
};
__device__ __forceinline__ void rms_row_to_bf16(const float* xrow, const float* g, bf16* orow, int lane) {
    const f32x4* xr = (const f32x4*)xrow + lane; const f32x4* gr = (const f32x4*)g + lane;
    f32x4 v[4]; float s = 0.f;
#pragma unroll
    for (int j = 0; j < 4; ++j) { v[j] = xr[64 * j]; s += (v[j].x * v[j].x + v[j].y * v[j].y) + (v[j].z * v[j].z + v[j].w * v[j].w); }
    const float r = 1.0f / sqrtf(wave_sum(s) * (1.f / 1024.f) + RMS_EPS);
    unsigned long long* o8 = (unsigned long long*)orow + lane;
#pragma unroll
    for (int j = 0; j < 4; ++j) { const f32x4 gg = gr[64 * j];
        o8[64 * j] = (unsigned long long)pk2(v[j].x * r * gg.x, v[j].y * r * gg.y) | ((unsigned long long)pk2(v[j].z * r * gg.z, v[j].w * r * gg.w) << 32); }
}

template <class RowPtr, class Epi>
__device__ __forceinline__ void naive_gemm(const Ctx& c, const RowPtr& rp, const bf16* Bt, int ldb, int M, int N, int K, const Epi& epi) {
    const int tilesN = N / 64, tilesM = (M + 7) / 8, lane = c.lane;
    for (int it = c.gw; it < tilesM * tilesN; it += c.ngw) {
        const int tm = it / tilesN, tn = it % tilesN;
        const int row = tm * 8 + (lane >> 3), col0 = tn * 64 + (lane & 7) * 8;
        const bool valid = row < M;
        const bf16* ap = rp(valid ? row : 0);
        float acc[8];
#pragma unroll
        for (int j = 0; j < 8; ++j) acc[j] = 0.f;
        for (int k = 0; k < K; k += 8) {
            float a[8]; unpack8(*(const u32x4*)(ap + k), a);
#pragma unroll
            for (int j = 0; j < 8; ++j) { float b[8]; unpack8(*(const u32x4*)(Bt + (size_t)(col0 + j) * ldb + k), b);
#pragma unroll
                for (int i = 0; i < 8; ++i) acc[j] += a[i] * b[i]; }
        }
        if (valid) epi(row, col0, (f32x4){acc[0], acc[1], acc[2], acc[3]}, (f32x4){acc[4], acc[5], acc[6], acc[7]});
    }
}
struct RowPlain { const bf16* A; int lda; __device__ const bf16* operator()(int r) const { return A + (size_t)r * lda; } };
struct RowGather { const bf16* A; int lda; const int* idx; __device__ const bf16* operator()(int r) const { return A + (size_t)idx[r] * lda; } };

struct EpiProjA {
    bf16 *RQ, *RK, *RV, *RG, *NQ, *NK, *NV, *XQ; const float *COS, *SIN;
    __device__ __forceinline__ void operator()(int row, int col0, f32x4 v0, f32x4 v1) const {
        if (col0 < 1024) {
            const int which = col0 >> 9, cc = col0 & 511, pos = row & (SEQ - 1), q = (cc & 127) >> 3;
            const f32x4 cs = *(const f32x4*)(COS + pos * 64 + 4 * q), sn = *(const f32x4*)(SIN + pos * 64 + 4 * q);
            f32x4 o1 = v0 * cs - v1 * sn, o2 = v0 * sn + v1 * cs;
            if (which == 0) { o1 = o1 * QK_SCALE; o2 = o2 * QK_SCALE; }
            store8((which ? RK : RQ) + (size_t)row * 512 + cc, o1, o2);
        } else if (col0 < 2048) { store8(RV + (size_t)row * 1024 + (col0 - 1024), v0, v1);
        } else if (col0 < 3072) {
            f32x4 a, b;
#pragma unroll
            for (int i = 0; i < 4; ++i) { a[i] = siluf_(v0[i]); b[i] = siluf_(v1[i]); }
            store8(RG + (size_t)row * 1024 + (col0 - 2048), a, b);
        } else if (col0 < 3584) { store8(NQ + (size_t)row * 512 + (col0 - 3072), v0 * 0.125f, v1 * 0.125f);
        } else if (col0 < 4096) { store8(NK + (size_t)row * 512 + (col0 - 3584), v0, v1);
        } else if (col0 < 4608) { store8(NV + (size_t)row * 512 + (col0 - 4096), v0, v1);
        } else { store8(XQ + (size_t)row * 512 + (col0 - 4608), v0 * QK_SCALE, v1 * QK_SCALE); }
    }
};
struct EpiBf16Plain { bf16* O; int ldc; __device__ __forceinline__ void operator()(int row, int col0, f32x4 v0, f32x4 v1) const { store8(O + (size_t)row * ldc + col0, v0, v1); } };
struct EpiSigmoid { bf16* O; int ldc;
    __device__ __forceinline__ void operator()(int row, int col0, f32x4 v0, f32x4 v1) const {
        f32x4 a, b;
#pragma unroll
        for (int i = 0; i < 4; ++i) { a[i] = sigmoidf_(v0[i]); b[i] = sigmoidf_(v1[i]); }
        store8(O + (size_t)row * ldc + col0, a, b); } };
template <int MODE> struct EpiMixNaive { float* TMP; bf16* MIX; const bf16* G;
    __device__ __forceinline__ void operator()(int row, int col0, f32x4 v0, f32x4 v1) const {
        float g[8]; unpack8(*(const u32x4*)(G + (size_t)row * NPG + col0), g);
        f32x4 a = {v0[0] * g[0], v0[1] * g[1], v0[2] * g[2], v0[3] * g[3]}, b = {v1[0] * g[4], v1[1] * g[5], v1[2] * g[6], v1[3] * g[7]};
        float* t = TMP + (size_t)row * DM + col0;
        if (MODE >= 1) { a = a + *(const f32x4*)t; b = b + *(const f32x4*)(t + 4); }
        if (MODE <= 1) { *(f32x4*)t = a; *(f32x4*)(t + 4) = b; } else store8(MIX + (size_t)row * DM + col0, a, b);
    } };
struct EpiResidF32 { const float* X; float* O;
    __device__ __forceinline__ void operator()(int row, int col0, f32x4 v0, f32x4 v1) const {
        const float* x = X + (size_t)row * DM + col0; float* o = O + (size_t)row * DM + col0;
        *(f32x4*)o = *(const f32x4*)x + v0; *(f32x4*)(o + 4) = *(const f32x4*)(x + 4) + v1; } };
struct EpiSwiGLU { bf16* HID; const float* wl; int rowbase;
    __device__ __forceinline__ void operator()(int row, int col0, f32x4 v0, f32x4 v1) const {
        const float w = wl[row]; f32x4 h;
#pragma unroll
        for (int i = 0; i < 4; ++i) h[i] = siluf_(v0[i]) * v1[i] * w;
        u32x2 o; o.x = pk2(h[0], h[1]); o.y = pk2(h[2], h[3]);
        *(u32x2*)(HID + (size_t)(rowbase + row) * DFF + (col0 >> 1)) = o; } };
struct EpiRowsBf16 { bf16* O; int ldc; int rowbase;
    __device__ __forceinline__ void operator()(int row, int col0, f32x4 v0, f32x4 v1) const { store8(O + (size_t)(rowbase + row) * ldc + col0, v0, v1); } };

namespace pg8 {
constexpr int BM = 256, BK = 64, HALF = 128, HTB = HALF * BK * 2, STAGE_BYTES = 8 * HTB;
__device__ __forceinline__ int lds_byte(int r, int c) { const int st = (r >> 4) * 2 + (c >> 5), rr = r & 15, cc = c & 31, ob = rr * 64 + cc * 2; return st * 1024 + (ob ^ (((ob >> 9) & 1) << 5)); }
__device__ __forceinline__ void stage_rc(int b, int& R, int& C) { const int st = b / 1024, sb = b % 1024, swz = sb ^ (((sb >> 9) & 1) << 5); R = (st >> 1) * 16 + swz / 64; C = (st & 1) * 32 + (swz % 64) / 2; }
__device__ __forceinline__ int perm32(int rho) { const int n = rho >> 4, i = rho & 15; return 8 * (i >> 2) + 4 * n + (i & 3); }

struct UnitDesc {
    const char* A; const char* B;
    unsigned lda2, ldb2;
    int nt;
    int row0, col0;
    int aux, aux2;
    const int* gidx; int gcnt;
    int chain;
};
__device__ __forceinline__ unsigned cvt_pk_bf16(float lo, float hi) { unsigned r; asm volatile("v_cvt_pk_bf16_f32 %0, %1, %2" : "=v"(r) : "v"(lo), "v"(hi)); return r; }

template <class F> __device__ __forceinline__ void epi_apply(const f32x4 (&acc)[2][2][4][2], const UnitDesc& u, int wr, int wc, int fr, int fq, const F& f) {
#pragma unroll
    for (int ai = 0; ai < 2; ++ai)
#pragma unroll
        for (int m = 0; m < 4; ++m) { const int row = u.row0 + ai * HALF + wr * 64 + m * 16 + fr;
#pragma unroll
            for (int bj = 0; bj < 2; ++bj) f(row, u.col0 + bj * HALF + wc * 32 + 8 * fq, acc[ai][bj][m][0], acc[ai][bj][m][1]);
            asm volatile("" ::: "memory"); __builtin_amdgcn_sched_barrier(0); }
}

template <bool GATHER> __device__ __forceinline__ void unit_offs(const UnitDesc& u, int tid, unsigned (&oA0)[2], unsigned (&oA1)[2], unsigned (&oB)[2]) {
#pragma unroll
    for (int i = 0; i < 2; ++i) { int R, C; stage_rc(tid * 16 + i * 8192, R, C); const int Rb = (R & ~31) + perm32(R & 31);
        oB[i] = (unsigned)Rb * u.ldb2 + (unsigned)C * 2u;
        if (GATHER && u.gidx) { const int last = u.gcnt - 1; int r0 = u.row0 + R, r1 = r0 + HALF; r0 = r0 < last ? r0 : last; r1 = r1 < last ? r1 : last;
            oA0[i] = (unsigned)u.gidx[r0] * u.lda2 + (unsigned)C * 2u; oA1[i] = (unsigned)u.gidx[r1] * u.lda2 + (unsigned)C * 2u;
        } else { oA0[i] = (unsigned)R * u.lda2 + (unsigned)C * 2u; oA1[i] = 0u; } }
}

template <bool GATHER, class Sched, class Epi>
__device__ __forceinline__ void gemm_phase(LAS unsigned char* lds, const Sched& S, const Epi& E, int sb = 0) {
#if PROBE_TS_A >= 0
#define GSTAMP(k) do { if (sb && blockIdx.x == 0 && threadIdx.x == 0) ((volatile LAS unsigned*)(lds + MISC_OFF))[32 + sb + (k)] = (unsigned)__builtin_amdgcn_s_memrealtime(); } while (0)
#else
#define GSTAMP(k) do { } while (0)
#endif
    const int tid = threadIdx.x, wid = __builtin_amdgcn_readfirstlane(tid >> 6), lane = tid & 63, wr = wid >> 2, wc = wid & 3, fr = lane & 15, fq = lane >> 4;
    const unsigned ldsw = (unsigned)wid * 1024u;
    const int aoff = lds_byte(wr * 64 + fr, fq * 8), boff = lds_byte(wc * 32 + fr, fq * 8);
    const size_t kstep = (size_t)(BK * 2);
#define PG8_SA(b, h) (((b) * 2 + (h)) * HTB)
#define PG8_SB(b, h) ((4 + (b) * 2 + (h)) * HTB)
#define PG8_STAGE(bufoff, gbase, voff) do { _Pragma("unroll") for (int _i = 0; _i < 2; ++_i) \
        __builtin_amdgcn_global_load_lds((const unsigned*)((const char*)(gbase) + (voff)[_i]), (LAS unsigned*)(lds + (bufoff) + ldsw + _i * 8192), 16, 0, 0); } while (0)
#define PG8_LDA(dst, b, h) do { _Pragma("unroll") for (int m = 0; m < 4; ++m) _Pragma("unroll") for (int k = 0; k < 2; ++k) dst[m][k] = *(const LAS bf16x8*)(lds + PG8_SA(b, h) + aoff + m * 2048 + k * 1024); } while (0)
#define PG8_LDB(dst, b, h) do { _Pragma("unroll") for (int n = 0; n < 2; ++n) _Pragma("unroll") for (int k = 0; k < 2; ++k) dst[n][k] = *(const LAS bf16x8*)(lds + PG8_SB(b, h) + boff + n * 2048 + k * 1024); } while (0)
#define PG8_MMA(ai, bj, At, Bt) do { __builtin_amdgcn_s_setprio(1); _Pragma("unroll") for (int m = 0; m < 4; ++m) _Pragma("unroll") for (int n = 0; n < 2; ++n) _Pragma("unroll") for (int k = 0; k < 2; ++k) \
        acc[ai][bj][m][n] = __builtin_amdgcn_mfma_f32_16x16x32_bf16(Bt[n][k], At[m][k], acc[ai][bj][m][n], 0, 0, 0); __builtin_amdgcn_s_setprio(0); } while (0)
#define PG8_WAIT_V(n) asm volatile("s_waitcnt vmcnt(" #n ")" ::: "memory")
#define PG8_WAIT_L(n) asm volatile("s_waitcnt lgkmcnt(" #n ")" ::: "memory")
#define PG8_BAR __builtin_amdgcn_s_barrier()
#define PG8_SCHED __builtin_amdgcn_sched_barrier(0)
    UnitDesc cur, nxt; int ui = 0;
    if (!S.next(0, cur)) return;
    f32x4 acc[2][2][4][2];
#pragma unroll
    for (int a = 0; a < 2; ++a)
#pragma unroll
        for (int b = 0; b < 2; ++b)
#pragma unroll
            for (int m = 0; m < 4; ++m)
#pragma unroll
                for (int n = 0; n < 2; ++n) acc[a][b][m][n] = (f32x4){0.f, 0.f, 0.f, 0.f};
    bf16x8 At[4][2], B0[2][2], B1[2][2];
    unsigned cA0[2], cA1[2], cB[2], nA0[2], nA1[2], nB[2];
    unit_offs<GATHER>(cur, tid, cA0, cA1, cB);
    const char* pA = cur.A; const char* pB = cur.B; size_t hB = (size_t)HALF * cur.ldb2; size_t hA = GATHER ? 0 : (size_t)HALF * cur.lda2;
#define PG8_A1(arr1, arr0) (GATHER ? (arr1) : (arr0))
    PG8_STAGE(PG8_SB(0, 0), pB, cB); PG8_STAGE(PG8_SB(0, 1), pB + hB, cB); PG8_STAGE(PG8_SA(0, 0), pA, cA0); PG8_STAGE(PG8_SA(0, 1), pA + hA, PG8_A1(cA1, cA0));
    if (wr == 1) PG8_BAR;
    PG8_WAIT_V(2); PG8_BAR;
    PG8_STAGE(PG8_SB(1, 0), pB + kstep, cB); PG8_STAGE(PG8_SA(1, 0), pA + kstep, cA0); PG8_STAGE(PG8_SB(1, 1), pB + hB + kstep, cB);
    PG8_WAIT_V(6); PG8_BAR;
    GSTAMP(0);
    for (;;) {
        const bool has_next = S.next(ui + 1, nxt);
        const char* qA = pA; const char* qB = pB; size_t hBn = hB, hAn = hA;
        if (has_next) { unit_offs<GATHER>(nxt, tid, nA0, nA1, nB); qA = nxt.A; qB = nxt.B; hBn = (size_t)HALF * nxt.ldb2; hAn = GATHER ? 0 : (size_t)HALF * nxt.lda2; }
        else {
#pragma unroll
            for (int i = 0; i < 2; ++i) { nA0[i] = cA0[i]; nA1[i] = cA1[i]; nB[i] = cB[i]; } }
        const int nt = cur.nt;
        for (int t = 0; t < nt; t += 2) {
            const bool last = (t == nt - 2);
            const char* a1 = pA + (size_t)(t + 1) * kstep;
            const char* a2 = last ? qA : pA + (size_t)(t + 2) * kstep; const char* b2 = last ? qB : pB + (size_t)(t + 2) * kstep;
            const char* a3 = a2 + kstep; const char* b3 = b2 + kstep;
            unsigned sA0[2], sA1[2], sB[2];
#pragma unroll
            for (int i = 0; i < 2; ++i) { sA0[i] = last ? nA0[i] : cA0[i]; sA1[i] = last ? nA1[i] : cA1[i]; sB[i] = last ? nB[i] : cB[i]; }
            const size_t shB = last ? hBn : hB, shA = last ? hAn : hA;
            PG8_LDB(B0, 0, 0); PG8_LDB(B1, 0, 1); PG8_SCHED; PG8_LDA(At, 0, 0); PG8_STAGE(PG8_SA(1, 1), a1 + hA, PG8_A1(cA1, cA0));
            PG8_WAIT_V(8); PG8_WAIT_L(0); PG8_BAR; PG8_MMA(0, 0, At, B0); PG8_MMA(0, 1, At, B1); PG8_BAR; PG8_SCHED;
            PG8_LDA(At, 0, 1); PG8_STAGE(PG8_SB(0, 0), b2, sB); PG8_STAGE(PG8_SB(0, 1), b2 + shB, sB); PG8_STAGE(PG8_SA(0, 0), a2, sA0);
            PG8_WAIT_V(8); PG8_WAIT_L(0); PG8_BAR; PG8_MMA(1, 0, At, B0); PG8_MMA(1, 1, At, B1); PG8_BAR; PG8_SCHED;
            PG8_LDB(B0, 1, 0); PG8_LDB(B1, 1, 1); PG8_SCHED; PG8_LDA(At, 1, 0); PG8_STAGE(PG8_SA(0, 1), a2 + shA, PG8_A1(sA1, sA0));
            PG8_WAIT_V(8); PG8_WAIT_L(0); PG8_BAR; PG8_MMA(0, 0, At, B0); PG8_MMA(0, 1, At, B1); PG8_BAR; PG8_SCHED;
            PG8_LDA(At, 1, 1); PG8_STAGE(PG8_SB(1, 0), b3, sB); PG8_STAGE(PG8_SB(1, 1), b3 + shB, sB); PG8_STAGE(PG8_SA(1, 0), a3, sA0);
            PG8_WAIT_V(8); PG8_WAIT_L(0); PG8_BAR; PG8_MMA(1, 0, At, B0); PG8_MMA(1, 1, At, B1); PG8_BAR; PG8_SCHED;
        }
        if (wr == 0) PG8_BAR;
        if (ui == 0) GSTAMP(1);
        E.finish(acc, cur, wr, wc, fr, fq);
        if (ui == 0) GSTAMP(2);
        if (!has_next) break;
        cur = nxt; pA = qA; pB = qB; hB = hBn; hA = hAn; ++ui;
#pragma unroll
        for (int i = 0; i < 2; ++i) { cA0[i] = nA0[i]; cA1[i] = nA1[i]; cB[i] = nB[i]; }
        if (wr == 1) PG8_BAR;
    }
    PG8_WAIT_V(0);
    PG8_BAR;
    GSTAMP(3);
#undef GSTAMP
#undef PG8_A1
#undef PG8_SA
#undef PG8_SB
#undef PG8_STAGE
#undef PG8_LDA
#undef PG8_LDB
#undef PG8_MMA
#undef PG8_WAIT_V
#undef PG8_WAIT_L
#undef PG8_BAR
#undef PG8_SCHED
}

__device__ __forceinline__ void zero_acc(f32x4 (&acc)[2][2][4][2]) {
#pragma unroll
    for (int a = 0; a < 2; ++a)
#pragma unroll
        for (int b = 0; b < 2; ++b)
#pragma unroll
            for (int m = 0; m < 4; ++m)
#pragma unroll
                for (int n = 0; n < 2; ++n) acc[a][b][m][n] = (f32x4){0.f, 0.f, 0.f, 0.f};
}
template <class F> struct EpiF { F f;
    __device__ __forceinline__ void finish(f32x4 (&acc)[2][2][4][2], const UnitDesc& u, int wr, int wc, int fr, int fq) const { epi_apply(acc, u, wr, wc, fr, fq, f); zero_acc(acc); } };

struct TileOrder {
    int nM, nN, nwg, G, c;
    __device__ __forceinline__ void init(int nM_, int nN_, int G_, int c_) { nM = nM_; nN = nN_; nwg = nM * nN; G = G_; c = c_; }
    __device__ __forceinline__ bool tile(int i, int& pm, int& pn) const {
        const long L = (long)i * G + c; if (L >= nwg) return false;
        int wgid = (int)L; { const int q = nwg / 8, r = nwg % 8, xcd = wgid % 8, off = wgid / 8; wgid = (xcd < r ? xcd * (q + 1) : r * (q + 1) + (xcd - r) * q) + off; }
        const int nig = 8 * nN, gid = wgid / nig, fm = gid * 8, gsz = (nM - fm) < 8 ? (nM - fm) : 8;
        pm = fm + ((wgid % nig) % gsz); pn = (wgid % nig) / gsz; return true;
    }
};
struct PlainSched { TileOrder o; const bf16* A; const bf16* Bt; int lda, ldb, K;
    __device__ __forceinline__ bool next(int i, UnitDesc& u) const { int pm, pn; if (!o.tile(i, pm, pn)) return false;
        u.A = (const char*)(A + (size_t)pm * BM * lda); u.B = (const char*)(Bt + (size_t)pn * BM * ldb); u.lda2 = lda * 2; u.ldb2 = ldb * 2; u.nt = K / BK;
        u.row0 = pm * BM; u.col0 = pn * BM; u.aux = 0; u.aux2 = 0; u.gidx = nullptr; u.gcnt = 0; u.chain = 0; return true; } };
}

#if PROBE_TS_A >= 0
#define MXSTAMP(k) do { if (blockIdx.x == 0 && threadIdx.x == 0) ((volatile LAS unsigned*)(lds + MISC_OFF))[32 + (k)] = (unsigned)__builtin_amdgcn_s_memrealtime(); } while (0)
#else
#define MXSTAMP(k) do { } while (0)
#endif
namespace mx {
typedef short s16x4 __attribute__((ext_vector_type(4)));
typedef __bf16 bf16x8_t __attribute__((ext_vector_type(8)));
typedef __bf16 bf16x4_t __attribute__((ext_vector_type(4)));
typedef float f32x8 __attribute__((ext_vector_type(8)));
__device__ __forceinline__ f32x4 mma(bf16x8 a, bf16x8 b, f32x4 c) { return __builtin_amdgcn_mfma_f32_16x16x32_bf16(a, b, c, 0, 0, 0); }
__device__ __forceinline__ bf16x8 ldsf(LAS unsigned char* p) { return *(LAS bf16x8*)p; }
__device__ __forceinline__ bf16x8 glbf(const bf16* p) { return *(const bf16x8*)p; }
__device__ __forceinline__ bf16x8 trf(LAS unsigned char* p0, LAS unsigned char* p1) {
    const s16x4 a = __builtin_amdgcn_ds_read_tr16_b64_v4i16((LAS s16x4*)p0), b = __builtin_amdgcn_ds_read_tr16_b64_v4i16((LAS s16x4*)p1);
    return __builtin_shufflevector(a, b, 0, 1, 2, 3, 4, 5, 6, 7);
}
__device__ __forceinline__ bf16x8 pack8(f32x4 a, f32x4 b) { const f32x8 v = {a[0], a[1], a[2], a[3], b[0], b[1], b[2], b[3]}; return __builtin_bit_cast(bf16x8, __builtin_convertvector(v, bf16x8_t)); }
__device__ __forceinline__ u32x2 pack4(f32x4 a) { return __builtin_bit_cast(u32x2, __builtin_convertvector(a, bf16x4_t)); }
__device__ __forceinline__ float red_g_max(float v) { v = fmaxf(v, __shfl_xor(v, 16)); return fmaxf(v, __shfl_xor(v, 32)); }
__device__ __forceinline__ float red_g_sum(float v) { v += __shfl_xor(v, 16); return v + __shfl_xor(v, 32); }

constexpr int XA_KP = 272, XA_VP = 288, XA_VOFF = 256 * XA_KP;
__device__ __forceinline__ void xa_phase(LAS unsigned char* lds, bf16* XQ, const bf16* MKV) {
    const int tid = threadIdx.x, lane = tid & 63, wave = __builtin_amdgcn_readfirstlane(tid >> 6), g = lane >> 4, li = lane & 15, q4 = li >> 2, p4 = li & 3;
    for (int it = blockIdx.x; it < NB * 4 * 8; it += gridDim.x) {
        const int b = it >> 5, h = (it >> 3) & 3, qb = it & 7;
        __syncthreads();
#pragma unroll
        for (int i = 0; i < 8; ++i) { const int id = tid + 512 * i, row = id >> 4, ch = id & 15; const bf16* src = MKV + (size_t)(b * MEML + row) * 1024 + h * 128 + ch * 8;
            *(LAS u32x4*)(lds + row * XA_KP + ch * 16) = *(const u32x4*)src; *(LAS u32x4*)(lds + XA_VOFF + row * XA_VP + ch * 16) = *(const u32x4*)(src + 512); }
        __syncthreads();
#pragma unroll 1
        for (int qi = 0; qi < 2; ++qi) {
            bf16* qrow = XQ + (size_t)(b * SEQ + qb * 256 + wave * 32 + qi * 16 + li) * 512 + h * 128;
            bf16x8 qf[4];
#pragma unroll
            for (int s = 0; s < 4; ++s) qf[s] = glbf(qrow + 32 * s + 8 * g);
            f32x4 st[16]; float mx = -3.0e38f;
#pragma unroll
            for (int kf = 0; kf < 16; ++kf) { f32x4 a = {0.f, 0.f, 0.f, 0.f};
#pragma unroll
                for (int s = 0; s < 4; ++s) a = mma(ldsf(lds + (16 * kf + li) * XA_KP + (32 * s + 8 * g) * 2), qf[s], a);
                st[kf] = a; mx = fmaxf(mx, fmaxf(fmaxf(a[0], a[1]), fmaxf(a[2], a[3]))); __builtin_amdgcn_sched_barrier(0); }
            mx = red_g_max(mx); float sum = 0.f;
#pragma unroll
            for (int kf = 0; kf < 16; ++kf) {
#pragma unroll
                for (int r = 0; r < 4; ++r) { const float e = __expf(st[kf][r] - mx); st[kf][r] = e; sum += e; } }
            sum = red_g_sum(sum); const float inv = 1.0f / sum;
            f32x4 o[8];
#pragma unroll
            for (int df = 0; df < 8; ++df) o[df] = (f32x4){0.f, 0.f, 0.f, 0.f};
#pragma unroll
            for (int x = 0; x < 8; ++x) { const bf16x8 pf = pack8(st[2 * x], st[2 * x + 1]);
                LAS unsigned char* vb = lds + XA_VOFF + (32 * x + 4 * g + q4) * XA_VP + 8 * p4;
#pragma unroll
                for (int df = 0; df < 8; ++df) o[df] = mma(trf(vb + 32 * df, vb + 16 * XA_VP + 32 * df), pf, o[df]); __builtin_amdgcn_sched_barrier(0); }
#pragma unroll
            for (int df = 0; df < 8; ++df) *(u32x2*)(qrow + 16 * df + 4 * g) = pack4(o[df] * inv);
        }
    }
}

constexpr int NA_KP = 144, NA_VP = 136, NA_VOFF = 576 * NA_KP;
__device__ __forceinline__ void na_phase(LAS unsigned char* lds, bf16* NQ, const bf16* NK, const bf16* NV, const bf16* FT) {
    const int tid = threadIdx.x, lane = tid & 63, wave = __builtin_amdgcn_readfirstlane(tid >> 6), g = lane >> 4, li = lane & 15, q4 = li >> 2, p4 = li & 3;
    const int ri = wave >> 2, qf = wave & 3, c0 = 16 * qf, w0 = qf == 0 ? 0 : (qf == 1 ? 8 : (qf == 2 ? 24 : 32));
    const int G = (int)gridDim.x, lite = G > 64 ? 32 : 0; const bool isl = (int)blockIdx.x < lite;
    const int it0 = isl ? (int)blockIdx.x : lite + ((int)blockIdx.x - lite), itstep = isl ? NB * 8 * 16 : G - lite;
    for (int it = it0; it < NB * 8 * 16; it += itstep) {
        const int b = it >> 7, h = (it >> 4) & 7, rp = it & 15;
        int krmin = 2 * rp - 4; krmin = krmin < 0 ? 0 : (krmin > 24 ? 24 : krmin);
        const int r = 2 * rp + ri; int rs = r - 4; rs = rs < 0 ? 0 : (rs > 24 ? 24 : rs);
        bf16x8 ff[16];
#pragma unroll
        for (int kri = 0; kri < 8; ++kri)
#pragma unroll
            for (int cf = 0; cf < 2; ++cf) ff[kri * 2 + cf] = glbf(FT + ((size_t)((h * 15 + (rs + kri - r + 7)) * 64 + w0 + 16 * cf + li)) * 64 + (c0 & 32) + 8 * g);
        u32x4 kv[9], vv[9];
#pragma unroll
        for (int i = 0; i < 9; ++i) { const int id = tid + 512 * i, trow = id >> 3, ch = id & 7; int kr = krmin + (trow >> 6); kr = kr > 31 ? 31 : kr;
            const size_t off = (size_t)(b * SEQ + kr * 64 + (trow & 63)) * 512 + h * 64 + ch * 8; kv[i] = *(const u32x4*)(NK + off); vv[i] = *(const u32x4*)(NV + off); }
        bf16* qrow = NQ + (size_t)(b * SEQ + r * 64 + c0 + li) * 512 + h * 64;
        const bf16x8 q0 = glbf(qrow + 8 * g), q1 = glbf(qrow + 32 + 8 * g);
        __syncthreads();
#pragma unroll
        for (int i = 0; i < 9; ++i) { const int id = tid + 512 * i, trow = id >> 3, ch = id & 7;
            *(LAS u32x4*)(lds + trow * NA_KP + ch * 16) = kv[i];
            *(LAS u32x2*)(lds + NA_VOFF + trow * NA_VP + ch * 16) = (u32x2){vv[i].x, vv[i].y}; *(LAS u32x2*)(lds + NA_VOFF + trow * NA_VP + ch * 16 + 8) = (u32x2){vv[i].z, vv[i].w}; }
        __syncthreads();
        bf16x8 e1;
#pragma unroll
        for (int j = 0; j < 8; ++j) e1[j] = (8 * g + j == ((c0 + li) & 31)) ? (short)0x3F80 : (short)0;
        f32x4 st[16]; float mx = -3.0e38f;
#pragma unroll
        for (int kri = 0; kri < 8; ++kri) {
#pragma unroll
            for (int cf = 0; cf < 2; ++cf) { LAS unsigned char* kp = lds + ((rs + kri - krmin) * 64 + w0 + 16 * cf + li) * NA_KP + 16 * g;
                f32x4 a = {0.f, 0.f, 0.f, 0.f};
                a = mma(ldsf(kp), q0, a); a = mma(ldsf(kp + 64), q1, a); a = mma(ff[kri * 2 + cf], e1, a);
                st[kri * 2 + cf] = a; mx = fmaxf(mx, fmaxf(fmaxf(a[0], a[1]), fmaxf(a[2], a[3]))); }
            __builtin_amdgcn_sched_barrier(0); }
        mx = red_g_max(mx); float sum = 0.f;
#pragma unroll
        for (int f = 0; f < 16; ++f) {
#pragma unroll
            for (int rr = 0; rr < 4; ++rr) { const float e = __expf(st[f][rr] - mx); st[f][rr] = e; sum += e; } }
        sum = red_g_sum(sum); const float inv = 1.0f / sum;
        f32x4 o[4];
#pragma unroll
        for (int df = 0; df < 4; ++df) o[df] = (f32x4){0.f, 0.f, 0.f, 0.f};
#pragma unroll
        for (int x = 0; x < 8; ++x) { const bf16x8 pf = pack8(st[2 * x], st[2 * x + 1]);
            LAS unsigned char* vb = lds + NA_VOFF + ((rs + x - krmin) * 64 + w0 + 4 * g + q4) * NA_VP + 8 * p4;
#pragma unroll
            for (int df = 0; df < 4; ++df) o[df] = mma(trf(vb + 32 * df, vb + 16 * NA_VP + 32 * df), pf, o[df]); __builtin_amdgcn_sched_barrier(0); }
#pragma unroll
        for (int df = 0; df < 4; ++df) *(u32x2*)(qrow + 16 * df + 4 * g) = pack4(o[df] * inv);
    }
}

constexpr int RT_P = 272, RT_VP = 544, RT_QOFF = 0, RT_KOFF = 128 * RT_P, RT_VOFF = 2 * 128 * RT_P, RT_RED = RT_VOFF + 128 * RT_VP, RT_STAT = RT_RED + 8 * 128 * 8;
__device__ __forceinline__ void ret_out_phase(LAS unsigned char* lds, const bf16* RQ, const bf16* RK, const bf16* RV, bf16* RG, const bf16* ST, const float* gain, const float* decf, const float* decb) {
    const int tid0 = threadIdx.x, lane = tid0 & 63, wave = __builtin_amdgcn_readfirstlane(tid0 >> 6), g = lane >> 4, li = lane & 15, q4 = li >> 2, p4 = li & 3;
    for (int it = blockIdx.x; it < NB * 4 * 16; it += gridDim.x) {
        const int b = it >> 6, h = (it >> 4) & 3, n = it & 15; const size_t tok0 = (size_t)b * SEQ + n * 128;
        int tid = tid0; asm volatile("" : "+v"(tid));
        const float lgf = -log1pf(expf(-decf[h])), lgb = -log1pf(expf(-decb[h]));
        const bf16* sfp = ST + ((size_t)(((b * 4 + h) * 2 + 0) * 16 + n) * 256 + 32 * wave + li) * 128 + 8 * g;
        const bf16* sbp = ST + ((size_t)(((b * 4 + h) * 2 + 1) * 16 + n) * 256 + 32 * wave + li) * 128 + 8 * g;
        __syncthreads();
#pragma unroll
        for (int i = 0; i < 4; ++i) { const int id = tid + 512 * i, row = id >> 4, ch = id & 15;
            *(LAS u32x4*)(lds + RT_QOFF + row * RT_P + ch * 16) = *(const u32x4*)(RQ + (tok0 + row) * 512 + h * 128 + ch * 8);
            *(LAS u32x4*)(lds + RT_KOFF + row * RT_P + ch * 16) = *(const u32x4*)(RK + (tok0 + row) * 512 + h * 128 + ch * 8); }
#pragma unroll
        for (int i = 0; i < 8; ++i) { const int id = tid + 512 * i, row = id >> 5, ch = id & 31;
            *(LAS u32x4*)(lds + RT_VOFF + row * RT_VP + ch * 16) = *(const u32x4*)(RV + (tok0 + row) * 1024 + h * 256 + ch * 8); }
        __builtin_amdgcn_sched_barrier(0);
        bf16x8 sf[2][4];
        if (it == (int)blockIdx.x) MXSTAMP(25);
#pragma unroll
        for (int a = 0; a < 2; ++a)
#pragma unroll
            for (int s = 0; s < 4; ++s) sf[a][s] = glbf(sfp + a * 16 * 128 + 32 * s);
        __syncthreads();
        if (it == (int)blockIdx.x) MXSTAMP(26);
        { bf16x8 qf[4];
#pragma unroll
          for (int s = 0; s < 4; ++s) qf[s] = ldsf(lds + RT_QOFF + (16 * wave + li) * RT_P + (32 * s + 8 * g) * 2);
          f32x4 st[8]; const int pi = 16 * wave + li;
#pragma unroll
          for (int jf = 0; jf < 8; ++jf) { f32x4 a = {0.f, 0.f, 0.f, 0.f};
#pragma unroll
              for (int s = 0; s < 4; ++s) a = mma(ldsf(lds + RT_KOFF + (16 * jf + li) * RT_P + (32 * s + 8 * g) * 2), qf[s], a);
#pragma unroll
              for (int r = 0; r < 4; ++r) { const int pj = 16 * jf + 4 * g + r; a[r] *= (pj <= pi) ? __expf((float)(pi - pj) * lgf) : __expf((float)(pj - pi) * lgb); }
              st[jf] = a; __builtin_amdgcn_sched_barrier(0); }
          __syncthreads();
#pragma unroll
          for (int jf = 0; jf < 8; ++jf) *(LAS u32x2*)(lds + RT_KOFF + pi * RT_P + (16 * jf + 4 * g) * 2) = pack4(st[jf]);
        }
        __syncthreads();
        if (it == (int)blockIdx.x) MXSTAMP(27);
        bf16x8 sb[2][4];
#pragma unroll
        for (int a = 0; a < 2; ++a)
#pragma unroll
            for (int s = 0; s < 4; ++s) sb[a][s] = glbf(sbp + a * 16 * 128 + 32 * s);
        f32x4 y[2][8];
#pragma unroll
        for (int a = 0; a < 2; ++a)
#pragma unroll
            for (int i = 0; i < 8; ++i) y[a][i] = (f32x4){0.f, 0.f, 0.f, 0.f};
        {
#pragma unroll
          for (int i = 0; i < 8; ++i) {
#pragma unroll
              for (int s = 0; s < 4; ++s) { const bf16x8 qfr = ldsf(lds + RT_QOFF + (16 * i + li) * RT_P + (32 * s + 8 * g) * 2); y[0][i] = mma(sf[0][s], qfr, y[0][i]); y[1][i] = mma(sf[1][s], qfr, y[1][i]); }
              const int pi = 16 * i + li; const float ratio = __expf((float)(pi + 1) * lgf - (float)(128 - pi) * lgb);
              y[0][i] = y[0][i] * ratio; y[1][i] = y[1][i] * ratio; __builtin_amdgcn_sched_barrier(0); } }
        if (it == (int)blockIdx.x) MXSTAMP(28);
        {
#pragma unroll
          for (int i = 0; i < 8; ++i) {
#pragma unroll
              for (int s = 0; s < 4; ++s) { const bf16x8 qfr = ldsf(lds + RT_QOFF + (16 * i + li) * RT_P + (32 * s + 8 * g) * 2); y[0][i] = mma(sb[0][s], qfr, y[0][i]); y[1][i] = mma(sb[1][s], qfr, y[1][i]); }
              const int pi = 16 * i + li; const float ab = __expf((float)(128 - pi) * lgb);
              y[0][i] = y[0][i] * ab; y[1][i] = y[1][i] * ab; __builtin_amdgcn_sched_barrier(0); } }
        if (it == (int)blockIdx.x) MXSTAMP(29);
#pragma unroll
        for (int x = 0; x < 4; ++x) {
            LAS unsigned char* vb = lds + RT_VOFF + (32 * x + 8 * g + q4) * RT_VP + (32 * wave) * 2 + 8 * p4;
            const bf16x8 v0 = trf(vb, vb + 4 * RT_VP), v1 = trf(vb + 32, vb + 4 * RT_VP + 32);
#pragma unroll
            for (int i = 0; i < 8; ++i) { const bf16x8 pfr = ldsf(lds + RT_KOFF + (16 * i + li) * RT_P + (32 * x + 8 * g) * 2); y[0][i] = mma(v0, pfr, y[0][i]); y[1][i] = mma(v1, pfr, y[1][i]); } __builtin_amdgcn_sched_barrier(0); }
        if (it == (int)blockIdx.x) MXSTAMP(30);
#pragma unroll
        for (int i = 0; i < 8; ++i) { float s1 = 0.f, s2 = 0.f;
#pragma unroll
            for (int a = 0; a < 2; ++a)
#pragma unroll
                for (int r = 0; r < 4; ++r) { const float v = y[a][i][r]; s1 += v; s2 += v * v; }
            s1 = red_g_sum(s1); s2 = red_g_sum(s2);
            if (g == 0) { LAS float* rp = (LAS float*)(lds + RT_RED) + (wave * 128 + 16 * i + li) * 2; rp[0] = s1; rp[1] = s2; } }
        __syncthreads();
        if (tid < 128) { float s1 = 0.f, s2 = 0.f;
#pragma unroll
            for (int w = 0; w < 8; ++w) { const LAS float* rp = (const LAS float*)(lds + RT_RED) + (w * 128 + tid) * 2; s1 += rp[0]; s2 += rp[1]; }
            const float mu = s1 * (1.f / 256.f); const float var = fmaxf(s2 * (1.f / 256.f) - mu * mu, 0.f);
            LAS float* sp = (LAS float*)(lds + RT_STAT) + tid * 2; sp[0] = mu; sp[1] = 1.0f / sqrtf(var + GN_EPS); }
        __syncthreads();
        if (it == (int)blockIdx.x) MXSTAMP(31);
        const f32x4 gn0 = *(const f32x4*)(gain + h * 256 + 32 * wave + 4 * g), gn1 = *(const f32x4*)(gain + h * 256 + 32 * wave + 16 + 4 * g);
#pragma unroll
        for (int i = 0; i < 8; ++i) { const LAS float* sp = (const LAS float*)(lds + RT_STAT) + (16 * i + li) * 2; const float mu = sp[0], rstd = sp[1];
            bf16* gp = RG + (tok0 + 16 * i + li) * 1024 + h * 256 + 32 * wave + 4 * g;
#pragma unroll
            for (int a = 0; a < 2; ++a) { const u32x2 gv = *(const u32x2*)(gp + 16 * a); const f32x4 gg = a ? gn1 : gn0;
                f32x4 o; o[0] = (y[a][i][0] - mu) * rstd * gg[0] * bf2f(gv.x & 0xffffu); o[1] = (y[a][i][1] - mu) * rstd * gg[1] * bf2f(gv.x >> 16);
                o[2] = (y[a][i][2] - mu) * rstd * gg[2] * bf2f(gv.y & 0xffffu); o[3] = (y[a][i][3] - mu) * rstd * gg[3] * bf2f(gv.y >> 16);
                *(u32x2*)(gp + 16 * a) = pack4(o); } }
    }
}

constexpr int RS_KP = 272, RS_VP = 144, RS_VOFF = 128 * RS_KP;
__device__ __forceinline__ void ret_state_phase(LAS unsigned char* lds, const bf16* RK, const bf16* RV, bf16* ST, const float* decf, const float* decb) {
    const int tid = threadIdx.x, lane = tid & 63, wave = __builtin_amdgcn_readfirstlane(tid >> 6), g = lane >> 4, li = lane & 15, q4 = li >> 2, p4 = li & 3;
    for (int it = blockIdx.x; it < NB * 4 * 2 * 4; it += gridDim.x) {
        const int es = it & 3, dir = (it >> 2) & 1, h = (it >> 3) & 3, b = it >> 5;
        const float lg = -log1pf(expf(-(dir ? decb[h] : decf[h]))); const float cd = __expf(128.f * lg);
        f32x4 st[4];
#pragma unroll
        for (int ef = 0; ef < 4; ++ef) st[ef] = (f32x4){0.f, 0.f, 0.f, 0.f};
        u32x4 kq[4], vq[2];
        { const size_t tk = (size_t)b * SEQ + (dir ? 15 : 0) * 128;
#pragma unroll
          for (int i = 0; i < 4; ++i) { const int id = tid + 512 * i, row = id >> 4, ch = id & 15; kq[i] = *(const u32x4*)(RK + (tk + row) * 512 + h * 128 + ch * 8); }
#pragma unroll
          for (int i = 0; i < 2; ++i) { const int id = tid + 512 * i, row = id >> 3, ch = id & 7; vq[i] = *(const u32x4*)(RV + (tk + row) * 1024 + h * 256 + es * 64 + ch * 8); } }
#pragma unroll 1
        for (int cc = 0; cc < 16; ++cc) { const int n = dir ? 15 - cc : cc;
            bf16* sp = ST + ((size_t)(((b * 4 + h) * 2 + dir) * 16 + n) * 256 + es * 64 + 4 * g) * 128 + 16 * wave + li;
#pragma unroll
            for (int ef = 0; ef < 4; ++ef)
#pragma unroll
                for (int r = 0; r < 4; ++r) sp[(16 * ef + r) * 128] = (bf16)f2bf(st[ef][r]);
            __syncthreads();
#pragma unroll
            for (int i = 0; i < 4; ++i) { const int id = tid + 512 * i, row = id >> 4, ch = id & 15;
                float v[8]; unpack8(kq[i], v);
                const float w = __expf((float)(dir ? row : 127 - row) * lg);
                u32x4 o; o.x = pk2(v[0] * w, v[1] * w); o.y = pk2(v[2] * w, v[3] * w); o.z = pk2(v[4] * w, v[5] * w); o.w = pk2(v[6] * w, v[7] * w);
                *(LAS u32x4*)(lds + row * RS_KP + ch * 16) = o; }
#pragma unroll
            for (int i = 0; i < 2; ++i) { const int id = tid + 512 * i, row = id >> 3, ch = id & 7; *(LAS u32x4*)(lds + RS_VOFF + row * RS_VP + ch * 16) = vq[i]; }
            if (cc < 15) { const int n2 = dir ? 14 - cc : cc + 1; const size_t tk = (size_t)b * SEQ + n2 * 128;
#pragma unroll
                for (int i = 0; i < 4; ++i) { const int id = tid + 512 * i, row = id >> 4, ch = id & 15; kq[i] = *(const u32x4*)(RK + (tk + row) * 512 + h * 128 + ch * 8); }
#pragma unroll
                for (int i = 0; i < 2; ++i) { const int id = tid + 512 * i, row = id >> 3, ch = id & 7; vq[i] = *(const u32x4*)(RV + (tk + row) * 1024 + h * 256 + es * 64 + ch * 8); } }
            __syncthreads();
#pragma unroll
            for (int ef = 0; ef < 4; ++ef) st[ef] = st[ef] * cd;
#pragma unroll
            for (int x = 0; x < 4; ++x) {
                LAS unsigned char* kb = lds + (32 * x + 8 * g + q4) * RS_KP + (16 * wave) * 2 + 8 * p4;
                const bf16x8 kfr = trf(kb, kb + 4 * RS_KP);
                LAS unsigned char* vb = lds + RS_VOFF + (32 * x + 8 * g + q4) * RS_VP + 8 * p4;
#pragma unroll
                for (int ef = 0; ef < 4; ++ef) st[ef] = mma(trf(vb + 32 * ef, vb + 4 * RS_VP + 32 * ef), kfr, st[ef]); __builtin_amdgcn_sched_barrier(0); }
        }
    }
}
__device__ __forceinline__ void memkv_phase(const bf16* MN, const bf16* WKV, bf16* MKV) {
    const int tid = threadIdx.x, lane = tid & 63, wave = __builtin_amdgcn_readfirstlane(tid >> 6), g = lane >> 4, li = lane & 15;
    for (int it = blockIdx.x; it < 256; it += gridDim.x) {
        const int r0 = (it >> 4) * 128 + wave * 16, c0 = (it & 15) * 64;
        const bf16* ap = MN + (size_t)(r0 + li) * 1024 + 8 * g; const bf16* bp = WKV + (size_t)(c0 + li) * 1024 + 8 * g;
        f32x4 acc[4];
#pragma unroll
        for (int nf = 0; nf < 4; ++nf) acc[nf] = (f32x4){0.f, 0.f, 0.f, 0.f};
#pragma unroll 4
        for (int s = 0; s < 32; ++s) { const bf16x8 a = glbf(ap + 32 * s);
#pragma unroll
            for (int nf = 0; nf < 4; ++nf) acc[nf] = mma(glbf(bp + (size_t)nf * 16 * 1024 + 32 * s), a, acc[nf]); }
#pragma unroll
        for (int nf = 0; nf < 4; ++nf) *(u32x2*)(MKV + (size_t)(r0 + li) * 1024 + c0 + 16 * nf + 4 * g) = pack4(acc[nf]);
    }
}
}


struct Ptrs {
    const float* in[23]; float* out; unsigned char* ws;
    __device__ bf16* b(size_t off) const { return (bf16*)(ws + off); }
    __device__ float* f(size_t off) const { return (float*)(ws + off); }
};

__device__ __forceinline__ void phase0(const Ctx& c, const Ptrs& P) {
    int tb = 0;
    transpose_all(c, tb, ColWA{P.in[3]}, 8192, NPA, 1024, P.b(WS_WA));
    transpose_all(c, tb, ColOff{P.in[3], NPA}, 8192, NPG, 1024, P.b(WS_WG));
    transpose_all(c, tb, ColPlain{P.in[11]}, 1024, 1024, 1024, P.b(WS_WKV));
    transpose_all(c, tb, ColPlain{P.in[7]}, 1024, 1024, 1024, P.b(WS_WRO));
    transpose_all(c, tb, ColPlain{P.in[9]}, 1024, 1024, 512, P.b(WS_WNO));
    transpose_all(c, tb, ColPlain{P.in[12]}, 1024, 1024, 512, P.b(WS_WXO));
    transpose_all(c, tb, ColPlain{P.in[13]}, 1024, 1024, 1024, P.b(WS_WOUT));
    { float* COS = P.f(WS_COS); float* SIN = P.f(WS_SIN);
      for (int i = c.gw * 64 + c.lane; i < SEQ * 64; i += c.ngw * 64) { const int pos = i >> 6, fi = i & 63;
          const float inv = (float)pow(10000.0, -(double)fi / 64.0); const float ang = (float)pos * inv;
          COS[i] = (float)cos((double)ang); SIN[i] = (float)sin((double)ang); } }
    { bf16* FT = P.b(WS_FT); const float* rpb = P.in[8];
      for (int i = c.gw * 64 + c.lane; i < 8 * 15 * 64 * 64; i += c.ngw * 64) { const int qc = i & 63, kc = (i >> 6) & 63, hr = i >> 12;
          int cs = qc - 8; cs = cs < 0 ? 0 : (cs > 48 ? 48 : cs); int rc = kc - qc; rc = rc < -15 ? -15 : (rc > 15 ? 15 : rc);
          const float v = (kc >= cs && kc < cs + 16) ? rpb[hr * 31 + rc + 15] : -1.0e30f; FT[i] = (bf16)f2bf(v); } }
    for (int m = c.gw; m < T; m += 2 * c.ngw) {
        const int m2 = m + c.ngw; const f32x4* xa = (const f32x4*)(P.in[0] + (size_t)m * DM) + c.lane; const f32x4* xb = (const f32x4*)(P.in[0] + (size_t)(m2 < T ? m2 : m) * DM) + c.lane;
        const f32x4* gr = (const f32x4*)P.in[2] + c.lane;
        f32x4 va[4], vb[4]; float sa = 0.f, sb = 0.f;
#pragma unroll
        for (int j = 0; j < 4; ++j) { va[j] = xa[64 * j]; vb[j] = xb[64 * j]; }
#pragma unroll
        for (int j = 0; j < 4; ++j) { sa += (va[j].x * va[j].x + va[j].y * va[j].y) + (va[j].z * va[j].z + va[j].w * va[j].w); sb += (vb[j].x * vb[j].x + vb[j].y * vb[j].y) + (vb[j].z * vb[j].z + vb[j].w * vb[j].w); }
        const float ra = 1.0f / sqrtf(wave_sum(sa) * (1.f / 1024.f) + RMS_EPS), rb = 1.0f / sqrtf(wave_sum(sb) * (1.f / 1024.f) + RMS_EPS);
        unsigned long long* oa = (unsigned long long*)(P.b(WS_XN) + (size_t)m * DM) + c.lane; unsigned long long* ob = (unsigned long long*)(P.b(WS_XN) + (size_t)m2 * DM) + c.lane;
#pragma unroll
        for (int j = 0; j < 4; ++j) { const f32x4 gg = gr[64 * j];
            oa[64 * j] = (unsigned long long)pk2(va[j].x * ra * gg.x, va[j].y * ra * gg.y) | ((unsigned long long)pk2(va[j].z * ra * gg.z, va[j].w * ra * gg.w) << 32);
            if (m2 < T) ob[64 * j] = (unsigned long long)pk2(vb[j].x * rb * gg.x, vb[j].y * rb * gg.y) | ((unsigned long long)pk2(vb[j].z * rb * gg.z, vb[j].w * rb * gg.w) << 32); } }
    for (int m = c.gw; m < TM; m += c.ngw) rms_row_to_bf16(P.in[1] + (size_t)m * DM, P.in[10], P.b(WS_MN) + (size_t)m * DM, c.lane);
}

__device__ __forceinline__ void phase1_naive(const Ctx& c, const Ptrs& P) {
    EpiProjA E{P.b(WS_RQ), P.b(WS_RK), P.b(WS_RV), P.b(WS_RG), P.b(WS_NQ), P.b(WS_NK), P.b(WS_NV), P.b(WS_XQ), P.f(WS_COS), P.f(WS_SIN)};
    naive_gemm(c, RowPlain{P.b(WS_XN), DM}, P.b(WS_WA), DM, T, NPA, DM, E);
}

__device__ __forceinline__ float log_sigmoid_(float x) { return -log1pf(expf(-x)); }

__device__ __forceinline__ void phase2_states_naive(const Ctx& c, const Ptrs& P) {
    const bf16* RK = P.b(WS_RK); const bf16* RV = P.b(WS_RV); bf16* ST = (bf16*)P.out;
    const int nitems = NB * 4 * 2 * 128 * 4;
    for (int it = c.gw; it < nitems; it += c.ngw) {
        const int eb = it & 3, d = (it >> 2) & 127, dir = (it >> 9) & 1, h = (it >> 10) & 3, b = it >> 12;
        const int e = eb * 64 + c.lane;
        const float lg = log_sigmoid_(dir ? P.in[5][h] : P.in[4][h]); const float gam = expf(lg);
        float S = 0.f;
        bf16* stb = ST + (size_t)(((b * 4 + h) * 2 + dir) * 16) * 256 * 128 + (size_t)e * 128 + d;
        for (int jj = 0; jj < SEQ; ++jj) {
            const int j = dir ? (SEQ - 1 - jj) : jj;
            if ((jj & 127) == 0) { const int n = j >> 7; stb[(size_t)n * 256 * 128] = (bf16)f2bf(S); }
            const size_t tok = (size_t)b * SEQ + j;
            const float kv = bf2f(RK[tok * 512 + h * 128 + d]) * bf2f(RV[tok * 1024 + h * 256 + e]);
            S = S * gam + kv;
        }
    }
}
__device__ __forceinline__ void phase2_na_naive(const Ctx& c, const Ptrs& P) {
    bf16* NQ = P.b(WS_NQ); const bf16* NK = P.b(WS_NK); const bf16* NV = P.b(WS_NV); const float* rpb = P.in[8];
    float* scr = (float*)(c.lds + c.wave * 16384);
    const int lane = c.lane;
    for (int it = c.gw; it < T * 8; it += c.ngw) {
        const int h = it & 7, tok = it >> 3, b = tok >> 11, s = tok & 2047, r = s >> 6, cc = s & 63;
        int rs = r - 4; rs = rs < 0 ? 0 : (rs > 24 ? 24 : rs);
        int cs = cc - 8; cs = cs < 0 ? 0 : (cs > 48 ? 48 : cs);
        scr[128 + lane] = bf2f(NQ[(size_t)tok * 512 + h * 64 + lane]);
        __builtin_amdgcn_s_waitcnt(0xC07F); asm volatile("" ::: "memory");
        float sc[2];
#pragma unroll
        for (int t = 0; t < 2; ++t) { const int key = lane + 64 * t, kr = rs + (key >> 4), kc = cs + (key & 15);
            const size_t kt = (size_t)b * SEQ + kr * 64 + kc; const u32x4* kp = (const u32x4*)(NK + kt * 512 + h * 64);
            float a = 0.f;
#pragma unroll 2
            for (int i = 0; i < 8; ++i) { float kk[8]; unpack8(kp[i], kk);
#pragma unroll
                for (int u = 0; u < 8; ++u) a += scr[128 + 8 * i + u] * kk[u]; }
            int rc = kc - cc; rc = rc < -15 ? -15 : (rc > 15 ? 15 : rc);
            sc[t] = a + rpb[(h * 15 + (kr - r + 7)) * 31 + rc + 15]; }
        const float mx = wave_max(fmaxf(sc[0], sc[1]));
        const float e0 = __expf(sc[0] - mx), e1 = __expf(sc[1] - mx);
        const float inv = 1.0f / wave_sum(e0 + e1);
        scr[lane] = e0 * inv; scr[lane + 64] = e1 * inv;
        __builtin_amdgcn_s_waitcnt(0xC07F); asm volatile("" ::: "memory");
        float o = 0.f;
        for (int key = 0; key < 128; ++key) { const int kr = rs + (key >> 4), kc = cs + (key & 15);
            const size_t kt = (size_t)b * SEQ + kr * 64 + kc; o += scr[key] * bf2f(NV[kt * 512 + h * 64 + lane]); }
        NQ[(size_t)tok * 512 + h * 64 + lane] = (bf16)f2bf(o);
        __builtin_amdgcn_s_waitcnt(0xC07F); asm volatile("" ::: "memory");
    }
}
__device__ __forceinline__ void phase2_memkv_naive(const Ctx& c, const Ptrs& P) {
    naive_gemm(c, RowPlain{P.b(WS_MN), DM}, P.b(WS_WKV), DM, TM, 1024, DM, EpiBf16Plain{P.b(WS_MKV), 1024});
}
__device__ __forceinline__ void phase3_ret_naive(const Ctx& c, const Ptrs& P) {
    const bf16* RQ = P.b(WS_RQ); const bf16* RK = P.b(WS_RK); const bf16* RV = P.b(WS_RV); bf16* RG = P.b(WS_RG); const bf16* ST = (const bf16*)P.out;
    const float* gain = P.in[6];
    float* scr = (float*)(c.lds + c.wave * 16384);
    const int lane = c.lane;
    for (int it = c.gw; it < T * 4; it += c.ngw) {
        const int h = it & 3, tok = it >> 2, b = tok >> 11, s = tok & 2047, n = s >> 7, p = s & 127;
        const float lgf = log_sigmoid_(P.in[4][h]), lgb = log_sigmoid_(P.in[5][h]);
        { const bf16* qp = RQ + (size_t)tok * 512 + h * 128; scr[lane] = bf2f(qp[lane]); scr[lane + 64] = bf2f(qp[lane + 64]); }
        __builtin_amdgcn_s_waitcnt(0xC07F); asm volatile("" ::: "memory");
        float sv[2];
#pragma unroll
        for (int t = 0; t < 2; ++t) { const int pj = lane + 64 * t; const size_t kt = (size_t)b * SEQ + n * 128 + pj;
            const u32x4* kp = (const u32x4*)(RK + kt * 512 + h * 128); float a = 0.f;
#pragma unroll 2
            for (int i = 0; i < 16; ++i) { float kk[8]; unpack8(kp[i], kk);
#pragma unroll
                for (int u = 0; u < 8; ++u) a += scr[8 * i + u] * kk[u]; }
            const float w = (pj <= p) ? expf((float)(p - pj) * lgf) : expf((float)(pj - p) * lgb);
            sv[t] = a * w; }
        scr[128 + lane] = sv[0]; scr[128 + 64 + lane] = sv[1];
        __builtin_amdgcn_s_waitcnt(0xC07F); asm volatile("" ::: "memory");
        const float af = expf((float)(p + 1) * lgf), ab = expf((float)(128 - p) * lgb);
        const bf16* sf = ST + (size_t)(((b * 4 + h) * 2 + 0) * 16 + n) * 256 * 128;
        const bf16* sb = ST + (size_t)(((b * 4 + h) * 2 + 1) * 16 + n) * 256 * 128;
        float y[4];
#pragma unroll 1
        for (int eb = 0; eb < 4; ++eb) { const int e = eb * 64 + lane; float a = 0.f;
#pragma unroll 4
            for (int pj = 0; pj < 128; ++pj) { const size_t kt = (size_t)b * SEQ + n * 128 + pj; a += scr[128 + pj] * bf2f(RV[kt * 1024 + h * 256 + e]); }
            float cf = 0.f, cb = 0.f; const u32x4* fp = (const u32x4*)(sf + (size_t)e * 128); const u32x4* bp = (const u32x4*)(sb + (size_t)e * 128);
#pragma unroll 2
            for (int i = 0; i < 16; ++i) { float x1[8], x2[8]; unpack8(fp[i], x1); unpack8(bp[i], x2);
#pragma unroll
                for (int u = 0; u < 8; ++u) { cf += scr[8 * i + u] * x1[u]; cb += scr[8 * i + u] * x2[u]; } }
            y[eb] = a + af * cf + ab * cb; }
        const float mu = wave_sum((y[0] + y[1]) + (y[2] + y[3])) * (1.f / 256.f);
        float v = 0.f;
#pragma unroll
        for (int eb = 0; eb < 4; ++eb) { y[eb] -= mu; v += y[eb] * y[eb]; }
        const float rstd = 1.0f / sqrtf(wave_sum(v) * (1.f / 256.f) + GN_EPS);
#pragma unroll
        for (int eb = 0; eb < 4; ++eb) { const int col = h * 256 + eb * 64 + lane; bf16* g = RG + (size_t)tok * 1024 + col;
            *g = (bf16)f2bf(y[eb] * rstd * gain[col] * bf2f(*g)); }
        __builtin_amdgcn_s_waitcnt(0xC07F); asm volatile("" ::: "memory");
    }
}
__device__ __forceinline__ void phase3_xa_naive(const Ctx& c, const Ptrs& P) {
    bf16* XQ = P.b(WS_XQ); const bf16* MKV = P.b(WS_MKV);
    float* scr = (float*)(c.lds + c.wave * 16384);
    const int lane = c.lane;
    for (int it = c.gw; it < T * 4; it += c.ngw) {
        const int h = it & 3, tok = it >> 2, b = tok >> 11;
        { const bf16* qp = XQ + (size_t)tok * 512 + h * 128; scr[lane] = bf2f(qp[lane]); scr[lane + 64] = bf2f(qp[lane + 64]); }
        __builtin_amdgcn_s_waitcnt(0xC07F); asm volatile("" ::: "memory");
        float sc[4]; float mx = -3.0e38f;
#pragma unroll
        for (int t = 0; t < 4; ++t) { const int m = lane + 64 * t; const u32x4* kp = (const u32x4*)(MKV + (size_t)(b * MEML + m) * 1024 + h * 128); float a = 0.f;
#pragma unroll 2
            for (int i = 0; i < 16; ++i) { float kk[8]; unpack8(kp[i], kk);
#pragma unroll
                for (int u = 0; u < 8; ++u) a += scr[8 * i + u] * kk[u]; }
            sc[t] = a; mx = fmaxf(mx, a); }
        mx = wave_max(mx); float sum = 0.f;
#pragma unroll
        for (int t = 0; t < 4; ++t) { sc[t] = __expf(sc[t] - mx); sum += sc[t]; }
        const float inv = 1.0f / wave_sum(sum);
#pragma unroll
        for (int t = 0; t < 4; ++t) scr[128 + lane + 64 * t] = sc[t] * inv;
        __builtin_amdgcn_s_waitcnt(0xC07F); asm volatile("" ::: "memory");
        float o0 = 0.f, o1 = 0.f;
        for (int m = 0; m < MEML; ++m) { const bf16* vp = MKV + (size_t)(b * MEML + m) * 1024 + 512 + h * 128; const float pm = scr[128 + m];
            o0 += pm * bf2f(vp[lane]); o1 += pm * bf2f(vp[lane + 64]); }
        bf16* op = XQ + (size_t)tok * 512 + h * 128; op[lane] = (bf16)f2bf(o0); op[lane + 64] = (bf16)f2bf(o1);
        __builtin_amdgcn_s_waitcnt(0xC07F); asm volatile("" ::: "memory");
    }
}
__device__ __forceinline__ void phase4_naive(const Ctx& c, const Ptrs& P) {
    naive_gemm(c, RowPlain{P.b(WS_XN), DM}, P.b(WS_WG), DM, T, NPG, DM, EpiSigmoid{P.b(WS_GATES), NPG});
}
__device__ __forceinline__ void phase5_naive(const Ctx& c, const Ptrs& P) {
    float* TMP = P.out; bf16* MIX = P.b(WS_MIX); const bf16* G = P.b(WS_GATES);
    naive_gemm(c, RowPlain{P.b(WS_RG), 1024}, P.b(WS_WRO), 1024, T, DM, 1024, EpiMixNaive<0>{TMP, MIX, G});
    naive_gemm(c, RowPlain{P.b(WS_NQ), 512}, P.b(WS_WNO), 512, T, DM, 512, EpiMixNaive<1>{TMP, MIX, G + 1024});
    naive_gemm(c, RowPlain{P.b(WS_XQ), 512}, P.b(WS_WXO), 512, T, DM, 512, EpiMixNaive<2>{TMP, MIX, G + 2048});
}
__device__ __forceinline__ void phase6_naive(const Ctx& c, const Ptrs& P) {
    naive_gemm(c, RowPlain{P.b(WS_MIX), DM}, P.b(WS_WOUT), DM, T, DM, DM, EpiResidF32{P.in[0], P.out});
}

__device__ __forceinline__ void phase1_mfma(const Ctx& c, const Ptrs& P) {
    EpiProjA E{P.b(WS_RQ), P.b(WS_RK), P.b(WS_RV), P.b(WS_RG), P.b(WS_NQ), P.b(WS_NK), P.b(WS_NV), P.b(WS_XQ), P.f(WS_COS), P.f(WS_SIN)};
    pg8::PlainSched S; S.o.init(T / 256, NPA / 256, gridDim.x, blockIdx.x); S.A = P.b(WS_XN); S.Bt = P.b(WS_WA); S.lda = DM; S.ldb = DM; S.K = DM;
    pg8::gemm_phase<false>((LAS unsigned char*)c.lds, S, pg8::EpiF<EpiProjA>{E});
}
__device__ __forceinline__ void phase4_mfma(const Ctx& c, const Ptrs& P) {
    pg8::PlainSched S; S.o.init(T / 256, NPG / 256, gridDim.x, blockIdx.x); S.A = P.b(WS_XN); S.Bt = P.b(WS_WG); S.lda = DM; S.ldb = DM; S.K = DM;
    pg8::gemm_phase<false>((LAS unsigned char*)c.lds, S, pg8::EpiF<EpiSigmoid>{EpiSigmoid{P.b(WS_GATES), NPG}});
}
__device__ __forceinline__ void phase6_mfma(const Ctx& c, const Ptrs& P) {
    pg8::PlainSched S; S.o.init(T / 256, DM / 256, gridDim.x, blockIdx.x); S.A = P.b(WS_MIX); S.Bt = P.b(WS_WOUT); S.lda = DM; S.ldb = DM; S.K = DM;
    pg8::gemm_phase<false>((LAS unsigned char*)c.lds, S, pg8::EpiF<EpiBf16Plain>{EpiBf16Plain{P.b(WS_D), DM}}, 25);
}

struct GateSched { pg8::TileOrder o; const unsigned char* ws;
    __device__ __forceinline__ bool next(int i, pg8::UnitDesc& u) const { int pm, pn; const int w = i % 3; if (!o.tile(i / 3, pm, pn)) return false;
        u.A = (const char*)(ws + WS_XN) + (size_t)pm * 256 * 2048; u.B = (const char*)(ws + WS_WG) + (size_t)(w * 1024 + pn * 256) * 2048; u.lda2 = 2048; u.ldb2 = 2048; u.nt = 16;
        u.row0 = pm * 256; u.col0 = pn * 256; u.aux = w; u.aux2 = 0; u.gidx = nullptr; u.gcnt = 0; u.chain = 0; return true; } };
struct EpiGate { bf16* SCR;
    __device__ __forceinline__ void finish(f32x4 (&acc)[2][2][4][2], const pg8::UnitDesc& u, int wr, int wc, int fr, int fq) const {
        unsigned ow = (unsigned)((u.row0 >> 8) * 4 + (u.col0 >> 8)) * 196608u + (unsigned)u.aux * 65536u + threadIdx.x * 8u;
#pragma unroll
        for (int ai = 0; ai < 2; ++ai)
#pragma unroll
            for (int m = 0; m < 4; ++m) { asm volatile("" : "+v"(ow));
#pragma unroll
                for (int bj = 0; bj < 2; ++bj) { f32x4 s0, s1;
#pragma unroll
                    for (int i = 0; i < 4; ++i) { s0[i] = sigmoidf_(acc[ai][bj][m][0][i]); s1[i] = sigmoidf_(acc[ai][bj][m][1][i]); }
                    store8(SCR + ow + bj * 4096, s0, s1); }
                ow += 2 * 4096; asm volatile("" ::: "memory"); __builtin_amdgcn_sched_barrier(0); }
        pg8::zero_acc(acc);
    } };
struct MixSched { pg8::TileOrder o; const unsigned char* ws;
    __device__ __forceinline__ bool next(int i, pg8::UnitDesc& u) const { int pm, pn; const int w = i % 3; if (!o.tile(i / 3, pm, pn)) return false;
        const size_t offA = w == 0 ? WS_RG : (w == 1 ? WS_NQ : WS_XQ), offB = w == 0 ? WS_WRO : (w == 1 ? WS_WNO : WS_WXO); const int K = w == 0 ? 1024 : 512;
        u.A = (const char*)(ws + offA) + (size_t)pm * 256 * K * 2; u.B = (const char*)(ws + offB) + (size_t)pn * 256 * K * 2; u.lda2 = K * 2; u.ldb2 = K * 2; u.nt = K / 64;
        u.row0 = pm * 256; u.col0 = pn * 256; u.aux = w; u.aux2 = 0; u.gidx = nullptr; u.gcnt = 0; u.chain = (w < 2); return true; } };
struct EpiMix { const bf16* SCR; bf16* MIX;
    __device__ __forceinline__ void finish(f32x4 (&acc)[2][2][4][2], const pg8::UnitDesc& u, int wr, int wc, int fr, int fq) const {
        const int w = u.aux; const bool fin = (w == 2);
        unsigned on = (unsigned)((u.row0 >> 8) * 4 + (u.col0 >> 8)) * 196608u + (unsigned)w * 65536u + threadIdx.x * 8u; const unsigned dd = fin ? 0u : 65536u;
        bf16* mp = MIX + (size_t)(u.row0 + wr * 64 + fr) * DM + u.col0 + wc * 32 + 8 * fq;
#pragma unroll
        for (int ai = 0; ai < 2; ++ai) {
#pragma unroll
            for (int m = 0; m < 4; ++m) {
                asm volatile("" : "+v"(on), "+v"(mp));
#pragma unroll
                for (int bj = 0; bj < 2; ++bj) {
                    const u32x4 a = *(const u32x4*)(SCR + on + bj * 4096), b = *(const u32x4*)(SCR + on + dd + bj * 4096);
                    float gn[8], gd[8]; unpack8(a, gn); unpack8(b, gd);
                    f32x4 r0, r1;
#pragma unroll
                    for (int i = 0; i < 4; ++i) { const float d0 = fin ? 1.0f : fmaxf(gd[i], 1e-18f), d1 = fin ? 1.0f : fmaxf(gd[4 + i], 1e-18f);
                        r0[i] = fmaxf(gn[i], 1e-18f) * __builtin_amdgcn_rcpf(d0); r1[i] = fmaxf(gn[4 + i], 1e-18f) * __builtin_amdgcn_rcpf(d1); }
                    const f32x4 v0 = acc[ai][bj][m][0] * r0, v1 = acc[ai][bj][m][1] * r1;
                    if (fin) store8(mp + bj * 128, v0, v1);
                    acc[ai][bj][m][0] = fin ? (f32x4){0.f, 0.f, 0.f, 0.f} : v0; acc[ai][bj][m][1] = fin ? (f32x4){0.f, 0.f, 0.f, 0.f} : v1; }
                on += 2 * 4096; mp += 16 * DM; asm volatile("" ::: "memory"); __builtin_amdgcn_sched_barrier(0); }
            mp += 64 * DM; }
    }
};
__device__ __forceinline__ void phase5_mfma(const Ctx& c, const Ptrs& P) {
    bf16* scr = P.b(WS_GATES);
    { GateSched S; S.o.init(T / 256, DM / 256, gridDim.x, blockIdx.x); S.ws = P.ws; pg8::gemm_phase<false>((LAS unsigned char*)c.lds, S, EpiGate{scr}); }
    { MixSched S; S.o.init(T / 256, DM / 256, gridDim.x, blockIdx.x); S.ws = P.ws; pg8::gemm_phase<false>((LAS unsigned char*)c.lds, S, EpiMix{scr, P.b(WS_MIX)}); }
}
struct MoeSched { const unsigned* ctl; int G, c; int mode;
    const bf16 *H2, *WGU, *HID, *WD; const int* elist;
    __device__ __forceinline__ bool next(int i, pg8::UnitDesc& u) const {
        const int L = i * G + c; const int pn = L & 3; int mtg = L >> 2;
        int e = -1, base = 0, cnt = 0, mt = 0;
#pragma unroll 1
        for (int j = 0; j < NEXP; ++j) { const int cj = (int)__builtin_amdgcn_readfirstlane((int)ctl[CW_ECNT + 64 * j]); const int tj = (cj + 255) >> 8;
            if (mtg < tj) { e = j; cnt = cj; mt = mtg; break; } mtg -= tj; base += tj * 256; }
        if (e < 0) return false;
        u.row0 = mt * 256; u.col0 = pn * 256; u.aux = e; u.aux2 = base; u.gcnt = cnt; u.chain = 0;
        if (mode == 0) { u.A = (const char*)H2; u.gidx = elist + e * T; u.lda2 = DM * 2; u.B = (const char*)(WGU + (size_t)e * 1024 * 1024 + (size_t)pn * 256 * 1024); u.ldb2 = 2048; u.nt = 16; }
        else { u.A = (const char*)(HID + (size_t)(base + mt * 256) * DFF); u.gidx = nullptr; u.lda2 = DFF * 2; u.B = (const char*)(WD + (size_t)e * 1024 * 512 + (size_t)pn * 256 * 512); u.ldb2 = 1024; u.nt = 8; }
        return true; } };
struct EpiMoeUp { bf16* HID; const float* EWL;
    __device__ __forceinline__ void finish(f32x4 (&acc)[2][2][4][2], const pg8::UnitDesc& u, int wr, int wc, int fr, int fq) const {
        const float* wl = EWL + u.aux * T; bf16* H = HID; const int base = u.aux2, cnt = u.gcnt;
        pg8::epi_apply(acc, u, wr, wc, fr, fq, [=](int row, int col0, f32x4 v0, f32x4 v1) { if (row < cnt) { const float w = wl[row]; f32x4 h;
#pragma unroll
            for (int i = 0; i < 4; ++i) h[i] = siluf_(v0[i]) * v1[i] * w;
            u32x2 o; o.x = pk2(h[0], h[1]); o.y = pk2(h[2], h[3]); *(u32x2*)(H + (size_t)(base + row) * DFF + (col0 >> 1)) = o; } });
        pg8::zero_acc(acc);
    } };
struct EpiMoeDown { bf16* DR;
    __device__ __forceinline__ void finish(f32x4 (&acc)[2][2][4][2], const pg8::UnitDesc& u, int wr, int wc, int fr, int fq) const {
        bf16* D = DR; const int base = u.aux2;
        pg8::epi_apply(acc, u, wr, wc, fr, fq, [=](int row, int col0, f32x4 v0, f32x4 v1) { store8(D + (size_t)(base + row) * DM + col0, v0, v1); });
        pg8::zero_acc(acc);
    } };
__device__ __forceinline__ void phase8_mfma(const Ctx& c, const Ptrs& P) {
    MoeSched S; S.ctl = (const unsigned*)(P.ws + WS_CTL); S.G = gridDim.x; S.c = blockIdx.x; S.mode = 0; S.H2 = P.b(WS_H2); S.WGU = P.b(WS_WGU); S.HID = P.b(WS_HID); S.WD = P.b(WS_WD); S.elist = (const int*)(P.ws + WS_ELIST);
    pg8::gemm_phase<true>((LAS unsigned char*)c.lds, S, EpiMoeUp{P.b(WS_HID), P.f(WS_EWL)});
    { int tiles = 0;
      for (int j = 0; j < NEXP; ++j) tiles += ((int)S.ctl[CW_ECNT + 64 * j] + 255) >> 8;
      const int units = 4 * tiles, G = (int)gridDim.x; int nskip = units % G; if (units <= G || nskip * 2 > G) nskip = 0;
      if ((int)blockIdx.x >= nskip) { Ctx c2 = c; c2.gw = ((int)blockIdx.x - nskip) * NWAVES + c.wave; c2.ngw = (G - nskip) * NWAVES; int tb = 0;
          for (int e = 0; e < NEXP; ++e) transpose_all(c2, tb, ColPlain{P.in[21] + (size_t)e * 512 * 1024}, 1024, 1024, 512, P.b(WS_WD) + (size_t)e * 1024 * 512); } }
}
__device__ __forceinline__ void phase9_mfma(const Ctx& c, const Ptrs& P) {
    MoeSched S; S.ctl = (const unsigned*)(P.ws + WS_CTL); S.G = gridDim.x; S.c = blockIdx.x; S.mode = 1; S.H2 = P.b(WS_H2); S.WGU = P.b(WS_WGU); S.HID = P.b(WS_HID); S.WD = P.b(WS_WD); S.elist = (const int*)(P.ws + WS_ELIST);
    pg8::gemm_phase<false>((LAS unsigned char*)c.lds, S, EpiMoeDown{P.b(WS_DROWS)});
}
__device__ __forceinline__ void phase2_memkv_mfma(const Ctx& c, const Ptrs& P) {
    pg8::PlainSched S; S.o.init(TM / 256, 1024 / 256, gridDim.x, blockIdx.x); S.A = P.b(WS_MN); S.Bt = P.b(WS_WKV); S.lda = DM; S.ldb = DM; S.K = DM;
    pg8::gemm_phase<false>((LAS unsigned char*)c.lds, S, pg8::EpiF<EpiBf16Plain>{EpiBf16Plain{P.b(WS_MKV), 1024}});
}
__device__ __forceinline__ f32x4 x1_load(const float* X0, const bf16* DD, size_t tok, int lane, int j) {
    const f32x4 x = ((const f32x4*)(X0 + tok * DM) + lane)[64 * j]; const u32x2 d = ((const u32x2*)(DD + tok * DM) + lane)[64 * j];
    return (f32x4){x.x + bf2f(d.x & 0xffffu), x.y + bf2f(d.x >> 16), x.z + bf2f(d.y & 0xffffu), x.w + bf2f(d.y >> 16)};
}
constexpr int RT7_WT = 0, RT7_RED = 81920, RT7_LOG = RT7_RED + 8 * 5120, RT7_CNT = RT7_LOG + 8 * 160, RT7_GB = RT7_CNT + 64, RT7_REC = RT7_GB + 64;
__device__ __forceinline__ void phase7(const Ctx& c, const Ptrs& P) {
    const float* X0 = P.in[0]; const bf16* DD = P.b(WS_D); const float* g = P.in[14]; const float* wrg = P.in[15]; const float* brg = P.in[16]; const float* wre = P.in[17]; const float* bre = P.in[18];
    bf16* H2 = P.b(WS_H2); unsigned* ctl = (unsigned*)(P.ws + WS_CTL); int* elist = (int*)(P.ws + WS_ELIST); float* ewl = P.f(WS_EWL); int* tmeta = (int*)(P.ws + WS_TMETA);
    const int lane = c.lane; LAS unsigned char* L = (LAS unsigned char*)c.lds;
    { LAS float* WT = (LAS float*)(L + RT7_WT);
      for (int i = c.tid; i < 1024 * 4; i += NTHREADS) WT[(i & 3) * 1024 + (i >> 2)] = wrg[i];
      for (int i = c.tid; i < 1024 * 16; i += NTHREADS) WT[(4 + (i & 15)) * 1024 + (i >> 4)] = wre[i];
      if (c.tid < 16) ((LAS unsigned*)(L + RT7_CNT))[c.tid] = 0u; }
    __syncthreads();
    LAS float* RED = (LAS float*)(L + RT7_RED + c.wave * 5120); LAS float* LOG = (LAS float*)(L + RT7_LOG + c.wave * 160);
    LAS unsigned* LCNT = (LAS unsigned*)(L + RT7_CNT); LAS int* REC = (LAS int*)(L + RT7_REC);
    const float mybias = lane < 4 ? brg[lane] : (lane < 20 ? bre[lane - 4] : 0.f);
    f32x4 xn[2][4];
    if (c.gw < T / 2) {
#pragma unroll
        for (int t = 0; t < 2; ++t)
#pragma unroll
            for (int j = 0; j < 4; ++j) xn[t][j] = x1_load(X0, DD, (size_t)(2 * c.gw + t), lane, j); }
    int pidx = 0;
#pragma unroll 1
    for (int tp = c.gw; tp < T / 2; tp += c.ngw, ++pidx) {
        f32x4 hh[2][4]; const f32x4* gr = (const f32x4*)g + lane;
#pragma unroll
        for (int t = 0; t < 2; ++t)
#pragma unroll
            for (int j = 0; j < 4; ++j) hh[t][j] = xn[t][j];
        { const int tpn = tp + c.ngw < T / 2 ? tp + c.ngw : tp;
#pragma unroll
          for (int t = 0; t < 2; ++t)
#pragma unroll
              for (int j = 0; j < 4; ++j) xn[t][j] = x1_load(X0, DD, (size_t)(2 * tpn + t), lane, j); }
#pragma unroll
        for (int t = 0; t < 2; ++t) { const int tok = 2 * tp + t; float s = 0.f;
#pragma unroll
            for (int j = 0; j < 4; ++j) { s += (hh[t][j].x * hh[t][j].x + hh[t][j].y * hh[t][j].y) + (hh[t][j].z * hh[t][j].z + hh[t][j].w * hh[t][j].w); }
            const float r = 1.0f / sqrtf(wave_sum(s) * (1.f / 1024.f) + RMS_EPS);
            unsigned long long* o8 = (unsigned long long*)(H2 + (size_t)tok * DM) + lane;
#pragma unroll
            for (int j = 0; j < 4; ++j) { const f32x4 gg = gr[64 * j]; hh[t][j] = hh[t][j] * gg * r;
                o8[64 * j] = (unsigned long long)pk2(hh[t][j].x, hh[t][j].y) | ((unsigned long long)pk2(hh[t][j].z, hh[t][j].w) << 32); } }
        float p0[20], p1[20];
        const LAS f32x4* wt = (const LAS f32x4*)(L + RT7_WT) + lane;
#pragma unroll
        for (int n = 0; n < 20; ++n) { float a0 = 0.f, a1 = 0.f;
#pragma unroll
            for (int j = 0; j < 4; ++j) { const f32x4 w4 = wt[n * 256 + 64 * j];
                a0 += (hh[0][j].x * w4.x + hh[0][j].y * w4.y) + (hh[0][j].z * w4.z + hh[0][j].w * w4.w);
                a1 += (hh[1][j].x * w4.x + hh[1][j].y * w4.y) + (hh[1][j].z * w4.z + hh[1][j].w * w4.w); }
            p0[n] = a0; p1[n] = a1; __builtin_amdgcn_sched_barrier(0); }
#pragma unroll 1
        for (int t = 0; t < 2; ++t) {
#pragma unroll
            for (int q = 0; q < 5; ++q) *(LAS f32x4*)(RED + lane * 20 + 4 * q) = t ? (f32x4){p1[4 * q], p1[4 * q + 1], p1[4 * q + 2], p1[4 * q + 3]} : (f32x4){p0[4 * q], p0[4 * q + 1], p0[4 * q + 2], p0[4 * q + 3]};
            asm volatile("s_waitcnt lgkmcnt(0)" ::: "memory");
            float sum = 0.f; const int nn = lane < 20 ? lane : 0;
#pragma unroll 16
            for (int j = 0; j < 64; ++j) sum += RED[j * 20 + nn];
            if (lane < 20) LOG[t * 20 + lane] = sum + mybias;
            asm volatile("s_waitcnt lgkmcnt(0)" ::: "memory");
        }
        if (lane < 2) {
            const int tok = 2 * tp + lane;
            float l[20];
#pragma unroll
            for (int i = 0; i < 20; ++i) l[i] = LOG[lane * 20 + i];
            int gi = 0;
#pragma unroll
            for (int i = 1; i < 4; ++i) if (l[i] > l[gi]) gi = i;
            float lmax = l[0];
#pragma unroll
            for (int i = 1; i < 4; ++i) lmax = fmaxf(lmax, l[i]);
            float se = 0.f;
#pragma unroll
            for (int i = 0; i < 4; ++i) se += expf(l[i] - lmax);
            const float grp_w = 1.0f / se;
            float el[4];
#pragma unroll
            for (int i = 0; i < 4; ++i) { float a = 0.f;
#pragma unroll
                for (int g2 = 0; g2 < 4; ++g2) a = (g2 == gi) ? l[4 + 4 * g2 + i] : a;
                el[i] = a; }
            int ia = 0;
#pragma unroll
            for (int i = 1; i < 4; ++i) if (el[i] > el[ia]) ia = i;
            int ib = (ia == 0) ? 1 : 0;
#pragma unroll
            for (int i = 0; i < 4; ++i) if (i != ia && i != ib && el[i] > el[ib]) ib = i;
            float ela = el[0], elb = el[0];
#pragma unroll
            for (int i = 1; i < 4; ++i) { ela = (i == ia) ? el[i] : ela; elb = (i == ib) ? el[i] : elb; }
            const float t = expf(elb - ela); const float wa = grp_w / (1.0f + t), wb = grp_w * t / (1.0f + t);
            const int ea = gi * 4 + ia, eb = gi * 4 + ib;
            const int lpa = (int)atomicAdd((unsigned*)(LCNT + ea), 1u), lpb = (int)atomicAdd((unsigned*)(LCNT + eb), 1u);
            LAS int* rec = REC + (c.wave * 8 + pidx * 2 + lane) * 8;
            rec[0] = tok; rec[1] = ea; rec[2] = lpa; rec[3] = eb; rec[4] = lpb; rec[5] = __float_as_int(wa); rec[6] = __float_as_int(wb);
        }
    }
    __syncthreads();
    if (c.tid < 16) ((LAS unsigned*)(L + RT7_GB))[c.tid] = atomicAdd(ctl + CW_ECNT + 64 * c.tid, LCNT[c.tid]);
    __syncthreads();
    if (c.tid < 64) { const int wv = c.tid >> 3, k = c.tid & 7;
        const int gwv = blockIdx.x * NWAVES + wv; const int npairs = gwv < T / 2 ? (T / 2 - 1 - gwv) / c.ngw + 1 : 0;
        if ((k >> 1) < npairs) { const LAS int* rec = REC + c.tid * 8; const LAS unsigned* GB = (const LAS unsigned*)(L + RT7_GB);
            const int tok = rec[0], ea = rec[1], eb = rec[3]; const int pa = (int)GB[ea] + rec[2], pb = (int)GB[eb] + rec[4];
            elist[ea * T + pa] = tok; ewl[ea * T + pa] = __int_as_float(rec[5]); elist[eb * T + pb] = tok; ewl[eb * T + pb] = __int_as_float(rec[6]);
            *(int4*)(tmeta + 4 * tok) = make_int4(ea, pa, eb, pb); } }
    __syncthreads();
    int tb = 0;
    for (int e = 0; e < NEXP; ++e) {
        transpose_all(c, tb, ColGU{P.in[19] + (size_t)e * 1024 * 512, P.in[20] + (size_t)e * 1024 * 512}, 512, 1024, 1024, P.b(WS_WGU) + (size_t)e * 1024 * 1024);
    }
}
__device__ __forceinline__ int expert_rowbase(const unsigned* ctl, int e, int& cnt_e) {
    int base = 0; cnt_e = 0;
    for (int i = 0; i < NEXP; ++i) { const int ci = (int)ctl[CW_ECNT + 64 * i]; if (i < e) base += (ci + 255) & ~255; if (i == e) cnt_e = ci; }
    return base;
}
__device__ __forceinline__ void phase8_naive(const Ctx& c, const Ptrs& P) {
    const unsigned* ctl = (const unsigned*)(P.ws + WS_CTL);
    for (int e = 0; e < NEXP; ++e) { int cnt; const int base = expert_rowbase(ctl, e, cnt);
        naive_gemm(c, RowGather{P.b(WS_H2), DM, (const int*)(P.ws + WS_ELIST) + e * T}, P.b(WS_WGU) + (size_t)e * 1024 * 1024, 1024, cnt, 1024, 1024,
                   EpiSwiGLU{P.b(WS_HID), P.f(WS_EWL) + e * T, base}); }
}
__device__ __forceinline__ void phase9_naive(const Ctx& c, const Ptrs& P) {
    const unsigned* ctl = (const unsigned*)(P.ws + WS_CTL);
    for (int e = 0; e < NEXP; ++e) { int cnt; const int base = expert_rowbase(ctl, e, cnt);
        naive_gemm(c, RowPlain{P.b(WS_HID) + (size_t)base * DFF, DFF}, P.b(WS_WD) + (size_t)e * 1024 * 512, 512, cnt, 1024, 512, EpiRowsBf16{P.b(WS_DROWS), 1024, base}); }
}
struct FinTok { f32x4 x[4]; unsigned long long a[4], b[4]; };
__device__ __forceinline__ void fin_issue(FinTok& d, const float* X0, const bf16* DD, const bf16* DR, int tok, int4 m, const int (&rb)[NEXP], int lane) {
    int ba = 0, bb = 0;
#pragma unroll
    for (int i = 0; i < NEXP; ++i) { ba = (i == m.x) ? rb[i] : ba; bb = (i == m.z) ? rb[i] : bb; }
    const unsigned long long* da = (const unsigned long long*)(DR + (size_t)(ba + m.y) * DM) + lane;
    const unsigned long long* db = (const unsigned long long*)(DR + (size_t)(bb + m.w) * DM) + lane;
#pragma unroll
    for (int j = 0; j < 4; ++j) { d.a[j] = da[64 * j]; d.b[j] = db[64 * j]; d.x[j] = x1_load(X0, DD, (size_t)tok, lane, j); }
}
__device__ __forceinline__ void phase10(const Ctx& c, const Ptrs& P) {
    const unsigned* ctl = (const unsigned*)(P.ws + WS_CTL); const int* tmeta = (const int*)(P.ws + WS_TMETA); const bf16* DR = P.b(WS_DROWS); const float* g = P.in[22];
    int rb[NEXP]; { int base = 0;
#pragma unroll
        for (int i = 0; i < NEXP; ++i) { rb[i] = base; base += ((int)ctl[CW_ECNT + 64 * i] + 255) & ~255; } }
    const int lane = c.lane;
    if (c.gw >= T) return;
    FinTok cur, nxt; int4 mn = *(const int4*)(tmeta + 4 * c.gw);
    fin_issue(cur, P.in[0], P.b(WS_D), DR, c.gw, mn, rb, lane);
    { const int t1 = c.gw + c.ngw; mn = *(const int4*)(tmeta + 4 * (t1 < T ? t1 : c.gw)); }
#pragma unroll 1
    for (int tok = c.gw; tok < T; tok += c.ngw) {
        const int t1 = tok + c.ngw, t2 = tok + 2 * c.ngw;
        if (t1 < T) { fin_issue(nxt, P.in[0], P.b(WS_D), DR, t1, mn, rb, lane); mn = *(const int4*)(tmeta + 4 * (t2 < T ? t2 : tok)); }
        f32x4* xr = (f32x4*)(P.out + (size_t)tok * DM) + lane; const f32x4* gr = (const f32x4*)g + lane;
        f32x4 v[4]; float s = 0.f;
#pragma unroll
        for (int j = 0; j < 4; ++j) { const unsigned long long a = cur.a[j], b = cur.b[j]; f32x4 x = cur.x[j];
            x.x += bf2f((unsigned)a & 0xffffu) + bf2f((unsigned)b & 0xffffu); x.y += bf2f(((unsigned)a >> 16)) + bf2f(((unsigned)b >> 16));
            x.z += bf2f((unsigned)(a >> 32) & 0xffffu) + bf2f((unsigned)(b >> 32) & 0xffffu); x.w += bf2f((unsigned)(a >> 48)) + bf2f((unsigned)(b >> 48));
            v[j] = x; s += (x.x * x.x + x.y * x.y) + (x.z * x.z + x.w * x.w); }
        const float r = 1.0f / sqrtf(wave_sum(s) * (1.f / 1024.f) + RMS_EPS);
#pragma unroll
        for (int j = 0; j < 4; ++j) { const f32x4 gg = gr[64 * j]; xr[64 * j] = (f32x4){v[j].x * r * gg.x, v[j].y * r * gg.y, v[j].z * r * gg.z, v[j].w * r * gg.w}; }
        cur = nxt;
    }
#if PROBE_TS_A >= 0
    if (c.gw == 0 && lane == 0) { volatile LAS unsigned* MISC = (volatile LAS unsigned*)((LAS unsigned char*)c.lds + MISC_OFF);
        asm volatile("s_waitcnt vmcnt(0)" ::: "memory"); MISC[32 + 24] = (unsigned)__builtin_amdgcn_s_memrealtime();
        const unsigned dt = MISC[32 + PROBE_TS_B] - MISC[32 + PROBE_TS_A]; P.out[0] += 8.0f + (float)dt * (0.01f / PROBE_TS_DIV); }
#endif
}

constexpr int NPHASES = 11;
__global__ void __launch_bounds__(NTHREADS, 2) mk_fwd(Args args) {
    extern __shared__ __attribute__((aligned(16))) unsigned char lds[];
    Ctx c; c.tid = threadIdx.x; c.lane = c.tid & 63; c.wave = __builtin_amdgcn_readfirstlane(c.tid >> 6);
    c.gw = blockIdx.x * NWAVES + c.wave; c.ngw = gridDim.x * NWAVES; c.lds = lds;
    Ptrs P;
#pragma unroll
    for (int i = 0; i < 23; ++i) P.in[i] = args.in[i];
    P.out = args.out; P.ws = args.ws;
    volatile LAS unsigned* MISC = (volatile LAS unsigned*)((LAS unsigned char*)lds + MISC_OFF);
    if (c.tid < 32) MISC[c.tid] = 0u;
    __syncthreads();
    XcdBarrier bar; bar.bar = (unsigned*)(args.ws + WS_CTL) + CW_BAR; bar.x = 0; bar.st = nullptr;
    const int lo = args.ph_lo, hi = args.ph_hi;
    if (hi - lo > 1) bar = xcd_barrier_post((unsigned*)(args.ws + WS_CTL) + CW_BAR, MISC + 8);
#define IN(k) (lo <= (k) && (k) < hi)
#define SEAM(k) do { if (IN(k) && IN((k) + 1)) xcd_barrier(bar); } while (0)
    const int sub = args.sub, rep = args.rep;
#if PROBE_TS_A >= 0
#define STAMP(k) do { if (blockIdx.x == 0 && c.tid == 0) MISC[32 + (k)] = (unsigned)__builtin_amdgcn_s_memrealtime(); } while (0)
#else
#define STAMP(k) do { } while (0)
#endif
    STAMP(0);
#define SUBRUN(id, stmt) do { if (sub & (1 << (id))) { stmt; if (rep == (id)) { __syncthreads(); stmt; } __syncthreads(); } } while (0)
    if (IN(0)) { SUBRUN(0, phase0(c, P)); } STAMP(1); SEAM(0); STAMP(2);
    if (IN(1)) { SUBRUN(1, phase1_mfma(c, P)); } STAMP(3); SEAM(1); STAMP(4);
    if (IN(2)) { SUBRUN(2, mx::ret_state_phase((LAS unsigned char*)lds, P.b(WS_RK), P.b(WS_RV), (bf16*)P.out, P.in[4], P.in[5])); STAMP(5);
                 SUBRUN(3, mx::na_phase((LAS unsigned char*)lds, P.b(WS_NQ), P.b(WS_NK), P.b(WS_NV), P.b(WS_FT))); STAMP(6);
                 SUBRUN(4, phase2_memkv_mfma(c, P)); } STAMP(7); SEAM(2); STAMP(8);
    if (IN(3)) { SUBRUN(5, mx::ret_out_phase((LAS unsigned char*)lds, P.b(WS_RQ), P.b(WS_RK), P.b(WS_RV), P.b(WS_RG), (const bf16*)P.out, P.in[6], P.in[4], P.in[5])); STAMP(9);
                 SUBRUN(6, mx::xa_phase((LAS unsigned char*)lds, P.b(WS_XQ), P.b(WS_MKV))); } STAMP(10); SEAM(3); STAMP(11);
    STAMP(12); STAMP(13);
    if (IN(5)) { SUBRUN(8, phase5_mfma(c, P)); } STAMP(14); SEAM(5); STAMP(15);
    if (IN(6)) { SUBRUN(9, phase6_mfma(c, P)); } STAMP(16); SEAM(6); STAMP(17);
    if (IN(7)) { SUBRUN(10, phase7(c, P)); } STAMP(18); SEAM(7); STAMP(19);
    if (IN(8)) { SUBRUN(11, phase8_mfma(c, P)); } STAMP(20); SEAM(8); STAMP(21);
    if (IN(9)) { SUBRUN(12, phase9_mfma(c, P)); } STAMP(22); SEAM(9); STAMP(23);
    if (IN(10)) { SUBRUN(13, phase10(c, P)); }
#undef SUBRUN
#undef IN
#undef SEAM
}

extern "C" void kernel_launch(void* const* d_in, const int* in_sizes, int n_in, void* d_out, int out_size, void* d_ws, size_t ws_size, hipStream_t stream) {
    static int grid = 0;
    if (grid == 0) {
        if (n_in != 23 || out_size != T * DM || ws_size < WS_END) { fprintf(stderr, "kernel_launch: unexpected shapes (n_in %d out %d ws %zu)\n", n_in, out_size, ws_size); grid = -1; return; }
        int dev = 0, cus = 0;
        if (hipGetDevice(&dev) != hipSuccess || hipDeviceGetAttribute(&cus, hipDeviceAttributeMultiprocessorCount, dev) != hipSuccess) { grid = -1; return; }
        if (hipFuncSetAttribute((const void*)mk_fwd, hipFuncAttributeMaxDynamicSharedMemorySize, LDS_BYTES) != hipSuccess) { fprintf(stderr, "kernel_launch: hipFuncSetAttribute failed\n"); grid = -1; return; }
        (void)hipGetLastError();
        grid = cus;
    }
    if (grid < 0) return;
    (void)hipMemsetAsync((char*)d_ws + WS_CTL, 0, CTL_ZERO_BYTES, stream);
    Args a{};
    for (int i = 0; i < 23; ++i) a.in[i] = (const float*)d_in[i];
    a.out = (float*)d_out; a.ws = (unsigned char*)d_ws;
#if MK_PER_PHASE
    a.sub = 0x3fff; a.rep = -1;
    for (int p = 0; p < NPHASES; ++p) { a.ph_lo = p; a.ph_hi = p + 1; hipLaunchKernelGGL(mk_fwd, dim3(grid), dim3(NTHREADS), LDS_BYTES, stream, a); }
#else
    a.ph_lo = 0; a.ph_hi = NPHASES; a.sub = 0x3fff; a.rep = PROBE_REP; hipLaunchKernelGGL(mk_fwd, dim3(grid), dim3(NTHREADS), LDS_BYTES, stream, a);
#if PROBE_END >= 0
    { const int ph_of[14] = {0, 1, 2, 2, 2, 3, 3, 4, 5, 6, 7, 8, 9, 10};
      a.ph_lo = ph_of[PROBE_END]; a.ph_hi = a.ph_lo + 1; a.sub = 1 << PROBE_END; a.rep = -1; hipLaunchKernelGGL(mk_fwd, dim3(grid), dim3(NTHREADS), LDS_BYTES, stream, a); }
#endif
#endif
}
```

```cpp
#include <hip/hip_runtime.h>
#include <cstdio>
#include <cstdint>

#ifndef PROBE_REP
#define PROBE_REP -1
#endif
#ifndef PROBE_END
#define PROBE_END -1
#endif
#ifndef PROBE_TS_A
#define PROBE_TS_A -1
#define PROBE_TS_B -1
#endif
#ifndef PROBE_TS_DIV
#define PROBE_TS_DIV 8.0f
#endif
#ifndef MK_PER_PHASE
#define MK_PER_PHASE 0
#endif

#define GAS __attribute__((address_space(1)))
#define LAS __attribute__((address_space(3)))
typedef unsigned short bf16;
typedef float f32x4 __attribute__((ext_vector_type(4)));
typedef unsigned u32x4 __attribute__((ext_vector_type(4)));
typedef unsigned u32x2 __attribute__((ext_vector_type(2)));
typedef short bf16x8 __attribute__((ext_vector_type(8)));

constexpr int NB = 8, SEQ = 2048, DM = 1024, T = NB * SEQ;
constexpr int MEML = 256, TM = NB * MEML;
constexpr int NWAVES = 8, NTHREADS = 512;
constexpr int NPA = 5120, NPG = 3072;
constexpr int NEXP = 16, DFF = 512;
constexpr float RMS_EPS = 1e-6f, GN_EPS = 1e-5f;
constexpr float QK_SCALE = 0.08838834764831845f;

constexpr size_t MiB = 1u << 20;
constexpr size_t WS_CTL = 0, CTL_ZERO_BYTES = 32768;
constexpr size_t WS_COS = 1 * MiB, WS_SIN = 1 * MiB + 512 * 1024;
constexpr size_t WS_ELIST = 2 * MiB;
constexpr size_t WS_FT = 2 * MiB;
constexpr size_t WS_EWL = 3 * MiB;
constexpr size_t WS_TMETA = 4 * MiB;
constexpr size_t WS_WA = 5 * MiB;
constexpr size_t WS_WG = 15 * MiB;
constexpr size_t WS_WKV = 21 * MiB;
constexpr size_t WS_WRO = 23 * MiB;
constexpr size_t WS_WNO = 25 * MiB;
constexpr size_t WS_WXO = 26 * MiB;
constexpr size_t WS_WOUT = 27 * MiB;
constexpr size_t WS_XN = 29 * MiB;
constexpr size_t WS_H2 = WS_XN;
constexpr size_t WS_RQ = 61 * MiB;
constexpr size_t WS_RK = 77 * MiB;
constexpr size_t WS_RV = 93 * MiB;
constexpr size_t WS_NK = 125 * MiB;
constexpr size_t WS_NV = 141 * MiB;
constexpr size_t WS_GATES = 61 * MiB;
constexpr size_t WS_HID = 61 * MiB;
constexpr size_t WS_DROWS = 97 * MiB;
constexpr size_t WS_RG = 157 * MiB;
constexpr size_t WS_NQ = 189 * MiB;
constexpr size_t WS_XQ = 205 * MiB;
constexpr size_t WS_WD = 205 * MiB;
constexpr size_t WS_MN = 221 * MiB;
constexpr size_t WS_MKV = 225 * MiB;
constexpr size_t WS_MIX = 221 * MiB;
constexpr size_t WS_WGU = 221 * MiB;
constexpr size_t WS_D = 169 * MiB;
constexpr size_t WS_ERS = 1 * MiB;
constexpr size_t WS_END = 256 * MiB;

constexpr int CW_ECNT = 64;
constexpr int CW_BAR = 4096;

constexpr int LDS_BYTES = 163840;
constexpr int MISC_OFF = 163840 - 512;

__device__ __forceinline__ float bf2f(unsigned v) { return __uint_as_float(v << 16); }
__device__ __forceinline__ unsigned f2bf(float f) { unsigned u = __float_as_uint(f); return (u + 0x7fffu + ((u >> 16) & 1u)) >> 16; }
typedef __bf16 hwbf16x2 __attribute__((ext_vector_type(2)));
typedef float f32x2_ __attribute__((ext_vector_type(2)));
__device__ __forceinline__ unsigned pk2(float lo, float hi) { const f32x2_ v = {lo, hi}; return __builtin_bit_cast(unsigned, __builtin_convertvector(v, hwbf16x2)); }
__device__ __forceinline__ void unpack8(const u32x4 v, float* o) {
    o[0] = __uint_as_float(v.x << 16); o[1] = __uint_as_float(v.x & 0xffff0000u);
    o[2] = __uint_as_float(v.y << 16); o[3] = __uint_as_float(v.y & 0xffff0000u);
    o[4] = __uint_as_float(v.z << 16); o[5] = __uint_as_float(v.z & 0xffff0000u);
    o[6] = __uint_as_float(v.w << 16); o[7] = __uint_as_float(v.w & 0xffff0000u);
}
__device__ __forceinline__ void store8(bf16* p, f32x4 a, f32x4 b) {
    u32x4 w; w.x = pk2(a[0], a[1]); w.y = pk2(a[2], a[3]); w.z = pk2(b[0], b[1]); w.w = pk2(b[2], b[3]);
    *(u32x4*)p = w;
}
__device__ __forceinline__ float wave_sum(float v) {
#pragma unroll
    for (int o = 1; o < 64; o <<= 1) v += __shfl_xor(v, o);
    return v;
}
__device__ __forceinline__ float wave_max(float v) {
#pragma unroll
    for (int o = 1; o < 64; o <<= 1) v = fmaxf(v, __shfl_xor(v, o));
    return v;
}
__device__ __forceinline__ float sigmoidf_(float x) { return __builtin_amdgcn_rcpf(1.0f + __expf(-x)); }
__device__ __forceinline__ float siluf_(float x) { return x * __builtin_amdgcn_rcpf(1.0f + __expf(-x)); }

#define XB_TMO      128
#define XB_XCNT(j)  (256  + 64 * (j))
#define XB_XSUB(j)  (1280 + 64 * (j))
#define XB_XGEN(j)  (2304 + 64 * (j))
#define XB_TOP      3328
#define XB_TOPGEN   3392
#define XCD_BAR_WORDS 3456
#define XB_SPIN_CAP (1u << 18)
__device__ __forceinline__ unsigned xb_ld(unsigned* p)              { return __hip_atomic_load(p, __ATOMIC_RELAXED, __HIP_MEMORY_SCOPE_AGENT); }
__device__ __forceinline__ unsigned xb_add(unsigned* p, unsigned v) { return __hip_atomic_fetch_add(p, v, __ATOMIC_RELAXED, __HIP_MEMORY_SCOPE_AGENT); }
__device__ __forceinline__ unsigned xb_xcc_id() { return (unsigned)__builtin_amdgcn_s_getreg((3 << 11) | 20) & 0xFu; }
#define XB_SPIN(cond, bar) do { unsigned _sp = 0; while (cond) { __builtin_amdgcn_s_sleep(1); \
    if ((++_sp & 255u) == 0u) { if (xb_ld(&(bar)[XB_TMO])) break; if (_sp > XB_SPIN_CAP) { atomicAdd(&(bar)[XB_TMO], 1u); break; } } } } while (0)
struct XcdBarrier { unsigned* bar; unsigned x; volatile LAS unsigned* st; };
__device__ __forceinline__ XcdBarrier xcd_barrier_post(unsigned* bar, volatile LAS unsigned* st) {
    XcdBarrier b; b.bar = bar; b.x = xb_xcc_id(); b.st = st;
    if (threadIdx.x == 0) (void)xb_add(&bar[XB_XCNT(b.x)], 1u);
    return b;
}
__device__ __forceinline__ void xcd_barrier_complete(unsigned* bar, unsigned x, unsigned& nloc, unsigned& nx) {
    const unsigned G = gridDim.x * gridDim.y * gridDim.z;
    unsigned sum, cnt, mine, sp = 0u;
    for (;;) {
        sum = 0u; cnt = 0u; mine = 0u;
#pragma unroll
        for (unsigned j = 0; j < 16; ++j) { const unsigned c = xb_ld(&bar[XB_XCNT(j)]); sum += c; cnt += (c > 0u) ? 1u : 0u; mine = (j == x) ? c : mine; }
        if (sum == G) break;
        __builtin_amdgcn_s_sleep(1);
        if ((++sp & 255u) == 0u) { if (xb_ld(&bar[XB_TMO])) break; if (sp > XB_SPIN_CAP) { atomicAdd(&bar[XB_TMO], 1u); break; } }
    }
    nloc = mine > 0u ? mine : 1u; nx = cnt > 0u ? cnt : 1u;
}
__device__ __forceinline__ void xcd_barrier(const XcdBarrier& b) {
    asm volatile("s_waitcnt vmcnt(0)" ::: "memory");
    __syncthreads();
    if (threadIdx.x == 0) {
        unsigned* bar = b.bar;
        __builtin_amdgcn_s_waitcnt(0);
        unsigned nloc = b.st[0], nx = b.st[1];
        if (nloc == 0u) { xcd_barrier_complete(bar, b.x, nloc, nx); b.st[0] = nloc; b.st[1] = nx; }
        const unsigned old = xb_add(&bar[XB_XSUB(b.x)], 1u);
        const unsigned gen = old / nloc;
        if (old + 1u == (gen + 1u) * nloc) {
            __builtin_amdgcn_fence(__ATOMIC_RELEASE, "agent");
            asm volatile("s_waitcnt vmcnt(0)" ::: "memory");
            const unsigned og = xb_add(&bar[XB_TOP], 1u);
            const unsigned tg = og / nx;
            if (og + 1u == (tg + 1u) * nx) xb_add(&bar[XB_TOPGEN], 1u);
            else XB_SPIN(xb_ld(&bar[XB_TOPGEN]) == tg, bar);
            __builtin_amdgcn_fence(__ATOMIC_ACQUIRE, "agent");
            xb_add(&bar[XB_XGEN(b.x)], 1u);
            asm volatile("s_waitcnt vmcnt(0)" ::: "memory");
        } else {
            XB_SPIN(xb_ld(&bar[XB_XGEN(b.x)]) == gen, bar);
            __builtin_amdgcn_fence(__ATOMIC_ACQUIRE, "agent");
            asm volatile("s_waitcnt vmcnt(0)" ::: "memory");
        }
    }
    __syncthreads();
}

struct Args { const float* in[23]; float* out; unsigned char* ws; int ph_lo, ph_hi; int sub, rep; };
struct Ctx {
    int tid, lane, wave, gw, ngw;
    unsigned char* lds;
};

template <class ColPtr>
__device__ __forceinline__ void transpose_all(const Ctx& c, int& base, ColPtr cp, int ldw, int P, int K, bf16* WT, const float* kscale = nullptr) {
    float* scr = (float*)(c.lds + c.wave * 16384);
    const int nkb = K / 64, npb = P / 32, lane = c.lane, nit = nkb * npb;
    int it0 = (c.gw - base) % c.ngw; it0 = it0 < 0 ? it0 + c.ngw : it0; base += nit;
    for (int it = it0; it < nit; it += c.ngw) {
        const int kb = it % nkb, pb = it / nkb, k0 = 64 * kb, p0 = 32 * pb;
        const float* colp = cp(p0 + (lane & 31));
        float tv[32];
#pragma unroll
        for (int i = 0; i < 32; ++i) tv[i] = colp[(size_t)(k0 + 2 * i + (lane >> 5)) * ldw];
#pragma unroll
        for (int i = 0; i < 32; ++i) scr[(2 * i + (lane >> 5)) * 33 + (lane & 31)] = tv[i];
        __builtin_amdgcn_s_waitcnt(0xC07F); asm volatile("" ::: "memory");
        const int cc = lane & 7;
        f32x4 ks0 = {1.f, 1.f, 1.f, 1.f}, ks1 = {1.f, 1.f, 1.f, 1.f};
        if (kscale) { ks0 = *(const f32x4*)(kscale + k0 + 8 * cc); ks1 = *(const f32x4*)(kscale + k0 + 8 * cc + 4); }
#pragma unroll
        for (int j = 0; j < 4; ++j) { const int n = (lane >> 3) + 8 * j; const float* s = scr + (8 * cc) * 33 + n;
            u32x4 o; o.x = pk2(s[0 * 33] * ks0[0], s[1 * 33] * ks0[1]); o.y = pk2(s[2 * 33] * ks0[2], s[3 * 33] * ks0[3]); o.z = pk2(s[4 * 33] * ks1[0], s[5 * 33] * ks1[1]); o.w = pk2(s[6 * 33] * ks1[2], s[7 * 33] * ks1[3]);
            *(u32x4*)(WT + (size_t)(p0 + n) * K + k0 + 8 * cc) = o; }
        __builtin_amdgcn_s_waitcnt(0xC07F); asm volatile("" ::: "memory");
    }
}
struct ColPlain { const float* W; __device__ const float* operator()(int p) const { return W + p; } };
struct ColOff { const float* W; int off; __device__ const float* operator()(int p) const { return W + off + p; } };
struct ColWA {
    const float* W;
    __device__ const float* operator()(int p) const {
        if (p < 1024) { const int pp = p & 127; const int d = ((pp & 4) ? 64 : 0) + 4 * (pp >> 3) + (pp & 3); return W + (p & ~127) + d; }
        return W + p;
    }
};
struct ColGU {
    const float* Wg; const float* Wu;
    __device__ const float* operator()(int p) const { const int f = 4 * (p >> 3) + (p & 3); return ((p >> 2) & 1) ? Wu + f : Wg + f; }
};
__device__ __forceinline__ void rms_row_to_bf16(const float* xrow, const float* g, bf16* orow, int lane) {
    const f32x4* xr = (const f32x4*)xrow + lane; const f32x4* gr = (const f32x4*)g + lane;
    f32x4 v[4]; float s = 0.f;
#pragma unroll
    for (int j = 0; j < 4; ++j) { v[j] = xr[64 * j]; s += (v[j].x * v[j].x + v[j].y * v[j].y) + (v[j].z * v[j].z + v[j].w * v[j].w); }
    const float r = 1.0f / sqrtf(wave_sum(s) * (1.f / 1024.f) + RMS_EPS);
    unsigned long long* o8 = (unsigned long long*)orow + lane;
#pragma unroll
    for (int j = 0; j < 4; ++j) { const f32x4 gg = gr[64 * j];
        o8[64 * j] = (unsigned long long)pk2(v[j].x * r * gg.x, v[j].y * r * gg.y) | ((unsigned long long)pk2(v[j].z * r * gg.z, v[j].w * r * gg.w) << 32); }
}

template <class RowPtr, class Epi>
__device__ __forceinline__ void naive_gemm(const Ctx& c, const RowPtr& rp, const bf16* Bt, int ldb, int M, int N, int K, const Epi& epi) {
    const int tilesN = N / 64, tilesM = (M + 7) / 8, lane = c.lane;
    for (int it = c.gw; it < tilesM * tilesN; it += c.ngw) {
        const int tm = it / tilesN, tn = it % tilesN;
        const int row = tm * 8 + (lane >> 3), col0 = tn * 64 + (lane & 7) * 8;
        const bool valid = row < M;
        const bf16* ap = rp(valid ? row : 0);
        float acc[8];
#pragma unroll
        for (int j = 0; j < 8; ++j) acc[j] = 0.f;
        for (int k = 0; k < K; k += 8) {
            float a[8]; unpack8(*(const u32x4*)(ap + k), a);
#pragma unroll
            for (int j = 0; j < 8; ++j) { float b[8]; unpack8(*(const u32x4*)(Bt + (size_t)(col0 + j) * ldb + k), b);
#pragma unroll
                for (int i = 0; i < 8; ++i) acc[j] += a[i] * b[i]; }
        }
        if (valid) epi(row, col0, (f32x4){acc[0], acc[1], acc[2], acc[3]}, (f32x4){acc[4], acc[5], acc[6], acc[7]});
    }
}
struct RowPlain { const bf16* A; int lda; __device__ const bf16* operator()(int r) const { return A + (size_t)r * lda; } };
struct RowGather { const bf16* A; int lda; const int* idx; __device__ const bf16* operator()(int r) const { return A + (size_t)idx[r] * lda; } };

struct EpiProjA {
    bf16 *RQ, *RK, *RV, *RG, *NQ, *NK, *NV, *XQ; const float *COS, *SIN;
    __device__ __forceinline__ void operator()(int row, int col0, f32x4 v0, f32x4 v1) const {
        if (col0 < 1024) {
            const int which = col0 >> 9, cc = col0 & 511, pos = row & (SEQ - 1), q = (cc & 127) >> 3;
            const f32x4 cs = *(const f32x4*)(COS + pos * 64 + 4 * q), sn = *(const f32x4*)(SIN + pos * 64 + 4 * q);
            f32x4 o1 = v0 * cs - v1 * sn, o2 = v0 * sn + v1 * cs;
            if (which == 0) { o1 = o1 * QK_SCALE; o2 = o2 * QK_SCALE; }
            store8((which ? RK : RQ) + (size_t)row * 512 + cc, o1, o2);
        } else if (col0 < 2048) { store8(RV + (size_t)row * 1024 + (col0 - 1024), v0, v1);
        } else if (col0 < 3072) {
            f32x4 a, b;
#pragma unroll
            for (int i = 0; i < 4; ++i) { a[i] = siluf_(v0[i]); b[i] = siluf_(v1[i]); }
            store8(RG + (size_t)row * 1024 + (col0 - 2048), a, b);
        } else if (col0 < 3584) { store8(NQ + (size_t)row * 512 + (col0 - 3072), v0 * 0.125f, v1 * 0.125f);
        } else if (col0 < 4096) { store8(NK + (size_t)row * 512 + (col0 - 3584), v0, v1);
        } else if (col0 < 4608) { store8(NV + (size_t)row * 512 + (col0 - 4096), v0, v1);
        } else { store8(XQ + (size_t)row * 512 + (col0 - 4608), v0 * QK_SCALE, v1 * QK_SCALE); }
    }
};
struct EpiBf16Plain { bf16* O; int ldc; __device__ __forceinline__ void operator()(int row, int col0, f32x4 v0, f32x4 v1) const { store8(O + (size_t)row * ldc + col0, v0, v1); } };
struct EpiSigmoid { bf16* O; int ldc;
    __device__ __forceinline__ void operator()(int row, int col0, f32x4 v0, f32x4 v1) const {
        f32x4 a, b;
#pragma unroll
        for (int i = 0; i < 4; ++i) { a[i] = sigmoidf_(v0[i]); b[i] = sigmoidf_(v1[i]); }
        store8(O + (size_t)row * ldc + col0, a, b); } };
template <int MODE> struct EpiMixNaive { float* TMP; bf16* MIX; const bf16* G;
    __device__ __forceinline__ void operator()(int row, int col0, f32x4 v0, f32x4 v1) const {
        float g[8]; unpack8(*(const u32x4*)(G + (size_t)row * NPG + col0), g);
        f32x4 a = {v0[0] * g[0], v0[1] * g[1], v0[2] * g[2], v0[3] * g[3]}, b = {v1[0] * g[4], v1[1] * g[5], v1[2] * g[6], v1[3] * g[7]};
        float* t = TMP + (size_t)row * DM + col0;
        if (MODE >= 1) { a = a + *(const f32x4*)t; b = b + *(const f32x4*)(t + 4); }
        if (MODE <= 1) { *(f32x4*)t = a; *(f32x4*)(t + 4) = b; } else store8(MIX + (size_t)row * DM + col0, a, b);
    } };
struct EpiResidBf16 { const float* X; bf16* O;
    __device__ __forceinline__ void operator()(int row, int col0, f32x4 v0, f32x4 v1) const {
        const float* x = X + (size_t)row * DM + col0; store8(O + (size_t)row * DM + col0, *(const f32x4*)x + v0, *(const f32x4*)(x + 4) + v1); } };
struct EpiResidF32 { const float* X; float* O;
    __device__ __forceinline__ void operator()(int row, int col0, f32x4 v0, f32x4 v1) const {
        const float* x = X + (size_t)row * DM + col0; float* o = O + (size_t)row * DM + col0;
        *(f32x4*)o = *(const f32x4*)x + v0; *(f32x4*)(o + 4) = *(const f32x4*)(x + 4) + v1; } };
struct EpiSwiGLU { bf16* HID; const float* wl; int rowbase;
    __device__ __forceinline__ void operator()(int row, int col0, f32x4 v0, f32x4 v1) const {
        const float w = wl[row]; f32x4 h;
#pragma unroll
        for (int i = 0; i < 4; ++i) h[i] = siluf_(v0[i]) * v1[i] * w;
        u32x2 o; o.x = pk2(h[0], h[1]); o.y = pk2(h[2], h[3]);
        *(u32x2*)(HID + (size_t)(rowbase + row) * DFF + (col0 >> 1)) = o; } };
struct EpiRowsBf16 { bf16* O; int ldc; int rowbase;
    __device__ __forceinline__ void operator()(int row, int col0, f32x4 v0, f32x4 v1) const { store8(O + (size_t)(rowbase + row) * ldc + col0, v0, v1); } };

namespace pg8 {
constexpr int BM = 256, BK = 64, HALF = 128, HTB = HALF * BK * 2, STAGE_BYTES = 8 * HTB;
__device__ __forceinline__ int lds_byte(int r, int c) { const int st = (r >> 4) * 2 + (c >> 5), rr = r & 15, cc = c & 31, ob = rr * 64 + cc * 2; return st * 1024 + (ob ^ (((ob >> 9) & 1) << 5)); }
__device__ __forceinline__ void stage_rc(int b, int& R, int& C) { const int st = b / 1024, sb = b % 1024, swz = sb ^ (((sb >> 9) & 1) << 5); R = (st >> 1) * 16 + swz / 64; C = (st & 1) * 32 + (swz % 64) / 2; }
__device__ __forceinline__ int perm32(int rho) { const int n = rho >> 4, i = rho & 15; return 8 * (i >> 2) + 4 * n + (i & 3); }

struct UnitDesc {
    const char* A; const char* B;
    unsigned lda2, ldb2;
    int nt;
    int row0, col0;
    int aux, aux2;
    const int* gidx; int gcnt;
    int chain;
};
__device__ __forceinline__ unsigned cvt_pk_bf16(float lo, float hi) { unsigned r; asm volatile("v_cvt_pk_bf16_f32 %0, %1, %2" : "=v"(r) : "v"(lo), "v"(hi)); return r; }

template <class F> __device__ __forceinline__ void epi_apply(const f32x4 (&acc)[2][2][4][2], const UnitDesc& u, int wr, int wc, int fr, int fq, const F& f) {
#pragma unroll
    for (int ai = 0; ai < 2; ++ai)
#pragma unroll
        for (int m = 0; m < 4; ++m) { const int row = u.row0 + ai * HALF + wr * 64 + m * 16 + fr;
#pragma unroll
            for (int bj = 0; bj < 2; ++bj) f(row, u.col0 + bj * HALF + wc * 32 + 8 * fq, acc[ai][bj][m][0], acc[ai][bj][m][1]);
            asm volatile("" ::: "memory"); __builtin_amdgcn_sched_barrier(0); }
}

template <bool GATHER> __device__ __forceinline__ void unit_offs(const UnitDesc& u, int tid, unsigned (&oA0)[2], unsigned (&oA1)[2], unsigned (&oB)[2]) {
#pragma unroll
    for (int i = 0; i < 2; ++i) { int R, C; stage_rc(tid * 16 + i * 8192, R, C); const int Rb = (R & ~31) + perm32(R & 31);
        oB[i] = (unsigned)Rb * u.ldb2 + (unsigned)C * 2u;
        if (GATHER && u.gidx) { const int last = u.gcnt - 1; int r0 = u.row0 + R, r1 = r0 + HALF; r0 = r0 < last ? r0 : last; r1 = r1 < last ? r1 : last;
            oA0[i] = (unsigned)u.gidx[r0] * u.lda2 + (unsigned)C * 2u; oA1[i] = (unsigned)u.gidx[r1] * u.lda2 + (unsigned)C * 2u;
        } else { oA0[i] = (unsigned)R * u.lda2 + (unsigned)C * 2u; oA1[i] = 0u; } }
}

template <bool GATHER, class Sched, class Epi>
__device__ __forceinline__ void gemm_phase(LAS unsigned char* lds, const Sched& S, const Epi& E, int sb = 0) {
#if PROBE_TS_A >= 0
#define GSTAMP(k) do { if (sb && blockIdx.x == 0 && threadIdx.x == 0) ((volatile LAS unsigned*)(lds + MISC_OFF))[32 + sb + (k)] = (unsigned)__builtin_amdgcn_s_memrealtime(); } while (0)
#else
#define GSTAMP(k) do { } while (0)
#endif
    const int tid = threadIdx.x, wid = __builtin_amdgcn_readfirstlane(tid >> 6), lane = tid & 63, wr = wid >> 2, wc = wid & 3, fr = lane & 15, fq = lane >> 4;
    const unsigned ldsw = (unsigned)wid * 1024u;
    const int aoff = lds_byte(wr * 64 + fr, fq * 8), boff = lds_byte(wc * 32 + fr, fq * 8);
    const size_t kstep = (size_t)(BK * 2);
#define PG8_SA(b, h) (((b) * 2 + (h)) * HTB)
#define PG8_SB(b, h) ((4 + (b) * 2 + (h)) * HTB)
#define PG8_STAGE(bufoff, gbase, voff) do { _Pragma("unroll") for (int _i = 0; _i < 2; ++_i) \
        __builtin_amdgcn_global_load_lds((const unsigned*)((const char*)(gbase) + (voff)[_i]), (LAS unsigned*)(lds + (bufoff) + ldsw + _i * 8192), 16, 0, 0); } while (0)
#define PG8_LDA(dst, b, h) do { _Pragma("unroll") for (int m = 0; m < 4; ++m) _Pragma("unroll") for (int k = 0; k < 2; ++k) dst[m][k] = *(const LAS bf16x8*)(lds + PG8_SA(b, h) + aoff + m * 2048 + k * 1024); } while (0)
#define PG8_LDB(dst, b, h) do { _Pragma("unroll") for (int n = 0; n < 2; ++n) _Pragma("unroll") for (int k = 0; k < 2; ++k) dst[n][k] = *(const LAS bf16x8*)(lds + PG8_SB(b, h) + boff + n * 2048 + k * 1024); } while (0)
#define PG8_MMA(ai, bj, At, Bt) do { __builtin_amdgcn_s_setprio(1); _Pragma("unroll") for (int m = 0; m < 4; ++m) _Pragma("unroll") for (int n = 0; n < 2; ++n) _Pragma("unroll") for (int k = 0; k < 2; ++k) \
        acc[ai][bj][m][n] = __builtin_amdgcn_mfma_f32_16x16x32_bf16(Bt[n][k], At[m][k], acc[ai][bj][m][n], 0, 0, 0); __builtin_amdgcn_s_setprio(0); } while (0)
#define PG8_WAIT_V(n) asm volatile("s_waitcnt vmcnt(" #n ")" ::: "memory")
#define PG8_WAIT_L(n) asm volatile("s_waitcnt lgkmcnt(" #n ")" ::: "memory")
#define PG8_BAR __builtin_amdgcn_s_barrier()
#define PG8_SCHED __builtin_amdgcn_sched_barrier(0)
    UnitDesc cur, nxt; int ui = 0;
    if (!S.next(0, cur)) return;
    f32x4 acc[2][2][4][2];
#pragma unroll
    for (int a = 0; a < 2; ++a)
#pragma unroll
        for (int b = 0; b < 2; ++b)
#pragma unroll
            for (int m = 0; m < 4; ++m)
#pragma unroll
                for (int n = 0; n < 2; ++n) acc[a][b][m][n] = (f32x4){0.f, 0.f, 0.f, 0.f};
    bf16x8 At[4][2], B0[2][2], B1[2][2];
    unsigned cA0[2], cA1[2], cB[2], nA0[2], nA1[2], nB[2];
    unit_offs<GATHER>(cur, tid, cA0, cA1, cB);
    const char* pA = cur.A; const char* pB = cur.B; size_t hB = (size_t)HALF * cur.ldb2; size_t hA = GATHER ? 0 : (size_t)HALF * cur.lda2;
#define PG8_A1(arr1, arr0) (GATHER ? (arr1) : (arr0))
    PG8_STAGE(PG8_SB(0, 0), pB, cB); PG8_STAGE(PG8_SB(0, 1), pB + hB, cB); PG8_STAGE(PG8_SA(0, 0), pA, cA0); PG8_STAGE(PG8_SA(0, 1), pA + hA, PG8_A1(cA1, cA0));
    if (wr == 1) PG8_BAR;
    PG8_WAIT_V(2); PG8_BAR;
    PG8_STAGE(PG8_SB(1, 0), pB + kstep, cB); PG8_STAGE(PG8_SA(1, 0), pA + kstep, cA0); PG8_STAGE(PG8_SB(1, 1), pB + hB + kstep, cB);
    PG8_WAIT_V(6); PG8_BAR;
    GSTAMP(0);
    for (;;) {
        const bool has_next = S.next(ui + 1, nxt);
        const char* qA = pA; const char* qB = pB; size_t hBn = hB, hAn = hA;
        if (has_next) { unit_offs<GATHER>(nxt, tid, nA0, nA1, nB); qA = nxt.A; qB = nxt.B; hBn = (size_t)HALF * nxt.ldb2; hAn = GATHER ? 0 : (size_t)HALF * nxt.lda2; }
        else {
#pragma unroll
            for (int i = 0; i < 2; ++i) { nA0[i] = cA0[i]; nA1[i] = cA1[i]; nB[i] = cB[i]; } }
        const int nt = cur.nt;
        for (int t = 0; t < nt; t += 2) {
            const bool last = (t == nt - 2);
            const char* a1 = pA + (size_t)(t + 1) * kstep;
            const char* a2 = last ? qA : pA + (size_t)(t + 2) * kstep; const char* b2 = last ? qB : pB + (size_t)(t + 2) * kstep;
            const char* a3 = a2 + kstep; const char* b3 = b2 + kstep;
            unsigned sA0[2], sA1[2], sB[2];
#pragma unroll
            for (int i = 0; i < 2; ++i) { sA0[i] = last ? nA0[i] : cA0[i]; sA1[i] = last ? nA1[i] : cA1[i]; sB[i] = last ? nB[i] : cB[i]; }
            const size_t shB = last ? hBn : hB, shA = last ? hAn : hA;
            PG8_LDB(B0, 0, 0); PG8_LDB(B1, 0, 1); PG8_SCHED; PG8_LDA(At, 0, 0); PG8_STAGE(PG8_SA(1, 1), a1 + hA, PG8_A1(cA1, cA0));
            PG8_WAIT_V(8); PG8_WAIT_L(0); PG8_BAR; PG8_MMA(0, 0, At, B0); PG8_MMA(0, 1, At, B1); PG8_BAR; PG8_SCHED;
            PG8_LDA(At, 0, 1); PG8_STAGE(PG8_SB(0, 0), b2, sB); PG8_STAGE(PG8_SB(0, 1), b2 + shB, sB); PG8_STAGE(PG8_SA(0, 0), a2, sA0);
            PG8_WAIT_V(8); PG8_WAIT_L(0); PG8_BAR; PG8_MMA(1, 0, At, B0); PG8_MMA(1, 1, At, B1); PG8_BAR; PG8_SCHED;
            PG8_LDB(B0, 1, 0); PG8_LDB(B1, 1, 1); PG8_SCHED; PG8_LDA(At, 1, 0); PG8_STAGE(PG8_SA(0, 1), a2 + shA, PG8_A1(sA1, sA0));
            PG8_WAIT_V(8); PG8_WAIT_L(0); PG8_BAR; PG8_MMA(0, 0, At, B0); PG8_MMA(0, 1, At, B1); PG8_BAR; PG8_SCHED;
            PG8_LDA(At, 1, 1); PG8_STAGE(PG8_SB(1, 0), b3, sB); PG8_STAGE(PG8_SB(1, 1), b3 + shB, sB); PG8_STAGE(PG8_SA(1, 0), a3, sA0);
            PG8_WAIT_V(8); PG8_WAIT_L(0); PG8_BAR; PG8_MMA(1, 0, At, B0); PG8_MMA(1, 1, At, B1); PG8_BAR; PG8_SCHED;
        }
        if (wr == 0) PG8_BAR;
        if (ui == 0) GSTAMP(1);
        E.finish(acc, cur, wr, wc, fr, fq);
        if (ui == 0) GSTAMP(2);
        if (!has_next) break;
        cur = nxt; pA = qA; pB = qB; hB = hBn; hA = hAn; ++ui;
#pragma unroll
        for (int i = 0; i < 2; ++i) { cA0[i] = nA0[i]; cA1[i] = nA1[i]; cB[i] = nB[i]; }
        if (wr == 1) PG8_BAR;
    }
    PG8_WAIT_V(0);
    PG8_BAR;
    GSTAMP(3);
#undef GSTAMP
#undef PG8_A1
#undef PG8_SA
#undef PG8_SB
#undef PG8_STAGE
#undef PG8_LDA
#undef PG8_LDB
#undef PG8_MMA
#undef PG8_WAIT_V
#undef PG8_WAIT_L
#undef PG8_BAR
#undef PG8_SCHED
}

__device__ __forceinline__ void zero_acc(f32x4 (&acc)[2][2][4][2]) {
#pragma unroll
    for (int a = 0; a < 2; ++a)
#pragma unroll
        for (int b = 0; b < 2; ++b)
#pragma unroll
            for (int m = 0; m < 4; ++m)
#pragma unroll
                for (int n = 0; n < 2; ++n) acc[a][b][m][n] = (f32x4){0.f, 0.f, 0.f, 0.f};
}
template <class F> struct EpiF { F f;
    __device__ __forceinline__ void finish(f32x4 (&acc)[2][2][4][2], const UnitDesc& u, int wr, int wc, int fr, int fq) const { epi_apply(acc, u, wr, wc, fr, fq, f); zero_acc(acc); } };

struct TileOrder {
    int nM, nN, nwg, G, c;
    __device__ __forceinline__ void init(int nM_, int nN_, int G_, int c_) { nM = nM_; nN = nN_; nwg = nM * nN; G = G_; c = c_; }
    __device__ __forceinline__ bool tile(int i, int& pm, int& pn) const {
        const long L = (long)i * G + c; if (L >= nwg) return false;
        int wgid = (int)L; { const int q = nwg / 8, r = nwg % 8, xcd = wgid % 8, off = wgid / 8; wgid = (xcd < r ? xcd * (q + 1) : r * (q + 1) + (xcd - r) * q) + off; }
        const int nig = 8 * nN, gid = wgid / nig, fm = gid * 8, gsz = (nM - fm) < 8 ? (nM - fm) : 8;
        pm = fm + ((wgid % nig) % gsz); pn = (wgid % nig) / gsz; return true;
    }
};
struct PlainSched { TileOrder o; const bf16* A; const bf16* Bt; int lda, ldb, K;
    __device__ __forceinline__ bool next(int i, UnitDesc& u) const { int pm, pn; if (!o.tile(i, pm, pn)) return false;
        u.A = (const char*)(A + (size_t)pm * BM * lda); u.B = (const char*)(Bt + (size_t)pn * BM * ldb); u.lda2 = lda * 2; u.ldb2 = ldb * 2; u.nt = K / BK;
        u.row0 = pm * BM; u.col0 = pn * BM; u.aux = 0; u.aux2 = 0; u.gidx = nullptr; u.gcnt = 0; u.chain = 0; return true; } };
}

#if PROBE_TS_A >= 0
#define MXSTAMP(k) do { if (blockIdx.x == 0 && threadIdx.x == 0) ((volatile LAS unsigned*)(lds + MISC_OFF))[32 + (k)] = (unsigned)__builtin_amdgcn_s_memrealtime(); } while (0)
#else
#define MXSTAMP(k) do { } while (0)
#endif
namespace mx {
typedef short s16x4 __attribute__((ext_vector_type(4)));
typedef __bf16 bf16x8_t __attribute__((ext_vector_type(8)));
typedef __bf16 bf16x4_t __attribute__((ext_vector_type(4)));
typedef float f32x8 __attribute__((ext_vector_type(8)));
__device__ __forceinline__ f32x4 mma(bf16x8 a, bf16x8 b, f32x4 c) { return __builtin_amdgcn_mfma_f32_16x16x32_bf16(a, b, c, 0, 0, 0); }
__device__ __forceinline__ bf16x8 ldsf(LAS unsigned char* p) { return *(LAS bf16x8*)p; }
__device__ __forceinline__ bf16x8 glbf(const bf16* p) { return *(const bf16x8*)p; }
__device__ __forceinline__ bf16x8 trf(LAS unsigned char* p0, LAS unsigned char* p1) {
    const s16x4 a = __builtin_amdgcn_ds_read_tr16_b64_v4i16((LAS s16x4*)p0), b = __builtin_amdgcn_ds_read_tr16_b64_v4i16((LAS s16x4*)p1);
    return __builtin_shufflevector(a, b, 0, 1, 2, 3, 4, 5, 6, 7);
}
__device__ __forceinline__ bf16x8 pack8(f32x4 a, f32x4 b) { const f32x8 v = {a[0], a[1], a[2], a[3], b[0], b[1], b[2], b[3]}; return __builtin_bit_cast(bf16x8, __builtin_convertvector(v, bf16x8_t)); }
__device__ __forceinline__ u32x2 pack4(f32x4 a) { return __builtin_bit_cast(u32x2, __builtin_convertvector(a, bf16x4_t)); }
__device__ __forceinline__ float red_g_max(float v) { v = fmaxf(v, __shfl_xor(v, 16)); return fmaxf(v, __shfl_xor(v, 32)); }
__device__ __forceinline__ float red_g_sum(float v) { v += __shfl_xor(v, 16); return v + __shfl_xor(v, 32); }

constexpr int XA_KP = 272, XA_VP = 288, XA_VOFF = 256 * XA_KP;
__device__ __forceinline__ void xa_phase(LAS unsigned char* lds, bf16* XQ, const bf16* MKV) {
    const int tid = threadIdx.x, lane = tid & 63, wave = __builtin_amdgcn_readfirstlane(tid >> 6), g = lane >> 4, li = lane & 15, q4 = li >> 2, p4 = li & 3;
    for (int it = blockIdx.x; it < NB * 4 * 8; it += gridDim.x) {
        const int b = it >> 5, h = (it >> 3) & 3, qb = it & 7;
        __syncthreads();
#pragma unroll
        for (int i = 0; i < 8; ++i) { const int id = tid + 512 * i, row = id >> 4, ch = id & 15; const bf16* src = MKV + (size_t)(b * MEML + row) * 1024 + h * 128 + ch * 8;
            *(LAS u32x4*)(lds + row * XA_KP + ch * 16) = *(const u32x4*)src; *(LAS u32x4*)(lds + XA_VOFF + row * XA_VP + ch * 16) = *(const u32x4*)(src + 512); }
        __syncthreads();
#pragma unroll 1
        for (int qi = 0; qi < 2; ++qi) {
            bf16* qrow = XQ + (size_t)(b * SEQ + qb * 256 + wave * 32 + qi * 16 + li) * 512 + h * 128;
            bf16x8 qf[4];
#pragma unroll
            for (int s = 0; s < 4; ++s) qf[s] = glbf(qrow + 32 * s + 8 * g);
            f32x4 st[16]; float mx = -3.0e38f;
#pragma unroll
            for (int kf = 0; kf < 16; ++kf) { f32x4 a = {0.f, 0.f, 0.f, 0.f};
#pragma unroll
                for (int s = 0; s < 4; ++s) a = mma(ldsf(lds + (16 * kf + li) * XA_KP + (32 * s + 8 * g) * 2), qf[s], a);
                st[kf] = a; mx = fmaxf(mx, fmaxf(fmaxf(a[0], a[1]), fmaxf(a[2], a[3]))); __builtin_amdgcn_sched_barrier(0); }
            mx = red_g_max(mx); float sum = 0.f;
#pragma unroll
            for (int kf = 0; kf < 16; ++kf) {
#pragma unroll
                for (int r = 0; r < 4; ++r) { const float e = __expf(st[kf][r] - mx); st[kf][r] = e; sum += e; } }
            sum = red_g_sum(sum); const float inv = 1.0f / sum;
            f32x4 o[8];
#pragma unroll
            for (int df = 0; df < 8; ++df) o[df] = (f32x4){0.f, 0.f, 0.f, 0.f};
#pragma unroll
            for (int x = 0; x < 8; ++x) { const bf16x8 pf = pack8(st[2 * x], st[2 * x + 1]);
                LAS unsigned char* vb = lds + XA_VOFF + (32 * x + 4 * g + q4) * XA_VP + 8 * p4;
#pragma unroll
                for (int df = 0; df < 8; ++df) o[df] = mma(trf(vb + 32 * df, vb + 16 * XA_VP + 32 * df), pf, o[df]); __builtin_amdgcn_sched_barrier(0); }
#pragma unroll
            for (int df = 0; df < 8; ++df) *(u32x2*)(qrow + 16 * df + 4 * g) = pack4(o[df] * inv);
        }
    }
}

constexpr int NA_KP = 144, NA_VP = 136, NA_VOFF = 576 * NA_KP;
struct NaItem { int b, h, krmin, r, rs; };
__device__ __forceinline__ NaItem na_item(int it, int ri) { NaItem a; a.b = it >> 7; a.h = (it >> 4) & 7; const int rp = it & 15;
    int k = 2 * rp - 4; a.krmin = k < 0 ? 0 : (k > 24 ? 24 : k); a.r = 2 * rp + ri; int rs = a.r - 4; a.rs = rs < 0 ? 0 : (rs > 24 ? 24 : rs); return a; }
__device__ __forceinline__ void na_load_kv(u32x4 (&kv)[9], u32x4 (&vv)[9], const NaItem& a, const bf16* NK, const bf16* NV, int tid) {
#pragma unroll
    for (int i = 0; i < 9; ++i) { const int id = tid + 512 * i, trow = id >> 3, ch = id & 7; int kr = a.krmin + (trow >> 6); kr = kr > 31 ? 31 : kr;
        const size_t off = (size_t)(a.b * SEQ + kr * 64 + (trow & 63)) * 512 + a.h * 64 + ch * 8; kv[i] = *(const u32x4*)(NK + off); vv[i] = *(const u32x4*)(NV + off); }
}
__device__ __forceinline__ void na_phase(LAS unsigned char* lds, bf16* NQ, const bf16* NK, const bf16* NV, const bf16* FT) {
    const int tid = threadIdx.x, lane = tid & 63, wave = __builtin_amdgcn_readfirstlane(tid >> 6), g = lane >> 4, li = lane & 15, q4 = li >> 2, p4 = li & 3;
    const int ri = wave >> 2, qf = wave & 3, c0 = 16 * qf, w0 = qf == 0 ? 0 : (qf == 1 ? 8 : (qf == 2 ? 24 : 32));
    const int G = (int)gridDim.x, lite = G > 64 ? 32 : 0; const bool isl = (int)blockIdx.x < lite;
    const int it0 = isl ? (int)blockIdx.x : lite + ((int)blockIdx.x - lite), itstep = isl ? NB * 8 * 16 : G - lite;
    if (it0 >= NB * 8 * 16) return;
    NaItem cur = na_item(it0, ri);
    u32x4 kv[9], vv[9]; bf16x8 ff[16]; bf16x8 q0, q1;
    na_load_kv(kv, vv, cur, NK, NV, tid);
#pragma unroll
    for (int f = 0; f < 16; ++f) ff[f] = glbf(FT + ((size_t)((cur.h * 15 + (cur.rs + (f >> 1) - cur.r + 7)) * 64 + w0 + 16 * (f & 1) + li)) * 64 + (c0 & 32) + 8 * g);
    { const bf16* qr = NQ + (size_t)(cur.b * SEQ + cur.r * 64 + c0 + li) * 512 + cur.h * 64; q0 = glbf(qr + 8 * g); q1 = glbf(qr + 32 + 8 * g); }
    bf16x8 e1;
#pragma unroll
    for (int j = 0; j < 8; ++j) e1[j] = (8 * g + j == ((c0 + li) & 31)) ? (short)0x3F80 : (short)0;
#pragma unroll 1
    for (int it = it0;;) {
        __syncthreads();
#pragma unroll
        for (int i = 0; i < 9; ++i) { const int id = tid + 512 * i, trow = id >> 3, ch = id & 7;
            *(LAS u32x4*)(lds + trow * NA_KP + ch * 16) = kv[i];
            *(LAS u32x2*)(lds + NA_VOFF + trow * NA_VP + ch * 16) = (u32x2){vv[i].x, vv[i].y}; *(LAS u32x2*)(lds + NA_VOFF + trow * NA_VP + ch * 16 + 8) = (u32x2){vv[i].z, vv[i].w}; }
        __syncthreads();
        const int itn = it + itstep; const bool has_next = itn < NB * 8 * 16; const NaItem nx = na_item(has_next ? itn : it, ri);
        if (has_next) na_load_kv(kv, vv, nx, NK, NV, tid);
        const int rs = cur.rs, krmin = cur.krmin;
        f32x4 st[16]; float mx = -3.0e38f;
#pragma unroll
        for (int kri = 0; kri < 8; ++kri) {
#pragma unroll
            for (int cf = 0; cf < 2; ++cf) { LAS unsigned char* kp = lds + ((rs + kri - krmin) * 64 + w0 + 16 * cf + li) * NA_KP + 16 * g;
                f32x4 a = {0.f, 0.f, 0.f, 0.f};
                a = mma(ldsf(kp), q0, a); a = mma(ldsf(kp + 64), q1, a); a = mma(ff[kri * 2 + cf], e1, a);
                st[kri * 2 + cf] = a; mx = fmaxf(mx, fmaxf(fmaxf(a[0], a[1]), fmaxf(a[2], a[3]))); }
            __builtin_amdgcn_sched_barrier(0); }
        bf16* qrow = NQ + (size_t)(cur.b * SEQ + cur.r * 64 + c0 + li) * 512 + cur.h * 64;
        if (has_next) {
#pragma unroll
            for (int f = 0; f < 8; ++f) ff[f] = glbf(FT + ((size_t)((nx.h * 15 + (nx.rs + (f >> 1) - nx.r + 7)) * 64 + w0 + 16 * (f & 1) + li)) * 64 + (c0 & 32) + 8 * g);
            const bf16* qr = NQ + (size_t)(nx.b * SEQ + nx.r * 64 + c0 + li) * 512 + nx.h * 64; q0 = glbf(qr + 8 * g); q1 = glbf(qr + 32 + 8 * g); }
        mx = red_g_max(mx); float sum = 0.f;
#pragma unroll
        for (int f = 0; f < 16; ++f) {
#pragma unroll
            for (int rr = 0; rr < 4; ++rr) { const float e = __expf(st[f][rr] - mx); st[f][rr] = e; sum += e; } }
        sum = red_g_sum(sum); const float inv = 1.0f / sum;
        f32x4 o[4];
#pragma unroll
        for (int df = 0; df < 4; ++df) o[df] = (f32x4){0.f, 0.f, 0.f, 0.f};
#pragma unroll
        for (int x = 0; x < 8; ++x) { const bf16x8 pf = pack8(st[2 * x], st[2 * x + 1]);
            LAS unsigned char* vb = lds + NA_VOFF + ((rs + x - krmin) * 64 + w0 + 4 * g + q4) * NA_VP + 8 * p4;
#pragma unroll
            for (int df = 0; df < 4; ++df) o[df] = mma(trf(vb + 32 * df, vb + 16 * NA_VP + 32 * df), pf, o[df]); __builtin_amdgcn_sched_barrier(0); }
#pragma unroll
        for (int df = 0; df < 4; ++df) *(u32x2*)(qrow + 16 * df + 4 * g) = pack4(o[df] * inv);
        if (!has_next) break;
#pragma unroll
        for (int f = 8; f < 16; ++f) ff[f] = glbf(FT + ((size_t)((nx.h * 15 + (nx.rs + (f >> 1) - nx.r + 7)) * 64 + w0 + 16 * (f & 1) + li)) * 64 + (c0 & 32) + 8 * g);
        cur = nx; it = itn;
    }
}

constexpr int RT_P = 272, RT_VP = 544, RT_QOFF = 0, RT_KOFF = 128 * RT_P, RT_VOFF = 2 * 128 * RT_P, RT_RED = RT_VOFF + 128 * RT_VP, RT_STAT = RT_RED + 8 * 128 * 8;
__device__ __forceinline__ void ret_out_phase(LAS unsigned char* lds, const bf16* RQ, const bf16* RK, const bf16* RV, bf16* RG, const bf16* ST, const float* gain, const float* decf, const float* decb) {
    const int tid0 = threadIdx.x, lane = tid0 & 63, wave = __builtin_amdgcn_readfirstlane(tid0 >> 6), g = lane >> 4, li = lane & 15, q4 = li >> 2, p4 = li & 3;
    for (int it = blockIdx.x; it < NB * 4 * 16; it += gridDim.x) {
        const int b = it >> 6, h = (it >> 4) & 3, n = it & 15; const size_t tok0 = (size_t)b * SEQ + n * 128;
        int tid = tid0; asm volatile("" : "+v"(tid));
        const float lgf = -log1pf(expf(-decf[h])), lgb = -log1pf(expf(-decb[h]));
        const bf16* sfp = ST + ((size_t)(((b * 4 + h) * 2 + 0) * 16 + n) * 256 + 32 * wave + li) * 128 + 8 * g;
        const bf16* sbp = ST + ((size_t)(((b * 4 + h) * 2 + 1) * 16 + n) * 256 + 32 * wave + li) * 128 + 8 * g;
        __syncthreads();
#pragma unroll
        for (int i = 0; i < 4; ++i) { const int id = tid + 512 * i, row = id >> 4, ch = id & 15;
            *(LAS u32x4*)(lds + RT_QOFF + row * RT_P + ch * 16) = *(const u32x4*)(RQ + (tok0 + row) * 512 + h * 128 + ch * 8);
            *(LAS u32x4*)(lds + RT_KOFF + row * RT_P + ch * 16) = *(const u32x4*)(RK + (tok0 + row) * 512 + h * 128 + ch * 8); }
#pragma unroll
        for (int i = 0; i < 8; ++i) { const int id = tid + 512 * i, row = id >> 5, ch = id & 31;
            *(LAS u32x4*)(lds + RT_VOFF + row * RT_VP + ch * 16) = *(const u32x4*)(RV + (tok0 + row) * 1024 + h * 256 + ch * 8); }
        __builtin_amdgcn_sched_barrier(0);
        bf16x8 sf[2][4];
        if (it == (int)blockIdx.x) MXSTAMP(25);
#pragma unroll
        for (int a = 0; a < 2; ++a)
#pragma unroll
            for (int s = 0; s < 4; ++s) sf[a][s] = glbf(sfp + a * 16 * 128 + 32 * s);
        __syncthreads();
        if (it == (int)blockIdx.x) MXSTAMP(26);
        { bf16x8 qf[4];
#pragma unroll
          for (int s = 0; s < 4; ++s) qf[s] = ldsf(lds + RT_QOFF + (16 * wave + li) * RT_P + (32 * s + 8 * g) * 2);
          f32x4 st[8]; const int pi = 16 * wave + li;
#pragma unroll
          for (int jf = 0; jf < 8; ++jf) { f32x4 a = {0.f, 0.f, 0.f, 0.f};
#pragma unroll
              for (int s = 0; s < 4; ++s) a = mma(ldsf(lds + RT_KOFF + (16 * jf + li) * RT_P + (32 * s + 8 * g) * 2), qf[s], a);
#pragma unroll
              for (int r = 0; r < 4; ++r) { const int pj = 16 * jf + 4 * g + r; a[r] *= (pj <= pi) ? __expf((float)(pi - pj) * lgf) : __expf((float)(pj - pi) * lgb); }
              st[jf] = a; __builtin_amdgcn_sched_barrier(0); }
          __syncthreads();
#pragma unroll
          for (int jf = 0; jf < 8; ++jf) *(LAS u32x2*)(lds + RT_KOFF + pi * RT_P + (16 * jf + 4 * g) * 2) = pack4(st[jf]);
        }
        __syncthreads();
        if (it == (int)blockIdx.x) MXSTAMP(27);
        bf16x8 sb[2][4];
#pragma unroll
        for (int a = 0; a < 2; ++a)
#pragma unroll
            for (int s = 0; s < 4; ++s) sb[a][s] = glbf(sbp + a * 16 * 128 + 32 * s);
        f32x4 y[2][8];
#pragma unroll
        for (int a = 0; a < 2; ++a)
#pragma unroll
            for (int i = 0; i < 8; ++i) y[a][i] = (f32x4){0.f, 0.f, 0.f, 0.f};
        {
#pragma unroll
          for (int i = 0; i < 8; ++i) {
#pragma unroll
              for (int s = 0; s < 4; ++s) { const bf16x8 qfr = ldsf(lds + RT_QOFF + (16 * i + li) * RT_P + (32 * s + 8 * g) * 2); y[0][i] = mma(sf[0][s], qfr, y[0][i]); y[1][i] = mma(sf[1][s], qfr, y[1][i]); }
              const int pi = 16 * i + li; const float ratio = __expf((float)(pi + 1) * lgf - (float)(128 - pi) * lgb);
              y[0][i] = y[0][i] * ratio; y[1][i] = y[1][i] * ratio; __builtin_amdgcn_sched_barrier(0); } }
        if (it == (int)blockIdx.x) MXSTAMP(28);
        {
#pragma unroll
          for (int i = 0; i < 8; ++i) {
#pragma unroll
              for (int s = 0; s < 4; ++s) { const bf16x8 qfr = ldsf(lds + RT_QOFF + (16 * i + li) * RT_P + (32 * s + 8 * g) * 2); y[0][i] = mma(sb[0][s], qfr, y[0][i]); y[1][i] = mma(sb[1][s], qfr, y[1][i]); }
              const int pi = 16 * i + li; const float ab = __expf((float)(128 - pi) * lgb);
              y[0][i] = y[0][i] * ab; y[1][i] = y[1][i] * ab; __builtin_amdgcn_sched_barrier(0); } }
        if (it == (int)blockIdx.x) MXSTAMP(29);
#pragma unroll
        for (int x = 0; x < 4; ++x) {
            LAS unsigned char* vb = lds + RT_VOFF + (32 * x + 8 * g + q4) * RT_VP + (32 * wave) * 2 + 8 * p4;
            const bf16x8 v0 = trf(vb, vb + 4 * RT_VP), v1 = trf(vb + 32, vb + 4 * RT_VP + 32);
#pragma unroll
            for (int i = 0; i < 8; ++i) { const bf16x8 pfr = ldsf(lds + RT_KOFF + (16 * i + li) * RT_P + (32 * x + 8 * g) * 2); y[0][i] = mma(v0, pfr, y[0][i]); y[1][i] = mma(v1, pfr, y[1][i]); } __builtin_amdgcn_sched_barrier(0); }
        if (it == (int)blockIdx.x) MXSTAMP(30);
#pragma unroll
        for (int i = 0; i < 8; ++i) { float s1 = 0.f, s2 = 0.f;
#pragma unroll
            for (int a = 0; a < 2; ++a)
#pragma unroll
                for (int r = 0; r < 4; ++r) { const float v = y[a][i][r]; s1 += v; s2 += v * v; }
            s1 = red_g_sum(s1); s2 = red_g_sum(s2);
            if (g == 0) { LAS float* rp = (LAS float*)(lds + RT_RED) + (wave * 128 + 16 * i + li) * 2; rp[0] = s1; rp[1] = s2; } }
        __syncthreads();
        if (tid < 128) { float s1 = 0.f, s2 = 0.f;
#pragma unroll
            for (int w = 0; w < 8; ++w) { const LAS float* rp = (const LAS float*)(lds + RT_RED) + (w * 128 + tid) * 2; s1 += rp[0]; s2 += rp[1]; }
            const float mu = s1 * (1.f / 256.f); const float var = fmaxf(s2 * (1.f / 256.f) - mu * mu, 0.f);
            LAS float* sp = (LAS float*)(lds + RT_STAT) + tid * 2; sp[0] = mu; sp[1] = 1.0f / sqrtf(var + GN_EPS); }
        __syncthreads();
        if (it == (int)blockIdx.x) MXSTAMP(31);
        const f32x4 gn0 = *(const f32x4*)(gain + h * 256 + 32 * wave + 4 * g), gn1 = *(const f32x4*)(gain + h * 256 + 32 * wave + 16 + 4 * g);
#pragma unroll
        for (int i = 0; i < 8; ++i) { const LAS float* sp = (const LAS float*)(lds + RT_STAT) + (16 * i + li) * 2; const float mu = sp[0], rstd = sp[1];
            bf16* gp = RG + (tok0 + 16 * i + li) * 1024 + h * 256 + 32 * wave + 4 * g;
#pragma unroll
            for (int a = 0; a < 2; ++a) { const u32x2 gv = *(const u32x2*)(gp + 16 * a); const f32x4 gg = a ? gn1 : gn0;
                f32x4 o; o[0] = (y[a][i][0] - mu) * rstd * gg[0] * bf2f(gv.x & 0xffffu); o[1] = (y[a][i][1] - mu) * rstd * gg[1] * bf2f(gv.x >> 16);
                o[2] = (y[a][i][2] - mu) * rstd * gg[2] * bf2f(gv.y & 0xffffu); o[3] = (y[a][i][3] - mu) * rstd * gg[3] * bf2f(gv.y >> 16);
                *(u32x2*)(gp + 16 * a) = pack4(o); } }
    }
}

constexpr int RS_KP = 272, RS_VP = 144, RS_VOFF = 128 * RS_KP;
__device__ __forceinline__ void ret_state_phase(LAS unsigned char* lds, const bf16* RK, const bf16* RV, bf16* ST, const float* decf, const float* decb) {
    const int tid = threadIdx.x, lane = tid & 63, wave = __builtin_amdgcn_readfirstlane(tid >> 6), g = lane >> 4, li = lane & 15, q4 = li >> 2, p4 = li & 3;
    for (int it = blockIdx.x; it < NB * 4 * 2 * 4; it += gridDim.x) {
        const int es = it & 3, dir = (it >> 2) & 1, h = (it >> 3) & 3, b = it >> 5;
        const float lg = -log1pf(expf(-(dir ? decb[h] : decf[h]))); const float cd = __expf(128.f * lg);
        f32x4 st[4];
#pragma unroll
        for (int ef = 0; ef < 4; ++ef) st[ef] = (f32x4){0.f, 0.f, 0.f, 0.f};
        u32x4 kq[4], vq[2];
        { const size_t tk = (size_t)b * SEQ + (dir ? 15 : 0) * 128;
#pragma unroll
          for (int i = 0; i < 4; ++i) { const int id = tid + 512 * i, row = id >> 4, ch = id & 15; kq[i] = *(const u32x4*)(RK + (tk + row) * 512 + h * 128 + ch * 8); }
#pragma unroll
          for (int i = 0; i < 2; ++i) { const int id = tid + 512 * i, row = id >> 3, ch = id & 7; vq[i] = *(const u32x4*)(RV + (tk + row) * 1024 + h * 256 + es * 64 + ch * 8); } }
#pragma unroll 1
        for (int cc = 0; cc < 16; ++cc) { const int n = dir ? 15 - cc : cc;
            bf16* sp = ST + ((size_t)(((b * 4 + h) * 2 + dir) * 16 + n) * 256 + es * 64 + 4 * g) * 128 + 16 * wave + li;
#pragma unroll
            for (int ef = 0; ef < 4; ++ef)
#pragma unroll
                for (int r = 0; r < 4; ++r) sp[(16 * ef + r) * 128] = (bf16)f2bf(st[ef][r]);
            __syncthreads();
#pragma unroll
            for (int i = 0; i < 4; ++i) { const int id = tid + 512 * i, row = id >> 4, ch = id & 15;
                float v[8]; unpack8(kq[i], v);
                const float w = __expf((float)(dir ? row : 127 - row) * lg);
                u32x4 o; o.x = pk2(v[0] * w, v[1] * w); o.y = pk2(v[2] * w, v[3] * w); o.z = pk2(v[4] * w, v[5] * w); o.w = pk2(v[6] * w, v[7] * w);
                *(LAS u32x4*)(lds + row * RS_KP + ch * 16) = o; }
#pragma unroll
            for (int i = 0; i < 2; ++i) { const int id = tid + 512 * i, row = id >> 3, ch = id & 7; *(LAS u32x4*)(lds + RS_VOFF + row * RS_VP + ch * 16) = vq[i]; }
            if (cc < 15) { const int n2 = dir ? 14 - cc : cc + 1; const size_t tk = (size_t)b * SEQ + n2 * 128;
#pragma unroll
                for (int i = 0; i < 4; ++i) { const int id = tid + 512 * i, row = id >> 4, ch = id & 15; kq[i] = *(const u32x4*)(RK + (tk + row) * 512 + h * 128 + ch * 8); }
#pragma unroll
                for (int i = 0; i < 2; ++i) { const int id = tid + 512 * i, row = id >> 3, ch = id & 7; vq[i] = *(const u32x4*)(RV + (tk + row) * 1024 + h * 256 + es * 64 + ch * 8); } }
            __syncthreads();
#pragma unroll
            for (int ef = 0; ef < 4; ++ef) st[ef] = st[ef] * cd;
#pragma unroll
            for (int x = 0; x < 4; ++x) {
                LAS unsigned char* kb = lds + (32 * x + 8 * g + q4) * RS_KP + (16 * wave) * 2 + 8 * p4;
                const bf16x8 kfr = trf(kb, kb + 4 * RS_KP);
                LAS unsigned char* vb = lds + RS_VOFF + (32 * x + 8 * g + q4) * RS_VP + 8 * p4;
#pragma unroll
                for (int ef = 0; ef < 4; ++ef) st[ef] = mma(trf(vb + 32 * ef, vb + 4 * RS_VP + 32 * ef), kfr, st[ef]); __builtin_amdgcn_sched_barrier(0); }
        }
    }
}
__device__ __forceinline__ void memkv_phase(const bf16* MN, const bf16* WKV, bf16* MKV) {
    const int tid = threadIdx.x, lane = tid & 63, wave = __builtin_amdgcn_readfirstlane(tid >> 6), g = lane >> 4, li = lane & 15;
    for (int it = blockIdx.x; it < 256; it += gridDim.x) {
        const int r0 = (it >> 4) * 128 + wave * 16, c0 = (it & 15) * 64;
        const bf16* ap = MN + (size_t)(r0 + li) * 1024 + 8 * g; const bf16* bp = WKV + (size_t)(c0 + li) * 1024 + 8 * g;
        f32x4 acc[4];
#pragma unroll
        for (int nf = 0; nf < 4; ++nf) acc[nf] = (f32x4){0.f, 0.f, 0.f, 0.f};
#pragma unroll 4
        for (int s = 0; s < 32; ++s) { const bf16x8 a = glbf(ap + 32 * s);
#pragma unroll
            for (int nf = 0; nf < 4; ++nf) acc[nf] = mma(glbf(bp + (size_t)nf * 16 * 1024 + 32 * s), a, acc[nf]); }
#pragma unroll
        for (int nf = 0; nf < 4; ++nf) *(u32x2*)(MKV + (size_t)(r0 + li) * 1024 + c0 + 16 * nf + 4 * g) = pack4(acc[nf]);
    }
}
}


struct Ptrs {
    const float* in[23]; float* out; unsigned char* ws;
    __device__ bf16* b(size_t off) const { return (bf16*)(ws + off); }
    __device__ float* f(size_t off) const { return (float*)(ws + off); }
};

__device__ __forceinline__ void phase0(const Ctx& c, const Ptrs& P) {
    int tb = 0;
    transpose_all(c, tb, ColWA{P.in[3]}, 8192, NPA, 1024, P.b(WS_WA));
    transpose_all(c, tb, ColOff{P.in[3], NPA}, 8192, NPG, 1024, P.b(WS_WG));
    transpose_all(c, tb, ColPlain{P.in[11]}, 1024, 1024, 1024, P.b(WS_WKV));
    transpose_all(c, tb, ColPlain{P.in[7]}, 1024, 1024, 1024, P.b(WS_WRO));
    transpose_all(c, tb, ColPlain{P.in[9]}, 1024, 1024, 512, P.b(WS_WNO));
    transpose_all(c, tb, ColPlain{P.in[12]}, 1024, 1024, 512, P.b(WS_WXO));
    transpose_all(c, tb, ColPlain{P.in[13]}, 1024, 1024, 1024, P.b(WS_WOUT));
    { float* COS = P.f(WS_COS); float* SIN = P.f(WS_SIN);
      for (int i = c.gw * 64 + c.lane; i < SEQ * 64; i += c.ngw * 64) { const int pos = i >> 6, fi = i & 63;
          const float inv = (float)pow(10000.0, -(double)fi / 64.0); const float ang = (float)pos * inv;
          COS[i] = (float)cos((double)ang); SIN[i] = (float)sin((double)ang); } }
    { bf16* FT = P.b(WS_FT); const float* rpb = P.in[8];
      for (int i = c.gw * 64 + c.lane; i < 8 * 15 * 64 * 64; i += c.ngw * 64) { const int qc = i & 63, kc = (i >> 6) & 63, hr = i >> 12;
          int cs = qc - 8; cs = cs < 0 ? 0 : (cs > 48 ? 48 : cs); int rc = kc - qc; rc = rc < -15 ? -15 : (rc > 15 ? 15 : rc);
          const float v = (kc >= cs && kc < cs + 16) ? rpb[hr * 31 + rc + 15] : -1.0e30f; FT[i] = (bf16)f2bf(v); } }
    for (int m = c.gw; m < T; m += 2 * c.ngw) {
        const int m2 = m + c.ngw; const f32x4* xa = (const f32x4*)(P.in[0] + (size_t)m * DM) + c.lane; const f32x4* xb = (const f32x4*)(P.in[0] + (size_t)(m2 < T ? m2 : m) * DM) + c.lane;
        const f32x4* gr = (const f32x4*)P.in[2] + c.lane;
        f32x4 va[4], vb[4]; float sa = 0.f, sb = 0.f;
#pragma unroll
        for (int j = 0; j < 4; ++j) { va[j] = xa[64 * j]; vb[j] = xb[64 * j]; }
#pragma unroll
        for (int j = 0; j < 4; ++j) { sa += (va[j].x * va[j].x + va[j].y * va[j].y) + (va[j].z * va[j].z + va[j].w * va[j].w); sb += (vb[j].x * vb[j].x + vb[j].y * vb[j].y) + (vb[j].z * vb[j].z + vb[j].w * vb[j].w); }
        const float ra = 1.0f / sqrtf(wave_sum(sa) * (1.f / 1024.f) + RMS_EPS), rb = 1.0f / sqrtf(wave_sum(sb) * (1.f / 1024.f) + RMS_EPS);
        unsigned long long* oa = (unsigned long long*)(P.b(WS_XN) + (size_t)m * DM) + c.lane; unsigned long long* ob = (unsigned long long*)(P.b(WS_XN) + (size_t)m2 * DM) + c.lane;
#pragma unroll
        for (int j = 0; j < 4; ++j) { const f32x4 gg = gr[64 * j];
            oa[64 * j] = (unsigned long long)pk2(va[j].x * ra * gg.x, va[j].y * ra * gg.y) | ((unsigned long long)pk2(va[j].z * ra * gg.z, va[j].w * ra * gg.w) << 32);
            if (m2 < T) ob[64 * j] = (unsigned long long)pk2(vb[j].x * rb * gg.x, vb[j].y * rb * gg.y) | ((unsigned long long)pk2(vb[j].z * rb * gg.z, vb[j].w * rb * gg.w) << 32); } }
    for (int m = c.gw; m < TM; m += c.ngw) rms_row_to_bf16(P.in[1] + (size_t)m * DM, P.in[10], P.b(WS_MN) + (size_t)m * DM, c.lane);
}

__device__ __forceinline__ void phase1_naive(const Ctx& c, const Ptrs& P) {
    EpiProjA E{P.b(WS_RQ), P.b(WS_RK), P.b(WS_RV), P.b(WS_RG), P.b(WS_NQ), P.b(WS_NK), P.b(WS_NV), P.b(WS_XQ), P.f(WS_COS), P.f(WS_SIN)};
    naive_gemm(c, RowPlain{P.b(WS_XN), DM}, P.b(WS_WA), DM, T, NPA, DM, E);
}

__device__ __forceinline__ float log_sigmoid_(float x) { return -log1pf(expf(-x)); }

__device__ __forceinline__ void phase2_states_naive(const Ctx& c, const Ptrs& P) {
    const bf16* RK = P.b(WS_RK); const bf16* RV = P.b(WS_RV); bf16* ST = (bf16*)P.out;
    const int nitems = NB * 4 * 2 * 128 * 4;
    for (int it = c.gw; it < nitems; it += c.ngw) {
        const int eb = it & 3, d = (it >> 2) & 127, dir = (it >> 9) & 1, h = (it >> 10) & 3, b = it >> 12;
        const int e = eb * 64 + c.lane;
        const float lg = log_sigmoid_(dir ? P.in[5][h] : P.in[4][h]); const float gam = expf(lg);
        float S = 0.f;
        bf16* stb = ST + (size_t)(((b * 4 + h) * 2 + dir) * 16) * 256 * 128 + (size_t)e * 128 + d;
        for (int jj = 0; jj < SEQ; ++jj) {
            const int j = dir ? (SEQ - 1 - jj) : jj;
            if ((jj & 127) == 0) { const int n = j >> 7; stb[(size_t)n * 256 * 128] = (bf16)f2bf(S); }
            const size_t tok = (size_t)b * SEQ + j;
            const float kv = bf2f(RK[tok * 512 + h * 128 + d]) * bf2f(RV[tok * 1024 + h * 256 + e]);
            S = S * gam + kv;
        }
    }
}
__device__ __forceinline__ void phase2_na_naive(const Ctx& c, const Ptrs& P) {
    bf16* NQ = P.b(WS_NQ); const bf16* NK = P.b(WS_NK); const bf16* NV = P.b(WS_NV); const float* rpb = P.in[8];
    float* scr = (float*)(c.lds + c.wave * 16384);
    const int lane = c.lane;
    for (int it = c.gw; it < T * 8; it += c.ngw) {
        const int h = it & 7, tok = it >> 3, b = tok >> 11, s = tok & 2047, r = s >> 6, cc = s & 63;
        int rs = r - 4; rs = rs < 0 ? 0 : (rs > 24 ? 24 : rs);
        int cs = cc - 8; cs = cs < 0 ? 0 : (cs > 48 ? 48 : cs);
        scr[128 + lane] = bf2f(NQ[(size_t)tok * 512 + h * 64 + lane]);
        __builtin_amdgcn_s_waitcnt(0xC07F); asm volatile("" ::: "memory");
        float sc[2];
#pragma unroll
        for (int t = 0; t < 2; ++t) { const int key = lane + 64 * t, kr = rs + (key >> 4), kc = cs + (key & 15);
            const size_t kt = (size_t)b * SEQ + kr * 64 + kc; const u32x4* kp = (const u32x4*)(NK + kt * 512 + h * 64);
            float a = 0.f;
#pragma unroll 2
            for (int i = 0; i < 8; ++i) { float kk[8]; unpack8(kp[i], kk);
#pragma unroll
                for (int u = 0; u < 8; ++u) a += scr[128 + 8 * i + u] * kk[u]; }
            int rc = kc - cc; rc = rc < -15 ? -15 : (rc > 15 ? 15 : rc);
            sc[t] = a + rpb[(h * 15 + (kr - r + 7)) * 31 + rc + 15]; }
        const float mx = wave_max(fmaxf(sc[0], sc[1]));
        const float e0 = __expf(sc[0] - mx), e1 = __expf(sc[1] - mx);
        const float inv = 1.0f / wave_sum(e0 + e1);
        scr[lane] = e0 * inv; scr[lane + 64] = e1 * inv;
        __builtin_amdgcn_s_waitcnt(0xC07F); asm volatile("" ::: "memory");
        float o = 0.f;
        for (int key = 0; key < 128; ++key) { const int kr = rs + (key >> 4), kc = cs + (key & 15);
            const size_t kt = (size_t)b * SEQ + kr * 64 + kc; o += scr[key] * bf2f(NV[kt * 512 + h * 64 + lane]); }
        NQ[(size_t)tok * 512 + h * 64 + lane] = (bf16)f2bf(o);
        __builtin_amdgcn_s_waitcnt(0xC07F); asm volatile("" ::: "memory");
    }
}
__device__ __forceinline__ void phase2_memkv_naive(const Ctx& c, const Ptrs& P) {
    naive_gemm(c, RowPlain{P.b(WS_MN), DM}, P.b(WS_WKV), DM, TM, 1024, DM, EpiBf16Plain{P.b(WS_MKV), 1024});
}
__device__ __forceinline__ void phase3_ret_naive(const Ctx& c, const Ptrs& P) {
    const bf16* RQ = P.b(WS_RQ); const bf16* RK = P.b(WS_RK); const bf16* RV = P.b(WS_RV); bf16* RG = P.b(WS_RG); const bf16* ST = (const bf16*)P.out;
    const float* gain = P.in[6];
    float* scr = (float*)(c.lds + c.wave * 16384);
    const int lane = c.lane;
    for (int it = c.gw; it < T * 4; it += c.ngw) {
        const int h = it & 3, tok = it >> 2, b = tok >> 11, s = tok & 2047, n = s >> 7, p = s & 127;
        const float lgf = log_sigmoid_(P.in[4][h]), lgb = log_sigmoid_(P.in[5][h]);
        { const bf16* qp = RQ + (size_t)tok * 512 + h * 128; scr[lane] = bf2f(qp[lane]); scr[lane + 64] = bf2f(qp[lane + 64]); }
        __builtin_amdgcn_s_waitcnt(0xC07F); asm volatile("" ::: "memory");
        float sv[2];
#pragma unroll
        for (int t = 0; t < 2; ++t) { const int pj = lane + 64 * t; const size_t kt = (size_t)b * SEQ + n * 128 + pj;
            const u32x4* kp = (const u32x4*)(RK + kt * 512 + h * 128); float a = 0.f;
#pragma unroll 2
            for (int i = 0; i < 16; ++i) { float kk[8]; unpack8(kp[i], kk);
#pragma unroll
                for (int u = 0; u < 8; ++u) a += scr[8 * i + u] * kk[u]; }
            const float w = (pj <= p) ? expf((float)(p - pj) * lgf) : expf((float)(pj - p) * lgb);
            sv[t] = a * w; }
        scr[128 + lane] = sv[0]; scr[128 + 64 + lane] = sv[1];
        __builtin_amdgcn_s_waitcnt(0xC07F); asm volatile("" ::: "memory");
        const float af = expf((float)(p + 1) * lgf), ab = expf((float)(128 - p) * lgb);
        const bf16* sf = ST + (size_t)(((b * 4 + h) * 2 + 0) * 16 + n) * 256 * 128;
        const bf16* sb = ST + (size_t)(((b * 4 + h) * 2 + 1) * 16 + n) * 256 * 128;
        float y[4];
#pragma unroll 1
        for (int eb = 0; eb < 4; ++eb) { const int e = eb * 64 + lane; float a = 0.f;
#pragma unroll 4
            for (int pj = 0; pj < 128; ++pj) { const size_t kt = (size_t)b * SEQ + n * 128 + pj; a += scr[128 + pj] * bf2f(RV[kt * 1024 + h * 256 + e]); }
            float cf = 0.f, cb = 0.f; const u32x4* fp = (const u32x4*)(sf + (size_t)e * 128); const u32x4* bp = (const u32x4*)(sb + (size_t)e * 128);
#pragma unroll 2
            for (int i = 0; i < 16; ++i) { float x1[8], x2[8]; unpack8(fp[i], x1); unpack8(bp[i], x2);
#pragma unroll
                for (int u = 0; u < 8; ++u) { cf += scr[8 * i + u] * x1[u]; cb += scr[8 * i + u] * x2[u]; } }
            y[eb] = a + af * cf + ab * cb; }
        const float mu = wave_sum((y[0] + y[1]) + (y[2] + y[3])) * (1.f / 256.f);
        float v = 0.f;
#pragma unroll
        for (int eb = 0; eb < 4; ++eb) { y[eb] -= mu; v += y[eb] * y[eb]; }
        const float rstd = 1.0f / sqrtf(wave_sum(v) * (1.f / 256.f) + GN_EPS);
#pragma unroll
        for (int eb = 0; eb < 4; ++eb) { const int col = h * 256 + eb * 64 + lane; bf16* g = RG + (size_t)tok * 1024 + col;
            *g = (bf16)f2bf(y[eb] * rstd * gain[col] * bf2f(*g)); }
        __builtin_amdgcn_s_waitcnt(0xC07F); asm volatile("" ::: "memory");
    }
}
__device__ __forceinline__ void phase3_xa_naive(const Ctx& c, const Ptrs& P) {
    bf16* XQ = P.b(WS_XQ); const bf16* MKV = P.b(WS_MKV);
    float* scr = (float*)(c.lds + c.wave * 16384);
    const int lane = c.lane;
    for (int it = c.gw; it < T * 4; it += c.ngw) {
        const int h = it & 3, tok = it >> 2, b = tok >> 11;
        { const bf16* qp = XQ + (size_t)tok * 512 + h * 128; scr[lane] = bf2f(qp[lane]); scr[lane + 64] = bf2f(qp[lane + 64]); }
        __builtin_amdgcn_s_waitcnt(0xC07F); asm volatile("" ::: "memory");
        float sc[4]; float mx = -3.0e38f;
#pragma unroll
        for (int t = 0; t < 4; ++t) { const int m = lane + 64 * t; const u32x4* kp = (const u32x4*)(MKV + (size_t)(b * MEML + m) * 1024 + h * 128); float a = 0.f;
#pragma unroll 2
            for (int i = 0; i < 16; ++i) { float kk[8]; unpack8(kp[i], kk);
#pragma unroll
                for (int u = 0; u < 8; ++u) a += scr[8 * i + u] * kk[u]; }
            sc[t] = a; mx = fmaxf(mx, a); }
        mx = wave_max(mx); float sum = 0.f;
#pragma unroll
        for (int t = 0; t < 4; ++t) { sc[t] = __expf(sc[t] - mx); sum += sc[t]; }
        const float inv = 1.0f / wave_sum(sum);
#pragma unroll
        for (int t = 0; t < 4; ++t) scr[128 + lane + 64 * t] = sc[t] * inv;
        __builtin_amdgcn_s_waitcnt(0xC07F); asm volatile("" ::: "memory");
        float o0 = 0.f, o1 = 0.f;
        for (int m = 0; m < MEML; ++m) { const bf16* vp = MKV + (size_t)(b * MEML + m) * 1024 + 512 + h * 128; const float pm = scr[128 + m];
            o0 += pm * bf2f(vp[lane]); o1 += pm * bf2f(vp[lane + 64]); }
        bf16* op = XQ + (size_t)tok * 512 + h * 128; op[lane] = (bf16)f2bf(o0); op[lane + 64] = (bf16)f2bf(o1);
        __builtin_amdgcn_s_waitcnt(0xC07F); asm volatile("" ::: "memory");
    }
}
__device__ __forceinline__ void phase4_naive(const Ctx& c, const Ptrs& P) {
    naive_gemm(c, RowPlain{P.b(WS_XN), DM}, P.b(WS_WG), DM, T, NPG, DM, EpiSigmoid{P.b(WS_GATES), NPG});
}
__device__ __forceinline__ void phase5_naive(const Ctx& c, const Ptrs& P) {
    float* TMP = P.out; bf16* MIX = P.b(WS_MIX); const bf16* G = P.b(WS_GATES);
    naive_gemm(c, RowPlain{P.b(WS_RG), 1024}, P.b(WS_WRO), 1024, T, DM, 1024, EpiMixNaive<0>{TMP, MIX, G});
    naive_gemm(c, RowPlain{P.b(WS_NQ), 512}, P.b(WS_WNO), 512, T, DM, 512, EpiMixNaive<1>{TMP, MIX, G + 1024});
    naive_gemm(c, RowPlain{P.b(WS_XQ), 512}, P.b(WS_WXO), 512, T, DM, 512, EpiMixNaive<2>{TMP, MIX, G + 2048});
}
__device__ __forceinline__ void phase6_naive(const Ctx& c, const Ptrs& P) {
    naive_gemm(c, RowPlain{P.b(WS_MIX), DM}, P.b(WS_WOUT), DM, T, DM, DM, EpiResidF32{P.in[0], P.out});
}

__device__ __forceinline__ void phase1_mfma(const Ctx& c, const Ptrs& P) {
    EpiProjA E{P.b(WS_RQ), P.b(WS_RK), P.b(WS_RV), P.b(WS_RG), P.b(WS_NQ), P.b(WS_NK), P.b(WS_NV), P.b(WS_XQ), P.f(WS_COS), P.f(WS_SIN)};
    pg8::PlainSched S; S.o.init(T / 256, NPA / 256, gridDim.x, blockIdx.x); S.A = P.b(WS_XN); S.Bt = P.b(WS_WA); S.lda = DM; S.ldb = DM; S.K = DM;
    pg8::gemm_phase<false>((LAS unsigned char*)c.lds, S, pg8::EpiF<EpiProjA>{E});
}
__device__ __forceinline__ void phase4_mfma(const Ctx& c, const Ptrs& P) {
    pg8::PlainSched S; S.o.init(T / 256, NPG / 256, gridDim.x, blockIdx.x); S.A = P.b(WS_XN); S.Bt = P.b(WS_WG); S.lda = DM; S.ldb = DM; S.K = DM;
    pg8::gemm_phase<false>((LAS unsigned char*)c.lds, S, pg8::EpiF<EpiSigmoid>{EpiSigmoid{P.b(WS_GATES), NPG}});
}
__device__ __forceinline__ void phase6_mfma(const Ctx& c, const Ptrs& P) {
    pg8::PlainSched S; S.o.init(T / 256, DM / 256, gridDim.x, blockIdx.x); S.A = P.b(WS_MIX); S.Bt = P.b(WS_WOUT); S.lda = DM; S.ldb = DM; S.K = DM;
    pg8::gemm_phase<false>((LAS unsigned char*)c.lds, S, pg8::EpiF<EpiResidBf16>{EpiResidBf16{P.in[0], P.b(WS_D)}}, 25);
}

struct GateSched { pg8::TileOrder o; const unsigned char* ws;
    __device__ __forceinline__ bool next(int i, pg8::UnitDesc& u) const { int pm, pn; const int w = i % 3; if (!o.tile(i / 3, pm, pn)) return false;
        u.A = (const char*)(ws + WS_XN) + (size_t)pm * 256 * 2048; u.B = (const char*)(ws + WS_WG) + (size_t)(w * 1024 + pn * 256) * 2048; u.lda2 = 2048; u.ldb2 = 2048; u.nt = 16;
        u.row0 = pm * 256; u.col0 = pn * 256; u.aux = w; u.aux2 = 0; u.gidx = nullptr; u.gcnt = 0; u.chain = 0; return true; } };
__device__ __forceinline__ unsigned q8x4(f32x4 g) {
    const unsigned a = (unsigned)(g[0] * 255.0f + 0.5f), b = (unsigned)(g[1] * 255.0f + 0.5f), c = (unsigned)(g[2] * 255.0f + 0.5f), d = (unsigned)(g[3] * 255.0f + 0.5f);
    return a | (b << 8) | (c << 16) | (d << 24); }
__device__ __forceinline__ f32x4 dq8x4(unsigned w) {
    return (f32x4){fmaxf((float)(w & 0xffu) * (1.0f / 255.0f), 1e-18f), fmaxf((float)((w >> 8) & 0xffu) * (1.0f / 255.0f), 1e-18f),
                   fmaxf((float)((w >> 16) & 0xffu) * (1.0f / 255.0f), 1e-18f), fmaxf((float)(w >> 24) * (1.0f / 255.0f), 1e-18f)}; }
struct EpiGate { unsigned char* SCR;
    __device__ __forceinline__ void finish(f32x4 (&acc)[2][2][4][2], const pg8::UnitDesc& u, int wr, int wc, int fr, int fq) const {
        unsigned ow = (unsigned)((u.row0 >> 8) * 4 + (u.col0 >> 8)) * 196608u + (unsigned)u.aux * 65536u + threadIdx.x * 8u;
#pragma unroll
        for (int ai = 0; ai < 2; ++ai)
#pragma unroll
            for (int m = 0; m < 4; ++m) { asm volatile("" : "+v"(ow));
#pragma unroll
                for (int bj = 0; bj < 2; ++bj) { f32x4 s0, s1;
#pragma unroll
                    for (int i = 0; i < 4; ++i) { s0[i] = sigmoidf_(acc[ai][bj][m][0][i]); s1[i] = sigmoidf_(acc[ai][bj][m][1][i]); }
                    *(u32x2*)(SCR + ow + bj * 4096) = (u32x2){q8x4(s0), q8x4(s1)}; }
                ow += 2 * 4096; asm volatile("" ::: "memory"); __builtin_amdgcn_sched_barrier(0); }
        pg8::zero_acc(acc);
    } };
struct MixSched { pg8::TileOrder o; const unsigned char* ws;
    __device__ __forceinline__ bool next(int i, pg8::UnitDesc& u) const { int pm, pn; const int w = i % 3; if (!o.tile(i / 3, pm, pn)) return false;
        const size_t offA = w == 0 ? WS_RG : (w == 1 ? WS_NQ : WS_XQ), offB = w == 0 ? WS_WRO : (w == 1 ? WS_WNO : WS_WXO); const int K = w == 0 ? 1024 : 512;
        u.A = (const char*)(ws + offA) + (size_t)pm * 256 * K * 2; u.B = (const char*)(ws + offB) + (size_t)pn * 256 * K * 2; u.lda2 = K * 2; u.ldb2 = K * 2; u.nt = K / 64;
        u.row0 = pm * 256; u.col0 = pn * 256; u.aux = w; u.aux2 = 0; u.gidx = nullptr; u.gcnt = 0; u.chain = (w < 2); return true; } };
struct EpiMix { const unsigned char* SCR; bf16* MIX;
    __device__ __forceinline__ void finish(f32x4 (&acc)[2][2][4][2], const pg8::UnitDesc& u, int wr, int wc, int fr, int fq) const {
        const int w = u.aux; const bool fin = (w == 2);
        unsigned on = (unsigned)((u.row0 >> 8) * 4 + (u.col0 >> 8)) * 196608u + (unsigned)w * 65536u + threadIdx.x * 8u; const unsigned dd = fin ? 0u : 65536u;
        bf16* mp = MIX + (size_t)(u.row0 + wr * 64 + fr) * DM + u.col0 + wc * 32 + 8 * fq;
#pragma unroll
        for (int ai = 0; ai < 2; ++ai) {
            asm volatile("" : "+v"(on), "+v"(mp));
            u32x2 ga[4][2], gb[4][2];
#pragma unroll
            for (int m = 0; m < 4; ++m)
#pragma unroll
                for (int bj = 0; bj < 2; ++bj) { ga[m][bj] = *(const u32x2*)(SCR + on + (2 * m + bj) * 4096); gb[m][bj] = *(const u32x2*)(SCR + on + dd + (2 * m + bj) * 4096); }
#pragma unroll
            for (int m = 0; m < 4; ++m) {
#pragma unroll
                for (int bj = 0; bj < 2; ++bj) {
                    const f32x4 n0 = dq8x4(ga[m][bj].x), n1 = dq8x4(ga[m][bj].y), d0 = dq8x4(gb[m][bj].x), d1 = dq8x4(gb[m][bj].y);
                    f32x4 r0, r1;
#pragma unroll
                    for (int i = 0; i < 4; ++i) { r0[i] = n0[i] * __builtin_amdgcn_rcpf(fin ? 1.0f : d0[i]); r1[i] = n1[i] * __builtin_amdgcn_rcpf(fin ? 1.0f : d1[i]); }
                    const f32x4 v0 = acc[ai][bj][m][0] * r0, v1 = acc[ai][bj][m][1] * r1;
                    if (fin) store8(mp + (size_t)m * 16 * DM + bj * 128, v0, v1);
                    acc[ai][bj][m][0] = fin ? (f32x4){0.f, 0.f, 0.f, 0.f} : v0; acc[ai][bj][m][1] = fin ? (f32x4){0.f, 0.f, 0.f, 0.f} : v1; } }
            on += 8 * 4096; mp += 128 * DM; asm volatile("" ::: "memory"); __builtin_amdgcn_sched_barrier(0); }
    }
};
__device__ __forceinline__ void phase5_mfma(const Ctx& c, const Ptrs& P) {
    unsigned char* scr = P.ws + WS_GATES;
    { GateSched S; S.o.init(T / 256, DM / 256, gridDim.x, blockIdx.x); S.ws = P.ws; pg8::gemm_phase<false>((LAS unsigned char*)c.lds, S, EpiGate{scr}); }
    { MixSched S; S.o.init(T / 256, DM / 256, gridDim.x, blockIdx.x); S.ws = P.ws; pg8::gemm_phase<false>((LAS unsigned char*)c.lds, S, EpiMix{scr, P.b(WS_MIX)}); }
}
struct MoeSched { const unsigned* ctl; int G, c; int mode;
    const bf16 *H2, *WGU, *HID, *WD; const int* elist;
    __device__ __forceinline__ bool next(int i, pg8::UnitDesc& u) const {
        const int L = i * G + c; const int pn = L & 3; int mtg = L >> 2;
        int e = -1, base = 0, cnt = 0, mt = 0;
#pragma unroll 1
        for (int j = 0; j < NEXP; ++j) { const int cj = (int)__builtin_amdgcn_readfirstlane((int)ctl[CW_ECNT + 64 * j]); const int tj = (cj + 255) >> 8;
            if (mtg < tj) { e = j; cnt = cj; mt = mtg; break; } mtg -= tj; base += tj * 256; }
        if (e < 0) return false;
        u.row0 = mt * 256; u.col0 = pn * 256; u.aux = e; u.aux2 = base; u.gcnt = cnt; u.chain = 0;
        if (mode == 0) { u.A = (const char*)H2; u.gidx = elist + e * T; u.lda2 = DM * 2; u.B = (const char*)(WGU + (size_t)e * 1024 * 1024 + (size_t)pn * 256 * 1024); u.ldb2 = 2048; u.nt = 16; }
        else { u.A = (const char*)(HID + (size_t)(base + mt * 256) * DFF); u.gidx = nullptr; u.lda2 = DFF * 2; u.B = (const char*)(WD + (size_t)e * 1024 * 512 + (size_t)pn * 256 * 512); u.ldb2 = 1024; u.nt = 8; }
        return true; } };
struct EpiMoeUp { bf16* HID; const float* EWL; const float* ERS;
    __device__ __forceinline__ void finish(f32x4 (&acc)[2][2][4][2], const pg8::UnitDesc& u, int wr, int wc, int fr, int fq) const {
        const float* wl = EWL + u.aux * T; const float* rl = ERS + u.aux * T; bf16* H = HID; const int base = u.aux2, cnt = u.gcnt;
        pg8::epi_apply(acc, u, wr, wc, fr, fq, [=](int row, int col0, f32x4 v0, f32x4 v1) { if (row < cnt) { const float rs = rl[row], w = wl[row] * rs; f32x4 h;
#pragma unroll
            for (int i = 0; i < 4; ++i) h[i] = siluf_(v0[i] * rs) * v1[i] * w;
            u32x2 o; o.x = pk2(h[0], h[1]); o.y = pk2(h[2], h[3]); *(u32x2*)(H + (size_t)(base + row) * DFF + (col0 >> 1)) = o; } });
        pg8::zero_acc(acc);
    } };
struct EpiMoeDown { bf16* DR;
    __device__ __forceinline__ void finish(f32x4 (&acc)[2][2][4][2], const pg8::UnitDesc& u, int wr, int wc, int fr, int fq) const {
        bf16* D = DR; const int base = u.aux2;
        pg8::epi_apply(acc, u, wr, wc, fr, fq, [=](int row, int col0, f32x4 v0, f32x4 v1) { store8(D + (size_t)(base + row) * DM + col0, v0, v1); });
        pg8::zero_acc(acc);
    } };
__device__ __forceinline__ void phase8_mfma(const Ctx& c, const Ptrs& P) {
    MoeSched S; S.ctl = (const unsigned*)(P.ws + WS_CTL); S.G = gridDim.x; S.c = blockIdx.x; S.mode = 0; S.H2 = P.b(WS_D); S.WGU = P.b(WS_WGU); S.HID = P.b(WS_HID); S.WD = P.b(WS_WD); S.elist = (const int*)(P.ws + WS_ELIST);
    pg8::gemm_phase<true>((LAS unsigned char*)c.lds, S, EpiMoeUp{P.b(WS_HID), P.f(WS_EWL), P.f(WS_ERS)});
    { int tiles = 0;
      for (int j = 0; j < NEXP; ++j) tiles += ((int)S.ctl[CW_ECNT + 64 * j] + 255) >> 8;
      const int units = 4 * tiles, G = (int)gridDim.x; int nskip = units % G; if (units <= G || nskip * 2 > G) nskip = 0;
      if ((int)blockIdx.x >= nskip) { Ctx c2 = c; c2.gw = ((int)blockIdx.x - nskip) * NWAVES + c.wave; c2.ngw = (G - nskip) * NWAVES; int tb = 0;
          for (int e = 0; e < NEXP; ++e) transpose_all(c2, tb, ColPlain{P.in[21] + (size_t)e * 512 * 1024}, 1024, 1024, 512, P.b(WS_WD) + (size_t)e * 1024 * 512); } }
}
__device__ __forceinline__ void phase9_mfma(const Ctx& c, const Ptrs& P) {
    MoeSched S; S.ctl = (const unsigned*)(P.ws + WS_CTL); S.G = gridDim.x; S.c = blockIdx.x; S.mode = 1; S.H2 = P.b(WS_H2); S.WGU = P.b(WS_WGU); S.HID = P.b(WS_HID); S.WD = P.b(WS_WD); S.elist = (const int*)(P.ws + WS_ELIST);
    pg8::gemm_phase<false>((LAS unsigned char*)c.lds, S, EpiMoeDown{P.b(WS_DROWS)});
}
__device__ __forceinline__ void phase2_memkv_mfma(const Ctx& c, const Ptrs& P) {
    pg8::PlainSched S; S.o.init(TM / 256, 1024 / 256, gridDim.x, blockIdx.x); S.A = P.b(WS_MN); S.Bt = P.b(WS_WKV); S.lda = DM; S.ldb = DM; S.K = DM;
    pg8::gemm_phase<false>((LAS unsigned char*)c.lds, S, pg8::EpiF<EpiBf16Plain>{EpiBf16Plain{P.b(WS_MKV), 1024}});
}
__device__ __forceinline__ f32x4 x1_load(const float* X0, const bf16* DD, size_t tok, int lane, int j) {
    const u32x2 d = ((const u32x2*)(DD + tok * DM) + lane)[64 * j];
    return (f32x4){bf2f(d.x & 0xffffu), bf2f(d.x >> 16), bf2f(d.y & 0xffffu), bf2f(d.y >> 16)};
}
constexpr int RT7_WT = 0, RT7_RED = 81920, RT7_LOG = RT7_RED + 8 * 5120, RT7_CNT = RT7_LOG + 8 * 160, RT7_GB = RT7_CNT + 64, RT7_REC = RT7_GB + 64;
__device__ __forceinline__ void phase7(const Ctx& c, const Ptrs& P) {
    const float* X0 = P.in[0]; const bf16* DD = P.b(WS_D); const float* g = P.in[14]; const float* wrg = P.in[15]; const float* brg = P.in[16]; const float* wre = P.in[17]; const float* bre = P.in[18];
    unsigned* ctl = (unsigned*)(P.ws + WS_CTL); int* elist = (int*)(P.ws + WS_ELIST); float* ewl = P.f(WS_EWL); int* tmeta = (int*)(P.ws + WS_TMETA);
    const int lane = c.lane; LAS unsigned char* L = (LAS unsigned char*)c.lds;
    { LAS float* WT = (LAS float*)(L + RT7_WT);
      for (int i = c.tid; i < 1024 * 4; i += NTHREADS) WT[(i & 3) * 1024 + (i >> 2)] = wrg[i];
      for (int i = c.tid; i < 1024 * 16; i += NTHREADS) WT[(4 + (i & 15)) * 1024 + (i >> 4)] = wre[i];
      if (c.tid < 16) ((LAS unsigned*)(L + RT7_CNT))[c.tid] = 0u; }
    __syncthreads();
    LAS float* RED = (LAS float*)(L + RT7_RED + c.wave * 5120); LAS float* LOG = (LAS float*)(L + RT7_LOG + c.wave * 160);
    LAS unsigned* LCNT = (LAS unsigned*)(L + RT7_CNT); LAS int* REC = (LAS int*)(L + RT7_REC);
    const float mybias = lane < 4 ? brg[lane] : (lane < 20 ? bre[lane - 4] : 0.f);
    f32x4 xn[2][4];
    if (c.gw < T / 2) {
#pragma unroll
        for (int t = 0; t < 2; ++t)
#pragma unroll
            for (int j = 0; j < 4; ++j) xn[t][j] = x1_load(X0, DD, (size_t)(2 * c.gw + t), lane, j); }
    int pidx = 0;
#pragma unroll 1
    for (int tp = c.gw; tp < T / 2; tp += c.ngw, ++pidx) {
        f32x4 hh[2][4]; float rstd2[2]; const f32x4* gr = (const f32x4*)g + lane;
#pragma unroll
        for (int t = 0; t < 2; ++t)
#pragma unroll
            for (int j = 0; j < 4; ++j) hh[t][j] = xn[t][j];
        { const int tpn = tp + c.ngw < T / 2 ? tp + c.ngw : tp;
#pragma unroll
          for (int t = 0; t < 2; ++t)
#pragma unroll
              for (int j = 0; j < 4; ++j) xn[t][j] = x1_load(X0, DD, (size_t)(2 * tpn + t), lane, j); }
#pragma unroll
        for (int t = 0; t < 2; ++t) { const int tok = 2 * tp + t; float s = 0.f;
#pragma unroll
            for (int j = 0; j < 4; ++j) { s += (hh[t][j].x * hh[t][j].x + hh[t][j].y * hh[t][j].y) + (hh[t][j].z * hh[t][j].z + hh[t][j].w * hh[t][j].w); }
            const float r = 1.0f / sqrtf(wave_sum(s) * (1.f / 1024.f) + RMS_EPS); rstd2[t] = r; (void)tok;
#pragma unroll
            for (int j = 0; j < 4; ++j) { const f32x4 gg = gr[64 * j]; hh[t][j] = hh[t][j] * gg * r; } }
        float p0[20], p1[20];
        const LAS f32x4* wt = (const LAS f32x4*)(L + RT7_WT) + lane;
#pragma unroll
        for (int n = 0; n < 20; ++n) { float a0 = 0.f, a1 = 0.f;
#pragma unroll
            for (int j = 0; j < 4; ++j) { const f32x4 w4 = wt[n * 256 + 64 * j];
                a0 += (hh[0][j].x * w4.x + hh[0][j].y * w4.y) + (hh[0][j].z * w4.z + hh[0][j].w * w4.w);
                a1 += (hh[1][j].x * w4.x + hh[1][j].y * w4.y) + (hh[1][j].z * w4.z + hh[1][j].w * w4.w); }
            p0[n] = a0; p1[n] = a1; __builtin_amdgcn_sched_barrier(0); }
#pragma unroll 1
        for (int t = 0; t < 2; ++t) {
#pragma unroll
            for (int q = 0; q < 5; ++q) *(LAS f32x4*)(RED + lane * 20 + 4 * q) = t ? (f32x4){p1[4 * q], p1[4 * q + 1], p1[4 * q + 2], p1[4 * q + 3]} : (f32x4){p0[4 * q], p0[4 * q + 1], p0[4 * q + 2], p0[4 * q + 3]};
            asm volatile("s_waitcnt lgkmcnt(0)" ::: "memory");
            float sum = 0.f; const int nn = lane < 20 ? lane : 0;
#pragma unroll 16
            for (int j = 0; j < 64; ++j) sum += RED[j * 20 + nn];
            if (lane < 20) LOG[t * 20 + lane] = sum + mybias;
            asm volatile("s_waitcnt lgkmcnt(0)" ::: "memory");
        }
        if (lane < 2) {
            const int tok = 2 * tp + lane;
            float l[20];
#pragma unroll
            for (int i = 0; i < 20; ++i) l[i] = LOG[lane * 20 + i];
            int gi = 0;
#pragma unroll
            for (int i = 1; i < 4; ++i) if (l[i] > l[gi]) gi = i;
            float lmax = l[0];
#pragma unroll
            for (int i = 1; i < 4; ++i) lmax = fmaxf(lmax, l[i]);
            float se = 0.f;
#pragma unroll
            for (int i = 0; i < 4; ++i) se += expf(l[i] - lmax);
            const float grp_w = 1.0f / se;
            float el[4];
#pragma unroll
            for (int i = 0; i < 4; ++i) { float a = 0.f;
#pragma unroll
                for (int g2 = 0; g2 < 4; ++g2) a = (g2 == gi) ? l[4 + 4 * g2 + i] : a;
                el[i] = a; }
            int ia = 0;
#pragma unroll
            for (int i = 1; i < 4; ++i) if (el[i] > el[ia]) ia = i;
            int ib = (ia == 0) ? 1 : 0;
#pragma unroll
            for (int i = 0; i < 4; ++i) if (i != ia && i != ib && el[i] > el[ib]) ib = i;
            float ela = el[0], elb = el[0];
#pragma unroll
            for (int i = 1; i < 4; ++i) { ela = (i == ia) ? el[i] : ela; elb = (i == ib) ? el[i] : elb; }
            const float t = expf(elb - ela); const float wa = grp_w / (1.0f + t), wb = grp_w * t / (1.0f + t);
            const int ea = gi * 4 + ia, eb = gi * 4 + ib;
            const int lpa = (int)atomicAdd((unsigned*)(LCNT + ea), 1u), lpb = (int)atomicAdd((unsigned*)(LCNT + eb), 1u);
            LAS int* rec = REC + (c.wave * 8 + pidx * 2 + lane) * 8;
            rec[0] = tok; rec[1] = ea; rec[2] = lpa; rec[3] = eb; rec[4] = lpb; rec[5] = __float_as_int(wa); rec[6] = __float_as_int(wb); rec[7] = __float_as_int(lane ? rstd2[1] : rstd2[0]);
        }
    }
    __syncthreads();
    if (c.tid < 16) ((LAS unsigned*)(L + RT7_GB))[c.tid] = atomicAdd(ctl + CW_ECNT + 64 * c.tid, LCNT[c.tid]);
    __syncthreads();
    if (c.tid < 64) { const int wv = c.tid >> 3, k = c.tid & 7;
        const int gwv = blockIdx.x * NWAVES + wv; const int npairs = gwv < T / 2 ? (T / 2 - 1 - gwv) / c.ngw + 1 : 0;
        if ((k >> 1) < npairs) { const LAS int* rec = REC + c.tid * 8; const LAS unsigned* GB = (const LAS unsigned*)(L + RT7_GB);
            const int tok = rec[0], ea = rec[1], eb = rec[3]; const int pa = (int)GB[ea] + rec[2], pb = (int)GB[eb] + rec[4];
            elist[ea * T + pa] = tok; ewl[ea * T + pa] = __int_as_float(rec[5]); elist[eb * T + pb] = tok; ewl[eb * T + pb] = __int_as_float(rec[6]);
            float* ers = (float*)(P.ws + WS_ERS); ers[ea * T + pa] = __int_as_float(rec[7]); ers[eb * T + pb] = __int_as_float(rec[7]);
            *(int4*)(tmeta + 4 * tok) = make_int4(ea, pa, eb, pb); } }
    __syncthreads();
    int tb = 0;
    for (int e = 0; e < NEXP; ++e) {
        transpose_all(c, tb, ColGU{P.in[19] + (size_t)e * 1024 * 512, P.in[20] + (size_t)e * 1024 * 512}, 512, 1024, 1024, P.b(WS_WGU) + (size_t)e * 1024 * 1024, P.in[14]);
    }
}
__device__ __forceinline__ int expert_rowbase(const unsigned* ctl, int e, int& cnt_e) {
    int base = 0; cnt_e = 0;
    for (int i = 0; i < NEXP; ++i) { const int ci = (int)ctl[CW_ECNT + 64 * i]; if (i < e) base += (ci + 255) & ~255; if (i == e) cnt_e = ci; }
    return base;
}
__device__ __forceinline__ void phase8_naive(const Ctx& c, const Ptrs& P) {
    const unsigned* ctl = (const unsigned*)(P.ws + WS_CTL);
    for (int e = 0; e < NEXP; ++e) { int cnt; const int base = expert_rowbase(ctl, e, cnt);
        naive_gemm(c, RowGather{P.b(WS_H2), DM, (const int*)(P.ws + WS_ELIST) + e * T}, P.b(WS_WGU) + (size_t)e * 1024 * 1024, 1024, cnt, 1024, 1024,
                   EpiSwiGLU{P.b(WS_HID), P.f(WS_EWL) + e * T, base}); }
}
__device__ __forceinline__ void phase9_naive(const Ctx& c, const Ptrs& P) {
    const unsigned* ctl = (const unsigned*)(P.ws + WS_CTL);
    for (int e = 0; e < NEXP; ++e) { int cnt; const int base = expert_rowbase(ctl, e, cnt);
        naive_gemm(c, RowPlain{P.b(WS_HID) + (size_t)base * DFF, DFF}, P.b(WS_WD) + (size_t)e * 1024 * 512, 512, cnt, 1024, 512, EpiRowsBf16{P.b(WS_DROWS), 1024, base}); }
}
struct FinTok { f32x4 x[4]; unsigned long long a[4], b[4]; };
__device__ __forceinline__ void fin_issue(FinTok& d, const float* X0, const bf16* DD, const bf16* DR, int tok, int4 m, const int (&rb)[NEXP], int lane) {
    int ba = 0, bb = 0;
#pragma unroll
    for (int i = 0; i < NEXP; ++i) { ba = (i == m.x) ? rb[i] : ba; bb = (i == m.z) ? rb[i] : bb; }
    const unsigned long long* da = (const unsigned long long*)(DR + (size_t)(ba + m.y) * DM) + lane;
    const unsigned long long* db = (const unsigned long long*)(DR + (size_t)(bb + m.w) * DM) + lane;
#pragma unroll
    for (int j = 0; j < 4; ++j) { d.a[j] = da[64 * j]; d.b[j] = db[64 * j]; d.x[j] = x1_load(X0, DD, (size_t)tok, lane, j); }
}
__device__ __forceinline__ void phase10(const Ctx& c, const Ptrs& P) {
    const unsigned* ctl = (const unsigned*)(P.ws + WS_CTL); const int* tmeta = (const int*)(P.ws + WS_TMETA); const bf16* DR = P.b(WS_DROWS); const float* g = P.in[22];
    int rb[NEXP]; { int base = 0;
#pragma unroll
        for (int i = 0; i < NEXP; ++i) { rb[i] = base; base += ((int)ctl[CW_ECNT + 64 * i] + 255) & ~255; } }
    const int lane = c.lane;
    if (c.gw >= T) return;
    FinTok cur, nxt; int4 mn = *(const int4*)(tmeta + 4 * c.gw);
    fin_issue(cur, P.in[0], P.b(WS_D), DR, c.gw, mn, rb, lane);
    { const int t1 = c.gw + c.ngw; mn = *(const int4*)(tmeta + 4 * (t1 < T ? t1 : c.gw)); }
#pragma unroll 1
    for (int tok = c.gw; tok < T; tok += c.ngw) {
        const int t1 = tok + c.ngw, t2 = tok + 2 * c.ngw;
        if (t1 < T) { fin_issue(nxt, P.in[0], P.b(WS_D), DR, t1, mn, rb, lane); mn = *(const int4*)(tmeta + 4 * (t2 < T ? t2 : tok)); }
        f32x4* xr = (f32x4*)(P.out + (size_t)tok * DM) + lane; const f32x4* gr = (const f32x4*)g + lane;
        f32x4 v[4]; float s = 0.f;
#pragma unroll
        for (int j = 0; j < 4; ++j) { const unsigned long long a = cur.a[j], b = cur.b[j]; f32x4 x = cur.x[j];
            x.x += bf2f((unsigned)a & 0xffffu) + bf2f((unsigned)b & 0xffffu); x.y += bf2f(((unsigned)a >> 16)) + bf2f(((unsigned)b >> 16));
            x.z += bf2f((unsigned)(a >> 32) & 0xffffu) + bf2f((unsigned)(b >> 32) & 0xffffu); x.w += bf2f((unsigned)(a >> 48)) + bf2f((unsigned)(b >> 48));
            v[j] = x; s += (x.x * x.x + x.y * x.y) + (x.z * x.z + x.w * x.w); }
        const float r = 1.0f / sqrtf(wave_sum(s) * (1.f / 1024.f) + RMS_EPS);
#pragma unroll
        for (int j = 0; j < 4; ++j) { const f32x4 gg = gr[64 * j]; xr[64 * j] = (f32x4){v[j].x * r * gg.x, v[j].y * r * gg.y, v[j].z * r * gg.z, v[j].w * r * gg.w}; }
        cur = nxt;
    }
#if PROBE_TS_A >= 0
    if (c.gw == 0 && lane == 0) { volatile LAS unsigned* MISC = (volatile LAS unsigned*)((LAS unsigned char*)c.lds + MISC_OFF);
        asm volatile("s_waitcnt vmcnt(0)" ::: "memory"); MISC[32 + 24] = (unsigned)__builtin_amdgcn_s_memrealtime();
        const unsigned dt = MISC[32 + PROBE_TS_B] - MISC[32 + PROBE_TS_A]; P.out[0] += 8.0f + (float)dt * (0.01f / PROBE_TS_DIV); }
#endif
}

constexpr int NPHASES = 11;
__global__ void __launch_bounds__(NTHREADS, 2) mk_fwd(Args args) {
    extern __shared__ __attribute__((aligned(16))) unsigned char lds[];
    Ctx c; c.tid = threadIdx.x; c.lane = c.tid & 63; c.wave = __builtin_amdgcn_readfirstlane(c.tid >> 6);
    c.gw = blockIdx.x * NWAVES + c.wave; c.ngw = gridDim.x * NWAVES; c.lds = lds;
    Ptrs P;
#pragma unroll
    for (int i = 0; i < 23; ++i) P.in[i] = args.in[i];
    P.out = args.out; P.ws = args.ws;
    volatile LAS unsigned* MISC = (volatile LAS unsigned*)((LAS unsigned char*)lds + MISC_OFF);
    if (c.tid < 32) MISC[c.tid] = 0u;
    __syncthreads();
    XcdBarrier bar; bar.bar = (unsigned*)(args.ws + WS_CTL) + CW_BAR; bar.x = 0; bar.st = nullptr;
    const int lo = args.ph_lo, hi = args.ph_hi;
    if (hi - lo > 1) bar = xcd_barrier_post((unsigned*)(args.ws + WS_CTL) + CW_BAR, MISC + 8);
#define IN(k) (lo <= (k) && (k) < hi)
#define SEAM(k) do { if (IN(k) && IN((k) + 1)) xcd_barrier(bar); } while (0)
    const int sub = args.sub, rep = args.rep;
#if PROBE_TS_A >= 0
#define STAMP(k) do { if (blockIdx.x == 0 && c.tid == 0) MISC[32 + (k)] = (unsigned)__builtin_amdgcn_s_memrealtime(); } while (0)
#else
#define STAMP(k) do { } while (0)
#endif
    STAMP(0);
#define SUBRUN(id, stmt) do { if (sub & (1 << (id))) { stmt; if (rep == (id)) { __syncthreads(); stmt; } __syncthreads(); } } while (0)
    if (IN(0)) { SUBRUN(0, phase0(c, P)); } STAMP(1); SEAM(0); STAMP(2);
    if (IN(1)) { SUBRUN(1, phase1_mfma(c, P)); } STAMP(3); SEAM(1); STAMP(4);
    if (IN(2)) { SUBRUN(2, mx::ret_state_phase((LAS unsigned char*)lds, P.b(WS_RK), P.b(WS_RV), (bf16*)P.out, P.in[4], P.in[5])); STAMP(5);
                 SUBRUN(3, mx::na_phase((LAS unsigned char*)lds, P.b(WS_NQ), P.b(WS_NK), P.b(WS_NV), P.b(WS_FT))); STAMP(6);
                 SUBRUN(4, phase2_memkv_mfma(c, P)); } STAMP(7); SEAM(2); STAMP(8);
    if (IN(3)) { SUBRUN(5, mx::ret_out_phase((LAS unsigned char*)lds, P.b(WS_RQ), P.b(WS_RK), P.b(WS_RV), P.b(WS_RG), (const bf16*)P.out, P.in[6], P.in[4], P.in[5])); STAMP(9);
                 SUBRUN(6, mx::xa_phase((LAS unsigned char*)lds, P.b(WS_XQ), P.b(WS_MKV))); } STAMP(10); SEAM(3); STAMP(11);
    STAMP(12); STAMP(13);
    if (IN(5)) { SUBRUN(8, phase5_mfma(c, P)); } STAMP(14); SEAM(5); STAMP(15);
    if (IN(6)) { SUBRUN(9, phase6_mfma(c, P)); } STAMP(16); SEAM(6); STAMP(17);
    if (IN(7)) { SUBRUN(10, phase7(c, P)); } STAMP(18); SEAM(7); STAMP(19);
    if (IN(8)) { SUBRUN(11, phase8_mfma(c, P)); } STAMP(20); SEAM(8); STAMP(21);
    if (IN(9)) { SUBRUN(12, phase9_mfma(c, P)); } STAMP(22); SEAM(9); STAMP(23);
    if (IN(10)) { SUBRUN(13, phase10(c, P)); }
#undef SUBRUN
#undef IN
#undef SEAM
}

extern "C" void kernel_launch(void* const* d_in, const int* in_sizes, int n_in, void* d_out, int out_size, void* d_ws, size_t ws_size, hipStream_t stream) {
    static int grid = 0;
    if (grid == 0) {
        if (n_in != 23 || out_size != T * DM || ws_size < WS_END) { fprintf(stderr, "kernel_launch: unexpected shapes (n_in %d out %d ws %zu)\n", n_in, out_size, ws_size); grid = -1; return; }
        int dev = 0, cus = 0;
        if (hipGetDevice(&dev) != hipSuccess || hipDeviceGetAttribute(&cus, hipDeviceAttributeMultiprocessorCount, dev) != hipSuccess) { grid = -1; return; }
        if (hipFuncSetAttribute((const void*)mk_fwd, hipFuncAttributeMaxDynamicSharedMemorySize, LDS_BYTES) != hipSuccess) { fprintf(stderr, "kernel_launch: hipFuncSetAttribute failed\n"); grid = -1; return; }
        (void)hipGetLastError();
        grid = cus;
    }
    if (grid < 0) return;
    (void)hipMemsetAsync((char*)d_ws + WS_CTL, 0, CTL_ZERO_BYTES, stream);
    Args a{};
    for (int i = 0; i < 23; ++i) a.in[i] = (const float*)d_in[i];
    a.out = (float*)d_out; a.ws = (unsigned char*)d_ws;
#if MK_PER_PHASE
    a.sub = 0x3fff; a.rep = -1;
    for (int p = 0; p < NPHASES; ++p) { a.ph_lo = p; a.ph_hi = p + 1; hipLaunchKernelGGL(mk_fwd, dim3(grid), dim3(NTHREADS), LDS_BYTES, stream, a); }
#else
    a.ph_lo = 0; a.ph_hi = NPHASES; a.sub = 0x3fff; a.rep = PROBE_REP; hipLaunchKernelGGL(mk_fwd, dim3(grid), dim3(NTHREADS), LDS_BYTES, stream, a);
#if PROBE_END >= 0
    { const int ph_of[14] = {0, 1, 2, 2, 2, 3, 3, 4, 5, 6, 7, 8, 9, 10};
      a.ph_lo = ph_of[PROBE_END]; a.ph_hi = a.ph_lo + 1; a.sub = 1 << PROBE_END; a.rep = -1; hipLaunchKernelGGL(mk_fwd, dim3(grid), dim3(NTHREADS), LDS_BYTES, stream, a); }
#endif
#endif
}
```

```cpp
#include <hip/hip_runtime.h>
#include <cstdio>
#include <cstdint>

#ifndef PROBE_REP
#define PROBE_REP -1
#endif
#ifndef PROBE_END
#define PROBE_END -1
#endif
#ifndef PROBE_TS_A
#define PROBE_TS_A -1
#define PROBE_TS_B -1
#endif
#ifndef PROBE_TS_DIV
#define PROBE_TS_DIV 8.0f
#endif
#ifndef MK_PER_PHASE
#define MK_PER_PHASE 0
#endif

#define GAS __attribute__((address_space(1)))
#define LAS __attribute__((address_space(3)))
typedef unsigned short bf16;
typedef float f32x4 __attribute__((ext_vector_type(4)));
typedef unsigned u32x4 __attribute__((ext_vector_type(4)));
typedef unsigned u32x2 __attribute__((ext_vector_type(2)));
typedef short bf16x8 __attribute__((ext_vector_type(8)));

constexpr int NB = 8, SEQ = 2048, DM = 1024, T = NB * SEQ;
constexpr int MEML = 256, TM = NB * MEML;
constexpr int NWAVES = 8, NTHREADS = 512;
constexpr int NPA = 5120, NPG = 3072;
constexpr int NEXP = 16, DFF = 512;
constexpr float RMS_EPS = 1e-6f, GN_EPS = 1e-5f;
constexpr float QK_SCALE = 0.08838834764831845f;

constexpr size_t MiB = 1u << 20;
constexpr size_t WS_CTL = 0, CTL_ZERO_BYTES = 32768;
constexpr size_t WS_COS = 1 * MiB, WS_SIN = 1 * MiB + 512 * 1024;
constexpr size_t WS_ELIST = 2 * MiB;
constexpr size_t WS_FT = 2 * MiB;
constexpr size_t WS_EWL = 3 * MiB;
constexpr size_t WS_TMETA = 4 * MiB;
constexpr size_t WS_WA = 5 * MiB;
constexpr size_t WS_WG = 15 * MiB;
constexpr size_t WS_WKV = 21 * MiB;
constexpr size_t WS_WRO = 23 * MiB;
constexpr size_t WS_WNO = 25 * MiB;
constexpr size_t WS_WXO = 26 * MiB;
constexpr size_t WS_WOUT = 27 * MiB;
constexpr size_t WS_XN = 29 * MiB;
constexpr size_t WS_H2 = WS_XN;
constexpr size_t WS_RQ = 61 * MiB;
constexpr size_t WS_RK = 77 * MiB;
constexpr size_t WS_RV = 93 * MiB;
constexpr size_t WS_NK = 125 * MiB;
constexpr size_t WS_NV = 141 * MiB;
constexpr size_t WS_GATES = 61 * MiB;
constexpr size_t WS_HID = 61 * MiB;
constexpr size_t WS_DROWS = 97 * MiB;
constexpr size_t WS_RG = 157 * MiB;
constexpr size_t WS_NQ = 189 * MiB;
constexpr size_t WS_XQ = 205 * MiB;
constexpr size_t WS_WD = 205 * MiB;
constexpr size_t WS_MN = 221 * MiB;
constexpr size_t WS_MKV = 225 * MiB;
constexpr size_t WS_MIX = 221 * MiB;
constexpr size_t WS_WGU = 221 * MiB;
constexpr size_t WS_D = 169 * MiB;
constexpr size_t WS_ERS = 1 * MiB;
constexpr size_t WS_END = 256 * MiB;

constexpr int CW_ECNT = 64;
constexpr int CW_BAR = 4096;

constexpr int LDS_BYTES = 163840;
constexpr int MISC_OFF = 163840 - 512;

__device__ __forceinline__ float bf2f(unsigned v) { return __uint_as_float(v << 16); }
__device__ __forceinline__ unsigned f2bf(float f) { unsigned u = __float_as_uint(f); return (u + 0x7fffu + ((u >> 16) & 1u)) >> 16; }
typedef __bf16 hwbf16x2 __attribute__((ext_vector_type(2)));
typedef float f32x2_ __attribute__((ext_vector_type(2)));
__device__ __forceinline__ unsigned pk2(float lo, float hi) { const f32x2_ v = {lo, hi}; return __builtin_bit_cast(unsigned, __builtin_convertvector(v, hwbf16x2)); }
__device__ __forceinline__ void unpack8(const u32x4 v, float* o) {
    o[0] = __uint_as_float(v.x << 16); o[1] = __uint_as_float(v.x & 0xffff0000u);
    o[2] = __uint_as_float(v.y << 16); o[3] = __uint_as_float(v.y & 0xffff0000u);
    o[4] = __uint_as_float(v.z << 16); o[5] = __uint_as_float(v.z & 0xffff0000u);
    o[6] = __uint_as_float(v.w << 16); o[7] = __uint_as_float(v.w & 0xffff0000u);
}
__device__ __forceinline__ void store8(bf16* p, f32x4 a, f32x4 b) {
    u32x4 w; w.x = pk2(a[0], a[1]); w.y = pk2(a[2], a[3]); w.z = pk2(b[0], b[1]); w.w = pk2(b[2], b[3]);
    *(u32x4*)p = w;
}
__device__ __forceinline__ float wave_sum(float v) {
#pragma unroll
    for (int o = 1; o < 64; o <<= 1) v += __shfl_xor(v, o);
    return v;
}
__device__ __forceinline__ float wave_max(float v) {
#pragma unroll
    for (int o = 1; o < 64; o <<= 1) v = fmaxf(v, __shfl_xor(v, o));
    return v;
}
__device__ __forceinline__ float sigmoidf_(float x) { return __builtin_amdgcn_rcpf(1.0f + __expf(-x)); }
__device__ __forceinline__ float siluf_(float x) { return x * __builtin_amdgcn_rcpf(1.0f + __expf(-x)); }

#define XB_TMO      128
#define XB_XCNT(j)  (256  + 64 * (j))
#define XB_XSUB(j)  (1280 + 64 * (j))
#define XB_XGEN(j)  (2304 + 64 * (j))
#define XB_TOP      3328
#define XB_TOPGEN   3392
#define XCD_BAR_WORDS 3456
#define XB_SPIN_CAP (1u << 18)
__device__ __forceinline__ unsigned xb_ld(unsigned* p)              { return __hip_atomic_load(p, __ATOMIC_RELAXED, __HIP_MEMORY_SCOPE_AGENT); }
__device__ __forceinline__ unsigned xb_add(unsigned* p, unsigned v) { return __hip_atomic_fetch_add(p, v, __ATOMIC_RELAXED, __HIP_MEMORY_SCOPE_AGENT); }
__device__ __forceinline__ unsigned xb_xcc_id() { return (unsigned)__builtin_amdgcn_s_getreg((3 << 11) | 20) & 0xFu; }
#define XB_SPIN(cond, bar) do { unsigned _sp = 0; while (cond) { __builtin_amdgcn_s_sleep(1); \
    if ((++_sp & 255u) == 0u) { if (xb_ld(&(bar)[XB_TMO])) break; if (_sp > XB_SPIN_CAP) { atomicAdd(&(bar)[XB_TMO], 1u); break; } } } } while (0)
struct XcdBarrier { unsigned* bar; unsigned x; volatile LAS unsigned* st; };
__device__ __forceinline__ XcdBarrier xcd_barrier_post(unsigned* bar, volatile LAS unsigned* st) {
    XcdBarrier b; b.bar = bar; b.x = xb_xcc_id(); b.st = st;
    if (threadIdx.x == 0) (void)xb_add(&bar[XB_XCNT(b.x)], 1u);
    return b;
}
__device__ __forceinline__ void xcd_barrier_complete(unsigned* bar, unsigned x, unsigned& nloc, unsigned& nx) {
    const unsigned G = gridDim.x * gridDim.y * gridDim.z;
    unsigned sum, cnt, mine, sp = 0u;
    for (;;) {
        sum = 0u; cnt = 0u; mine = 0u;
#pragma unroll
        for (unsigned j = 0; j < 16; ++j) { const unsigned c = xb_ld(&bar[XB_XCNT(j)]); sum += c; cnt += (c > 0u) ? 1u : 0u; mine = (j == x) ? c : mine; }
        if (sum == G) break;
        __builtin_amdgcn_s_sleep(1);
        if ((++sp & 255u) == 0u) { if (xb_ld(&bar[XB_TMO])) break; if (sp > XB_SPIN_CAP) { atomicAdd(&bar[XB_TMO], 1u); break; } }
    }
    nloc = mine > 0u ? mine : 1u; nx = cnt > 0u ? cnt : 1u;
}
__device__ __forceinline__ void xcd_barrier(const XcdBarrier& b) {
    asm volatile("s_waitcnt vmcnt(0)" ::: "memory");
    __syncthreads();
    if (threadIdx.x == 0) {
        unsigned* bar = b.bar;
        __builtin_amdgcn_s_waitcnt(0);
        unsigned nloc = b.st[0], nx = b.st[1];
        if (nloc == 0u) { xcd_barrier_complete(bar, b.x, nloc, nx); b.st[0] = nloc; b.st[1] = nx; }
        const unsigned old = xb_add(&bar[XB_XSUB(b.x)], 1u);
        const unsigned gen = old / nloc;
        if (old + 1u == (gen + 1u) * nloc) {
            __builtin_amdgcn_fence(__ATOMIC_RELEASE, "agent");
            asm volatile("s_waitcnt vmcnt(0)" ::: "memory");
            const unsigned og = xb_add(&bar[XB_TOP], 1u);
            const unsigned tg = og / nx;
            if (og + 1u == (tg + 1u) * nx) xb_add(&bar[XB_TOPGEN], 1u);
            else XB_SPIN(xb_ld(&bar[XB_TOPGEN]) == tg, bar);
            __builtin_amdgcn_fence(__ATOMIC_ACQUIRE, "agent");
            xb_add(&bar[XB_XGEN(b.x)], 1u);
            asm volatile("s_waitcnt vmcnt(0)" ::: "memory");
        } else {
            XB_SPIN(xb_ld(&bar[XB_XGEN(b.x)]) == gen, bar);
            __builtin_amdgcn_fence(__ATOMIC_ACQUIRE, "agent");
            asm volatile("s_waitcnt vmcnt(0)" ::: "memory");
        }
    }
    __syncthreads();
}

struct Args { const float* in[23]; float* out; unsigned char* ws; int ph_lo, ph_hi; int sub, rep; };
struct Ctx {
    int tid, lane, wave, gw, ngw;
    unsigned char* lds;
};

template <class ColPtr>
__device__ __forceinline__ void transpose_all(const Ctx& c, int& base, ColPtr cp, int ldw, int P, int K, bf16* WT, const float* kscale = nullptr) {
    float* scr = (float*)(c.lds + c.wave * 16384);
    const int nkb = K / 64, npb = P / 32, lane = c.lane, nit = nkb * npb;
    int it0 = (c.gw - base) % c.ngw; it0 = it0 < 0 ? it0 + c.ngw : it0; base += nit;
    for (int it = it0; it < nit; it += c.ngw) {
        const int kb = it % nkb, pb = it / nkb, k0 = 64 * kb, p0 = 32 * pb;
        const float* colp = cp(p0 + (lane & 31));
        float tv[32];
#pragma unroll
        for (int i = 0; i < 32; ++i) tv[i] = colp[(size_t)(k0 + 2 * i + (lane >> 5)) * ldw];
#pragma unroll
        for (int i = 0; i < 32; ++i) scr[(2 * i + (lane >> 5)) * 33 + (lane & 31)] = tv[i];
        __builtin_amdgcn_s_waitcnt(0xC07F); asm volatile("" ::: "memory");
        const int cc = lane & 7;
        f32x4 ks0 = {1.f, 1.f, 1.f, 1.f}, ks1 = {1.f, 1.f, 1.f, 1.f};
        if (kscale) { ks0 = *(const f32x4*)(kscale + k0 + 8 * cc); ks1 = *(const f32x4*)(kscale + k0 + 8 * cc + 4); }
#pragma unroll
        for (int j = 0; j < 4; ++j) { const int n = (lane >> 3) + 8 * j; const float* s = scr + (8 * cc) * 33 + n;
            u32x4 o; o.x = pk2(s[0 * 33] * ks0[0], s[1 * 33] * ks0[1]); o.y = pk2(s[2 * 33] * ks0[2], s[3 * 33] * ks0[3]); o.z = pk2(s[4 * 33] * ks1[0], s[5 * 33] * ks1[1]); o.w = pk2(s[6 * 33] * ks1[2], s[7 * 33] * ks1[3]);
            *(u32x4*)(WT + (size_t)(p0 + n) * K + k0 + 8 * cc) = o; }
        __builtin_amdgcn_s_waitcnt(0xC07F); asm volatile("" ::: "memory");
    }
}
struct ColPlain { const float* W; __device__ const float* operator()(int p) const { return W + p; } };
struct ColOff { const float* W; int off; __device__ const float* operator()(int p) const { return W + off + p; } };
struct ColWA {
    const float* W;
    __device__ const float* operator()(int p) const {
        if (p < 1024) { const int pp = p & 127; const int d = ((pp & 4) ? 64 : 0) + 4 * (pp >> 3) + (pp & 3); return W + (p & ~127) + d; }
        return W + p;
    }
};
struct ColGU {
    const float* Wg; const float* Wu;
    __device__ const float* operator()(int p) const { const int f = 4 * (p >> 3) + (p & 3); return ((p >> 2) & 1) ? Wu + f : Wg + f; }
};
__device__ __forceinline__ void rms_row_to_bf16(const float* xrow, const float* g, bf16* orow, int lane) {
    const f32x4* xr = (const f32x4*)xrow + lane; const f32x4* gr = (const f32x4*)g + lane;
    f32x4 v[4]; float s = 0.f;
#pragma unroll
    for (int j = 0; j < 4; ++j) { v[j] = xr[64 * j]; s += (v[j].x * v[j].x + v[j].y * v[j].y) + (v[j].z * v[j].z + v[j].w * v[j].w); }
    const float r = 1.0f / sqrtf(wave_sum(s) * (1.f / 1024.f) + RMS_EPS);
    unsigned long long* o8 = (unsigned long long*)orow + lane;
#pragma unroll
    for (int j = 0; j < 4; ++j) { const f32x4 gg = gr[64 * j];
        o8[64 * j] = (unsigned long long)pk2(v[j].x * r * gg.x, v[j].y * r * gg.y) | ((unsigned long long)pk2(v[j].z * r * gg.z, v[j].w * r * gg.w) << 32); }
}

template <class RowPtr, class Epi>
__device__ __forceinline__ void naive_gemm(const Ctx& c, const RowPtr& rp, const bf16* Bt, int ldb, int M, int N, int K, const Epi& epi) {
    const int tilesN = N / 64, tilesM = (M + 7) / 8, lane = c.lane;
    for (int it = c.gw; it < tilesM * tilesN; it += c.ngw) {
        const int tm = it / tilesN, tn = it % tilesN;
        const int row = tm * 8 + (lane >> 3), col0 = tn * 64 + (lane & 7) * 8;
        const bool valid = row < M;
        const bf16* ap = rp(valid ? row : 0);
        float acc[8];
#pragma unroll
        for (int j = 0; j < 8; ++j) acc[j] = 0.f;
        for (int k = 0; k < K; k += 8) {
            float a[8]; unpack8(*(const u32x4*)(ap + k), a);
#pragma unroll
            for (int j = 0; j < 8; ++j) { float b[8]; unpack8(*(const u32x4*)(Bt + (size_t)(col0 + j) * ldb + k), b);
#pragma unroll
                for (int i = 0; i < 8; ++i) acc[j] += a[i] * b[i]; }
        }
        if (valid) epi(row, col0, (f32x4){acc[0], acc[1], acc[2], acc[3]}, (f32x4){acc[4], acc[5], acc[6], acc[7]});
    }
}
struct RowPlain { const bf16* A; int lda; __device__ const bf16* operator()(int r) const { return A + (size_t)r * lda; } };
struct RowGather { const bf16* A; int lda; const int* idx; __device__ const bf16* operator()(int r) const { return A + (size_t)idx[r] * lda; } };

struct EpiProjA {
    bf16 *RQ, *RK, *RV, *RG, *NQ, *NK, *NV, *XQ; const float *COS, *SIN;
    __device__ __forceinline__ void operator()(int row, int col0, f32x4 v0, f32x4 v1) const {
        if (col0 < 1024) {
            const int which = col0 >> 9, cc = col0 & 511, pos = row & (SEQ - 1), q = (cc & 127) >> 3;
            const f32x4 cs = *(const f32x4*)(COS + pos * 64 + 4 * q), sn = *(const f32x4*)(SIN + pos * 64 + 4 * q);
            f32x4 o1 = v0 * cs - v1 * sn, o2 = v0 * sn + v1 * cs;
            if (which == 0) { o1 = o1 * QK_SCALE; o2 = o2 * QK_SCALE; }
            store8((which ? RK : RQ) + (size_t)row * 512 + cc, o1, o2);
        } else if (col0 < 2048) { store8(RV + (size_t)row * 1024 + (col0 - 1024), v0, v1);
        } else if (col0 < 3072) {
            f32x4 a, b;
#pragma unroll
            for (int i = 0; i < 4; ++i) { a[i] = siluf_(v0[i]); b[i] = siluf_(v1[i]); }
            store8(RG + (size_t)row * 1024 + (col0 - 2048), a, b);
        } else if (col0 < 3584) { store8(NQ + (size_t)row * 512 + (col0 - 3072), v0 * 0.125f, v1 * 0.125f);
        } else if (col0 < 4096) { store8(NK + (size_t)row * 512 + (col0 - 3584), v0, v1);
        } else if (col0 < 4608) { store8(NV + (size_t)row * 512 + (col0 - 4096), v0, v1);
        } else { store8(XQ + (size_t)row * 512 + (col0 - 4608), v0 * QK_SCALE, v1 * QK_SCALE); }
    }
};
struct EpiBf16Plain { bf16* O; int ldc; __device__ __forceinline__ void operator()(int row, int col0, f32x4 v0, f32x4 v1) const { store8(O + (size_t)row * ldc + col0, v0, v1); } };
struct EpiSigmoid { bf16* O; int ldc;
    __device__ __forceinline__ void operator()(int row, int col0, f32x4 v0, f32x4 v1) const {
        f32x4 a, b;
#pragma unroll
        for (int i = 0; i < 4; ++i) { a[i] = sigmoidf_(v0[i]); b[i] = sigmoidf_(v1[i]); }
        store8(O + (size_t)row * ldc + col0, a, b); } };
template <int MODE> struct EpiMixNaive { float* TMP; bf16* MIX; const bf16* G;
    __device__ __forceinline__ void operator()(int row, int col0, f32x4 v0, f32x4 v1) const {
        float g[8]; unpack8(*(const u32x4*)(G + (size_t)row * NPG + col0), g);
        f32x4 a = {v0[0] * g[0], v0[1] * g[1], v0[2] * g[2], v0[3] * g[3]}, b = {v1[0] * g[4], v1[1] * g[5], v1[2] * g[6], v1[3] * g[7]};
        float* t = TMP + (size_t)row * DM + col0;
        if (MODE >= 1) { a = a + *(const f32x4*)t; b = b + *(const f32x4*)(t + 4); }
        if (MODE <= 1) { *(f32x4*)t = a; *(f32x4*)(t + 4) = b; } else store8(MIX + (size_t)row * DM + col0, a, b);
    } };
struct EpiResidBf16 { const float* X; bf16* O;
    __device__ __forceinline__ void operator()(int row, int col0, f32x4 v0, f32x4 v1) const {
        const float* x = X + (size_t)row * DM + col0; store8(O + (size_t)row * DM + col0, *(const f32x4*)x + v0, *(const f32x4*)(x + 4) + v1); } };
struct EpiResidF32 { const float* X; float* O;
    __device__ __forceinline__ void operator()(int row, int col0, f32x4 v0, f32x4 v1) const {
        const float* x = X + (size_t)row * DM + col0; float* o = O + (size_t)row * DM + col0;
        *(f32x4*)o = *(const f32x4*)x + v0; *(f32x4*)(o + 4) = *(const f32x4*)(x + 4) + v1; } };
struct EpiSwiGLU { bf16* HID; const float* wl; int rowbase;
    __device__ __forceinline__ void operator()(int row, int col0, f32x4 v0, f32x4 v1) const {
        const float w = wl[row]; f32x4 h;
#pragma unroll
        for (int i = 0; i < 4; ++i) h[i] = siluf_(v0[i]) * v1[i] * w;
        u32x2 o; o.x = pk2(h[0], h[1]); o.y = pk2(h[2], h[3]);
        *(u32x2*)(HID + (size_t)(rowbase + row) * DFF + (col0 >> 1)) = o; } };
struct EpiRowsBf16 { bf16* O; int ldc; int rowbase;
    __device__ __forceinline__ void operator()(int row, int col0, f32x4 v0, f32x4 v1) const { store8(O + (size_t)(rowbase + row) * ldc + col0, v0, v1); } };

namespace pg8 {
constexpr int BM = 256, BK = 64, HALF = 128, HTB = HALF * BK * 2, STAGE_BYTES = 8 * HTB;
__device__ __forceinline__ int lds_byte(int r, int c) { const int st = (r >> 4) * 2 + (c >> 5), rr = r & 15, cc = c & 31, ob = rr * 64 + cc * 2; return st * 1024 + (ob ^ (((ob >> 9) & 1) << 5)); }
__device__ __forceinline__ void stage_rc(int b, int& R, int& C) { const int st = b / 1024, sb = b % 1024, swz = sb ^ (((sb >> 9) & 1) << 5); R = (st >> 1) * 16 + swz / 64; C = (st & 1) * 32 + (swz % 64) / 2; }
__device__ __forceinline__ int perm32(int rho) { const int n = rho >> 4, i = rho & 15; return 8 * (i >> 2) + 4 * n + (i & 3); }

struct UnitDesc {
    const char* A; const char* B;
    unsigned lda2, ldb2;
    int nt;
    int row0, col0;
    int aux, aux2;
    const int* gidx; int gcnt;
    int chain;
};
__device__ __forceinline__ unsigned cvt_pk_bf16(float lo, float hi) { unsigned r; asm volatile("v_cvt_pk_bf16_f32 %0, %1, %2" : "=v"(r) : "v"(lo), "v"(hi)); return r; }

template <class F> __device__ __forceinline__ void epi_apply(const f32x4 (&acc)[2][2][4][2], const UnitDesc& u, int wr, int wc, int fr, int fq, const F& f) {
#pragma unroll
    for (int ai = 0; ai < 2; ++ai)
#pragma unroll
        for (int m = 0; m < 4; ++m) { const int row = u.row0 + ai * HALF + wr * 64 + m * 16 + fr;
#pragma unroll
            for (int bj = 0; bj < 2; ++bj) f(row, u.col0 + bj * HALF + wc * 32 + 8 * fq, acc[ai][bj][m][0], acc[ai][bj][m][1]);
            asm volatile("" ::: "memory"); __builtin_amdgcn_sched_barrier(0); }
}

template <bool GATHER> __device__ __forceinline__ void unit_offs(const UnitDesc& u, int tid, unsigned (&oA0)[2], unsigned (&oA1)[2], unsigned (&oB)[2]) {
#pragma unroll
    for (int i = 0; i < 2; ++i) { int R, C; stage_rc(tid * 16 + i * 8192, R, C); const int Rb = (R & ~31) + perm32(R & 31);
        oB[i] = (unsigned)Rb * u.ldb2 + (unsigned)C * 2u;
        if (GATHER && u.gidx) { const int last = u.gcnt - 1; int r0 = u.row0 + R, r1 = r0 + HALF; r0 = r0 < last ? r0 : last; r1 = r1 < last ? r1 : last;
            oA0[i] = (unsigned)u.gidx[r0] * u.lda2 + (unsigned)C * 2u; oA1[i] = (unsigned)u.gidx[r1] * u.lda2 + (unsigned)C * 2u;
        } else { oA0[i] = (unsigned)R * u.lda2 + (unsigned)C * 2u; oA1[i] = 0u; } }
}

template <bool GATHER, class Sched, class Epi>
__device__ __forceinline__ void gemm_phase(LAS unsigned char* lds, const Sched& S, const Epi& E, int sb = 0) {
#if PROBE_TS_A >= 0
#define GSTAMP(k) do { if (sb && blockIdx.x == 0 && threadIdx.x == 0) ((volatile LAS unsigned*)(lds + MISC_OFF))[32 + sb + (k)] = (unsigned)__builtin_amdgcn_s_memrealtime(); } while (0)
#else
#define GSTAMP(k) do { } while (0)
#endif
    const int tid = threadIdx.x, wid = __builtin_amdgcn_readfirstlane(tid >> 6), lane = tid & 63, wr = wid >> 2, wc = wid & 3, fr = lane & 15, fq = lane >> 4;
    const unsigned ldsw = (unsigned)wid * 1024u;
    const int aoff = lds_byte(wr * 64 + fr, fq * 8), boff = lds_byte(wc * 32 + fr, fq * 8);
    const size_t kstep = (size_t)(BK * 2);
#define PG8_SA(b, h) (((b) * 2 + (h)) * HTB)
#define PG8_SB(b, h) ((4 + (b) * 2 + (h)) * HTB)
#define PG8_STAGE(bufoff, gbase, voff) do { _Pragma("unroll") for (int _i = 0; _i < 2; ++_i) \
        __builtin_amdgcn_global_load_lds((const unsigned*)((const char*)(gbase) + (voff)[_i]), (LAS unsigned*)(lds + (bufoff) + ldsw + _i * 8192), 16, 0, 0); } while (0)
#define PG8_LDA(dst, b, h) do { _Pragma("unroll") for (int m = 0; m < 4; ++m) _Pragma("unroll") for (int k = 0; k < 2; ++k) dst[m][k] = *(const LAS bf16x8*)(lds + PG8_SA(b, h) + aoff + m * 2048 + k * 1024); } while (0)
#define PG8_LDB(dst, b, h) do { _Pragma("unroll") for (int n = 0; n < 2; ++n) _Pragma("unroll") for (int k = 0; k < 2; ++k) dst[n][k] = *(const LAS bf16x8*)(lds + PG8_SB(b, h) + boff + n * 2048 + k * 1024); } while (0)
#define PG8_MMA(ai, bj, At, Bt) do { __builtin_amdgcn_s_setprio(1); _Pragma("unroll") for (int m = 0; m < 4; ++m) _Pragma("unroll") for (int n = 0; n < 2; ++n) _Pragma("unroll") for (int k = 0; k < 2; ++k) \
        acc[ai][bj][m][n] = __builtin_amdgcn_mfma_f32_16x16x32_bf16(Bt[n][k], At[m][k], acc[ai][bj][m][n], 0, 0, 0); __builtin_amdgcn_s_setprio(0); } while (0)
#define PG8_WAIT_V(n) asm volatile("s_waitcnt vmcnt(" #n ")" ::: "memory")
#define PG8_WAIT_L(n) asm volatile("s_waitcnt lgkmcnt(" #n ")" ::: "memory")
#define PG8_BAR __builtin_amdgcn_s_barrier()
#define PG8_SCHED __builtin_amdgcn_sched_barrier(0)
    UnitDesc cur, nxt; int ui = 0;
    if (!S.next(0, cur)) return;
    f32x4 acc[2][2][4][2];
#pragma unroll
    for (int a = 0; a < 2; ++a)
#pragma unroll
        for (int b = 0; b < 2; ++b)
#pragma unroll
            for (int m = 0; m < 4; ++m)
#pragma unroll
                for (int n = 0; n < 2; ++n) acc[a][b][m][n] = (f32x4){0.f, 0.f, 0.f, 0.f};
    bf16x8 At[4][2], B0[2][2], B1[2][2];
    unsigned cA0[2], cA1[2], cB[2], nA0[2], nA1[2], nB[2];
    unit_offs<GATHER>(cur, tid, cA0, cA1, cB);
    const char* pA = cur.A; const char* pB = cur.B; size_t hB = (size_t)HALF * cur.ldb2; size_t hA = GATHER ? 0 : (size_t)HALF * cur.lda2;
#define PG8_A1(arr1, arr0) (GATHER ? (arr1) : (arr0))
    PG8_STAGE(PG8_SB(0, 0), pB, cB); PG8_STAGE(PG8_SB(0, 1), pB + hB, cB); PG8_STAGE(PG8_SA(0, 0), pA, cA0); PG8_STAGE(PG8_SA(0, 1), pA + hA, PG8_A1(cA1, cA0));
    if (wr == 1) PG8_BAR;
    PG8_WAIT_V(2); PG8_BAR;
    PG8_STAGE(PG8_SB(1, 0), pB + kstep, cB); PG8_STAGE(PG8_SA(1, 0), pA + kstep, cA0); PG8_STAGE(PG8_SB(1, 1), pB + hB + kstep, cB);
    PG8_WAIT_V(6); PG8_BAR;
    GSTAMP(0);
    for (;;) {
        const bool has_next = S.next(ui + 1, nxt);
        const char* qA = pA; const char* qB = pB; size_t hBn = hB, hAn = hA;
        if (has_next) { unit_offs<GATHER>(nxt, tid, nA0, nA1, nB); qA = nxt.A; qB = nxt.B; hBn = (size_t)HALF * nxt.ldb2; hAn = GATHER ? 0 : (size_t)HALF * nxt.lda2; }
        else {
#pragma unroll
            for (int i = 0; i < 2; ++i) { nA0[i] = cA0[i]; nA1[i] = cA1[i]; nB[i] = cB[i]; } }
        const int nt = cur.nt;
        for (int t = 0; t < nt; t += 2) {
            const bool last = (t == nt - 2);
            const char* a1 = pA + (size_t)(t + 1) * kstep;
            const char* a2 = last ? qA : pA + (size_t)(t + 2) * kstep; const char* b2 = last ? qB : pB + (size_t)(t + 2) * kstep;
            const char* a3 = a2 + kstep; const char* b3 = b2 + kstep;
            unsigned sA0[2], sA1[2], sB[2];
#pragma unroll
            for (int i = 0; i < 2; ++i) { sA0[i] = last ? nA0[i] : cA0[i]; sA1[i] = last ? nA1[i] : cA1[i]; sB[i] = last ? nB[i] : cB[i]; }
            const size_t shB = last ? hBn : hB, shA = last ? hAn : hA;
            PG8_LDB(B0, 0, 0); PG8_LDB(B1, 0, 1); PG8_SCHED; PG8_LDA(At, 0, 0); PG8_STAGE(PG8_SA(1, 1), a1 + hA, PG8_A1(cA1, cA0));
            PG8_WAIT_V(8); PG8_WAIT_L(0); PG8_BAR; PG8_MMA(0, 0, At, B0); PG8_MMA(0, 1, At, B1); PG8_BAR; PG8_SCHED;
            PG8_LDA(At, 0, 1); PG8_STAGE(PG8_SB(0, 0), b2, sB); PG8_STAGE(PG8_SB(0, 1), b2 + shB, sB); PG8_STAGE(PG8_SA(0, 0), a2, sA0);
            PG8_WAIT_V(8); PG8_WAIT_L(0); PG8_BAR; PG8_MMA(1, 0, At, B0); PG8_MMA(1, 1, At, B1); PG8_BAR; PG8_SCHED;
            PG8_LDB(B0, 1, 0); PG8_LDB(B1, 1, 1); PG8_SCHED; PG8_LDA(At, 1, 0); PG8_STAGE(PG8_SA(0, 1), a2 + shA, PG8_A1(sA1, sA0));
            PG8_WAIT_V(8); PG8_WAIT_L(0); PG8_BAR; PG8_MMA(0, 0, At, B0); PG8_MMA(0, 1, At, B1); PG8_BAR; PG8_SCHED;
            PG8_LDA(At, 1, 1); PG8_STAGE(PG8_SB(1, 0), b3, sB); PG8_STAGE(PG8_SB(1, 1), b3 + shB, sB); PG8_STAGE(PG8_SA(1, 0), a3, sA0);
            PG8_WAIT_V(8); PG8_WAIT_L(0); PG8_BAR; PG8_MMA(1, 0, At, B0); PG8_MMA(1, 1, At, B1); PG8_BAR; PG8_SCHED;
        }
        if (wr == 0) PG8_BAR;
        if (ui == 0) GSTAMP(1);
        E.finish(acc, cur, wr, wc, fr, fq);
        if (ui == 0) GSTAMP(2);
        if (!has_next) break;
        cur = nxt; pA = qA; pB = qB; hB = hBn; hA = hAn; ++ui;
#pragma unroll
        for (int i = 0; i < 2; ++i) { cA0[i] = nA0[i]; cA1[i] = nA1[i]; cB[i] = nB[i]; }
        if (wr == 1) PG8_BAR;
    }
    PG8_WAIT_V(0);
    PG8_BAR;
    GSTAMP(3);
#undef GSTAMP
#undef PG8_A1
#undef PG8_SA
#undef PG8_SB
#undef PG8_STAGE
#undef PG8_LDA
#undef PG8_LDB
#undef PG8_MMA
#undef PG8_WAIT_V
#undef PG8_WAIT_L
#undef PG8_BAR
#undef PG8_SCHED
}

__device__ __forceinline__ void zero_acc(f32x4 (&acc)[2][2][4][2]) {
#pragma unroll
    for (int a = 0; a < 2; ++a)
#pragma unroll
        for (int b = 0; b < 2; ++b)
#pragma unroll
            for (int m = 0; m < 4; ++m)
#pragma unroll
                for (int n = 0; n < 2; ++n) acc[a][b][m][n] = (f32x4){0.f, 0.f, 0.f, 0.f};
}
template <class F> struct EpiF { F f;
    __device__ __forceinline__ void finish(f32x4 (&acc)[2][2][4][2], const UnitDesc& u, int wr, int wc, int fr, int fq) const { epi_apply(acc, u, wr, wc, fr, fq, f); zero_acc(acc); } };

struct TileOrder {
    int nM, nN, nwg, G, c;
    __device__ __forceinline__ void init(int nM_, int nN_, int G_, int c_) { nM = nM_; nN = nN_; nwg = nM * nN; G = G_; c = c_; }
    __device__ __forceinline__ bool tile(int i, int& pm, int& pn) const {
        const long L = (long)i * G + c; if (L >= nwg) return false;
        int wgid = (int)L; { const int q = nwg / 8, r = nwg % 8, xcd = wgid % 8, off = wgid / 8; wgid = (xcd < r ? xcd * (q + 1) : r * (q + 1) + (xcd - r) * q) + off; }
        const int nig = 8 * nN, gid = wgid / nig, fm = gid * 8, gsz = (nM - fm) < 8 ? (nM - fm) : 8;
        pm = fm + ((wgid % nig) % gsz); pn = (wgid % nig) / gsz; return true;
    }
};
struct PlainSched { TileOrder o; const bf16* A; const bf16* Bt; int lda, ldb, K;
    __device__ __forceinline__ bool next(int i, UnitDesc& u) const { int pm, pn; if (!o.tile(i, pm, pn)) return false;
        u.A = (const char*)(A + (size_t)pm * BM * lda); u.B = (const char*)(Bt + (size_t)pn * BM * ldb); u.lda2 = lda * 2; u.ldb2 = ldb * 2; u.nt = K / BK;
        u.row0 = pm * BM; u.col0 = pn * BM; u.aux = 0; u.aux2 = 0; u.gidx = nullptr; u.gcnt = 0; u.chain = 0; return true; } };
}

#if PROBE_TS_A >= 0
#define MXSTAMP(k) do { if (blockIdx.x == 0 && threadIdx.x == 0) ((volatile LAS unsigned*)(lds + MISC_OFF))[32 + (k)] = (unsigned)__builtin_amdgcn_s_memrealtime(); } while (0)
#else
#define MXSTAMP(k) do { } while (0)
#endif
namespace mx {
typedef short s16x4 __attribute__((ext_vector_type(4)));
typedef __bf16 bf16x8_t __attribute__((ext_vector_type(8)));
typedef __bf16 bf16x4_t __attribute__((ext_vector_type(4)));
typedef float f32x8 __attribute__((ext_vector_type(8)));
__device__ __forceinline__ f32x4 mma(bf16x8 a, bf16x8 b, f32x4 c) { return __builtin_amdgcn_mfma_f32_16x16x32_bf16(a, b, c, 0, 0, 0); }
__device__ __forceinline__ bf16x8 ldsf(LAS unsigned char* p) { return *(LAS bf16x8*)p; }
__device__ __forceinline__ bf16x8 glbf(const bf16* p) { return *(const bf16x8*)p; }
__device__ __forceinline__ bf16x8 trf(LAS unsigned char* p0, LAS unsigned char* p1) {
    const s16x4 a = __builtin_amdgcn_ds_read_tr16_b64_v4i16((LAS s16x4*)p0), b = __builtin_amdgcn_ds_read_tr16_b64_v4i16((LAS s16x4*)p1);
    return __builtin_shufflevector(a, b, 0, 1, 2, 3, 4, 5, 6, 7);
}
__device__ __forceinline__ bf16x8 pack8(f32x4 a, f32x4 b) { const f32x8 v = {a[0], a[1], a[2], a[3], b[0], b[1], b[2], b[3]}; return __builtin_bit_cast(bf16x8, __builtin_convertvector(v, bf16x8_t)); }
__device__ __forceinline__ u32x2 pack4(f32x4 a) { return __builtin_bit_cast(u32x2, __builtin_convertvector(a, bf16x4_t)); }
__device__ __forceinline__ float red_g_max(float v) { v = fmaxf(v, __shfl_xor(v, 16)); return fmaxf(v, __shfl_xor(v, 32)); }
__device__ __forceinline__ float red_g_sum(float v) { v += __shfl_xor(v, 16); return v + __shfl_xor(v, 32); }

__device__ __forceinline__ int vblock() { const int G = (int)gridDim.x, bx = (int)blockIdx.x; return (G % 8 == 0) ? (bx % 8) * (G / 8) + bx / 8 : bx; }
constexpr int XA_KP = 272, XA_VP = 288, XA_VOFF = 256 * XA_KP;
__device__ __forceinline__ void xa_phase(LAS unsigned char* lds, bf16* XQ, const bf16* MKV) {
    const int tid = threadIdx.x, lane = tid & 63, wave = __builtin_amdgcn_readfirstlane(tid >> 6), g = lane >> 4, li = lane & 15, q4 = li >> 2, p4 = li & 3;
    for (int it = vblock(); it < NB * 4 * 8; it += gridDim.x) {
        const int b = it >> 5, h = (it >> 3) & 3, qb = it & 7;
        __syncthreads();
#pragma unroll
        for (int i = 0; i < 8; ++i) { const int id = tid + 512 * i, row = id >> 4, ch = id & 15; const bf16* src = MKV + (size_t)(b * MEML + row) * 1024 + h * 128 + ch * 8;
            *(LAS u32x4*)(lds + row * XA_KP + ch * 16) = *(const u32x4*)src; *(LAS u32x4*)(lds + XA_VOFF + row * XA_VP + ch * 16) = *(const u32x4*)(src + 512); }
        __syncthreads();
#pragma unroll 1
        for (int qi = 0; qi < 2; ++qi) {
            bf16* qrow = XQ + (size_t)(b * SEQ + qb * 256 + wave * 32 + qi * 16 + li) * 512 + h * 128;
            bf16x8 qf[4];
#pragma unroll
            for (int s = 0; s < 4; ++s) qf[s] = glbf(qrow + 32 * s + 8 * g);
            f32x4 st[16]; float mx = -3.0e38f;
#pragma unroll
            for (int kf = 0; kf < 16; ++kf) { f32x4 a = {0.f, 0.f, 0.f, 0.f};
#pragma unroll
                for (int s = 0; s < 4; ++s) a = mma(ldsf(lds + (16 * kf + li) * XA_KP + (32 * s + 8 * g) * 2), qf[s], a);
                st[kf] = a; mx = fmaxf(mx, fmaxf(fmaxf(a[0], a[1]), fmaxf(a[2], a[3]))); __builtin_amdgcn_sched_barrier(0); }
            mx = red_g_max(mx); float sum = 0.f;
#pragma unroll
            for (int kf = 0; kf < 16; ++kf) {
#pragma unroll
                for (int r = 0; r < 4; ++r) { const float e = __expf(st[kf][r] - mx); st[kf][r] = e; sum += e; } }
            sum = red_g_sum(sum); const float inv = 1.0f / sum;
            f32x4 o[8];
#pragma unroll
            for (int df = 0; df < 8; ++df) o[df] = (f32x4){0.f, 0.f, 0.f, 0.f};
#pragma unroll
            for (int x = 0; x < 8; ++x) { const bf16x8 pf = pack8(st[2 * x], st[2 * x + 1]);
                LAS unsigned char* vb = lds + XA_VOFF + (32 * x + 4 * g + q4) * XA_VP + 8 * p4;
#pragma unroll
                for (int df = 0; df < 8; ++df) o[df] = mma(trf(vb + 32 * df, vb + 16 * XA_VP + 32 * df), pf, o[df]); __builtin_amdgcn_sched_barrier(0); }
#pragma unroll
            for (int df = 0; df < 8; ++df) *(u32x2*)(qrow + 16 * df + 4 * g) = pack4(o[df] * inv);
        }
    }
}

constexpr int NA_KP = 144, NA_VP = 136, NA_VOFF = 576 * NA_KP;
struct NaItem { int b, h, krmin, r, rs; };
__device__ __forceinline__ NaItem na_item(int it, int ri) { NaItem a; a.b = it >> 7; a.h = (it >> 4) & 7; const int rp = it & 15;
    int k = 2 * rp - 4; a.krmin = k < 0 ? 0 : (k > 24 ? 24 : k); a.r = 2 * rp + ri; int rs = a.r - 4; a.rs = rs < 0 ? 0 : (rs > 24 ? 24 : rs); return a; }
__device__ __forceinline__ void na_load_kv(u32x4 (&kv)[9], u32x4 (&vv)[9], const NaItem& a, const bf16* NK, const bf16* NV, int tid) {
#pragma unroll
    for (int i = 0; i < 9; ++i) { const int id = tid + 512 * i, trow = id >> 3, ch = id & 7; int kr = a.krmin + (trow >> 6); kr = kr > 31 ? 31 : kr;
        const size_t off = (size_t)(a.b * SEQ + kr * 64 + (trow & 63)) * 512 + a.h * 64 + ch * 8; kv[i] = *(const u32x4*)(NK + off); vv[i] = *(const u32x4*)(NV + off); }
}
__device__ __forceinline__ void na_phase(LAS unsigned char* lds, bf16* NQ, const bf16* NK, const bf16* NV, const bf16* FT) {
    const int tid = threadIdx.x, lane = tid & 63, wave = __builtin_amdgcn_readfirstlane(tid >> 6), g = lane >> 4, li = lane & 15, q4 = li >> 2, p4 = li & 3;
    const int ri = wave >> 2, qf = wave & 3, c0 = 16 * qf, w0 = qf == 0 ? 0 : (qf == 1 ? 8 : (qf == 2 ? 24 : 32));
    const int G = (int)gridDim.x, lite = G > 64 ? 32 : 0; const bool isl = (int)blockIdx.x < lite;
    int vnl = (int)blockIdx.x - lite;
    if (lite && G % 8 == 0) { const int x = (int)blockIdx.x % 8, q = (int)blockIdx.x / 8 - lite / 8; vnl = x * ((G - lite) / 8) + q; }
    const int it0 = isl ? (int)blockIdx.x : lite + vnl, itstep = isl ? NB * 8 * 16 : G - lite;
    if (it0 >= NB * 8 * 16) return;
    NaItem cur = na_item(it0, ri);
    u32x4 kv[9], vv[9]; bf16x8 ff[16]; bf16x8 q0, q1;
    na_load_kv(kv, vv, cur, NK, NV, tid);
#pragma unroll
    for (int f = 0; f < 16; ++f) ff[f] = glbf(FT + ((size_t)((cur.h * 15 + (cur.rs + (f >> 1) - cur.r + 7)) * 64 + w0 + 16 * (f & 1) + li)) * 64 + (c0 & 32) + 8 * g);
    { const bf16* qr = NQ + (size_t)(cur.b * SEQ + cur.r * 64 + c0 + li) * 512 + cur.h * 64; q0 = glbf(qr + 8 * g); q1 = glbf(qr + 32 + 8 * g); }
    bf16x8 e1;
#pragma unroll
    for (int j = 0; j < 8; ++j) e1[j] = (8 * g + j == ((c0 + li) & 31)) ? (short)0x3F80 : (short)0;
#pragma unroll 1
    for (int it = it0;;) {
        __syncthreads();
#pragma unroll
        for (int i = 0; i < 9; ++i) { const int id = tid + 512 * i, trow = id >> 3, ch = id & 7;
            *(LAS u32x4*)(lds + trow * NA_KP + ch * 16) = kv[i];
            *(LAS u32x2*)(lds + NA_VOFF + trow * NA_VP + ch * 16) = (u32x2){vv[i].x, vv[i].y}; *(LAS u32x2*)(lds + NA_VOFF + trow * NA_VP + ch * 16 + 8) = (u32x2){vv[i].z, vv[i].w}; }
        __syncthreads();
        const int itn = it + itstep; const bool has_next = itn < NB * 8 * 16; const NaItem nx = na_item(has_next ? itn : it, ri);
        if (has_next) na_load_kv(kv, vv, nx, NK, NV, tid);
        const int rs = cur.rs, krmin = cur.krmin;
        f32x4 st[16]; float mx = -3.0e38f;
#pragma unroll
        for (int kri = 0; kri < 8; ++kri) {
#pragma unroll
            for (int cf = 0; cf < 2; ++cf) { LAS unsigned char* kp = lds + ((rs + kri - krmin) * 64 + w0 + 16 * cf + li) * NA_KP + 16 * g;
                f32x4 a = {0.f, 0.f, 0.f, 0.f};
                a = mma(ldsf(kp), q0, a); a = mma(ldsf(kp + 64), q1, a); a = mma(ff[kri * 2 + cf], e1, a);
                st[kri * 2 + cf] = a; mx = fmaxf(mx, fmaxf(fmaxf(a[0], a[1]), fmaxf(a[2], a[3]))); }
            __builtin_amdgcn_sched_barrier(0); }
        bf16* qrow = NQ + (size_t)(cur.b * SEQ + cur.r * 64 + c0 + li) * 512 + cur.h * 64;
        if (has_next) {
#pragma unroll
            for (int f = 0; f < 8; ++f) ff[f] = glbf(FT + ((size_t)((nx.h * 15 + (nx.rs + (f >> 1) - nx.r + 7)) * 64 + w0 + 16 * (f & 1) + li)) * 64 + (c0 & 32) + 8 * g);
            const bf16* qr = NQ + (size_t)(nx.b * SEQ + nx.r * 64 + c0 + li) * 512 + nx.h * 64; q0 = glbf(qr + 8 * g); q1 = glbf(qr + 32 + 8 * g); }
        mx = red_g_max(mx); float sum = 0.f;
#pragma unroll
        for (int f = 0; f < 16; ++f) {
#pragma unroll
            for (int rr = 0; rr < 4; ++rr) { const float e = __expf(st[f][rr] - mx); st[f][rr] = e; sum += e; } }
        sum = red_g_sum(sum); const float inv = 1.0f / sum;
        f32x4 o[4];
#pragma unroll
        for (int df = 0; df < 4; ++df) o[df] = (f32x4){0.f, 0.f, 0.f, 0.f};
#pragma unroll
        for (int x = 0; x < 8; ++x) { const bf16x8 pf = pack8(st[2 * x], st[2 * x + 1]);
            LAS unsigned char* vb = lds + NA_VOFF + ((rs + x - krmin) * 64 + w0 + 4 * g + q4) * NA_VP + 8 * p4;
#pragma unroll
            for (int df = 0; df < 4; ++df) o[df] = mma(trf(vb + 32 * df, vb + 16 * NA_VP + 32 * df), pf, o[df]); __builtin_amdgcn_sched_barrier(0); }
#pragma unroll
        for (int df = 0; df < 4; ++df) *(u32x2*)(qrow + 16 * df + 4 * g) = pack4(o[df] * inv);
        if (!has_next) break;
#pragma unroll
        for (int f = 8; f < 16; ++f) ff[f] = glbf(FT + ((size_t)((nx.h * 15 + (nx.rs + (f >> 1) - nx.r + 7)) * 64 + w0 + 16 * (f & 1) + li)) * 64 + (c0 & 32) + 8 * g);
        cur = nx; it = itn;
    }
}

constexpr int RT_P = 272, RT_VP = 544, RT_QOFF = 0, RT_KOFF = 128 * RT_P, RT_VOFF = 2 * 128 * RT_P, RT_RED = RT_VOFF + 128 * RT_VP, RT_STAT = RT_RED + 8 * 128 * 8;
__device__ __forceinline__ void ret_out_phase(LAS unsigned char* lds, const bf16* RQ, const bf16* RK, const bf16* RV, bf16* RG, const bf16* ST, const float* gain, const float* decf, const float* decb) {
    const int tid0 = threadIdx.x, lane = tid0 & 63, wave = __builtin_amdgcn_readfirstlane(tid0 >> 6), g = lane >> 4, li = lane & 15, q4 = li >> 2, p4 = li & 3;
    for (int it = blockIdx.x; it < NB * 4 * 16; it += gridDim.x) {
        const int b = it >> 6, h = (it >> 4) & 3, n = it & 15; const size_t tok0 = (size_t)b * SEQ + n * 128;
        int tid = tid0; asm volatile("" : "+v"(tid));
        const float lgf = -log1pf(expf(-decf[h])), lgb = -log1pf(expf(-decb[h]));
        const bf16* sfp = ST + ((size_t)(((b * 4 + h) * 2 + 0) * 16 + n) * 256 + 32 * wave + li) * 128 + 8 * g;
        const bf16* sbp = ST + ((size_t)(((b * 4 + h) * 2 + 1) * 16 + n) * 256 + 32 * wave + li) * 128 + 8 * g;
        __syncthreads();
#pragma unroll
        for (int i = 0; i < 4; ++i) { const int id = tid + 512 * i, row = id >> 4, ch = id & 15;
            *(LAS u32x4*)(lds + RT_QOFF + row * RT_P + ch * 16) = *(const u32x4*)(RQ + (tok0 + row) * 512 + h * 128 + ch * 8);
            *(LAS u32x4*)(lds + RT_KOFF + row * RT_P + ch * 16) = *(const u32x4*)(RK + (tok0 + row) * 512 + h * 128 + ch * 8); }
#pragma unroll
        for (int i = 0; i < 8; ++i) { const int id = tid + 512 * i, row = id >> 5, ch = id & 31;
            *(LAS u32x4*)(lds + RT_VOFF + row * RT_VP + ch * 16) = *(const u32x4*)(RV + (tok0 + row) * 1024 + h * 256 + ch * 8); }
        __builtin_amdgcn_sched_barrier(0);
        bf16x8 sf[2][4];
        if (it == (int)blockIdx.x) MXSTAMP(25);
#pragma unroll
        for (int a = 0; a < 2; ++a)
#pragma unroll
            for (int s = 0; s < 4; ++s) sf[a][s] = glbf(sfp + a * 16 * 128 + 32 * s);
        __syncthreads();
        if (it == (int)blockIdx.x) MXSTAMP(26);
        { bf16x8 qf[4];
#pragma unroll
          for (int s = 0; s < 4; ++s) qf[s] = ldsf(lds + RT_QOFF + (16 * wave + li) * RT_P + (32 * s + 8 * g) * 2);
          f32x4 st[8]; const int pi = 16 * wave + li;
#pragma unroll
          for (int jf = 0; jf < 8; ++jf) { f32x4 a = {0.f, 0.f, 0.f, 0.f};
#pragma unroll
              for (int s = 0; s < 4; ++s) a = mma(ldsf(lds + RT_KOFF + (16 * jf + li) * RT_P + (32 * s + 8 * g) * 2), qf[s], a);
#pragma unroll
              for (int r = 0; r < 4; ++r) { const int pj = 16 * jf + 4 * g + r; a[r] *= (pj <= pi) ? __expf((float)(pi - pj) * lgf) : __expf((float)(pj - pi) * lgb); }
              st[jf] = a; __builtin_amdgcn_sched_barrier(0); }
          __syncthreads();
#pragma unroll
          for (int jf = 0; jf < 8; ++jf) *(LAS u32x2*)(lds + RT_KOFF + pi * RT_P + (16 * jf + 4 * g) * 2) = pack4(st[jf]);
        }
        __syncthreads();
        if (it == (int)blockIdx.x) MXSTAMP(27);
        bf16x8 sb[2][4];
#pragma unroll
        for (int a = 0; a < 2; ++a)
#pragma unroll
            for (int s = 0; s < 4; ++s) sb[a][s] = glbf(sbp + a * 16 * 128 + 32 * s);
        f32x4 y[2][8];
#pragma unroll
        for (int a = 0; a < 2; ++a)
#pragma unroll
            for (int i = 0; i < 8; ++i) y[a][i] = (f32x4){0.f, 0.f, 0.f, 0.f};
        {
#pragma unroll
          for (int i = 0; i < 8; ++i) {
#pragma unroll
              for (int s = 0; s < 4; ++s) { const bf16x8 qfr = ldsf(lds + RT_QOFF + (16 * i + li) * RT_P + (32 * s + 8 * g) * 2); y[0][i] = mma(sf[0][s], qfr, y[0][i]); y[1][i] = mma(sf[1][s], qfr, y[1][i]); }
              const int pi = 16 * i + li; const float ratio = __expf((float)(pi + 1) * lgf - (float)(128 - pi) * lgb);
              y[0][i] = y[0][i] * ratio; y[1][i] = y[1][i] * ratio; __builtin_amdgcn_sched_barrier(0); } }
        if (it == (int)blockIdx.x) MXSTAMP(28);
        {
#pragma unroll
          for (int i = 0; i < 8; ++i) {
#pragma unroll
              for (int s = 0; s < 4; ++s) { const bf16x8 qfr = ldsf(lds + RT_QOFF + (16 * i + li) * RT_P + (32 * s + 8 * g) * 2); y[0][i] = mma(sb[0][s], qfr, y[0][i]); y[1][i] = mma(sb[1][s], qfr, y[1][i]); }
              const int pi = 16 * i + li; const float ab = __expf((float)(128 - pi) * lgb);
              y[0][i] = y[0][i] * ab; y[1][i] = y[1][i] * ab; __builtin_amdgcn_sched_barrier(0); } }
        if (it == (int)blockIdx.x) MXSTAMP(29);
#pragma unroll
        for (int x = 0; x < 4; ++x) {
            LAS unsigned char* vb = lds + RT_VOFF + (32 * x + 8 * g + q4) * RT_VP + (32 * wave) * 2 + 8 * p4;
            const bf16x8 v0 = trf(vb, vb + 4 * RT_VP), v1 = trf(vb + 32, vb + 4 * RT_VP + 32);
#pragma unroll
            for (int i = 0; i < 8; ++i) { const bf16x8 pfr = ldsf(lds + RT_KOFF + (16 * i + li) * RT_P + (32 * x + 8 * g) * 2); y[0][i] = mma(v0, pfr, y[0][i]); y[1][i] = mma(v1, pfr, y[1][i]); } __builtin_amdgcn_sched_barrier(0); }
        if (it == (int)blockIdx.x) MXSTAMP(30);
#pragma unroll
        for (int i = 0; i < 8; ++i) { float s1 = 0.f, s2 = 0.f;
#pragma unroll
            for (int a = 0; a < 2; ++a)
#pragma unroll
                for (int r = 0; r < 4; ++r) { const float v = y[a][i][r]; s1 += v; s2 += v * v; }
            s1 = red_g_sum(s1); s2 = red_g_sum(s2);
            if (g == 0) { LAS float* rp = (LAS float*)(lds + RT_RED) + (wave * 128 + 16 * i + li) * 2; rp[0] = s1; rp[1] = s2; } }
        __syncthreads();
        if (tid < 128) { float s1 = 0.f, s2 = 0.f;
#pragma unroll
            for (int w = 0; w < 8; ++w) { const LAS float* rp = (const LAS float*)(lds + RT_RED) + (w * 128 + tid) * 2; s1 += rp[0]; s2 += rp[1]; }
            const float mu = s1 * (1.f / 256.f); const float var = fmaxf(s2 * (1.f / 256.f) - mu * mu, 0.f);
            LAS float* sp = (LAS float*)(lds + RT_STAT) + tid * 2; sp[0] = mu; sp[1] = 1.0f / sqrtf(var + GN_EPS); }
        __syncthreads();
        if (it == (int)blockIdx.x) MXSTAMP(31);
        const f32x4 gn0 = *(const f32x4*)(gain + h * 256 + 32 * wave + 4 * g), gn1 = *(const f32x4*)(gain + h * 256 + 32 * wave + 16 + 4 * g);
#pragma unroll
        for (int i = 0; i < 8; ++i) { const LAS float* sp = (const LAS float*)(lds + RT_STAT) + (16 * i + li) * 2; const float mu = sp[0], rstd = sp[1];
            bf16* gp = RG + (tok0 + 16 * i + li) * 1024 + h * 256 + 32 * wave + 4 * g;
#pragma unroll
            for (int a = 0; a < 2; ++a) { const u32x2 gv = *(const u32x2*)(gp + 16 * a); const f32x4 gg = a ? gn1 : gn0;
                f32x4 o; o[0] = (y[a][i][0] - mu) * rstd * gg[0] * bf2f(gv.x & 0xffffu); o[1] = (y[a][i][1] - mu) * rstd * gg[1] * bf2f(gv.x >> 16);
                o[2] = (y[a][i][2] - mu) * rstd * gg[2] * bf2f(gv.y & 0xffffu); o[3] = (y[a][i][3] - mu) * rstd * gg[3] * bf2f(gv.y >> 16);
                *(u32x2*)(gp + 16 * a) = pack4(o); } }
    }
}

constexpr int RS_KP = 272, RS_VP = 144, RS_VOFF = 128 * RS_KP;
__device__ __forceinline__ void ret_state_phase(LAS unsigned char* lds, const bf16* RK, const bf16* RV, bf16* ST, const float* decf, const float* decb) {
    const int tid = threadIdx.x, lane = tid & 63, wave = __builtin_amdgcn_readfirstlane(tid >> 6), g = lane >> 4, li = lane & 15, q4 = li >> 2, p4 = li & 3;
    for (int it = vblock(); it < NB * 4 * 2 * 4; it += gridDim.x) {
        const int es = it & 3, dir = (it >> 2) & 1, h = (it >> 3) & 3, b = it >> 5;
        const float lg = -log1pf(expf(-(dir ? decb[h] : decf[h]))); const float cd = __expf(128.f * lg);
        f32x4 st[4];
#pragma unroll
        for (int ef = 0; ef < 4; ++ef) st[ef] = (f32x4){0.f, 0.f, 0.f, 0.f};
        u32x4 kq[4], vq[2];
        { const size_t tk = (size_t)b * SEQ + (dir ? 15 : 0) * 128;
#pragma unroll
          for (int i = 0; i < 4; ++i) { const int id = tid + 512 * i, row = id >> 4, ch = id & 15; kq[i] = *(const u32x4*)(RK + (tk + row) * 512 + h * 128 + ch * 8); }
#pragma unroll
          for (int i = 0; i < 2; ++i) { const int id = tid + 512 * i, row = id >> 3, ch = id & 7; vq[i] = *(const u32x4*)(RV + (tk + row) * 1024 + h * 256 + es * 64 + ch * 8); } }
#pragma unroll 1
        for (int cc = 0; cc < 16; ++cc) { const int n = dir ? 15 - cc : cc;
            bf16* sp = ST + ((size_t)(((b * 4 + h) * 2 + dir) * 16 + n) * 256 + es * 64 + 4 * g) * 128 + 16 * wave + li;
#pragma unroll
            for (int ef = 0; ef < 4; ++ef)
#pragma unroll
                for (int r = 0; r < 4; ++r) sp[(16 * ef + r) * 128] = (bf16)f2bf(st[ef][r]);
            __syncthreads();
#pragma unroll
            for (int i = 0; i < 4; ++i) { const int id = tid + 512 * i, row = id >> 4, ch = id & 15;
                float v[8]; unpack8(kq[i], v);
                const float w = __expf((float)(dir ? row : 127 - row) * lg);
                u32x4 o; o.x = pk2(v[0] * w, v[1] * w); o.y = pk2(v[2] * w, v[3] * w); o.z = pk2(v[4] * w, v[5] * w); o.w = pk2(v[6] * w, v[7] * w);
                *(LAS u32x4*)(lds + row * RS_KP + ch * 16) = o; }
#pragma unroll
            for (int i = 0; i < 2; ++i) { const int id = tid + 512 * i, row = id >> 3, ch = id & 7; *(LAS u32x4*)(lds + RS_VOFF + row * RS_VP + ch * 16) = vq[i]; }
            if (cc < 15) { const int n2 = dir ? 14 - cc : cc + 1; const size_t tk = (size_t)b * SEQ + n2 * 128;
#pragma unroll
                for (int i = 0; i < 4; ++i) { const int id = tid + 512 * i, row = id >> 4, ch = id & 15; kq[i] = *(const u32x4*)(RK + (tk + row) * 512 + h * 128 + ch * 8); }
#pragma unroll
                for (int i = 0; i < 2; ++i) { const int id = tid + 512 * i, row = id >> 3, ch = id & 7; vq[i] = *(const u32x4*)(RV + (tk + row) * 1024 + h * 256 + es * 64 + ch * 8); } }
            __syncthreads();
#pragma unroll
            for (int ef = 0; ef < 4; ++ef) st[ef] = st[ef] * cd;
#pragma unroll
            for (int x = 0; x < 4; ++x) {
                LAS unsigned char* kb = lds + (32 * x + 8 * g + q4) * RS_KP + (16 * wave) * 2 + 8 * p4;
                const bf16x8 kfr = trf(kb, kb + 4 * RS_KP);
                LAS unsigned char* vb = lds + RS_VOFF + (32 * x + 8 * g + q4) * RS_VP + 8 * p4;
#pragma unroll
                for (int ef = 0; ef < 4; ++ef) st[ef] = mma(trf(vb + 32 * ef, vb + 4 * RS_VP + 32 * ef), kfr, st[ef]); __builtin_amdgcn_sched_barrier(0); }
        }
    }
}
__device__ __forceinline__ void memkv_phase(const bf16* MN, const bf16* WKV, bf16* MKV) {
    const int tid = threadIdx.x, lane = tid & 63, wave = __builtin_amdgcn_readfirstlane(tid >> 6), g = lane >> 4, li = lane & 15;
    for (int it = blockIdx.x; it < 256; it += gridDim.x) {
        const int r0 = (it >> 4) * 128 + wave * 16, c0 = (it & 15) * 64;
        const bf16* ap = MN + (size_t)(r0 + li) * 1024 + 8 * g; const bf16* bp = WKV + (size_t)(c0 + li) * 1024 + 8 * g;
        f32x4 acc[4];
#pragma unroll
        for (int nf = 0; nf < 4; ++nf) acc[nf] = (f32x4){0.f, 0.f, 0.f, 0.f};
#pragma unroll 4
        for (int s = 0; s < 32; ++s) { const bf16x8 a = glbf(ap + 32 * s);
#pragma unroll
            for (int nf = 0; nf < 4; ++nf) acc[nf] = mma(glbf(bp + (size_t)nf * 16 * 1024 + 32 * s), a, acc[nf]); }
#pragma unroll
        for (int nf = 0; nf < 4; ++nf) *(u32x2*)(MKV + (size_t)(r0 + li) * 1024 + c0 + 16 * nf + 4 * g) = pack4(acc[nf]);
    }
}
}


struct Ptrs {
    const float* in[23]; float* out; unsigned char* ws;
    __device__ bf16* b(size_t off) const { return (bf16*)(ws + off); }
    __device__ float* f(size_t off) const { return (float*)(ws + off); }
};

__device__ __forceinline__ void phase0(const Ctx& c, const Ptrs& P) {
    int tb = 0;
    transpose_all(c, tb, ColWA{P.in[3]}, 8192, NPA, 1024, P.b(WS_WA));
    transpose_all(c, tb, ColOff{P.in[3], NPA}, 8192, NPG, 1024, P.b(WS_WG));
    transpose_all(c, tb, ColPlain{P.in[11]}, 1024, 1024, 1024, P.b(WS_WKV));
    transpose_all(c, tb, ColPlain{P.in[7]}, 1024, 1024, 1024, P.b(WS_WRO));
    transpose_all(c, tb, ColPlain{P.in[9]}, 1024, 1024, 512, P.b(WS_WNO));
    transpose_all(c, tb, ColPlain{P.in[12]}, 1024, 1024, 512, P.b(WS_WXO));
    transpose_all(c, tb, ColPlain{P.in[13]}, 1024, 1024, 1024, P.b(WS_WOUT));
    { float* COS = P.f(WS_COS); float* SIN = P.f(WS_SIN);
      for (int i = c.gw * 64 + c.lane; i < SEQ * 64; i += c.ngw * 64) { const int pos = i >> 6, fi = i & 63;
          const float inv = (float)pow(10000.0, -(double)fi / 64.0); const float ang = (float)pos * inv;
          COS[i] = (float)cos((double)ang); SIN[i] = (float)sin((double)ang); } }
    { bf16* FT = P.b(WS_FT); const float* rpb = P.in[8];
      for (int i = c.gw * 64 + c.lane; i < 8 * 15 * 64 * 64; i += c.ngw * 64) { const int qc = i & 63, kc = (i >> 6) & 63, hr = i >> 12;
          int cs = qc - 8; cs = cs < 0 ? 0 : (cs > 48 ? 48 : cs); int rc = kc - qc; rc = rc < -15 ? -15 : (rc > 15 ? 15 : rc);
          const float v = (kc >= cs && kc < cs + 16) ? rpb[hr * 31 + rc + 15] : -1.0e30f; FT[i] = (bf16)f2bf(v); } }
    for (int m = c.gw; m < T; m += 2 * c.ngw) {
        const int m2 = m + c.ngw; const f32x4* xa = (const f32x4*)(P.in[0] + (size_t)m * DM) + c.lane; const f32x4* xb = (const f32x4*)(P.in[0] + (size_t)(m2 < T ? m2 : m) * DM) + c.lane;
        const f32x4* gr = (const f32x4*)P.in[2] + c.lane;
        f32x4 va[4], vb[4]; float sa = 0.f, sb = 0.f;
#pragma unroll
        for (int j = 0; j < 4; ++j) { va[j] = xa[64 * j]; vb[j] = xb[64 * j]; }
#pragma unroll
        for (int j = 0; j < 4; ++j) { sa += (va[j].x * va[j].x + va[j].y * va[j].y) + (va[j].z * va[j].z + va[j].w * va[j].w); sb += (vb[j].x * vb[j].x + vb[j].y * vb[j].y) + (vb[j].z * vb[j].z + vb[j].w * vb[j].w); }
        const float ra = 1.0f / sqrtf(wave_sum(sa) * (1.f / 1024.f) + RMS_EPS), rb = 1.0f / sqrtf(wave_sum(sb) * (1.f / 1024.f) + RMS_EPS);
        unsigned long long* oa = (unsigned long long*)(P.b(WS_XN) + (size_t)m * DM) + c.lane; unsigned long long* ob = (unsigned long long*)(P.b(WS_XN) + (size_t)m2 * DM) + c.lane;
#pragma unroll
        for (int j = 0; j < 4; ++j) { const f32x4 gg = gr[64 * j];
            oa[64 * j] = (unsigned long long)pk2(va[j].x * ra * gg.x, va[j].y * ra * gg.y) | ((unsigned long long)pk2(va[j].z * ra * gg.z, va[j].w * ra * gg.w) << 32);
            if (m2 < T) ob[64 * j] = (unsigned long long)pk2(vb[j].x * rb * gg.x, vb[j].y * rb * gg.y) | ((unsigned long long)pk2(vb[j].z * rb * gg.z, vb[j].w * rb * gg.w) << 32); } }
    for (int m = c.gw; m < TM; m += c.ngw) rms_row_to_bf16(P.in[1] + (size_t)m * DM, P.in[10], P.b(WS_MN) + (size_t)m * DM, c.lane);
}

__device__ __forceinline__ void phase1_naive(const Ctx& c, const Ptrs& P) {
    EpiProjA E{P.b(WS_RQ), P.b(WS_RK), P.b(WS_RV), P.b(WS_RG), P.b(WS_NQ), P.b(WS_NK), P.b(WS_NV), P.b(WS_XQ), P.f(WS_COS), P.f(WS_SIN)};
    naive_gemm(c, RowPlain{P.b(WS_XN), DM}, P.b(WS_WA), DM, T, NPA, DM, E);
}

__device__ __forceinline__ float log_sigmoid_(float x) { return -log1pf(expf(-x)); }

__device__ __forceinline__ void phase2_states_naive(const Ctx& c, const Ptrs& P) {
    const bf16* RK = P.b(WS_RK); const bf16* RV = P.b(WS_RV); bf16* ST = (bf16*)P.out;
    const int nitems = NB * 4 * 2 * 128 * 4;
    for (int it = c.gw; it < nitems; it += c.ngw) {
        const int eb = it & 3, d = (it >> 2) & 127, dir = (it >> 9) & 1, h = (it >> 10) & 3, b = it >> 12;
        const int e = eb * 64 + c.lane;
        const float lg = log_sigmoid_(dir ? P.in[5][h] : P.in[4][h]); const float gam = expf(lg);
        float S = 0.f;
        bf16* stb = ST + (size_t)(((b * 4 + h) * 2 + dir) * 16) * 256 * 128 + (size_t)e * 128 + d;
        for (int jj = 0; jj < SEQ; ++jj) {
            const int j = dir ? (SEQ - 1 - jj) : jj;
            if ((jj & 127) == 0) { const int n = j >> 7; stb[(size_t)n * 256 * 128] = (bf16)f2bf(S); }
            const size_t tok = (size_t)b * SEQ + j;
            const float kv = bf2f(RK[tok * 512 + h * 128 + d]) * bf2f(RV[tok * 1024 + h * 256 + e]);
            S = S * gam + kv;
        }
    }
}
__device__ __forceinline__ void phase2_na_naive(const Ctx& c, const Ptrs& P) {
    bf16* NQ = P.b(WS_NQ); const bf16* NK = P.b(WS_NK); const bf16* NV = P.b(WS_NV); const float* rpb = P.in[8];
    float* scr = (float*)(c.lds + c.wave * 16384);
    const int lane = c.lane;
    for (int it = c.gw; it < T * 8; it += c.ngw) {
        const int h = it & 7, tok = it >> 3, b = tok >> 11, s = tok & 2047, r = s >> 6, cc = s & 63;
        int rs = r - 4; rs = rs < 0 ? 0 : (rs > 24 ? 24 : rs);
        int cs = cc - 8; cs = cs < 0 ? 0 : (cs > 48 ? 48 : cs);
        scr[128 + lane] = bf2f(NQ[(size_t)tok * 512 + h * 64 + lane]);
        __builtin_amdgcn_s_waitcnt(0xC07F); asm volatile("" ::: "memory");
        float sc[2];
#pragma unroll
        for (int t = 0; t < 2; ++t) { const int key = lane + 64 * t, kr = rs + (key >> 4), kc = cs + (key & 15);
            const size_t kt = (size_t)b * SEQ + kr * 64 + kc; const u32x4* kp = (const u32x4*)(NK + kt * 512 + h * 64);
            float a = 0.f;
#pragma unroll 2
            for (int i = 0; i < 8; ++i) { float kk[8]; unpack8(kp[i], kk);
#pragma unroll
                for (int u = 0; u < 8; ++u) a += scr[128 + 8 * i + u] * kk[u]; }
            int rc = kc - cc; rc = rc < -15 ? -15 : (rc > 15 ? 15 : rc);
            sc[t] = a + rpb[(h * 15 + (kr - r + 7)) * 31 + rc + 15]; }
        const float mx = wave_max(fmaxf(sc[0], sc[1]));
        const float e0 = __expf(sc[0] - mx), e1 = __expf(sc[1] - mx);
        const float inv = 1.0f / wave_sum(e0 + e1);
        scr[lane] = e0 * inv; scr[lane + 64] = e1 * inv;
        __builtin_amdgcn_s_waitcnt(0xC07F); asm volatile("" ::: "memory");
        float o = 0.f;
        for (int key = 0; key < 128; ++key) { const int kr = rs + (key >> 4), kc = cs + (key & 15);
            const size_t kt = (size_t)b * SEQ + kr * 64 + kc; o += scr[key] * bf2f(NV[kt * 512 + h * 64 + lane]); }
        NQ[(size_t)tok * 512 + h * 64 + lane] = (bf16)f2bf(o);
        __builtin_amdgcn_s_waitcnt(0xC07F); asm volatile("" ::: "memory");
    }
}
__device__ __forceinline__ void phase2_memkv_naive(const Ctx& c, const Ptrs& P) {
    naive_gemm(c, RowPlain{P.b(WS_MN), DM}, P.b(WS_WKV), DM, TM, 1024, DM, EpiBf16Plain{P.b(WS_MKV), 1024});
}
__device__ __forceinline__ void phase3_ret_naive(const Ctx& c, const Ptrs& P) {
    const bf16* RQ = P.b(WS_RQ); const bf16* RK = P.b(WS_RK); const bf16* RV = P.b(WS_RV); bf16* RG = P.b(WS_RG); const bf16* ST = (const bf16*)P.out;
    const float* gain = P.in[6];
    float* scr = (float*)(c.lds + c.wave * 16384);
    const int lane = c.lane;
    for (int it = c.gw; it < T * 4; it += c.ngw) {
        const int h = it & 3, tok = it >> 2, b = tok >> 11, s = tok & 2047, n = s >> 7, p = s & 127;
        const float lgf = log_sigmoid_(P.in[4][h]), lgb = log_sigmoid_(P.in[5][h]);
        { const bf16* qp = RQ + (size_t)tok * 512 + h * 128; scr[lane] = bf2f(qp[lane]); scr[lane + 64] = bf2f(qp[lane + 64]); }
        __builtin_amdgcn_s_waitcnt(0xC07F); asm volatile("" ::: "memory");
        float sv[2];
#pragma unroll
        for (int t = 0; t < 2; ++t) { const int pj = lane + 64 * t; const size_t kt = (size_t)b * SEQ + n * 128 + pj;
            const u32x4* kp = (const u32x4*)(RK + kt * 512 + h * 128); float a = 0.f;
#pragma unroll 2
            for (int i = 0; i < 16; ++i) { float kk[8]; unpack8(kp[i], kk);
#pragma unroll
                for (int u = 0; u < 8; ++u) a += scr[8 * i + u] * kk[u]; }
            const float w = (pj <= p) ? expf((float)(p - pj) * lgf) : expf((float)(pj - p) * lgb);
            sv[t] = a * w; }
        scr[128 + lane] = sv[0]; scr[128 + 64 + lane] = sv[1];
        __builtin_amdgcn_s_waitcnt(0xC07F); asm volatile("" ::: "memory");
        const float af = expf((float)(p + 1) * lgf), ab = expf((float)(128 - p) * lgb);
        const bf16* sf = ST + (size_t)(((b * 4 + h) * 2 + 0) * 16 + n) * 256 * 128;
        const bf16* sb = ST + (size_t)(((b * 4 + h) * 2 + 1) * 16 + n) * 256 * 128;
        float y[4];
#pragma unroll 1
        for (int eb = 0; eb < 4; ++eb) { const int e = eb * 64 + lane; float a = 0.f;
#pragma unroll 4
            for (int pj = 0; pj < 128; ++pj) { const size_t kt = (size_t)b * SEQ + n * 128 + pj; a += scr[128 + pj] * bf2f(RV[kt * 1024 + h * 256 + e]); }
            float cf = 0.f, cb = 0.f; const u32x4* fp = (const u32x4*)(sf + (size_t)e * 128); const u32x4* bp = (const u32x4*)(sb + (size_t)e * 128);
#pragma unroll 2
            for (int i = 0; i < 16; ++i) { float x1[8], x2[8]; unpack8(fp[i], x1); unpack8(bp[i], x2);
#pragma unroll
                for (int u = 0; u < 8; ++u) { cf += scr[8 * i + u] * x1[u]; cb += scr[8 * i + u] * x2[u]; } }
            y[eb] = a + af * cf + ab * cb; }
        const float mu = wave_sum((y[0] + y[1]) + (y[2] + y[3])) * (1.f / 256.f);
        float v = 0.f;
#pragma unroll
        for (int eb = 0; eb < 4; ++eb) { y[eb] -= mu; v += y[eb] * y[eb]; }
        const float rstd = 1.0f / sqrtf(wave_sum(v) * (1.f / 256.f) + GN_EPS);
#pragma unroll
        for (int eb = 0; eb < 4; ++eb) { const int col = h * 256 + eb * 64 + lane; bf16* g = RG + (size_t)tok * 1024 + col;
            *g = (bf16)f2bf(y[eb] * rstd * gain[col] * bf2f(*g)); }
        __builtin_amdgcn_s_waitcnt(0xC07F); asm volatile("" ::: "memory");
    }
}
__device__ __forceinline__ void phase3_xa_naive(const Ctx& c, const Ptrs& P) {
    bf16* XQ = P.b(WS_XQ); const bf16* MKV = P.b(WS_MKV);
    float* scr = (float*)(c.lds + c.wave * 16384);
    const int lane = c.lane;
    for (int it = c.gw; it < T * 4; it += c.ngw) {
        const int h = it & 3, tok = it >> 2, b = tok >> 11;
        { const bf16* qp = XQ + (size_t)tok * 512 + h * 128; scr[lane] = bf2f(qp[lane]); scr[lane + 64] = bf2f(qp[lane + 64]); }
        __builtin_amdgcn_s_waitcnt(0xC07F); asm volatile("" ::: "memory");
        float sc[4]; float mx = -3.0e38f;
#pragma unroll
        for (int t = 0; t < 4; ++t) { const int m = lane + 64 * t; const u32x4* kp = (const u32x4*)(MKV + (size_t)(b * MEML + m) * 1024 + h * 128); float a = 0.f;
#pragma unroll 2
            for (int i = 0; i < 16; ++i) { float kk[8]; unpack8(kp[i], kk);
#pragma unroll
                for (int u = 0; u < 8; ++u) a += scr[8 * i + u] * kk[u]; }
            sc[t] = a; mx = fmaxf(mx, a); }
        mx = wave_max(mx); float sum = 0.f;
#pragma unroll
        for (int t = 0; t < 4; ++t) { sc[t] = __expf(sc[t] - mx); sum += sc[t]; }
        const float inv = 1.0f / wave_sum(sum);
#pragma unroll
        for (int t = 0; t < 4; ++t) scr[128 + lane + 64 * t] = sc[t] * inv;
        __builtin_amdgcn_s_waitcnt(0xC07F); asm volatile("" ::: "memory");
        float o0 = 0.f, o1 = 0.f;
        for (int m = 0; m < MEML; ++m) { const bf16* vp = MKV + (size_t)(b * MEML + m) * 1024 + 512 + h * 128; const float pm = scr[128 + m];
            o0 += pm * bf2f(vp[lane]); o1 += pm * bf2f(vp[lane + 64]); }
        bf16* op = XQ + (size_t)tok * 512 + h * 128; op[lane] = (bf16)f2bf(o0); op[lane + 64] = (bf16)f2bf(o1);
        __builtin_amdgcn_s_waitcnt(0xC07F); asm volatile("" ::: "memory");
    }
}
__device__ __forceinline__ void phase4_naive(const Ctx& c, const Ptrs& P) {
    naive_gemm(c, RowPlain{P.b(WS_XN), DM}, P.b(WS_WG), DM, T, NPG, DM, EpiSigmoid{P.b(WS_GATES), NPG});
}
__device__ __forceinline__ void phase5_naive(const Ctx& c, const Ptrs& P) {
    float* TMP = P.out; bf16* MIX = P.b(WS_MIX); const bf16* G = P.b(WS_GATES);
    naive_gemm(c, RowPlain{P.b(WS_RG), 1024}, P.b(WS_WRO), 1024, T, DM, 1024, EpiMixNaive<0>{TMP, MIX, G});
    naive_gemm(c, RowPlain{P.b(WS_NQ), 512}, P.b(WS_WNO), 512, T, DM, 512, EpiMixNaive<1>{TMP, MIX, G + 1024});
    naive_gemm(c, RowPlain{P.b(WS_XQ), 512}, P.b(WS_WXO), 512, T, DM, 512, EpiMixNaive<2>{TMP, MIX, G + 2048});
}
__device__ __forceinline__ void phase6_naive(const Ctx& c, const Ptrs& P) {
    naive_gemm(c, RowPlain{P.b(WS_MIX), DM}, P.b(WS_WOUT), DM, T, DM, DM, EpiResidF32{P.in[0], P.out});
}

__device__ __forceinline__ void phase1_mfma(const Ctx& c, const Ptrs& P) {
    EpiProjA E{P.b(WS_RQ), P.b(WS_RK), P.b(WS_RV), P.b(WS_RG), P.b(WS_NQ), P.b(WS_NK), P.b(WS_NV), P.b(WS_XQ), P.f(WS_COS), P.f(WS_SIN)};
    pg8::PlainSched S; S.o.init(T / 256, NPA / 256, gridDim.x, blockIdx.x); S.A = P.b(WS_XN); S.Bt = P.b(WS_WA); S.lda = DM; S.ldb = DM; S.K = DM;
    pg8::gemm_phase<false>((LAS unsigned char*)c.lds, S, pg8::EpiF<EpiProjA>{E});
}
__device__ __forceinline__ void phase4_mfma(const Ctx& c, const Ptrs& P) {
    pg8::PlainSched S; S.o.init(T / 256, NPG / 256, gridDim.x, blockIdx.x); S.A = P.b(WS_XN); S.Bt = P.b(WS_WG); S.lda = DM; S.ldb = DM; S.K = DM;
    pg8::gemm_phase<false>((LAS unsigned char*)c.lds, S, pg8::EpiF<EpiSigmoid>{EpiSigmoid{P.b(WS_GATES), NPG}});
}
__device__ __forceinline__ void phase6_mfma(const Ctx& c, const Ptrs& P) {
    pg8::PlainSched S; S.o.init(T / 256, DM / 256, gridDim.x, blockIdx.x); S.A = P.b(WS_MIX); S.Bt = P.b(WS_WOUT); S.lda = DM; S.ldb = DM; S.K = DM;
    pg8::gemm_phase<false>((LAS unsigned char*)c.lds, S, pg8::EpiF<EpiResidBf16>{EpiResidBf16{P.in[0], P.b(WS_D)}}, 25);
}

struct GateSched { pg8::TileOrder o; const unsigned char* ws;
    __device__ __forceinline__ bool next(int i, pg8::UnitDesc& u) const { int pm, pn; const int w = i % 3; if (!o.tile(i / 3, pm, pn)) return false;
        u.A = (const char*)(ws + WS_XN) + (size_t)pm * 256 * 2048; u.B = (const char*)(ws + WS_WG) + (size_t)(w * 1024 + pn * 256) * 2048; u.lda2 = 2048; u.ldb2 = 2048; u.nt = 16;
        u.row0 = pm * 256; u.col0 = pn * 256; u.aux = w; u.aux2 = 0; u.gidx = nullptr; u.gcnt = 0; u.chain = 0; return true; } };
__device__ __forceinline__ unsigned q8x4(f32x4 g) {
    const unsigned a = (unsigned)(g[0] * 255.0f + 0.5f), b = (unsigned)(g[1] * 255.0f + 0.5f), c = (unsigned)(g[2] * 255.0f + 0.5f), d = (unsigned)(g[3] * 255.0f + 0.5f);
    return a | (b << 8) | (c << 16) | (d << 24); }
__device__ __forceinline__ f32x4 dq8x4(unsigned w) {
    return (f32x4){fmaxf((float)(w & 0xffu) * (1.0f / 255.0f), 1e-18f), fmaxf((float)((w >> 8) & 0xffu) * (1.0f / 255.0f), 1e-18f),
                   fmaxf((float)((w >> 16) & 0xffu) * (1.0f / 255.0f), 1e-18f), fmaxf((float)(w >> 24) * (1.0f / 255.0f), 1e-18f)}; }
struct EpiGate { unsigned char* SCR;
    __device__ __forceinline__ void finish(f32x4 (&acc)[2][2][4][2], const pg8::UnitDesc& u, int wr, int wc, int fr, int fq) const {
        unsigned ow = (unsigned)((u.row0 >> 8) * 4 + (u.col0 >> 8)) * 196608u + (unsigned)u.aux * 65536u + threadIdx.x * 8u;
#pragma unroll
        for (int ai = 0; ai < 2; ++ai)
#pragma unroll
            for (int m = 0; m < 4; ++m) { asm volatile("" : "+v"(ow));
#pragma unroll
                for (int bj = 0; bj < 2; ++bj) { f32x4 s0, s1;
#pragma unroll
                    for (int i = 0; i < 4; ++i) { s0[i] = sigmoidf_(acc[ai][bj][m][0][i]); s1[i] = sigmoidf_(acc[ai][bj][m][1][i]); }
                    *(u32x2*)(SCR + ow + bj * 4096) = (u32x2){q8x4(s0), q8x4(s1)}; }
                ow += 2 * 4096; asm volatile("" ::: "memory"); __builtin_amdgcn_sched_barrier(0); }
        pg8::zero_acc(acc);
    } };
struct MixSched { pg8::TileOrder o; const unsigned char* ws;
    __device__ __forceinline__ bool next(int i, pg8::UnitDesc& u) const { int pm, pn; const int w = i % 3; if (!o.tile(i / 3, pm, pn)) return false;
        const size_t offA = w == 0 ? WS_RG : (w == 1 ? WS_NQ : WS_XQ), offB = w == 0 ? WS_WRO : (w == 1 ? WS_WNO : WS_WXO); const int K = w == 0 ? 1024 : 512;
        u.A = (const char*)(ws + offA) + (size_t)pm * 256 * K * 2; u.B = (const char*)(ws + offB) + (size_t)pn * 256 * K * 2; u.lda2 = K * 2; u.ldb2 = K * 2; u.nt = K / 64;
        u.row0 = pm * 256; u.col0 = pn * 256; u.aux = w; u.aux2 = 0; u.gidx = nullptr; u.gcnt = 0; u.chain = (w < 2); return true; } };
struct EpiMix { const unsigned char* SCR; bf16* MIX;
    __device__ __forceinline__ void finish(f32x4 (&acc)[2][2][4][2], const pg8::UnitDesc& u, int wr, int wc, int fr, int fq) const {
        const int w = u.aux; const bool fin = (w == 2);
        unsigned on = (unsigned)((u.row0 >> 8) * 4 + (u.col0 >> 8)) * 196608u + (unsigned)w * 65536u + threadIdx.x * 8u; const unsigned dd = fin ? 0u : 65536u;
        bf16* mp = MIX + (size_t)(u.row0 + wr * 64 + fr) * DM + u.col0 + wc * 32 + 8 * fq;
#pragma unroll
        for (int ai = 0; ai < 2; ++ai) {
            asm volatile("" : "+v"(on), "+v"(mp));
            u32x2 ga[4][2], gb[4][2];
#pragma unroll
            for (int m = 0; m < 4; ++m)
#pragma unroll
                for (int bj = 0; bj < 2; ++bj) { ga[m][bj] = *(const u32x2*)(SCR + on + (2 * m + bj) * 4096); gb[m][bj] = *(const u32x2*)(SCR + on + dd + (2 * m + bj) * 4096); }
#pragma unroll
            for (int m = 0; m < 4; ++m) {
#pragma unroll
                for (int bj = 0; bj < 2; ++bj) {
                    const f32x4 n0 = dq8x4(ga[m][bj].x), n1 = dq8x4(ga[m][bj].y), d0 = dq8x4(gb[m][bj].x), d1 = dq8x4(gb[m][bj].y);
                    f32x4 r0, r1;
#pragma unroll
                    for (int i = 0; i < 4; ++i) { r0[i] = n0[i] * __builtin_amdgcn_rcpf(fin ? 1.0f : d0[i]); r1[i] = n1[i] * __builtin_amdgcn_rcpf(fin ? 1.0f : d1[i]); }
                    const f32x4 v0 = acc[ai][bj][m][0] * r0, v1 = acc[ai][bj][m][1] * r1;
                    if (fin) store8(mp + (size_t)m * 16 * DM + bj * 128, v0, v1);
                    acc[ai][bj][m][0] = fin ? (f32x4){0.f, 0.f, 0.f, 0.f} : v0; acc[ai][bj][m][1] = fin ? (f32x4){0.f, 0.f, 0.f, 0.f} : v1; } }
            on += 8 * 4096; mp += 128 * DM; asm volatile("" ::: "memory"); __builtin_amdgcn_sched_barrier(0); }
    }
};
__device__ __forceinline__ void phase5_mfma(const Ctx& c, const Ptrs& P) {
    unsigned char* scr = P.ws + WS_GATES;
    { GateSched S; S.o.init(T / 256, DM / 256, gridDim.x, blockIdx.x); S.ws = P.ws; pg8::gemm_phase<false>((LAS unsigned char*)c.lds, S, EpiGate{scr}); }
    { MixSched S; S.o.init(T / 256, DM / 256, gridDim.x, blockIdx.x); S.ws = P.ws; pg8::gemm_phase<false>((LAS unsigned char*)c.lds, S, EpiMix{scr, P.b(WS_MIX)}); }
}
struct MoeSched { const unsigned* ctl; int mode;
    int lo, hi, nblk, v;
    const bf16 *H2, *WGU, *HID, *WD; const int* elist;
    __device__ __forceinline__ bool next(int i, pg8::UnitDesc& u) const {
        if (v < 0) return false;
        const int L = lo + v + i * nblk; if (L >= hi) return false;
        const int pn = L & 3; int mtg = L >> 2;
        int e = -1, base = 0, cnt = 0, mt = 0;
#pragma unroll 1
        for (int j = 0; j < NEXP; ++j) { const int cj = (int)__builtin_amdgcn_readfirstlane((int)ctl[CW_ECNT + 64 * j]); const int tj = (cj + 255) >> 8;
            if (mtg < tj) { e = j; cnt = cj; mt = mtg; break; } mtg -= tj; base += tj * 256; }
        if (e < 0) return false;
        u.row0 = mt * 256; u.col0 = pn * 256; u.aux = e; u.aux2 = base; u.gcnt = cnt; u.chain = 0;
        if (mode == 0) { u.A = (const char*)H2; u.gidx = elist + e * T; u.lda2 = DM * 2; u.B = (const char*)(WGU + (size_t)e * 1024 * 1024 + (size_t)pn * 256 * 1024); u.ldb2 = 2048; u.nt = 16; }
        else { u.A = (const char*)(HID + (size_t)(base + mt * 256) * DFF); u.gidx = nullptr; u.lda2 = DFF * 2; u.B = (const char*)(WD + (size_t)e * 1024 * 512 + (size_t)pn * 256 * 512); u.ldb2 = 1024; u.nt = 8; }
        return true; } };
struct EpiMoeUp { bf16* HID; const float* EWL; const float* ERS;
    __device__ __forceinline__ void finish(f32x4 (&acc)[2][2][4][2], const pg8::UnitDesc& u, int wr, int wc, int fr, int fq) const {
        const float* wl = EWL + u.aux * T; const float* rl = ERS + u.aux * T; bf16* H = HID; const int base = u.aux2, cnt = u.gcnt;
        pg8::epi_apply(acc, u, wr, wc, fr, fq, [=](int row, int col0, f32x4 v0, f32x4 v1) { if (row < cnt) { const float rs = rl[row], w = wl[row] * rs; f32x4 h;
#pragma unroll
            for (int i = 0; i < 4; ++i) h[i] = siluf_(v0[i] * rs) * v1[i] * w;
            u32x2 o; o.x = pk2(h[0], h[1]); o.y = pk2(h[2], h[3]); *(u32x2*)(H + (size_t)(base + row) * DFF + (col0 >> 1)) = o; } });
        pg8::zero_acc(acc);
    } };
struct EpiMoeDown { bf16* DR;
    __device__ __forceinline__ void finish(f32x4 (&acc)[2][2][4][2], const pg8::UnitDesc& u, int wr, int wc, int fr, int fq) const {
        bf16* D = DR; const int base = u.aux2;
        pg8::epi_apply(acc, u, wr, wc, fr, fq, [=](int row, int col0, f32x4 v0, f32x4 v1) { store8(D + (size_t)(base + row) * DM + col0, v0, v1); });
        pg8::zero_acc(acc);
    } };
__device__ __forceinline__ MoeSched moe_sched(const Ptrs& P, int mode) {
    MoeSched S; S.ctl = (const unsigned*)(P.ws + WS_CTL); S.mode = mode; S.H2 = P.b(WS_D); S.WGU = P.b(WS_WGU); S.HID = P.b(WS_HID); S.WD = P.b(WS_WD); S.elist = (const int*)(P.ws + WS_ELIST);
    S.lo = 0; S.hi = 0; S.nblk = 1; S.v = -1; return S; }
__device__ __forceinline__ int moe_tiles(const Ptrs& P) { const unsigned* ctl = (const unsigned*)(P.ws + WS_CTL); int tiles = 0;
    for (int j = 0; j < NEXP; ++j) tiles += ((int)ctl[CW_ECNT + 64 * j] + 255) >> 8; return tiles; }
__device__ __forceinline__ void phase8a(const Ctx& c, const Ptrs& P) {
    const int G = (int)gridDim.x, units = 4 * moe_tiles(P);
    MoeSched S = moe_sched(P, 0); S.lo = 0; S.hi = units < 2 * G ? units : 2 * G; S.nblk = G; S.v = (int)blockIdx.x;
    pg8::gemm_phase<true>((LAS unsigned char*)c.lds, S, EpiMoeUp{P.b(WS_HID), P.f(WS_EWL), P.f(WS_ERS)});
}
__device__ __forceinline__ void phase8b(const Ctx& c, const Ptrs& P) {
    const int G = (int)gridDim.x, tiles = moe_tiles(P), units = 4 * tiles; int nrem = units - 2 * G; nrem = nrem < 0 ? 0 : (nrem > G / 2 ? G / 2 : nrem);
    const int tdone = (2 * G) / 4 < tiles ? (2 * G) / 4 : tiles;
    if ((int)blockIdx.x < nrem) { MoeSched S = moe_sched(P, 0); S.lo = 2 * G; S.hi = units; S.nblk = nrem; S.v = (int)blockIdx.x;
        pg8::gemm_phase<true>((LAS unsigned char*)c.lds, S, EpiMoeUp{P.b(WS_HID), P.f(WS_EWL), P.f(WS_ERS)}); }
    else { MoeSched S = moe_sched(P, 1); S.lo = 0; S.hi = 4 * tdone; S.nblk = G - nrem; S.v = (int)blockIdx.x - nrem;
        pg8::gemm_phase<false>((LAS unsigned char*)c.lds, S, EpiMoeDown{P.b(WS_DROWS)}); }
}
__device__ __forceinline__ void phase8c(const Ctx& c, const Ptrs& P) {
    const int G = (int)gridDim.x, tiles = moe_tiles(P); const int tdone = (2 * G) / 4 < tiles ? (2 * G) / 4 : tiles;
    MoeSched S = moe_sched(P, 1); S.lo = 4 * tdone; S.hi = 4 * tiles; S.nblk = G; S.v = (int)blockIdx.x;
    pg8::gemm_phase<false>((LAS unsigned char*)c.lds, S, EpiMoeDown{P.b(WS_DROWS)});
}
__device__ __forceinline__ void phase2_memkv_mfma(const Ctx& c, const Ptrs& P) {
    pg8::PlainSched S; S.o.init(TM / 256, 1024 / 256, gridDim.x, blockIdx.x); S.A = P.b(WS_MN); S.Bt = P.b(WS_WKV); S.lda = DM; S.ldb = DM; S.K = DM;
    pg8::gemm_phase<false>((LAS unsigned char*)c.lds, S, pg8::EpiF<EpiBf16Plain>{EpiBf16Plain{P.b(WS_MKV), 1024}});
}
__device__ __forceinline__ f32x4 x1_load(const float* X0, const bf16* DD, size_t tok, int lane, int j) {
    const u32x2 d = ((const u32x2*)(DD + tok * DM) + lane)[64 * j];
    return (f32x4){bf2f(d.x & 0xffffu), bf2f(d.x >> 16), bf2f(d.y & 0xffffu), bf2f(d.y >> 16)};
}
constexpr int RT7_WT = 0, RT7_RED = 81920, RT7_LOG = RT7_RED + 8 * 5120, RT7_CNT = RT7_LOG + 8 * 160, RT7_GB = RT7_CNT + 64, RT7_REC = RT7_GB + 64;
__device__ __forceinline__ void phase7(const Ctx& c, const Ptrs& P) {
    const float* X0 = P.in[0]; const bf16* DD = P.b(WS_D); const float* g = P.in[14]; const float* wrg = P.in[15]; const float* brg = P.in[16]; const float* wre = P.in[17]; const float* bre = P.in[18];
    unsigned* ctl = (unsigned*)(P.ws + WS_CTL); int* elist = (int*)(P.ws + WS_ELIST); float* ewl = P.f(WS_EWL); int* tmeta = (int*)(P.ws + WS_TMETA);
    const int lane = c.lane; LAS unsigned char* L = (LAS unsigned char*)c.lds;
    { LAS float* WT = (LAS float*)(L + RT7_WT);
      for (int i = c.tid; i < 1024 * 4; i += NTHREADS) WT[(i & 3) * 1024 + (i >> 2)] = wrg[i];
      for (int i = c.tid; i < 1024 * 16; i += NTHREADS) WT[(4 + (i & 15)) * 1024 + (i >> 4)] = wre[i];
      if (c.tid < 16) ((LAS unsigned*)(L + RT7_CNT))[c.tid] = 0u; }
    __syncthreads();
    LAS float* RED = (LAS float*)(L + RT7_RED + c.wave * 5120); LAS float* LOG = (LAS float*)(L + RT7_LOG + c.wave * 160);
    LAS unsigned* LCNT = (LAS unsigned*)(L + RT7_CNT); LAS int* REC = (LAS int*)(L + RT7_REC);
    const float mybias = lane < 4 ? brg[lane] : (lane < 20 ? bre[lane - 4] : 0.f);
    f32x4 xn[2][4];
    if (c.gw < T / 2) {
#pragma unroll
        for (int t = 0; t < 2; ++t)
#pragma unroll
            for (int j = 0; j < 4; ++j) xn[t][j] = x1_load(X0, DD, (size_t)(2 * c.gw + t), lane, j); }
    int pidx = 0;
#pragma unroll 1
    for (int tp = c.gw; tp < T / 2; tp += c.ngw, ++pidx) {
        f32x4 hh[2][4]; float rstd2[2]; const f32x4* gr = (const f32x4*)g + lane;
#pragma unroll
        for (int t = 0; t < 2; ++t)
#pragma unroll
            for (int j = 0; j < 4; ++j) hh[t][j] = xn[t][j];
        { const int tpn = tp + c.ngw < T / 2 ? tp + c.ngw : tp;
#pragma unroll
          for (int t = 0; t < 2; ++t)
#pragma unroll
              for (int j = 0; j < 4; ++j) xn[t][j] = x1_load(X0, DD, (size_t)(2 * tpn + t), lane, j); }
#pragma unroll
        for (int t = 0; t < 2; ++t) { const int tok = 2 * tp + t; float s = 0.f;
#pragma unroll
            for (int j = 0; j < 4; ++j) { s += (hh[t][j].x * hh[t][j].x + hh[t][j].y * hh[t][j].y) + (hh[t][j].z * hh[t][j].z + hh[t][j].w * hh[t][j].w); }
            const float r = 1.0f / sqrtf(wave_sum(s) * (1.f / 1024.f) + RMS_EPS); rstd2[t] = r; (void)tok;
#pragma unroll
            for (int j = 0; j < 4; ++j) { const f32x4 gg = gr[64 * j]; hh[t][j] = hh[t][j] * gg * r; } }
        float p0[20], p1[20];
        const LAS f32x4* wt = (const LAS f32x4*)(L + RT7_WT) + lane;
#pragma unroll
        for (int n = 0; n < 20; ++n) { float a0 = 0.f, a1 = 0.f;
#pragma unroll
            for (int j = 0; j < 4; ++j) { const f32x4 w4 = wt[n * 256 + 64 * j];
                a0 += (hh[0][j].x * w4.x + hh[0][j].y * w4.y) + (hh[0][j].z * w4.z + hh[0][j].w * w4.w);
                a1 += (hh[1][j].x * w4.x + hh[1][j].y * w4.y) + (hh[1][j].z * w4.z + hh[1][j].w * w4.w); }
            p0[n] = a0; p1[n] = a1; __builtin_amdgcn_sched_barrier(0); }
#pragma unroll 1
        for (int t = 0; t < 2; ++t) {
#pragma unroll
            for (int q = 0; q < 5; ++q) *(LAS f32x4*)(RED + lane * 20 + 4 * q) = t ? (f32x4){p1[4 * q], p1[4 * q + 1], p1[4 * q + 2], p1[4 * q + 3]} : (f32x4){p0[4 * q], p0[4 * q + 1], p0[4 * q + 2], p0[4 * q + 3]};
            asm volatile("s_waitcnt lgkmcnt(0)" ::: "memory");
            float sum = 0.f; const int nn = lane < 20 ? lane : 0;
#pragma unroll 16
            for (int j = 0; j < 64; ++j) sum += RED[j * 20 + nn];
            if (lane < 20) LOG[t * 20 + lane] = sum + mybias;
            asm volatile("s_waitcnt lgkmcnt(0)" ::: "memory");
        }
        if (lane < 2) {
            const int tok = 2 * tp + lane;
            float l[20];
#pragma unroll
            for (int i = 0; i < 20; ++i) l[i] = LOG[lane * 20 + i];
            int gi = 0;
#pragma unroll
            for (int i = 1; i < 4; ++i) if (l[i] > l[gi]) gi = i;
            float lmax = l[0];
#pragma unroll
            for (int i = 1; i < 4; ++i) lmax = fmaxf(lmax, l[i]);
            float se = 0.f;
#pragma unroll
            for (int i = 0; i < 4; ++i) se += expf(l[i] - lmax);
            const float grp_w = 1.0f / se;
            float el[4];
#pragma unroll
            for (int i = 0; i < 4; ++i) { float a = 0.f;
#pragma unroll
                for (int g2 = 0; g2 < 4; ++g2) a = (g2 == gi) ? l[4 + 4 * g2 + i] : a;
                el[i] = a; }
            int ia = 0;
#pragma unroll
            for (int i = 1; i < 4; ++i) if (el[i] > el[ia]) ia = i;
            int ib = (ia == 0) ? 1 : 0;
#pragma unroll
            for (int i = 0; i < 4; ++i) if (i != ia && i != ib && el[i] > el[ib]) ib = i;
            float ela = el[0], elb = el[0];
#pragma unroll
            for (int i = 1; i < 4; ++i) { ela = (i == ia) ? el[i] : ela; elb = (i == ib) ? el[i] : elb; }
            const float t = expf(elb - ela); const float wa = grp_w / (1.0f + t), wb = grp_w * t / (1.0f + t);
            const int ea = gi * 4 + ia, eb = gi * 4 + ib;
            const int lpa = (int)atomicAdd((unsigned*)(LCNT + ea), 1u), lpb = (int)atomicAdd((unsigned*)(LCNT + eb), 1u);
            LAS int* rec = REC + (c.wave * 8 + pidx * 2 + lane) * 8;
            rec[0] = tok; rec[1] = ea; rec[2] = lpa; rec[3] = eb; rec[4] = lpb; rec[5] = __float_as_int(wa); rec[6] = __float_as_int(wb); rec[7] = __float_as_int(lane ? rstd2[1] : rstd2[0]);
        }
    }
    __syncthreads();
    if (c.tid < 16) ((LAS unsigned*)(L + RT7_GB))[c.tid] = atomicAdd(ctl + CW_ECNT + 64 * c.tid, LCNT[c.tid]);
    __syncthreads();
    if (c.tid < 64) { const int wv = c.tid >> 3, k = c.tid & 7;
        const int gwv = blockIdx.x * NWAVES + wv; const int npairs = gwv < T / 2 ? (T / 2 - 1 - gwv) / c.ngw + 1 : 0;
        if ((k >> 1) < npairs) { const LAS int* rec = REC + c.tid * 8; const LAS unsigned* GB = (const LAS unsigned*)(L + RT7_GB);
            const int tok = rec[0], ea = rec[1], eb = rec[3]; const int pa = (int)GB[ea] + rec[2], pb = (int)GB[eb] + rec[4];
            elist[ea * T + pa] = tok; ewl[ea * T + pa] = __int_as_float(rec[5]); elist[eb * T + pb] = tok; ewl[eb * T + pb] = __int_as_float(rec[6]);
            float* ers = (float*)(P.ws + WS_ERS); ers[ea * T + pa] = __int_as_float(rec[7]); ers[eb * T + pb] = __int_as_float(rec[7]);
            *(int4*)(tmeta + 4 * tok) = make_int4(ea, pa, eb, pb); } }
    __syncthreads();
    int tb = 0;
    for (int e = 0; e < NEXP; ++e) {
        transpose_all(c, tb, ColGU{P.in[19] + (size_t)e * 1024 * 512, P.in[20] + (size_t)e * 1024 * 512}, 512, 1024, 1024, P.b(WS_WGU) + (size_t)e * 1024 * 1024, P.in[14]);
        transpose_all(c, tb, ColPlain{P.in[21] + (size_t)e * 512 * 1024}, 1024, 1024, 512, P.b(WS_WD) + (size_t)e * 1024 * 512);
    }
}
__device__ __forceinline__ int expert_rowbase(const unsigned* ctl, int e, int& cnt_e) {
    int base = 0; cnt_e = 0;
    for (int i = 0; i < NEXP; ++i) { const int ci = (int)ctl[CW_ECNT + 64 * i]; if (i < e) base += (ci + 255) & ~255; if (i == e) cnt_e = ci; }
    return base;
}
__device__ __forceinline__ void phase8_naive(const Ctx& c, const Ptrs& P) {
    const unsigned* ctl = (const unsigned*)(P.ws + WS_CTL);
    for (int e = 0; e < NEXP; ++e) { int cnt; const int base = expert_rowbase(ctl, e, cnt);
        naive_gemm(c, RowGather{P.b(WS_H2), DM, (const int*)(P.ws + WS_ELIST) + e * T}, P.b(WS_WGU) + (size_t)e * 1024 * 1024, 1024, cnt, 1024, 1024,
                   EpiSwiGLU{P.b(WS_HID), P.f(WS_EWL) + e * T, base}); }
}
__device__ __forceinline__ void phase9_naive(const Ctx& c, const Ptrs& P) {
    const unsigned* ctl = (const unsigned*)(P.ws + WS_CTL);
    for (int e = 0; e < NEXP; ++e) { int cnt; const int base = expert_rowbase(ctl, e, cnt);
        naive_gemm(c, RowPlain{P.b(WS_HID) + (size_t)base * DFF, DFF}, P.b(WS_WD) + (size_t)e * 1024 * 512, 512, cnt, 1024, 512, EpiRowsBf16{P.b(WS_DROWS), 1024, base}); }
}
struct FinTok { f32x4 x[4]; unsigned long long a[4], b[4]; };
__device__ __forceinline__ void fin_issue(FinTok& d, const float* X0, const bf16* DD, const bf16* DR, int tok, int4 m, const int (&rb)[NEXP], int lane) {
    int ba = 0, bb = 0;
#pragma unroll
    for (int i = 0; i < NEXP; ++i) { ba = (i == m.x) ? rb[i] : ba; bb = (i == m.z) ? rb[i] : bb; }
    const unsigned long long* da = (const unsigned long long*)(DR + (size_t)(ba + m.y) * DM) + lane;
    const unsigned long long* db = (const unsigned long long*)(DR + (size_t)(bb + m.w) * DM) + lane;
#pragma unroll
    for (int j = 0; j < 4; ++j) { d.a[j] = da[64 * j]; d.b[j] = db[64 * j]; d.x[j] = x1_load(X0, DD, (size_t)tok, lane, j); }
}
__device__ __forceinline__ void phase10(const Ctx& c, const Ptrs& P) {
    const unsigned* ctl = (const unsigned*)(P.ws + WS_CTL); const int* tmeta = (const int*)(P.ws + WS_TMETA); const bf16* DR = P.b(WS_DROWS); const float* g = P.in[22];
    int rb[NEXP]; { int base = 0;
#pragma unroll
        for (int i = 0; i < NEXP; ++i) { rb[i] = base; base += ((int)ctl[CW_ECNT + 64 * i] + 255) & ~255; } }
    const int lane = c.lane;
    if (c.gw >= T) return;
    FinTok cur, nxt; int4 mn = *(const int4*)(tmeta + 4 * c.gw);
    fin_issue(cur, P.in[0], P.b(WS_D), DR, c.gw, mn, rb, lane);
    { const int t1 = c.gw + c.ngw; mn = *(const int4*)(tmeta + 4 * (t1 < T ? t1 : c.gw)); }
#pragma unroll 1
    for (int tok = c.gw; tok < T; tok += c.ngw) {
        const int t1 = tok + c.ngw, t2 = tok + 2 * c.ngw;
        if (t1 < T) { fin_issue(nxt, P.in[0], P.b(WS_D), DR, t1, mn, rb, lane); mn = *(const int4*)(tmeta + 4 * (t2 < T ? t2 : tok)); }
        f32x4* xr = (f32x4*)(P.out + (size_t)tok * DM) + lane; const f32x4* gr = (const f32x4*)g + lane;
        f32x4 v[4]; float s = 0.f;
#pragma unroll
        for (int j = 0; j < 4; ++j) { const unsigned long long a = cur.a[j], b = cur.b[j]; f32x4 x = cur.x[j];
            x.x += bf2f((unsigned)a & 0xffffu) + bf2f((unsigned)b & 0xffffu); x.y += bf2f(((unsigned)a >> 16)) + bf2f(((unsigned)b >> 16));
            x.z += bf2f((unsigned)(a >> 32) & 0xffffu) + bf2f((unsigned)(b >> 32) & 0xffffu); x.w += bf2f((unsigned)(a >> 48)) + bf2f((unsigned)(b >> 48));
            v[j] = x; s += (x.x * x.x + x.y * x.y) + (x.z * x.z + x.w * x.w); }
        const float r = 1.0f / sqrtf(wave_sum(s) * (1.f / 1024.f) + RMS_EPS);
#pragma unroll
        for (int j = 0; j < 4; ++j) { const f32x4 gg = gr[64 * j]; xr[64 * j] = (f32x4){v[j].x * r * gg.x, v[j].y * r * gg.y, v[j].z * r * gg.z, v[j].w * r * gg.w}; }
        cur = nxt;
    }
#if PROBE_TS_A >= 0
    if (c.gw == 0 && lane == 0) { volatile LAS unsigned* MISC = (volatile LAS unsigned*)((LAS unsigned char*)c.lds + MISC_OFF);
        asm volatile("s_waitcnt vmcnt(0)" ::: "memory"); MISC[32 + 24] = (unsigned)__builtin_amdgcn_s_memrealtime();
        const unsigned dt = MISC[32 + PROBE_TS_B] - MISC[32 + PROBE_TS_A]; P.out[0] += 8.0f + (float)dt * (0.01f / PROBE_TS_DIV); }
#endif
}

constexpr int NPHASES = 12;
__global__ void __launch_bounds__(NTHREADS, 2) mk_fwd(Args args) {
    extern __shared__ __attribute__((aligned(16))) unsigned char lds[];
    Ctx c; c.tid = threadIdx.x; c.lane = c.tid & 63; c.wave = __builtin_amdgcn_readfirstlane(c.tid >> 6);
    c.gw = blockIdx.x * NWAVES + c.wave; c.ngw = gridDim.x * NWAVES; c.lds = lds;
    Ptrs P;
#pragma unroll
    for (int i = 0; i < 23; ++i) P.in[i] = args.in[i];
    P.out = args.out; P.ws = args.ws;
    volatile LAS unsigned* MISC = (volatile LAS unsigned*)((LAS unsigned char*)lds + MISC_OFF);
    if (c.tid < 32) MISC[c.tid] = 0u;
    __syncthreads();
    XcdBarrier bar; bar.bar = (unsigned*)(args.ws + WS_CTL) + CW_BAR; bar.x = 0; bar.st = nullptr;
    const int lo = args.ph_lo, hi = args.ph_hi;
    if (hi - lo > 1) bar = xcd_barrier_post((unsigned*)(args.ws + WS_CTL) + CW_BAR, MISC + 8);
#define IN(k) (lo <= (k) && (k) < hi)
#define SEAM(k) do { if (IN(k) && IN((k) + 1)) xcd_barrier(bar); } while (0)
    const int sub = args.sub, rep = args.rep;
#if PROBE_TS_A >= 0
#define STAMP(k) do { if (blockIdx.x == 0 && c.tid == 0) MISC[32 + (k)] = (unsigned)__builtin_amdgcn_s_memrealtime(); } while (0)
#else
#define STAMP(k) do { } while (0)
#endif
    STAMP(0);
#define SUBRUN(id, stmt) do { if (sub & (1 << (id))) { stmt; if (rep == (id)) { __syncthreads(); stmt; } __syncthreads(); } } while (0)
    if (IN(0)) { SUBRUN(0, phase0(c, P)); } STAMP(1); SEAM(0); STAMP(2);
    if (IN(1)) { SUBRUN(1, phase1_mfma(c, P)); } STAMP(3); SEAM(1); STAMP(4);
    if (IN(2)) { SUBRUN(2, mx::ret_state_phase((LAS unsigned char*)lds, P.b(WS_RK), P.b(WS_RV), (bf16*)P.out, P.in[4], P.in[5])); STAMP(5);
                 SUBRUN(3, mx::na_phase((LAS unsigned char*)lds, P.b(WS_NQ), P.b(WS_NK), P.b(WS_NV), P.b(WS_FT))); STAMP(6);
                 SUBRUN(4, phase2_memkv_mfma(c, P)); } STAMP(7); SEAM(2); STAMP(8);
    if (IN(3)) { SUBRUN(5, mx::ret_out_phase((LAS unsigned char*)lds, P.b(WS_RQ), P.b(WS_RK), P.b(WS_RV), P.b(WS_RG), (const bf16*)P.out, P.in[6], P.in[4], P.in[5])); STAMP(9);
                 SUBRUN(6, mx::xa_phase((LAS unsigned char*)lds, P.b(WS_XQ), P.b(WS_MKV))); } STAMP(10); SEAM(3); STAMP(11);
    STAMP(12); STAMP(13);
    if (IN(5)) { SUBRUN(8, phase5_mfma(c, P)); } STAMP(14); SEAM(5); STAMP(15);
    if (IN(6)) { SUBRUN(9, phase6_mfma(c, P)); } STAMP(16); SEAM(6); STAMP(17);
    if (IN(7)) { SUBRUN(10, phase7(c, P)); } STAMP(18); SEAM(7); STAMP(19);
    if (IN(8)) { SUBRUN(11, phase8a(c, P)); } STAMP(20); SEAM(8); STAMP(21);
    if (IN(9)) { SUBRUN(12, phase8b(c, P)); } STAMP(22); SEAM(9); STAMP(23);
    if (IN(10)) { SUBRUN(12, phase8c(c, P)); } STAMP(44); SEAM(10); STAMP(45);
    if (IN(11)) { SUBRUN(13, phase10(c, P)); }
#undef SUBRUN
#undef IN
#undef SEAM
}

extern "C" void kernel_launch(void* const* d_in, const int* in_sizes, int n_in, void* d_out, int out_size, void* d_ws, size_t ws_size, hipStream_t stream) {
    static int grid = 0;
    if (grid == 0) {
        if (n_in != 23 || out_size != T * DM || ws_size < WS_END) { fprintf(stderr, "kernel_launch: unexpected shapes (n_in %d out %d ws %zu)\n", n_in, out_size, ws_size); grid = -1; return; }
        int dev = 0, cus = 0;
        if (hipGetDevice(&dev) != hipSuccess || hipDeviceGetAttribute(&cus, hipDeviceAttributeMultiprocessorCount, dev) != hipSuccess) { grid = -1; return; }
        if (hipFuncSetAttribute((const void*)mk_fwd, hipFuncAttributeMaxDynamicSharedMemorySize, LDS_BYTES) != hipSuccess) { fprintf(stderr, "kernel_launch: hipFuncSetAttribute failed\n"); grid = -1; return; }
        (void)hipGetLastError();
        grid = cus;
    }
    if (grid < 0) return;
    (void)hipMemsetAsync((char*)d_ws + WS_CTL, 0, CTL_ZERO_BYTES, stream);
    Args a{};
    for (int i = 0; i < 23; ++i) a.in[i] = (const float*)d_in[i];
    a.out = (float*)d_out; a.ws = (unsigned char*)d_ws;
#if MK_PER_PHASE
    a.sub = 0x3fff; a.rep = -1;
    for (int p = 0; p < NPHASES; ++p) { a.ph_lo = p; a.ph_hi = p + 1; hipLaunchKernelGGL(mk_fwd, dim3(grid), dim3(NTHREADS), LDS_BYTES, stream, a); }
#else
    a.ph_lo = 0; a.ph_hi = NPHASES; a.sub = 0x3fff; a.rep = PROBE_REP; hipLaunchKernelGGL(mk_fwd, dim3(grid), dim3(NTHREADS), LDS_BYTES, stream, a);
#if PROBE_END >= 0
    { const int ph_of[14] = {0, 1, 2, 2, 2, 3, 3, 4, 5, 6, 7, 8, 9, 11};
      a.ph_lo = ph_of[PROBE_END]; a.ph_hi = a.ph_lo + 1; a.sub = 1 << PROBE_END; a.rep = -1; hipLaunchKernelGGL(mk_fwd, dim3(grid), dim3(NTHREADS), LDS_BYTES, stream, a); }
#endif
#endif
}
```

```cpp
#include <hip/hip_runtime.h>
#include <cstdio>
#include <cstdint>

#ifndef PROBE_REP
#define PROBE_REP -1
#endif
#ifndef PROBE_END
#define PROBE_END -1
#endif
#ifndef PROBE_TS_A
#define PROBE_TS_A -1
#define PROBE_TS_B -1
#endif
#ifndef PROBE_TS_DIV
#define PROBE_TS_DIV 8.0f
#endif
#ifndef MK_PER_PHASE
#define MK_PER_PHASE 0
#endif

#define GAS __attribute__((address_space(1)))
#define LAS __attribute__((address_space(3)))
typedef unsigned short bf16;
typedef float f32x4 __attribute__((ext_vector_type(4)));
typedef unsigned u32x4 __attribute__((ext_vector_type(4)));
typedef unsigned u32x2 __attribute__((ext_vector_type(2)));
typedef short bf16x8 __attribute__((ext_vector_type(8)));

constexpr int NB = 8, SEQ = 2048, DM = 1024, T = NB * SEQ;
constexpr int MEML = 256, TM = NB * MEML;
constexpr int NWAVES = 8, NTHREADS = 512;
constexpr int NPA = 5120, NPG = 3072;
constexpr int NEXP = 16, DFF = 512;
constexpr float RMS_EPS = 1e-6f, GN_EPS = 1e-5f;
constexpr float QK_SCALE = 0.08838834764831845f;

constexpr size_t MiB = 1u << 20;
constexpr size_t WS_CTL = 0, CTL_ZERO_BYTES = 32768;
constexpr size_t WS_COS = 1 * MiB, WS_SIN = 1 * MiB + 512 * 1024;
constexpr size_t WS_ELIST = 2 * MiB;
constexpr size_t WS_FT = 2 * MiB;
constexpr size_t WS_EWL = 3 * MiB;
constexpr size_t WS_TMETA = 4 * MiB;
constexpr size_t WS_WA = 5 * MiB;
constexpr size_t WS_WG = 15 * MiB;
constexpr size_t WS_WKV = 21 * MiB;
constexpr size_t WS_WRO = 23 * MiB;
constexpr size_t WS_WNO = 25 * MiB;
constexpr size_t WS_WXO = 26 * MiB;
constexpr size_t WS_WOUT = 27 * MiB;
constexpr size_t WS_XN = 29 * MiB;
constexpr size_t WS_H2 = WS_XN;
constexpr size_t WS_RQ = 61 * MiB;
constexpr size_t WS_RK = 77 * MiB;
constexpr size_t WS_RV = 93 * MiB;
constexpr size_t WS_NK = 125 * MiB;
constexpr size_t WS_NV = 141 * MiB;
constexpr size_t WS_GATES = 61 * MiB;
constexpr size_t WS_HID = 61 * MiB;
constexpr size_t WS_DROWS = 97 * MiB;
constexpr size_t WS_RG = 157 * MiB;
constexpr size_t WS_NQ = 189 * MiB;
constexpr size_t WS_XQ = 205 * MiB;
constexpr size_t WS_WD = 205 * MiB;
constexpr size_t WS_MN = 221 * MiB;
constexpr size_t WS_MKV = 225 * MiB;
constexpr size_t WS_MIX = 221 * MiB;
constexpr size_t WS_WGU = 221 * MiB;
constexpr size_t WS_D = 169 * MiB;
constexpr size_t WS_ERS = 1 * MiB;
constexpr size_t WS_WTR = 4 * MiB + 512 * 1024;
constexpr size_t WS_END = 256 * MiB;

constexpr int CW_ECNT = 64;
constexpr int CW_BAR = 4096;
constexpr int CW_TCNT = 1152;

constexpr int LDS_BYTES = 163840;
constexpr int MISC_OFF = 163840 - 512;

__device__ __forceinline__ float bf2f(unsigned v) { return __uint_as_float(v << 16); }
__device__ __forceinline__ unsigned f2bf(float f) { unsigned u = __float_as_uint(f); return (u + 0x7fffu + ((u >> 16) & 1u)) >> 16; }
typedef __bf16 hwbf16x2 __attribute__((ext_vector_type(2)));
typedef float f32x2_ __attribute__((ext_vector_type(2)));
__device__ __forceinline__ unsigned pk2(float lo, float hi) { const f32x2_ v = {lo, hi}; return __builtin_bit_cast(unsigned, __builtin_convertvector(v, hwbf16x2)); }
__device__ __forceinline__ void unpack8(const u32x4 v, float* o) {
    o[0] = __uint_as_float(v.x << 16); o[1] = __uint_as_float(v.x & 0xffff0000u);
    o[2] = __uint_as_float(v.y << 16); o[3] = __uint_as_float(v.y & 0xffff0000u);
    o[4] = __uint_as_float(v.z << 16); o[5] = __uint_as_float(v.z & 0xffff0000u);
    o[6] = __uint_as_float(v.w << 16); o[7] = __uint_as_float(v.w & 0xffff0000u);
}
__device__ __forceinline__ void store8(bf16* p, f32x4 a, f32x4 b) {
    u32x4 w; w.x = pk2(a[0], a[1]); w.y = pk2(a[2], a[3]); w.z = pk2(b[0], b[1]); w.w = pk2(b[2], b[3]);
    *(u32x4*)p = w;
}
__device__ __forceinline__ float wave_sum(float v) {
#pragma unroll
    for (int o = 1; o < 64; o <<= 1) v += __shfl_xor(v, o);
    return v;
}
__device__ __forceinline__ float wave_max(float v) {
#pragma unroll
    for (int o = 1; o < 64; o <<= 1) v = fmaxf(v, __shfl_xor(v, o));
    return v;
}
__device__ __forceinline__ float sigmoidf_(float x) { return __builtin_amdgcn_rcpf(1.0f + __expf(-x)); }
__device__ __forceinline__ float siluf_(float x) { return x * __builtin_amdgcn_rcpf(1.0f + __expf(-x)); }

#define XB_TMO      128
#define XB_XCNT(j)  (256  + 64 * (j))
#define XB_XSUB(j)  (1280 + 64 * (j))
#define XB_XGEN(j)  (2304 + 64 * (j))
#define XB_TOP      3328
#define XB_TOPGEN   3392
#define XCD_BAR_WORDS 3456
#define XB_SPIN_CAP (1u << 18)
__device__ __forceinline__ unsigned xb_ld(unsigned* p)              { return __hip_atomic_load(p, __ATOMIC_RELAXED, __HIP_MEMORY_SCOPE_AGENT); }
__device__ __forceinline__ unsigned xb_add(unsigned* p, unsigned v) { return __hip_atomic_fetch_add(p, v, __ATOMIC_RELAXED, __HIP_MEMORY_SCOPE_AGENT); }
__device__ __forceinline__ unsigned xb_xcc_id() { return (unsigned)__builtin_amdgcn_s_getreg((3 << 11) | 20) & 0xFu; }
#define XB_SPIN(cond, bar) do { unsigned _sp = 0; while (cond) { __builtin_amdgcn_s_sleep(1); \
    if ((++_sp & 255u) == 0u) { if (xb_ld(&(bar)[XB_TMO])) break; if (_sp > XB_SPIN_CAP) { atomicAdd(&(bar)[XB_TMO], 1u); break; } } } } while (0)
struct XcdBarrier { unsigned* bar; unsigned x; volatile LAS unsigned* st; };
__device__ __forceinline__ XcdBarrier xcd_barrier_post(unsigned* bar, volatile LAS unsigned* st) {
    XcdBarrier b; b.bar = bar; b.x = xb_xcc_id(); b.st = st;
    if (threadIdx.x == 0) (void)xb_add(&bar[XB_XCNT(b.x)], 1u);
    return b;
}
__device__ __forceinline__ void xcd_barrier_complete(unsigned* bar, unsigned x, unsigned& nloc, unsigned& nx) {
    const unsigned G = gridDim.x * gridDim.y * gridDim.z;
    unsigned sum, cnt, mine, sp = 0u;
    for (;;) {
        sum = 0u; cnt = 0u; mine = 0u;
#pragma unroll
        for (unsigned j = 0; j < 16; ++j) { const unsigned c = xb_ld(&bar[XB_XCNT(j)]); sum += c; cnt += (c > 0u) ? 1u : 0u; mine = (j == x) ? c : mine; }
        if (sum == G) break;
        __builtin_amdgcn_s_sleep(1);
        if ((++sp & 255u) == 0u) { if (xb_ld(&bar[XB_TMO])) break; if (sp > XB_SPIN_CAP) { atomicAdd(&bar[XB_TMO], 1u); break; } }
    }
    nloc = mine > 0u ? mine : 1u; nx = cnt > 0u ? cnt : 1u;
}
__device__ __forceinline__ void xcd_barrier(const XcdBarrier& b) {
    asm volatile("s_waitcnt vmcnt(0)" ::: "memory");
    __syncthreads();
    if (threadIdx.x == 0) {
        unsigned* bar = b.bar;
        __builtin_amdgcn_s_waitcnt(0);
        unsigned nloc = b.st[0], nx = b.st[1];
        if (nloc == 0u) { xcd_barrier_complete(bar, b.x, nloc, nx); b.st[0] = nloc; b.st[1] = nx; }
        const unsigned old = xb_add(&bar[XB_XSUB(b.x)], 1u);
        const unsigned gen = old / nloc;
        if (old + 1u == (gen + 1u) * nloc) {
            __builtin_amdgcn_fence(__ATOMIC_RELEASE, "agent");
            asm volatile("s_waitcnt vmcnt(0)" ::: "memory");
            const unsigned og = xb_add(&bar[XB_TOP], 1u);
            const unsigned tg = og / nx;
            if (og + 1u == (tg + 1u) * nx) xb_add(&bar[XB_TOPGEN], 1u);
            else XB_SPIN(xb_ld(&bar[XB_TOPGEN]) == tg, bar);
            __builtin_amdgcn_fence(__ATOMIC_ACQUIRE, "agent");
            xb_add(&bar[XB_XGEN(b.x)], 1u);
            asm volatile("s_waitcnt vmcnt(0)" ::: "memory");
        } else {
            XB_SPIN(xb_ld(&bar[XB_XGEN(b.x)]) == gen, bar);
            __builtin_amdgcn_fence(__ATOMIC_ACQUIRE, "agent");
            asm volatile("s_waitcnt vmcnt(0)" ::: "memory");
        }
    }
    __syncthreads();
}

struct Args { const float* in[23]; float* out; unsigned char* ws; int ph_lo, ph_hi; int sub, rep; };
struct Ctx {
    int tid, lane, wave, gw, ngw;
    unsigned char* lds;
};

template <class ColPtr>
__device__ __forceinline__ void transpose_all(const Ctx& c, int& base, ColPtr cp, int ldw, int P, int K, bf16* WT, const float* kscale = nullptr) {
    float* scr = (float*)(c.lds + c.wave * 16384);
    const int nkb = K / 64, npb = P / 32, lane = c.lane, nit = nkb * npb;
    int it0 = (c.gw - base) % c.ngw; it0 = it0 < 0 ? it0 + c.ngw : it0; base += nit;
    for (int it = it0; it < nit; it += c.ngw) {
        const int kb = it % nkb, pb = it / nkb, k0 = 64 * kb, p0 = 32 * pb;
        const float* colp = cp(p0 + (lane & 31));
        float tv[32];
#pragma unroll
        for (int i = 0; i < 32; ++i) tv[i] = colp[(size_t)(k0 + 2 * i + (lane >> 5)) * ldw];
#pragma unroll
        for (int i = 0; i < 32; ++i) scr[(2 * i + (lane >> 5)) * 33 + (lane & 31)] = tv[i];
        __builtin_amdgcn_s_waitcnt(0xC07F); asm volatile("" ::: "memory");
        const int cc = lane & 7;
        f32x4 ks0 = {1.f, 1.f, 1.f, 1.f}, ks1 = {1.f, 1.f, 1.f, 1.f};
        if (kscale) { ks0 = *(const f32x4*)(kscale + k0 + 8 * cc); ks1 = *(const f32x4*)(kscale + k0 + 8 * cc + 4); }
#pragma unroll
        for (int j = 0; j < 4; ++j) { const int n = (lane >> 3) + 8 * j; const float* s = scr + (8 * cc) * 33 + n;
            u32x4 o; o.x = pk2(s[0 * 33] * ks0[0], s[1 * 33] * ks0[1]); o.y = pk2(s[2 * 33] * ks0[2], s[3 * 33] * ks0[3]); o.z = pk2(s[4 * 33] * ks1[0], s[5 * 33] * ks1[1]); o.w = pk2(s[6 * 33] * ks1[2], s[7 * 33] * ks1[3]);
            *(u32x4*)(WT + (size_t)(p0 + n) * K + k0 + 8 * cc) = o; }
        __builtin_amdgcn_s_waitcnt(0xC07F); asm volatile("" ::: "memory");
    }
}
struct ColPlain { const float* W; __device__ const float* operator()(int p) const { return W + p; } };
struct ColOff { const float* W; int off; __device__ const float* operator()(int p) const { return W + off + p; } };
struct ColWA {
    const float* W;
    __device__ const float* operator()(int p) const {
        if (p < 1024) { const int pp = p & 127; const int d = ((pp & 4) ? 64 : 0) + 4 * (pp >> 3) + (pp & 3); return W + (p & ~127) + d; }
        return W + p;
    }
};
struct ColGU {
    const float* Wg; const float* Wu;
    __device__ const float* operator()(int p) const { const int f = 4 * (p >> 3) + (p & 3); return ((p >> 2) & 1) ? Wu + f : Wg + f; }
};
__device__ __forceinline__ void rms_row_to_bf16(const float* xrow, const float* g, bf16* orow, int lane) {
    const f32x4* xr = (const f32x4*)xrow + lane; const f32x4* gr = (const f32x4*)g + lane;
    f32x4 v[4]; float s = 0.f;
#pragma unroll
    for (int j = 0; j < 4; ++j) { v[j] = xr[64 * j]; s += (v[j].x * v[j].x + v[j].y * v[j].y) + (v[j].z * v[j].z + v[j].w * v[j].w); }
    const float r = 1.0f / sqrtf(wave_sum(s) * (1.f / 1024.f) + RMS_EPS);
    unsigned long long* o8 = (unsigned long long*)orow + lane;
#pragma unroll
    for (int j = 0; j < 4; ++j) { const f32x4 gg = gr[64 * j];
        o8[64 * j] = (unsigned long long)pk2(v[j].x * r * gg.x, v[j].y * r * gg.y) | ((unsigned long long)pk2(v[j].z * r * gg.z, v[j].w * r * gg.w) << 32); }
}

template <class RowPtr, class Epi>
__device__ __forceinline__ void naive_gemm(const Ctx& c, const RowPtr& rp, const bf16* Bt, int ldb, int M, int N, int K, const Epi& epi) {
    const int tilesN = N / 64, tilesM = (M + 7) / 8, lane = c.lane;
    for (int it = c.gw; it < tilesM * tilesN; it += c.ngw) {
        const int tm = it / tilesN, tn = it % tilesN;
        const int row = tm * 8 + (lane >> 3), col0 = tn * 64 + (lane & 7) * 8;
        const bool valid = row < M;
        const bf16* ap = rp(valid ? row : 0);
        float acc[8];
#pragma unroll
        for (int j = 0; j < 8; ++j) acc[j] = 0.f;
        for (int k = 0; k < K; k += 8) {
            float a[8]; unpack8(*(const u32x4*)(ap + k), a);
#pragma unroll
            for (int j = 0; j < 8; ++j) { float b[8]; unpack8(*(const u32x4*)(Bt + (size_t)(col0 + j) * ldb + k), b);
#pragma unroll
                for (int i = 0; i < 8; ++i) acc[j] += a[i] * b[i]; }
        }
        if (valid) epi(row, col0, (f32x4){acc[0], acc[1], acc[2], acc[3]}, (f32x4){acc[4], acc[5], acc[6], acc[7]});
    }
}
struct RowPlain { const bf16* A; int lda; __device__ const bf16* operator()(int r) const { return A + (size_t)r * lda; } };
struct RowGather { const bf16* A; int lda; const int* idx; __device__ const bf16* operator()(int r) const { return A + (size_t)idx[r] * lda; } };

struct EpiProjA {
    bf16 *RQ, *RK, *RV, *RG, *NQ, *NK, *NV, *XQ; const float *COS, *SIN;
    __device__ __forceinline__ void operator()(int row, int col0, f32x4 v0, f32x4 v1) const {
        if (col0 < 1024) {
            const int which = col0 >> 9, cc = col0 & 511, pos = row & (SEQ - 1), q = (cc & 127) >> 3;
            const f32x4 cs = *(const f32x4*)(COS + pos * 64 + 4 * q), sn = *(const f32x4*)(SIN + pos * 64 + 4 * q);
            f32x4 o1 = v0 * cs - v1 * sn, o2 = v0 * sn + v1 * cs;
            if (which == 0) { o1 = o1 * QK_SCALE; o2 = o2 * QK_SCALE; }
            store8((which ? RK : RQ) + (size_t)row * 512 + cc, o1, o2);
        } else if (col0 < 2048) { store8(RV + (size_t)row * 1024 + (col0 - 1024), v0, v1);
        } else if (col0 < 3072) {
            f32x4 a, b;
#pragma unroll
            for (int i = 0; i < 4; ++i) { a[i] = siluf_(v0[i]); b[i] = siluf_(v1[i]); }
            store8(RG + (size_t)row * 1024 + (col0 - 2048), a, b);
        } else if (col0 < 3584) { store8(NQ + (size_t)row * 512 + (col0 - 3072), v0 * 0.125f, v1 * 0.125f);
        } else if (col0 < 4096) { store8(NK + (size_t)row * 512 + (col0 - 3584), v0, v1);
        } else if (col0 < 4608) { store8(NV + (size_t)row * 512 + (col0 - 4096), v0, v1);
        } else { store8(XQ + (size_t)row * 512 + (col0 - 4608), v0 * QK_SCALE, v1 * QK_SCALE); }
    }
};
struct EpiBf16Plain { bf16* O; int ldc; __device__ __forceinline__ void operator()(int row, int col0, f32x4 v0, f32x4 v1) const { store8(O + (size_t)row * ldc + col0, v0, v1); } };
struct EpiSigmoid { bf16* O; int ldc;
    __device__ __forceinline__ void operator()(int row, int col0, f32x4 v0, f32x4 v1) const {
        f32x4 a, b;
#pragma unroll
        for (int i = 0; i < 4; ++i) { a[i] = sigmoidf_(v0[i]); b[i] = sigmoidf_(v1[i]); }
        store8(O + (size_t)row * ldc + col0, a, b); } };
template <int MODE> struct EpiMixNaive { float* TMP; bf16* MIX; const bf16* G;
    __device__ __forceinline__ void operator()(int row, int col0, f32x4 v0, f32x4 v1) const {
        float g[8]; unpack8(*(const u32x4*)(G + (size_t)row * NPG + col0), g);
        f32x4 a = {v0[0] * g[0], v0[1] * g[1], v0[2] * g[2], v0[3] * g[3]}, b = {v1[0] * g[4], v1[1] * g[5], v1[2] * g[6], v1[3] * g[7]};
        float* t = TMP + (size_t)row * DM + col0;
        if (MODE >= 1) { a = a + *(const f32x4*)t; b = b + *(const f32x4*)(t + 4); }
        if (MODE <= 1) { *(f32x4*)t = a; *(f32x4*)(t + 4) = b; } else store8(MIX + (size_t)row * DM + col0, a, b);
    } };
struct EpiResidBf16 { const float* X; bf16* O;
    __device__ __forceinline__ void operator()(int row, int col0, f32x4 v0, f32x4 v1) const {
        const float* x = X + (size_t)row * DM + col0; store8(O + (size_t)row * DM + col0, *(const f32x4*)x + v0, *(const f32x4*)(x + 4) + v1); } };
struct EpiResidF32 { const float* X; float* O;
    __device__ __forceinline__ void operator()(int row, int col0, f32x4 v0, f32x4 v1) const {
        const float* x = X + (size_t)row * DM + col0; float* o = O + (size_t)row * DM + col0;
        *(f32x4*)o = *(const f32x4*)x + v0; *(f32x4*)(o + 4) = *(const f32x4*)(x + 4) + v1; } };
struct EpiSwiGLU { bf16* HID; const float* wl; int rowbase;
    __device__ __forceinline__ void operator()(int row, int col0, f32x4 v0, f32x4 v1) const {
        const float w = wl[row]; f32x4 h;
#pragma unroll
        for (int i = 0; i < 4; ++i) h[i] = siluf_(v0[i]) * v1[i] * w;
        u32x2 o; o.x = pk2(h[0], h[1]); o.y = pk2(h[2], h[3]);
        *(u32x2*)(HID + (size_t)(rowbase + row) * DFF + (col0 >> 1)) = o; } };
struct EpiRowsBf16 { bf16* O; int ldc; int rowbase;
    __device__ __forceinline__ void operator()(int row, int col0, f32x4 v0, f32x4 v1) const { store8(O + (size_t)(rowbase + row) * ldc + col0, v0, v1); } };

namespace pg8 {
constexpr int BM = 256, BK = 64, HALF = 128, HTB = HALF * BK * 2, STAGE_BYTES = 8 * HTB;
__device__ __forceinline__ int lds_byte(int r, int c) { const int st = (r >> 4) * 2 + (c >> 5), rr = r & 15, cc = c & 31, ob = rr * 64 + cc * 2; return st * 1024 + (ob ^ (((ob >> 9) & 1) << 5)); }
__device__ __forceinline__ void stage_rc(int b, int& R, int& C) { const int st = b / 1024, sb = b % 1024, swz = sb ^ (((sb >> 9) & 1) << 5); R = (st >> 1) * 16 + swz / 64; C = (st & 1) * 32 + (swz % 64) / 2; }
__device__ __forceinline__ int perm32(int rho) { const int n = rho >> 4, i = rho & 15; return 8 * (i >> 2) + 4 * n + (i & 3); }

struct UnitDesc {
    const char* A; const char* B;
    unsigned lda2, ldb2;
    int nt;
    int row0, col0;
    int aux, aux2;
    const int* gidx; int gcnt;
    int chain;
};
__device__ __forceinline__ unsigned cvt_pk_bf16(float lo, float hi) { unsigned r; asm volatile("v_cvt_pk_bf16_f32 %0, %1, %2" : "=v"(r) : "v"(lo), "v"(hi)); return r; }

template <int GRP = 1, class F> __device__ __forceinline__ void epi_apply(const f32x4 (&acc)[2][2][4][2], const UnitDesc& u, int wr, int wc, int fr, int fq, const F& f) {
#pragma unroll
    for (int ai = 0; ai < 2; ++ai)
#pragma unroll
        for (int m = 0; m < 4; ++m) { const int row = u.row0 + ai * HALF + wr * 64 + m * 16 + fr;
#pragma unroll
            for (int bj = 0; bj < 2; ++bj) f(row, u.col0 + bj * HALF + wc * 32 + 8 * fq, acc[ai][bj][m][0], acc[ai][bj][m][1]);
            if (((ai * 4 + m) % GRP) == GRP - 1) { asm volatile("" ::: "memory"); __builtin_amdgcn_sched_barrier(0); } }
}

template <bool GATHER> __device__ __forceinline__ void unit_offs(const UnitDesc& u, int tid, unsigned (&oA0)[2], unsigned (&oA1)[2], unsigned (&oB)[2]) {
#pragma unroll
    for (int i = 0; i < 2; ++i) { int R, C; stage_rc(tid * 16 + i * 8192, R, C); const int Rb = (R & ~31) + perm32(R & 31);
        oB[i] = (unsigned)Rb * u.ldb2 + (unsigned)C * 2u;
        if (GATHER && u.gidx) { const int last = u.gcnt - 1; int r0 = u.row0 + R, r1 = r0 + HALF; r0 = r0 < last ? r0 : last; r1 = r1 < last ? r1 : last;
            oA0[i] = (unsigned)u.gidx[r0] * u.lda2 + (unsigned)C * 2u; oA1[i] = (unsigned)u.gidx[r1] * u.lda2 + (unsigned)C * 2u;
        } else { oA0[i] = (unsigned)R * u.lda2 + (unsigned)C * 2u; oA1[i] = 0u; } }
}

template <bool GATHER, class Sched, class Epi>
__device__ __forceinline__ void gemm_phase(LAS unsigned char* lds, const Sched& S, const Epi& E, int sb = 0) {
#if PROBE_TS_A >= 0
#define GSTAMP(k) do { if (sb && blockIdx.x == 0 && threadIdx.x == 0) ((volatile LAS unsigned*)(lds + MISC_OFF))[32 + sb + (k)] = (unsigned)__builtin_amdgcn_s_memrealtime(); } while (0)
#else
#define GSTAMP(k) do { } while (0)
#endif
    const int tid = threadIdx.x, wid = __builtin_amdgcn_readfirstlane(tid >> 6), lane = tid & 63, wr = wid >> 2, wc = wid & 3, fr = lane & 15, fq = lane >> 4;
    const unsigned ldsw = (unsigned)wid * 1024u;
    const int aoff = lds_byte(wr * 64 + fr, fq * 8), boff = lds_byte(wc * 32 + fr, fq * 8);
    const size_t kstep = (size_t)(BK * 2);
#define PG8_SA(b, h) (((b) * 2 + (h)) * HTB)
#define PG8_SB(b, h) ((4 + (b) * 2 + (h)) * HTB)
#define PG8_STAGE(bufoff, gbase, voff) do { _Pragma("unroll") for (int _i = 0; _i < 2; ++_i) \
        __builtin_amdgcn_global_load_lds((const unsigned*)((const char*)(gbase) + (voff)[_i]), (LAS unsigned*)(lds + (bufoff) + ldsw + _i * 8192), 16, 0, 0); } while (0)
#define PG8_LDA(dst, b, h) do { _Pragma("unroll") for (int m = 0; m < 4; ++m) _Pragma("unroll") for (int k = 0; k < 2; ++k) dst[m][k] = *(const LAS bf16x8*)(lds + PG8_SA(b, h) + aoff + m * 2048 + k * 1024); } while (0)
#define PG8_LDB(dst, b, h) do { _Pragma("unroll") for (int n = 0; n < 2; ++n) _Pragma("unroll") for (int k = 0; k < 2; ++k) dst[n][k] = *(const LAS bf16x8*)(lds + PG8_SB(b, h) + boff + n * 2048 + k * 1024); } while (0)
#define PG8_MMA(ai, bj, At, Bt) do { __builtin_amdgcn_s_setprio(1); _Pragma("unroll") for (int m = 0; m < 4; ++m) _Pragma("unroll") for (int n = 0; n < 2; ++n) _Pragma("unroll") for (int k = 0; k < 2; ++k) \
        acc[ai][bj][m][n] = __builtin_amdgcn_mfma_f32_16x16x32_bf16(Bt[n][k], At[m][k], acc[ai][bj][m][n], 0, 0, 0); __builtin_amdgcn_s_setprio(0); } while (0)
#define PG8_WAIT_V(n) asm volatile("s_waitcnt vmcnt(" #n ")" ::: "memory")
#define PG8_WAIT_L(n) asm volatile("s_waitcnt lgkmcnt(" #n ")" ::: "memory")
#define PG8_BAR __builtin_amdgcn_s_barrier()
#define PG8_SCHED __builtin_amdgcn_sched_barrier(0)
    UnitDesc cur, nxt; int ui = 0;
    if (!S.next(0, cur)) return;
    f32x4 acc[2][2][4][2];
#pragma unroll
    for (int a = 0; a < 2; ++a)
#pragma unroll
        for (int b = 0; b < 2; ++b)
#pragma unroll
            for (int m = 0; m < 4; ++m)
#pragma unroll
                for (int n = 0; n < 2; ++n) acc[a][b][m][n] = (f32x4){0.f, 0.f, 0.f, 0.f};
    bf16x8 At[4][2], B0[2][2], B1[2][2];
    unsigned cA0[2], cA1[2], cB[2], nA0[2], nA1[2], nB[2];
    unit_offs<GATHER>(cur, tid, cA0, cA1, cB);
    const char* pA = cur.A; const char* pB = cur.B; size_t hB = (size_t)HALF * cur.ldb2; size_t hA = GATHER ? 0 : (size_t)HALF * cur.lda2;
#define PG8_A1(arr1, arr0) (GATHER ? (arr1) : (arr0))
    PG8_STAGE(PG8_SB(0, 0), pB, cB); PG8_STAGE(PG8_SB(0, 1), pB + hB, cB); PG8_STAGE(PG8_SA(0, 0), pA, cA0); PG8_STAGE(PG8_SA(0, 1), pA + hA, PG8_A1(cA1, cA0));
    if (wr == 1) PG8_BAR;
    PG8_WAIT_V(2); PG8_BAR;
    PG8_STAGE(PG8_SB(1, 0), pB + kstep, cB); PG8_STAGE(PG8_SA(1, 0), pA + kstep, cA0); PG8_STAGE(PG8_SB(1, 1), pB + hB + kstep, cB);
    PG8_WAIT_V(6); PG8_BAR;
    GSTAMP(0);
    for (;;) {
        const bool has_next = S.next(ui + 1, nxt);
        const char* qA = pA; const char* qB = pB; size_t hBn = hB, hAn = hA;
        if (has_next) { unit_offs<GATHER>(nxt, tid, nA0, nA1, nB); qA = nxt.A; qB = nxt.B; hBn = (size_t)HALF * nxt.ldb2; hAn = GATHER ? 0 : (size_t)HALF * nxt.lda2; }
        else {
#pragma unroll
            for (int i = 0; i < 2; ++i) { nA0[i] = cA0[i]; nA1[i] = cA1[i]; nB[i] = cB[i]; } }
        const int nt = cur.nt;
        for (int t = 0; t < nt; t += 2) {
            const bool last = (t == nt - 2);
            const char* a1 = pA + (size_t)(t + 1) * kstep;
            const char* a2 = last ? qA : pA + (size_t)(t + 2) * kstep; const char* b2 = last ? qB : pB + (size_t)(t + 2) * kstep;
            const char* a3 = a2 + kstep; const char* b3 = b2 + kstep;
            unsigned sA0[2], sA1[2], sB[2];
#pragma unroll
            for (int i = 0; i < 2; ++i) { sA0[i] = last ? nA0[i] : cA0[i]; sA1[i] = last ? nA1[i] : cA1[i]; sB[i] = last ? nB[i] : cB[i]; }
            const size_t shB = last ? hBn : hB, shA = last ? hAn : hA;
            PG8_LDB(B0, 0, 0); PG8_LDB(B1, 0, 1); PG8_SCHED; PG8_LDA(At, 0, 0); PG8_STAGE(PG8_SA(1, 1), a1 + hA, PG8_A1(cA1, cA0));
            PG8_WAIT_V(8); PG8_WAIT_L(0); PG8_BAR; PG8_MMA(0, 0, At, B0); PG8_MMA(0, 1, At, B1); PG8_BAR; PG8_SCHED;
            PG8_LDA(At, 0, 1); PG8_STAGE(PG8_SB(0, 0), b2, sB); PG8_STAGE(PG8_SB(0, 1), b2 + shB, sB); PG8_STAGE(PG8_SA(0, 0), a2, sA0);
            PG8_WAIT_V(8); PG8_WAIT_L(0); PG8_BAR; PG8_MMA(1, 0, At, B0); PG8_MMA(1, 1, At, B1); PG8_BAR; PG8_SCHED;
            PG8_LDB(B0, 1, 0); PG8_LDB(B1, 1, 1); PG8_SCHED; PG8_LDA(At, 1, 0); PG8_STAGE(PG8_SA(0, 1), a2 + shA, PG8_A1(sA1, sA0));
            PG8_WAIT_V(8); PG8_WAIT_L(0); PG8_BAR; PG8_MMA(0, 0, At, B0); PG8_MMA(0, 1, At, B1); PG8_BAR; PG8_SCHED;
            PG8_LDA(At, 1, 1); PG8_STAGE(PG8_SB(1, 0), b3, sB); PG8_STAGE(PG8_SB(1, 1), b3 + shB, sB); PG8_STAGE(PG8_SA(1, 0), a3, sA0);
            PG8_WAIT_V(8); PG8_WAIT_L(0); PG8_BAR; PG8_MMA(1, 0, At, B0); PG8_MMA(1, 1, At, B1); PG8_BAR; PG8_SCHED;
        }
        if (wr == 0) PG8_BAR;
        if (ui == 0) GSTAMP(1);
        E.finish(acc, cur, wr, wc, fr, fq);
        if (ui == 0) GSTAMP(2);
        if (!has_next) break;
        cur = nxt; pA = qA; pB = qB; hB = hBn; hA = hAn; ++ui;
#pragma unroll
        for (int i = 0; i < 2; ++i) { cA0[i] = nA0[i]; cA1[i] = nA1[i]; cB[i] = nB[i]; }
        if (wr == 1) PG8_BAR;
    }
    PG8_WAIT_V(0);
    PG8_BAR;
    GSTAMP(3);
#undef GSTAMP
#undef PG8_A1
#undef PG8_SA
#undef PG8_SB
#undef PG8_STAGE
#undef PG8_LDA
#undef PG8_LDB
#undef PG8_MMA
#undef PG8_WAIT_V
#undef PG8_WAIT_L
#undef PG8_BAR
#undef PG8_SCHED
}

__device__ __forceinline__ void zero_acc(f32x4 (&acc)[2][2][4][2]) {
#pragma unroll
    for (int a = 0; a < 2; ++a)
#pragma unroll
        for (int b = 0; b < 2; ++b)
#pragma unroll
            for (int m = 0; m < 4; ++m)
#pragma unroll
                for (int n = 0; n < 2; ++n) acc[a][b][m][n] = (f32x4){0.f, 0.f, 0.f, 0.f};
}
template <class F, int GRP = 1> struct EpiF { F f;
    __device__ __forceinline__ void finish(f32x4 (&acc)[2][2][4][2], const UnitDesc& u, int wr, int wc, int fr, int fq) const { epi_apply<GRP>(acc, u, wr, wc, fr, fq, f); zero_acc(acc); } };

struct TileOrder {
    int nM, nN, nwg, G, c;
    __device__ __forceinline__ void init(int nM_, int nN_, int G_, int c_) { nM = nM_; nN = nN_; nwg = nM * nN; G = G_; c = c_; }
    __device__ __forceinline__ bool tile(int i, int& pm, int& pn) const {
        const long L = (long)i * G + c; if (L >= nwg) return false;
        int wgid = (int)L; { const int q = nwg / 8, r = nwg % 8, xcd = wgid % 8, off = wgid / 8; wgid = (xcd < r ? xcd * (q + 1) : r * (q + 1) + (xcd - r) * q) + off; }
        const int nig = 8 * nN, gid = wgid / nig, fm = gid * 8, gsz = (nM - fm) < 8 ? (nM - fm) : 8;
        pm = fm + ((wgid % nig) % gsz); pn = (wgid % nig) / gsz; return true;
    }
};
struct PlainSched { TileOrder o; const bf16* A; const bf16* Bt; int lda, ldb, K;
    __device__ __forceinline__ bool next(int i, UnitDesc& u) const { int pm, pn; if (!o.tile(i, pm, pn)) return false;
        u.A = (const char*)(A + (size_t)pm * BM * lda); u.B = (const char*)(Bt + (size_t)pn * BM * ldb); u.lda2 = lda * 2; u.ldb2 = ldb * 2; u.nt = K / BK;
        u.row0 = pm * BM; u.col0 = pn * BM; u.aux = 0; u.aux2 = 0; u.gidx = nullptr; u.gcnt = 0; u.chain = 0; return true; } };
}

#if PROBE_TS_A >= 0
#define MXSTAMP(k) do { if (blockIdx.x == 0 && threadIdx.x == 0) ((volatile LAS unsigned*)(lds + MISC_OFF))[32 + (k)] = (unsigned)__builtin_amdgcn_s_memrealtime(); } while (0)
#else
#define MXSTAMP(k) do { } while (0)
#endif
namespace mx {
typedef short s16x4 __attribute__((ext_vector_type(4)));
typedef __bf16 bf16x8_t __attribute__((ext_vector_type(8)));
typedef __bf16 bf16x4_t __attribute__((ext_vector_type(4)));
typedef float f32x8 __attribute__((ext_vector_type(8)));
__device__ __forceinline__ f32x4 mma(bf16x8 a, bf16x8 b, f32x4 c) { return __builtin_amdgcn_mfma_f32_16x16x32_bf16(a, b, c, 0, 0, 0); }
__device__ __forceinline__ bf16x8 ldsf(LAS unsigned char* p) { return *(LAS bf16x8*)p; }
__device__ __forceinline__ bf16x8 glbf(const bf16* p) { return *(const bf16x8*)p; }
__device__ __forceinline__ bf16x8 trf(LAS unsigned char* p0, LAS unsigned char* p1) {
    const s16x4 a = __builtin_amdgcn_ds_read_tr16_b64_v4i16((LAS s16x4*)p0), b = __builtin_amdgcn_ds_read_tr16_b64_v4i16((LAS s16x4*)p1);
    return __builtin_shufflevector(a, b, 0, 1, 2, 3, 4, 5, 6, 7);
}
__device__ __forceinline__ bf16x8 pack8(f32x4 a, f32x4 b) { const f32x8 v = {a[0], a[1], a[2], a[3], b[0], b[1], b[2], b[3]}; return __builtin_bit_cast(bf16x8, __builtin_convertvector(v, bf16x8_t)); }
__device__ __forceinline__ u32x2 pack4(f32x4 a) { return __builtin_bit_cast(u32x2, __builtin_convertvector(a, bf16x4_t)); }
__device__ __forceinline__ float red_g_max(float v) { v = fmaxf(v, __shfl_xor(v, 16)); return fmaxf(v, __shfl_xor(v, 32)); }
__device__ __forceinline__ float red_g_sum(float v) { v += __shfl_xor(v, 16); return v + __shfl_xor(v, 32); }

__device__ __forceinline__ int vblock() { const int G = (int)gridDim.x, bx = (int)blockIdx.x; return (G % 8 == 0) ? (bx % 8) * (G / 8) + bx / 8 : bx; }
constexpr int XA_KP = 272, XA_VP = 288, XA_VOFF = 256 * XA_KP;
__device__ __forceinline__ void xa_phase(LAS unsigned char* lds, bf16* XQ, const bf16* MKV) {
    const int tid = threadIdx.x, lane = tid & 63, wave = __builtin_amdgcn_readfirstlane(tid >> 6), g = lane >> 4, li = lane & 15, q4 = li >> 2, p4 = li & 3;
    for (int it = vblock(); it < NB * 4 * 8; it += gridDim.x) {
        const int b = it >> 5, h = (it >> 3) & 3, qb = it & 7;
        __syncthreads();
#pragma unroll
        for (int i = 0; i < 8; ++i) { const int id = tid + 512 * i, row = id >> 4, ch = id & 15; const bf16* src = MKV + (size_t)(b * MEML + row) * 1024 + h * 128 + ch * 8;
            *(LAS u32x4*)(lds + row * XA_KP + ch * 16) = *(const u32x4*)src; *(LAS u32x4*)(lds + XA_VOFF + row * XA_VP + ch * 16) = *(const u32x4*)(src + 512); }
        __syncthreads();
#pragma unroll 1
        for (int qi = 0; qi < 2; ++qi) {
            bf16* qrow = XQ + (size_t)(b * SEQ + qb * 256 + wave * 32 + qi * 16 + li) * 512 + h * 128;
            bf16x8 qf[4];
#pragma unroll
            for (int s = 0; s < 4; ++s) qf[s] = glbf(qrow + 32 * s + 8 * g);
            f32x4 st[16]; float mx = -3.0e38f;
#pragma unroll
            for (int kf = 0; kf < 16; ++kf) { f32x4 a = {0.f, 0.f, 0.f, 0.f};
#pragma unroll
                for (int s = 0; s < 4; ++s) a = mma(ldsf(lds + (16 * kf + li) * XA_KP + (32 * s + 8 * g) * 2), qf[s], a);
                st[kf] = a; mx = fmaxf(mx, fmaxf(fmaxf(a[0], a[1]), fmaxf(a[2], a[3]))); __builtin_amdgcn_sched_barrier(0); }
            mx = red_g_max(mx); float sum = 0.f;
#pragma unroll
            for (int kf = 0; kf < 16; ++kf) {
#pragma unroll
                for (int r = 0; r < 4; ++r) { const float e = __expf(st[kf][r] - mx); st[kf][r] = e; sum += e; } }
            sum = red_g_sum(sum); const float inv = 1.0f / sum;
            f32x4 o[8];
#pragma unroll
            for (int df = 0; df < 8; ++df) o[df] = (f32x4){0.f, 0.f, 0.f, 0.f};
#pragma unroll
            for (int x = 0; x < 8; ++x) { const bf16x8 pf = pack8(st[2 * x], st[2 * x + 1]);
                LAS unsigned char* vb = lds + XA_VOFF + (32 * x + 4 * g + q4) * XA_VP + 8 * p4;
#pragma unroll
                for (int df = 0; df < 8; ++df) o[df] = mma(trf(vb + 32 * df, vb + 16 * XA_VP + 32 * df), pf, o[df]); __builtin_amdgcn_sched_barrier(0); }
#pragma unroll
            for (int df = 0; df < 8; ++df) *(u32x2*)(qrow + 16 * df + 4 * g) = pack4(o[df] * inv);
        }
    }
}

constexpr int NA_KP = 144, NA_VP = 136, NA_VOFF = 576 * NA_KP;
struct NaItem { int b, h, krmin, r, rs; };
__device__ __forceinline__ NaItem na_item(int it, int ri) { NaItem a; a.b = it >> 7; a.h = (it >> 4) & 7; const int rp = it & 15;
    int k = 2 * rp - 4; a.krmin = k < 0 ? 0 : (k > 24 ? 24 : k); a.r = 2 * rp + ri; int rs = a.r - 4; a.rs = rs < 0 ? 0 : (rs > 24 ? 24 : rs); return a; }
__device__ __forceinline__ void na_load_kv(u32x4 (&kv)[9], u32x4 (&vv)[9], const NaItem& a, const bf16* NK, const bf16* NV, int tid) {
#pragma unroll
    for (int i = 0; i < 9; ++i) { const int id = tid + 512 * i, trow = id >> 3, ch = id & 7; int kr = a.krmin + (trow >> 6); kr = kr > 31 ? 31 : kr;
        const size_t off = (size_t)(a.b * SEQ + kr * 64 + (trow & 63)) * 512 + a.h * 64 + ch * 8; kv[i] = *(const u32x4*)(NK + off); vv[i] = *(const u32x4*)(NV + off); }
}
__device__ __forceinline__ void na_phase(LAS unsigned char* lds, bf16* NQ, const bf16* NK, const bf16* NV, const bf16* FT) {
    const int tid = threadIdx.x, lane = tid & 63, wave = __builtin_amdgcn_readfirstlane(tid >> 6), g = lane >> 4, li = lane & 15, q4 = li >> 2, p4 = li & 3;
    const int ri = wave >> 2, qf = wave & 3, c0 = 16 * qf, w0 = qf == 0 ? 0 : (qf == 1 ? 8 : (qf == 2 ? 24 : 32));
    const int G = (int)gridDim.x, lite = G > 64 ? 32 : 0; const bool isl = (int)blockIdx.x < lite;
    int vnl = (int)blockIdx.x - lite;
    if (lite && G % 8 == 0) { const int x = (int)blockIdx.x % 8, q = (int)blockIdx.x / 8 - lite / 8; vnl = x * ((G - lite) / 8) + q; }
    const int it0 = isl ? (int)blockIdx.x : lite + vnl, itstep = isl ? NB * 8 * 16 : G - lite;
    if (it0 >= NB * 8 * 16) return;
    NaItem cur = na_item(it0, ri);
    u32x4 kv[9], vv[9]; bf16x8 ff[16]; bf16x8 q0, q1;
    na_load_kv(kv, vv, cur, NK, NV, tid);
#pragma unroll
    for (int f = 0; f < 16; ++f) ff[f] = glbf(FT + ((size_t)((cur.h * 15 + (cur.rs + (f >> 1) - cur.r + 7)) * 64 + w0 + 16 * (f & 1) + li)) * 64 + (c0 & 32) + 8 * g);
    { const bf16* qr = NQ + (size_t)(cur.b * SEQ + cur.r * 64 + c0 + li) * 512 + cur.h * 64; q0 = glbf(qr + 8 * g); q1 = glbf(qr + 32 + 8 * g); }
    bf16x8 e1;
#pragma unroll
    for (int j = 0; j < 8; ++j) e1[j] = (8 * g + j == ((c0 + li) & 31)) ? (short)0x3F80 : (short)0;
#pragma unroll 1
    for (int it = it0;;) {
        __syncthreads();
#pragma unroll
        for (int i = 0; i < 9; ++i) { const int id = tid + 512 * i, trow = id >> 3, ch = id & 7;
            *(LAS u32x4*)(lds + trow * NA_KP + ch * 16) = kv[i];
            *(LAS u32x2*)(lds + NA_VOFF + trow * NA_VP + ch * 16) = (u32x2){vv[i].x, vv[i].y}; *(LAS u32x2*)(lds + NA_VOFF + trow * NA_VP + ch * 16 + 8) = (u32x2){vv[i].z, vv[i].w}; }
        __syncthreads();
        const int itn = it + itstep; const bool has_next = itn < NB * 8 * 16; const NaItem nx = na_item(has_next ? itn : it, ri);
        if (has_next) na_load_kv(kv, vv, nx, NK, NV, tid);
        const int rs = cur.rs, krmin = cur.krmin;
        f32x4 st[16]; float mx = -3.0e38f;
#pragma unroll
        for (int kri = 0; kri < 8; ++kri) {
#pragma unroll
            for (int cf = 0; cf < 2; ++cf) { LAS unsigned char* kp = lds + ((rs + kri - krmin) * 64 + w0 + 16 * cf + li) * NA_KP + 16 * g;
                f32x4 a = {0.f, 0.f, 0.f, 0.f};
                a = mma(ldsf(kp), q0, a); a = mma(ldsf(kp + 64), q1, a); a = mma(ff[kri * 2 + cf], e1, a);
                st[kri * 2 + cf] = a; mx = fmaxf(mx, fmaxf(fmaxf(a[0], a[1]), fmaxf(a[2], a[3]))); }
            __builtin_amdgcn_sched_barrier(0); }
        bf16* qrow = NQ + (size_t)(cur.b * SEQ + cur.r * 64 + c0 + li) * 512 + cur.h * 64;
        if (has_next) {
#pragma unroll
            for (int f = 0; f < 8; ++f) ff[f] = glbf(FT + ((size_t)((nx.h * 15 + (nx.rs + (f >> 1) - nx.r + 7)) * 64 + w0 + 16 * (f & 1) + li)) * 64 + (c0 & 32) + 8 * g);
            const bf16* qr = NQ + (size_t)(nx.b * SEQ + nx.r * 64 + c0 + li) * 512 + nx.h * 64; q0 = glbf(qr + 8 * g); q1 = glbf(qr + 32 + 8 * g); }
        mx = red_g_max(mx); float sum = 0.f;
#pragma unroll
        for (int f = 0; f < 16; ++f) {
#pragma unroll
            for (int rr = 0; rr < 4; ++rr) { const float e = __expf(st[f][rr] - mx); st[f][rr] = e; sum += e; } }
        sum = red_g_sum(sum); const float inv = 1.0f / sum;
        f32x4 o[4];
#pragma unroll
        for (int df = 0; df < 4; ++df) o[df] = (f32x4){0.f, 0.f, 0.f, 0.f};
#pragma unroll
        for (int x = 0; x < 8; ++x) { const bf16x8 pf = pack8(st[2 * x], st[2 * x + 1]);
            LAS unsigned char* vb = lds + NA_VOFF + ((rs + x - krmin) * 64 + w0 + 4 * g + q4) * NA_VP + 8 * p4;
#pragma unroll
            for (int df = 0; df < 4; ++df) o[df] = mma(trf(vb + 32 * df, vb + 16 * NA_VP + 32 * df), pf, o[df]); __builtin_amdgcn_sched_barrier(0); }
#pragma unroll
        for (int df = 0; df < 4; ++df) *(u32x2*)(qrow + 16 * df + 4 * g) = pack4(o[df] * inv);
        if (!has_next) break;
#pragma unroll
        for (int f = 8; f < 16; ++f) ff[f] = glbf(FT + ((size_t)((nx.h * 15 + (nx.rs + (f >> 1) - nx.r + 7)) * 64 + w0 + 16 * (f & 1) + li)) * 64 + (c0 & 32) + 8 * g);
        cur = nx; it = itn;
    }
}

constexpr int RT_P = 272, RT_VP = 544, RT_QOFF = 0, RT_KOFF = 128 * RT_P, RT_VOFF = 2 * 128 * RT_P, RT_RED = RT_VOFF + 128 * RT_VP, RT_STAT = RT_RED + 8 * 128 * 8;
__device__ __forceinline__ void ret_out_phase(LAS unsigned char* lds, const bf16* RQ, const bf16* RK, const bf16* RV, bf16* RG, const bf16* ST, const float* gain, const float* decf, const float* decb) {
    const int tid0 = threadIdx.x, lane = tid0 & 63, wave = __builtin_amdgcn_readfirstlane(tid0 >> 6), g = lane >> 4, li = lane & 15, q4 = li >> 2, p4 = li & 3;
    for (int it = blockIdx.x; it < NB * 4 * 16; it += gridDim.x) {
        const int b = it >> 6, h = (it >> 4) & 3, n = it & 15; const size_t tok0 = (size_t)b * SEQ + n * 128;
        int tid = tid0; asm volatile("" : "+v"(tid));
        const float lgf = -log1pf(expf(-decf[h])), lgb = -log1pf(expf(-decb[h]));
        const bf16* sfp = ST + ((size_t)(((b * 4 + h) * 2 + 0) * 16 + n) * 256 + 32 * wave + li) * 128 + 8 * g;
        const bf16* sbp = ST + ((size_t)(((b * 4 + h) * 2 + 1) * 16 + n) * 256 + 32 * wave + li) * 128 + 8 * g;
        __syncthreads();
#pragma unroll
        for (int i = 0; i < 4; ++i) { const int id = tid + 512 * i, row = id >> 4, ch = id & 15;
            *(LAS u32x4*)(lds + RT_QOFF + row * RT_P + ch * 16) = *(const u32x4*)(RQ + (tok0 + row) * 512 + h * 128 + ch * 8);
            *(LAS u32x4*)(lds + RT_KOFF + row * RT_P + ch * 16) = *(const u32x4*)(RK + (tok0 + row) * 512 + h * 128 + ch * 8); }
#pragma unroll
        for (int i = 0; i < 8; ++i) { const int id = tid + 512 * i, row = id >> 5, ch = id & 31;
            *(LAS u32x4*)(lds + RT_VOFF + row * RT_VP + ch * 16) = *(const u32x4*)(RV + (tok0 + row) * 1024 + h * 256 + ch * 8); }
        __builtin_amdgcn_sched_barrier(0);
        bf16x8 sf[2][4];
        if (it == (int)blockIdx.x) MXSTAMP(25);
#pragma unroll
        for (int a = 0; a < 2; ++a)
#pragma unroll
            for (int s = 0; s < 4; ++s) sf[a][s] = glbf(sfp + a * 16 * 128 + 32 * s);
        __syncthreads();
        if (it == (int)blockIdx.x) MXSTAMP(26);
        { bf16x8 qf[4];
#pragma unroll
          for (int s = 0; s < 4; ++s) qf[s] = ldsf(lds + RT_QOFF + (16 * wave + li) * RT_P + (32 * s + 8 * g) * 2);
          f32x4 st[8]; const int pi = 16 * wave + li;
#pragma unroll
          for (int jf = 0; jf < 8; ++jf) { f32x4 a = {0.f, 0.f, 0.f, 0.f};
#pragma unroll
              for (int s = 0; s < 4; ++s) a = mma(ldsf(lds + RT_KOFF + (16 * jf + li) * RT_P + (32 * s + 8 * g) * 2), qf[s], a);
#pragma unroll
              for (int r = 0; r < 4; ++r) { const int pj = 16 * jf + 4 * g + r; a[r] *= (pj <= pi) ? __expf((float)(pi - pj) * lgf) : __expf((float)(pj - pi) * lgb); }
              st[jf] = a; __builtin_amdgcn_sched_barrier(0); }
          __syncthreads();
#pragma unroll
          for (int jf = 0; jf < 8; ++jf) *(LAS u32x2*)(lds + RT_KOFF + pi * RT_P + (16 * jf + 4 * g) * 2) = pack4(st[jf]);
        }
        __syncthreads();
        if (it == (int)blockIdx.x) MXSTAMP(27);
        bf16x8 sb[2][4];
#pragma unroll
        for (int a = 0; a < 2; ++a)
#pragma unroll
            for (int s = 0; s < 4; ++s) sb[a][s] = glbf(sbp + a * 16 * 128 + 32 * s);
        f32x4 y[2][8];
#pragma unroll
        for (int a = 0; a < 2; ++a)
#pragma unroll
            for (int i = 0; i < 8; ++i) y[a][i] = (f32x4){0.f, 0.f, 0.f, 0.f};
        {
#pragma unroll
          for (int i = 0; i < 8; ++i) {
#pragma unroll
              for (int s = 0; s < 4; ++s) { const bf16x8 qfr = ldsf(lds + RT_QOFF + (16 * i + li) * RT_P + (32 * s + 8 * g) * 2); y[0][i] = mma(sf[0][s], qfr, y[0][i]); y[1][i] = mma(sf[1][s], qfr, y[1][i]); }
              const int pi = 16 * i + li; const float ratio = __expf((float)(pi + 1) * lgf - (float)(128 - pi) * lgb);
              y[0][i] = y[0][i] * ratio; y[1][i] = y[1][i] * ratio; __builtin_amdgcn_sched_barrier(0); } }
        if (it == (int)blockIdx.x) MXSTAMP(28);
        {
#pragma unroll
          for (int i = 0; i < 8; ++i) {
#pragma unroll
              for (int s = 0; s < 4; ++s) { const bf16x8 qfr = ldsf(lds + RT_QOFF + (16 * i + li) * RT_P + (32 * s + 8 * g) * 2); y[0][i] = mma(sb[0][s], qfr, y[0][i]); y[1][i] = mma(sb[1][s], qfr, y[1][i]); }
              const int pi = 16 * i + li; const float ab = __expf((float)(128 - pi) * lgb);
              y[0][i] = y[0][i] * ab; y[1][i] = y[1][i] * ab; __builtin_amdgcn_sched_barrier(0); } }
        if (it == (int)blockIdx.x) MXSTAMP(29);
#pragma unroll
        for (int x = 0; x < 4; ++x) {
            LAS unsigned char* vb = lds + RT_VOFF + (32 * x + 8 * g + q4) * RT_VP + (32 * wave) * 2 + 8 * p4;
            const bf16x8 v0 = trf(vb, vb + 4 * RT_VP), v1 = trf(vb + 32, vb + 4 * RT_VP + 32);
#pragma unroll
            for (int i = 0; i < 8; ++i) { const bf16x8 pfr = ldsf(lds + RT_KOFF + (16 * i + li) * RT_P + (32 * x + 8 * g) * 2); y[0][i] = mma(v0, pfr, y[0][i]); y[1][i] = mma(v1, pfr, y[1][i]); } __builtin_amdgcn_sched_barrier(0); }
        if (it == (int)blockIdx.x) MXSTAMP(30);
#pragma unroll
        for (int i = 0; i < 8; ++i) { float s1 = 0.f, s2 = 0.f;
#pragma unroll
            for (int a = 0; a < 2; ++a)
#pragma unroll
                for (int r = 0; r < 4; ++r) { const float v = y[a][i][r]; s1 += v; s2 += v * v; }
            s1 = red_g_sum(s1); s2 = red_g_sum(s2);
            if (g == 0) { LAS float* rp = (LAS float*)(lds + RT_RED) + (wave * 128 + 16 * i + li) * 2; rp[0] = s1; rp[1] = s2; } }
        __syncthreads();
        if (tid < 128) { float s1 = 0.f, s2 = 0.f;
#pragma unroll
            for (int w = 0; w < 8; ++w) { const LAS float* rp = (const LAS float*)(lds + RT_RED) + (w * 128 + tid) * 2; s1 += rp[0]; s2 += rp[1]; }
            const float mu = s1 * (1.f / 256.f); const float var = fmaxf(s2 * (1.f / 256.f) - mu * mu, 0.f);
            LAS float* sp = (LAS float*)(lds + RT_STAT) + tid * 2; sp[0] = mu; sp[1] = 1.0f / sqrtf(var + GN_EPS); }
        __syncthreads();
        if (it == (int)blockIdx.x) MXSTAMP(31);
        const f32x4 gn0 = *(const f32x4*)(gain + h * 256 + 32 * wave + 4 * g), gn1 = *(const f32x4*)(gain + h * 256 + 32 * wave + 16 + 4 * g);
#pragma unroll
        for (int i = 0; i < 8; ++i) { const LAS float* sp = (const LAS float*)(lds + RT_STAT) + (16 * i + li) * 2; const float mu = sp[0], rstd = sp[1];
            bf16* gp = RG + (tok0 + 16 * i + li) * 1024 + h * 256 + 32 * wave + 4 * g;
#pragma unroll
            for (int a = 0; a < 2; ++a) { const u32x2 gv = *(const u32x2*)(gp + 16 * a); const f32x4 gg = a ? gn1 : gn0;
                f32x4 o; o[0] = (y[a][i][0] - mu) * rstd * gg[0] * bf2f(gv.x & 0xffffu); o[1] = (y[a][i][1] - mu) * rstd * gg[1] * bf2f(gv.x >> 16);
                o[2] = (y[a][i][2] - mu) * rstd * gg[2] * bf2f(gv.y & 0xffffu); o[3] = (y[a][i][3] - mu) * rstd * gg[3] * bf2f(gv.y >> 16);
                *(u32x2*)(gp + 16 * a) = pack4(o); } }
    }
}

constexpr int RS_KP = 272, RS_VP = 144, RS_VOFF = 128 * RS_KP;
__device__ __forceinline__ void ret_state_phase(LAS unsigned char* lds, const bf16* RK, const bf16* RV, bf16* ST, const float* decf, const float* decb) {
    const int tid = threadIdx.x, lane = tid & 63, wave = __builtin_amdgcn_readfirstlane(tid >> 6), g = lane >> 4, li = lane & 15, q4 = li >> 2, p4 = li & 3;
    for (int it = vblock(); it < NB * 4 * 2 * 4; it += gridDim.x) {
        const int es = it & 3, dir = (it >> 2) & 1, h = (it >> 3) & 3, b = it >> 5;
        const float lg = -log1pf(expf(-(dir ? decb[h] : decf[h]))); const float cd = __expf(128.f * lg);
        f32x4 st[4];
#pragma unroll
        for (int ef = 0; ef < 4; ++ef) st[ef] = (f32x4){0.f, 0.f, 0.f, 0.f};
        u32x4 kq[4], vq[2];
        { const size_t tk = (size_t)b * SEQ + (dir ? 15 : 0) * 128;
#pragma unroll
          for (int i = 0; i < 4; ++i) { const int id = tid + 512 * i, row = id >> 4, ch = id & 15; kq[i] = *(const u32x4*)(RK + (tk + row) * 512 + h * 128 + ch * 8); }
#pragma unroll
          for (int i = 0; i < 2; ++i) { const int id = tid + 512 * i, row = id >> 3, ch = id & 7; vq[i] = *(const u32x4*)(RV + (tk + row) * 1024 + h * 256 + es * 64 + ch * 8); } }
#pragma unroll 1
        for (int cc = 0; cc < 16; ++cc) { const int n = dir ? 15 - cc : cc;
            bf16* sp = ST + ((size_t)(((b * 4 + h) * 2 + dir) * 16 + n) * 256 + es * 64 + li) * 128 + 16 * wave + 4 * g;
#pragma unroll
            for (int ef = 0; ef < 4; ++ef) *(u32x2*)(sp + (size_t)16 * ef * 128) = pack4(st[ef]);
            __syncthreads();
#pragma unroll
            for (int i = 0; i < 4; ++i) { const int id = tid + 512 * i, row = id >> 4, ch = id & 15;
                float v[8]; unpack8(kq[i], v);
                const float w = __expf((float)(dir ? row : 127 - row) * lg);
                u32x4 o; o.x = pk2(v[0] * w, v[1] * w); o.y = pk2(v[2] * w, v[3] * w); o.z = pk2(v[4] * w, v[5] * w); o.w = pk2(v[6] * w, v[7] * w);
                *(LAS u32x4*)(lds + row * RS_KP + ch * 16) = o; }
#pragma unroll
            for (int i = 0; i < 2; ++i) { const int id = tid + 512 * i, row = id >> 3, ch = id & 7; *(LAS u32x4*)(lds + RS_VOFF + row * RS_VP + ch * 16) = vq[i]; }
            if (cc < 15) { const int n2 = dir ? 14 - cc : cc + 1; const size_t tk = (size_t)b * SEQ + n2 * 128;
#pragma unroll
                for (int i = 0; i < 4; ++i) { const int id = tid + 512 * i, row = id >> 4, ch = id & 15; kq[i] = *(const u32x4*)(RK + (tk + row) * 512 + h * 128 + ch * 8); }
#pragma unroll
                for (int i = 0; i < 2; ++i) { const int id = tid + 512 * i, row = id >> 3, ch = id & 7; vq[i] = *(const u32x4*)(RV + (tk + row) * 1024 + h * 256 + es * 64 + ch * 8); } }
            __syncthreads();
#pragma unroll
            for (int ef = 0; ef < 4; ++ef) st[ef] = st[ef] * cd;
#pragma unroll
            for (int x = 0; x < 4; ++x) {
                LAS unsigned char* kb = lds + (32 * x + 8 * g + q4) * RS_KP + (16 * wave) * 2 + 8 * p4;
                const bf16x8 kfr = trf(kb, kb + 4 * RS_KP);
                LAS unsigned char* vb = lds + RS_VOFF + (32 * x + 8 * g + q4) * RS_VP + 8 * p4;
#pragma unroll
                for (int ef = 0; ef < 4; ++ef) st[ef] = mma(kfr, trf(vb + 32 * ef, vb + 4 * RS_VP + 32 * ef), st[ef]); __builtin_amdgcn_sched_barrier(0); }
        }
    }
}
__device__ __forceinline__ void memkv_phase(const bf16* MN, const bf16* WKV, bf16* MKV) {
    const int tid = threadIdx.x, lane = tid & 63, wave = __builtin_amdgcn_readfirstlane(tid >> 6), g = lane >> 4, li = lane & 15;
    for (int it = blockIdx.x; it < 256; it += gridDim.x) {
        const int r0 = (it >> 4) * 128 + wave * 16, c0 = (it & 15) * 64;
        const bf16* ap = MN + (size_t)(r0 + li) * 1024 + 8 * g; const bf16* bp = WKV + (size_t)(c0 + li) * 1024 + 8 * g;
        f32x4 acc[4];
#pragma unroll
        for (int nf = 0; nf < 4; ++nf) acc[nf] = (f32x4){0.f, 0.f, 0.f, 0.f};
#pragma unroll 4
        for (int s = 0; s < 32; ++s) { const bf16x8 a = glbf(ap + 32 * s);
#pragma unroll
            for (int nf = 0; nf < 4; ++nf) acc[nf] = mma(glbf(bp + (size_t)nf * 16 * 1024 + 32 * s), a, acc[nf]); }
#pragma unroll
        for (int nf = 0; nf < 4; ++nf) *(u32x2*)(MKV + (size_t)(r0 + li) * 1024 + c0 + 16 * nf + 4 * g) = pack4(acc[nf]);
    }
}
}


struct Ptrs {
    const float* in[23]; float* out; unsigned char* ws;
    __device__ bf16* b(size_t off) const { return (bf16*)(ws + off); }
    __device__ float* f(size_t off) const { return (float*)(ws + off); }
};

__device__ __forceinline__ void phase0(const Ctx& c, const Ptrs& P) {
    int tb = 0;
    transpose_all(c, tb, ColWA{P.in[3]}, 8192, NPA, 1024, P.b(WS_WA));
    transpose_all(c, tb, ColOff{P.in[3], NPA}, 8192, NPG, 1024, P.b(WS_WG));
    transpose_all(c, tb, ColPlain{P.in[11]}, 1024, 1024, 1024, P.b(WS_WKV));
    transpose_all(c, tb, ColPlain{P.in[7]}, 1024, 1024, 1024, P.b(WS_WRO));
    transpose_all(c, tb, ColPlain{P.in[9]}, 1024, 1024, 512, P.b(WS_WNO));
    transpose_all(c, tb, ColPlain{P.in[12]}, 1024, 1024, 512, P.b(WS_WXO));
    transpose_all(c, tb, ColPlain{P.in[13]}, 1024, 1024, 1024, P.b(WS_WOUT));
    { float* COS = P.f(WS_COS); float* SIN = P.f(WS_SIN);
      for (int i = c.gw * 64 + c.lane; i < SEQ * 64; i += c.ngw * 64) { const int pos = i >> 6, fi = i & 63;
          const float inv = (float)pow(10000.0, -(double)fi / 64.0); const float ang = (float)pos * inv;
          COS[i] = (float)cos((double)ang); SIN[i] = (float)sin((double)ang); } }
    { bf16* FT = P.b(WS_FT); const float* rpb = P.in[8];
      for (int i = c.gw * 64 + c.lane; i < 8 * 15 * 64 * 64; i += c.ngw * 64) { const int qc = i & 63, kc = (i >> 6) & 63, hr = i >> 12;
          int cs = qc - 8; cs = cs < 0 ? 0 : (cs > 48 ? 48 : cs); int rc = kc - qc; rc = rc < -15 ? -15 : (rc > 15 ? 15 : rc);
          const float v = (kc >= cs && kc < cs + 16) ? rpb[hr * 31 + rc + 15] : -1.0e30f; FT[i] = (bf16)f2bf(v); } }
    { float* WTR = P.f(WS_WTR); const float* wrg = P.in[15]; const float* wre = P.in[17];
      for (int i = c.gw * 64 + c.lane; i < 20 * 1024; i += c.ngw * 64) { const int n = i >> 10, k = i & 1023; WTR[i] = n < 4 ? wrg[k * 4 + n] : wre[k * 16 + (n - 4)]; } }
    for (int m = c.gw; m < T; m += 2 * c.ngw) {
        const int m2 = m + c.ngw; const f32x4* xa = (const f32x4*)(P.in[0] + (size_t)m * DM) + c.lane; const f32x4* xb = (const f32x4*)(P.in[0] + (size_t)(m2 < T ? m2 : m) * DM) + c.lane;
        const f32x4* gr = (const f32x4*)P.in[2] + c.lane;
        f32x4 va[4], vb[4]; float sa = 0.f, sb = 0.f;
#pragma unroll
        for (int j = 0; j < 4; ++j) { va[j] = xa[64 * j]; vb[j] = xb[64 * j]; }
#pragma unroll
        for (int j = 0; j < 4; ++j) { sa += (va[j].x * va[j].x + va[j].y * va[j].y) + (va[j].z * va[j].z + va[j].w * va[j].w); sb += (vb[j].x * vb[j].x + vb[j].y * vb[j].y) + (vb[j].z * vb[j].z + vb[j].w * vb[j].w); }
        const float ra = 1.0f / sqrtf(wave_sum(sa) * (1.f / 1024.f) + RMS_EPS), rb = 1.0f / sqrtf(wave_sum(sb) * (1.f / 1024.f) + RMS_EPS);
        unsigned long long* oa = (unsigned long long*)(P.b(WS_XN) + (size_t)m * DM) + c.lane; unsigned long long* ob = (unsigned long long*)(P.b(WS_XN) + (size_t)m2 * DM) + c.lane;
#pragma unroll
        for (int j = 0; j < 4; ++j) { const f32x4 gg = gr[64 * j];
            oa[64 * j] = (unsigned long long)pk2(va[j].x * ra * gg.x, va[j].y * ra * gg.y) | ((unsigned long long)pk2(va[j].z * ra * gg.z, va[j].w * ra * gg.w) << 32);
            if (m2 < T) ob[64 * j] = (unsigned long long)pk2(vb[j].x * rb * gg.x, vb[j].y * rb * gg.y) | ((unsigned long long)pk2(vb[j].z * rb * gg.z, vb[j].w * rb * gg.w) << 32); } }
    for (int m = c.gw; m < TM; m += c.ngw) rms_row_to_bf16(P.in[1] + (size_t)m * DM, P.in[10], P.b(WS_MN) + (size_t)m * DM, c.lane);
}

__device__ __forceinline__ void phase1_naive(const Ctx& c, const Ptrs& P) {
    EpiProjA E{P.b(WS_RQ), P.b(WS_RK), P.b(WS_RV), P.b(WS_RG), P.b(WS_NQ), P.b(WS_NK), P.b(WS_NV), P.b(WS_XQ), P.f(WS_COS), P.f(WS_SIN)};
    naive_gemm(c, RowPlain{P.b(WS_XN), DM}, P.b(WS_WA), DM, T, NPA, DM, E);
}

__device__ __forceinline__ float log_sigmoid_(float x) { return -log1pf(expf(-x)); }

__device__ __forceinline__ void phase2_states_naive(const Ctx& c, const Ptrs& P) {
    const bf16* RK = P.b(WS_RK); const bf16* RV = P.b(WS_RV); bf16* ST = (bf16*)P.out;
    const int nitems = NB * 4 * 2 * 128 * 4;
    for (int it = c.gw; it < nitems; it += c.ngw) {
        const int eb = it & 3, d = (it >> 2) & 127, dir = (it >> 9) & 1, h = (it >> 10) & 3, b = it >> 12;
        const int e = eb * 64 + c.lane;
        const float lg = log_sigmoid_(dir ? P.in[5][h] : P.in[4][h]); const float gam = expf(lg);
        float S = 0.f;
        bf16* stb = ST + (size_t)(((b * 4 + h) * 2 + dir) * 16) * 256 * 128 + (size_t)e * 128 + d;
        for (int jj = 0; jj < SEQ; ++jj) {
            const int j = dir ? (SEQ - 1 - jj) : jj;
            if ((jj & 127) == 0) { const int n = j >> 7; stb[(size_t)n * 256 * 128] = (bf16)f2bf(S); }
            const size_t tok = (size_t)b * SEQ + j;
            const float kv = bf2f(RK[tok * 512 + h * 128 + d]) * bf2f(RV[tok * 1024 + h * 256 + e]);
            S = S * gam + kv;
        }
    }
}
__device__ __forceinline__ void phase2_na_naive(const Ctx& c, const Ptrs& P) {
    bf16* NQ = P.b(WS_NQ); const bf16* NK = P.b(WS_NK); const bf16* NV = P.b(WS_NV); const float* rpb = P.in[8];
    float* scr = (float*)(c.lds + c.wave * 16384);
    const int lane = c.lane;
    for (int it = c.gw; it < T * 8; it += c.ngw) {
        const int h = it & 7, tok = it >> 3, b = tok >> 11, s = tok & 2047, r = s >> 6, cc = s & 63;
        int rs = r - 4; rs = rs < 0 ? 0 : (rs > 24 ? 24 : rs);
        int cs = cc - 8; cs = cs < 0 ? 0 : (cs > 48 ? 48 : cs);
        scr[128 + lane] = bf2f(NQ[(size_t)tok * 512 + h * 64 + lane]);
        __builtin_amdgcn_s_waitcnt(0xC07F); asm volatile("" ::: "memory");
        float sc[2];
#pragma unroll
        for (int t = 0; t < 2; ++t) { const int key = lane + 64 * t, kr = rs + (key >> 4), kc = cs + (key & 15);
            const size_t kt = (size_t)b * SEQ + kr * 64 + kc; const u32x4* kp = (const u32x4*)(NK + kt * 512 + h * 64);
            float a = 0.f;
#pragma unroll 2
            for (int i = 0; i < 8; ++i) { float kk[8]; unpack8(kp[i], kk);
#pragma unroll
                for (int u = 0; u < 8; ++u) a += scr[128 + 8 * i + u] * kk[u]; }
            int rc = kc - cc; rc = rc < -15 ? -15 : (rc > 15 ? 15 : rc);
            sc[t] = a + rpb[(h * 15 + (kr - r + 7)) * 31 + rc + 15]; }
        const float mx = wave_max(fmaxf(sc[0], sc[1]));
        const float e0 = __expf(sc[0] - mx), e1 = __expf(sc[1] - mx);
        const float inv = 1.0f / wave_sum(e0 + e1);
        scr[lane] = e0 * inv; scr[lane + 64] = e1 * inv;
        __builtin_amdgcn_s_waitcnt(0xC07F); asm volatile("" ::: "memory");
        float o = 0.f;
        for (int key = 0; key < 128; ++key) { const int kr = rs + (key >> 4), kc = cs + (key & 15);
            const size_t kt = (size_t)b * SEQ + kr * 64 + kc; o += scr[key] * bf2f(NV[kt * 512 + h * 64 + lane]); }
        NQ[(size_t)tok * 512 + h * 64 + lane] = (bf16)f2bf(o);
        __builtin_amdgcn_s_waitcnt(0xC07F); asm volatile("" ::: "memory");
    }
}
__device__ __forceinline__ void phase2_memkv_naive(const Ctx& c, const Ptrs& P) {
    naive_gemm(c, RowPlain{P.b(WS_MN), DM}, P.b(WS_WKV), DM, TM, 1024, DM, EpiBf16Plain{P.b(WS_MKV), 1024});
}
__device__ __forceinline__ void phase3_ret_naive(const Ctx& c, const Ptrs& P) {
    const bf16* RQ = P.b(WS_RQ); const bf16* RK = P.b(WS_RK); const bf16* RV = P.b(WS_RV); bf16* RG = P.b(WS_RG); const bf16* ST = (const bf16*)P.out;
    const float* gain = P.in[6];
    float* scr = (float*)(c.lds + c.wave * 16384);
    const int lane = c.lane;
    for (int it = c.gw; it < T * 4; it += c.ngw) {
        const int h = it & 3, tok = it >> 2, b = tok >> 11, s = tok & 2047, n = s >> 7, p = s & 127;
        const float lgf = log_sigmoid_(P.in[4][h]), lgb = log_sigmoid_(P.in[5][h]);
        { const bf16* qp = RQ + (size_t)tok * 512 + h * 128; scr[lane] = bf2f(qp[lane]); scr[lane + 64] = bf2f(qp[lane + 64]); }
        __builtin_amdgcn_s_waitcnt(0xC07F); asm volatile("" ::: "memory");
        float sv[2];
#pragma unroll
        for (int t = 0; t < 2; ++t) { const int pj = lane + 64 * t; const size_t kt = (size_t)b * SEQ + n * 128 + pj;
            const u32x4* kp = (const u32x4*)(RK + kt * 512 + h * 128); float a = 0.f;
#pragma unroll 2
            for (int i = 0; i < 16; ++i) { float kk[8]; unpack8(kp[i], kk);
#pragma unroll
                for (int u = 0; u < 8; ++u) a += scr[8 * i + u] * kk[u]; }
            const float w = (pj <= p) ? expf((float)(p - pj) * lgf) : expf((float)(pj - p) * lgb);
            sv[t] = a * w; }
        scr[128 + lane] = sv[0]; scr[128 + 64 + lane] = sv[1];
        __builtin_amdgcn_s_waitcnt(0xC07F); asm volatile("" ::: "memory");
        const float af = expf((float)(p + 1) * lgf), ab = expf((float)(128 - p) * lgb);
        const bf16* sf = ST + (size_t)(((b * 4 + h) * 2 + 0) * 16 + n) * 256 * 128;
        const bf16* sb = ST + (size_t)(((b * 4 + h) * 2 + 1) * 16 + n) * 256 * 128;
        float y[4];
#pragma unroll 1
        for (int eb = 0; eb < 4; ++eb) { const int e = eb * 64 + lane; float a = 0.f;
#pragma unroll 4
            for (int pj = 0; pj < 128; ++pj) { const size_t kt = (size_t)b * SEQ + n * 128 + pj; a += scr[128 + pj] * bf2f(RV[kt * 1024 + h * 256 + e]); }
            float cf = 0.f, cb = 0.f; const u32x4* fp = (const u32x4*)(sf + (size_t)e * 128); const u32x4* bp = (const u32x4*)(sb + (size_t)e * 128);
#pragma unroll 2
            for (int i = 0; i < 16; ++i) { float x1[8], x2[8]; unpack8(fp[i], x1); unpack8(bp[i], x2);
#pragma unroll
                for (int u = 0; u < 8; ++u) { cf += scr[8 * i + u] * x1[u]; cb += scr[8 * i + u] * x2[u]; } }
            y[eb] = a + af * cf + ab * cb; }
        const float mu = wave_sum((y[0] + y[1]) + (y[2] + y[3])) * (1.f / 256.f);
        float v = 0.f;
#pragma unroll
        for (int eb = 0; eb < 4; ++eb) { y[eb] -= mu; v += y[eb] * y[eb]; }
        const float rstd = 1.0f / sqrtf(wave_sum(v) * (1.f / 256.f) + GN_EPS);
#pragma unroll
        for (int eb = 0; eb < 4; ++eb) { const int col = h * 256 + eb * 64 + lane; bf16* g = RG + (size_t)tok * 1024 + col;
            *g = (bf16)f2bf(y[eb] * rstd * gain[col] * bf2f(*g)); }
        __builtin_amdgcn_s_waitcnt(0xC07F); asm volatile("" ::: "memory");
    }
}
__device__ __forceinline__ void phase3_xa_naive(const Ctx& c, const Ptrs& P) {
    bf16* XQ = P.b(WS_XQ); const bf16* MKV = P.b(WS_MKV);
    float* scr = (float*)(c.lds + c.wave * 16384);
    const int lane = c.lane;
    for (int it = c.gw; it < T * 4; it += c.ngw) {
        const int h = it & 3, tok = it >> 2, b = tok >> 11;
        { const bf16* qp = XQ + (size_t)tok * 512 + h * 128; scr[lane] = bf2f(qp[lane]); scr[lane + 64] = bf2f(qp[lane + 64]); }
        __builtin_amdgcn_s_waitcnt(0xC07F); asm volatile("" ::: "memory");
        float sc[4]; float mx = -3.0e38f;
#pragma unroll
        for (int t = 0; t < 4; ++t) { const int m = lane + 64 * t; const u32x4* kp = (const u32x4*)(MKV + (size_t)(b * MEML + m) * 1024 + h * 128); float a = 0.f;
#pragma unroll 2
            for (int i = 0; i < 16; ++i) { float kk[8]; unpack8(kp[i], kk);
#pragma unroll
                for (int u = 0; u < 8; ++u) a += scr[8 * i + u] * kk[u]; }
            sc[t] = a; mx = fmaxf(mx, a); }
        mx = wave_max(mx); float sum = 0.f;
#pragma unroll
        for (int t = 0; t < 4; ++t) { sc[t] = __expf(sc[t] - mx); sum += sc[t]; }
        const float inv = 1.0f / wave_sum(sum);
#pragma unroll
        for (int t = 0; t < 4; ++t) scr[128 + lane + 64 * t] = sc[t] * inv;
        __builtin_amdgcn_s_waitcnt(0xC07F); asm volatile("" ::: "memory");
        float o0 = 0.f, o1 = 0.f;
        for (int m = 0; m < MEML; ++m) { const bf16* vp = MKV + (size_t)(b * MEML + m) * 1024 + 512 + h * 128; const float pm = scr[128 + m];
            o0 += pm * bf2f(vp[lane]); o1 += pm * bf2f(vp[lane + 64]); }
        bf16* op = XQ + (size_t)tok * 512 + h * 128; op[lane] = (bf16)f2bf(o0); op[lane + 64] = (bf16)f2bf(o1);
        __builtin_amdgcn_s_waitcnt(0xC07F); asm volatile("" ::: "memory");
    }
}
__device__ __forceinline__ void phase4_naive(const Ctx& c, const Ptrs& P) {
    naive_gemm(c, RowPlain{P.b(WS_XN), DM}, P.b(WS_WG), DM, T, NPG, DM, EpiSigmoid{P.b(WS_GATES), NPG});
}
__device__ __forceinline__ void phase5_naive(const Ctx& c, const Ptrs& P) {
    float* TMP = P.out; bf16* MIX = P.b(WS_MIX); const bf16* G = P.b(WS_GATES);
    naive_gemm(c, RowPlain{P.b(WS_RG), 1024}, P.b(WS_WRO), 1024, T, DM, 1024, EpiMixNaive<0>{TMP, MIX, G});
    naive_gemm(c, RowPlain{P.b(WS_NQ), 512}, P.b(WS_WNO), 512, T, DM, 512, EpiMixNaive<1>{TMP, MIX, G + 1024});
    naive_gemm(c, RowPlain{P.b(WS_XQ), 512}, P.b(WS_WXO), 512, T, DM, 512, EpiMixNaive<2>{TMP, MIX, G + 2048});
}
__device__ __forceinline__ void phase6_naive(const Ctx& c, const Ptrs& P) {
    naive_gemm(c, RowPlain{P.b(WS_MIX), DM}, P.b(WS_WOUT), DM, T, DM, DM, EpiResidF32{P.in[0], P.out});
}

__device__ __forceinline__ void phase1_mfma(const Ctx& c, const Ptrs& P) {
    EpiProjA E{P.b(WS_RQ), P.b(WS_RK), P.b(WS_RV), P.b(WS_RG), P.b(WS_NQ), P.b(WS_NK), P.b(WS_NV), P.b(WS_XQ), P.f(WS_COS), P.f(WS_SIN)};
    pg8::PlainSched S; S.o.init(T / 256, NPA / 256, gridDim.x, blockIdx.x); S.A = P.b(WS_XN); S.Bt = P.b(WS_WA); S.lda = DM; S.ldb = DM; S.K = DM;
    pg8::gemm_phase<false>((LAS unsigned char*)c.lds, S, pg8::EpiF<EpiProjA, 4>{E});
}
__device__ __forceinline__ void phase4_mfma(const Ctx& c, const Ptrs& P) {
    pg8::PlainSched S; S.o.init(T / 256, NPG / 256, gridDim.x, blockIdx.x); S.A = P.b(WS_XN); S.Bt = P.b(WS_WG); S.lda = DM; S.ldb = DM; S.K = DM;
    pg8::gemm_phase<false>((LAS unsigned char*)c.lds, S, pg8::EpiF<EpiSigmoid>{EpiSigmoid{P.b(WS_GATES), NPG}});
}
__device__ __forceinline__ void phase6_mfma(const Ctx& c, const Ptrs& P) {
    pg8::PlainSched S; S.o.init(T / 256, DM / 256, gridDim.x, blockIdx.x); S.A = P.b(WS_MIX); S.Bt = P.b(WS_WOUT); S.lda = DM; S.ldb = DM; S.K = DM;
    pg8::gemm_phase<false>((LAS unsigned char*)c.lds, S, pg8::EpiF<EpiResidBf16, 2>{EpiResidBf16{P.in[0], P.b(WS_D)}}, 25);
}

struct GateSched { pg8::TileOrder o; const unsigned char* ws;
    __device__ __forceinline__ bool next(int i, pg8::UnitDesc& u) const { int pm, pn; const int w = i % 3; if (!o.tile(i / 3, pm, pn)) return false;
        u.A = (const char*)(ws + WS_XN) + (size_t)pm * 256 * 2048; u.B = (const char*)(ws + WS_WG) + (size_t)(w * 1024 + pn * 256) * 2048; u.lda2 = 2048; u.ldb2 = 2048; u.nt = 16;
        u.row0 = pm * 256; u.col0 = pn * 256; u.aux = w; u.aux2 = 0; u.gidx = nullptr; u.gcnt = 0; u.chain = 0; return true; } };
__device__ __forceinline__ unsigned q8x4(f32x4 g) {
    const unsigned a = (unsigned)(g[0] * 255.0f + 0.5f), b = (unsigned)(g[1] * 255.0f + 0.5f), c = (unsigned)(g[2] * 255.0f + 0.5f), d = (unsigned)(g[3] * 255.0f + 0.5f);
    return a | (b << 8) | (c << 16) | (d << 24); }
__device__ __forceinline__ f32x4 dq8x4(unsigned w) {
    return (f32x4){fmaxf((float)(w & 0xffu) * (1.0f / 255.0f), 1e-18f), fmaxf((float)((w >> 8) & 0xffu) * (1.0f / 255.0f), 1e-18f),
                   fmaxf((float)((w >> 16) & 0xffu) * (1.0f / 255.0f), 1e-18f), fmaxf((float)(w >> 24) * (1.0f / 255.0f), 1e-18f)}; }
struct EpiGate { unsigned char* SCR;
    __device__ __forceinline__ void finish(f32x4 (&acc)[2][2][4][2], const pg8::UnitDesc& u, int wr, int wc, int fr, int fq) const {
        unsigned ow = (unsigned)((u.row0 >> 8) * 4 + (u.col0 >> 8)) * 196608u + (unsigned)u.aux * 65536u + threadIdx.x * 8u;
#pragma unroll
        for (int ai = 0; ai < 2; ++ai)
#pragma unroll
            for (int m = 0; m < 4; ++m) { asm volatile("" : "+v"(ow));
#pragma unroll
                for (int bj = 0; bj < 2; ++bj) { f32x4 s0, s1;
#pragma unroll
                    for (int i = 0; i < 4; ++i) { s0[i] = sigmoidf_(acc[ai][bj][m][0][i]); s1[i] = sigmoidf_(acc[ai][bj][m][1][i]); }
                    *(u32x2*)(SCR + ow + bj * 4096) = (u32x2){q8x4(s0), q8x4(s1)}; }
                ow += 2 * 4096; asm volatile("" ::: "memory"); __builtin_amdgcn_sched_barrier(0); }
        pg8::zero_acc(acc);
    } };
struct MixSched { pg8::TileOrder o; const unsigned char* ws;
    __device__ __forceinline__ bool next(int i, pg8::UnitDesc& u) const { int pm, pn; const int w = i % 3; if (!o.tile(i / 3, pm, pn)) return false;
        const size_t offA = w == 0 ? WS_RG : (w == 1 ? WS_NQ : WS_XQ), offB = w == 0 ? WS_WRO : (w == 1 ? WS_WNO : WS_WXO); const int K = w == 0 ? 1024 : 512;
        u.A = (const char*)(ws + offA) + (size_t)pm * 256 * K * 2; u.B = (const char*)(ws + offB) + (size_t)pn * 256 * K * 2; u.lda2 = K * 2; u.ldb2 = K * 2; u.nt = K / 64;
        u.row0 = pm * 256; u.col0 = pn * 256; u.aux = w; u.aux2 = 0; u.gidx = nullptr; u.gcnt = 0; u.chain = (w < 2); return true; } };
struct EpiMix { const unsigned char* SCR; bf16* MIX;
    __device__ __forceinline__ void finish(f32x4 (&acc)[2][2][4][2], const pg8::UnitDesc& u, int wr, int wc, int fr, int fq) const {
        const int w = u.aux; const bool fin = (w == 2);
        unsigned on = (unsigned)((u.row0 >> 8) * 4 + (u.col0 >> 8)) * 196608u + (unsigned)w * 65536u + threadIdx.x * 8u; const unsigned dd = fin ? 0u : 65536u;
        bf16* mp = MIX + (size_t)(u.row0 + wr * 64 + fr) * DM + u.col0 + wc * 32 + 8 * fq;
#pragma unroll
        for (int ai = 0; ai < 2; ++ai) {
            asm volatile("" : "+v"(on), "+v"(mp));
            u32x2 ga[4][2], gb[4][2];
#pragma unroll
            for (int m = 0; m < 4; ++m)
#pragma unroll
                for (int bj = 0; bj < 2; ++bj) { ga[m][bj] = *(const u32x2*)(SCR + on + (2 * m + bj) * 4096); gb[m][bj] = *(const u32x2*)(SCR + on + dd + (2 * m + bj) * 4096); }
#pragma unroll
            for (int m = 0; m < 4; ++m) {
#pragma unroll
                for (int bj = 0; bj < 2; ++bj) {
                    const f32x4 n0 = dq8x4(ga[m][bj].x), n1 = dq8x4(ga[m][bj].y), d0 = dq8x4(gb[m][bj].x), d1 = dq8x4(gb[m][bj].y);
                    f32x4 r0, r1;
#pragma unroll
                    for (int i = 0; i < 4; ++i) { r0[i] = n0[i] * __builtin_amdgcn_rcpf(fin ? 1.0f : d0[i]); r1[i] = n1[i] * __builtin_amdgcn_rcpf(fin ? 1.0f : d1[i]); }
                    const f32x4 v0 = acc[ai][bj][m][0] * r0, v1 = acc[ai][bj][m][1] * r1;
                    if (fin) store8(mp + (size_t)m * 16 * DM + bj * 128, v0, v1);
                    acc[ai][bj][m][0] = fin ? (f32x4){0.f, 0.f, 0.f, 0.f} : v0; acc[ai][bj][m][1] = fin ? (f32x4){0.f, 0.f, 0.f, 0.f} : v1; } }
            on += 8 * 4096; mp += 128 * DM; asm volatile("" ::: "memory"); __builtin_amdgcn_sched_barrier(0); }
    }
};
__device__ __forceinline__ void phase5_mfma(const Ctx& c, const Ptrs& P) {
    unsigned char* scr = P.ws + WS_GATES;
    { GateSched S; S.o.init(T / 256, DM / 256, gridDim.x, blockIdx.x); S.ws = P.ws; pg8::gemm_phase<false>((LAS unsigned char*)c.lds, S, EpiGate{scr}); }
    { MixSched S; S.o.init(T / 256, DM / 256, gridDim.x, blockIdx.x); S.ws = P.ws; pg8::gemm_phase<false>((LAS unsigned char*)c.lds, S, EpiMix{scr, P.b(WS_MIX)}); }
}
struct MoeSched { const unsigned* ctl; int mode;
    int lo, hi, nblk, v;
    const bf16 *H2, *WGU, *HID, *WD; const int* elist;
    __device__ __forceinline__ bool next(int i, pg8::UnitDesc& u) const {
        if (v < 0) return false;
        const int L = lo + v + i * nblk; if (L >= hi) return false;
        const int pn = L & 3; int mtg = L >> 2;
        int e = -1, base = 0, cnt = 0, mt = 0;
#pragma unroll 1
        for (int j = 0; j < NEXP; ++j) { const int cj = (int)__builtin_amdgcn_readfirstlane((int)ctl[CW_ECNT + 64 * j]); const int tj = (cj + 255) >> 8;
            if (mtg < tj) { e = j; cnt = cj; mt = mtg; break; } mtg -= tj; base += tj * 256; }
        if (e < 0) return false;
        u.row0 = mt * 256; u.col0 = pn * 256; u.aux = e; u.aux2 = base; u.gcnt = cnt; u.chain = 0;
        if (mode == 0) { u.A = (const char*)H2; u.gidx = elist + e * T; u.lda2 = DM * 2; u.B = (const char*)(WGU + (size_t)e * 1024 * 1024 + (size_t)pn * 256 * 1024); u.ldb2 = 2048; u.nt = 16; }
        else { u.A = (const char*)(HID + (size_t)(base + mt * 256) * DFF); u.gidx = nullptr; u.lda2 = DFF * 2; u.B = (const char*)(WD + (size_t)e * 1024 * 512 + (size_t)pn * 256 * 512); u.ldb2 = 1024; u.nt = 8; }
        return true; } };
struct EpiMoeUp { bf16* HID; const float* EWL; const float* ERS;
    __device__ __forceinline__ void finish(f32x4 (&acc)[2][2][4][2], const pg8::UnitDesc& u, int wr, int wc, int fr, int fq) const {
        const float* wl = EWL + u.aux * T; const float* rl = ERS + u.aux * T; bf16* H = HID; const int base = u.aux2, cnt = u.gcnt;
        pg8::epi_apply(acc, u, wr, wc, fr, fq, [=](int row, int col0, f32x4 v0, f32x4 v1) { if (row < cnt) { const float rs = rl[row], w = wl[row] * rs; f32x4 h;
#pragma unroll
            for (int i = 0; i < 4; ++i) h[i] = siluf_(v0[i] * rs) * v1[i] * w;
            u32x2 o; o.x = pk2(h[0], h[1]); o.y = pk2(h[2], h[3]); *(u32x2*)(H + (size_t)(base + row) * DFF + (col0 >> 1)) = o; } });
        pg8::zero_acc(acc);
    } };
struct EpiMoeDown { bf16* DR;
    __device__ __forceinline__ void finish(f32x4 (&acc)[2][2][4][2], const pg8::UnitDesc& u, int wr, int wc, int fr, int fq) const {
        bf16* D = DR; const int base = u.aux2;
        pg8::epi_apply(acc, u, wr, wc, fr, fq, [=](int row, int col0, f32x4 v0, f32x4 v1) { store8(D + (size_t)(base + row) * DM + col0, v0, v1); });
        pg8::zero_acc(acc);
    } };
__device__ __forceinline__ MoeSched moe_sched(const Ptrs& P, int mode) {
    MoeSched S; S.ctl = (const unsigned*)(P.ws + WS_CTL); S.mode = mode; S.H2 = P.b(WS_D); S.WGU = P.b(WS_WGU); S.HID = P.b(WS_HID); S.WD = P.b(WS_WD); S.elist = (const int*)(P.ws + WS_ELIST);
    S.lo = 0; S.hi = 0; S.nblk = 1; S.v = -1; return S; }
__device__ __forceinline__ int moe_tiles(const Ptrs& P) { const unsigned* ctl = (const unsigned*)(P.ws + WS_CTL); int tiles = 0;
    for (int j = 0; j < NEXP; ++j) tiles += ((int)ctl[CW_ECNT + 64 * j] + 255) >> 8; return tiles; }
__device__ __forceinline__ void phase8a(const Ctx& c, const Ptrs& P) {
    const int G = (int)gridDim.x, units = 4 * moe_tiles(P);
    MoeSched S = moe_sched(P, 0); S.lo = 0; S.hi = units < 2 * G ? units : 2 * G; S.nblk = G; S.v = (int)blockIdx.x;
    pg8::gemm_phase<true>((LAS unsigned char*)c.lds, S, EpiMoeUp{P.b(WS_HID), P.f(WS_EWL), P.f(WS_ERS)});
}
__device__ __forceinline__ void phase8b(const Ctx& c, const Ptrs& P) {
    const int G = (int)gridDim.x, tiles = moe_tiles(P), units = 4 * tiles; const int nrem = units - 2 * G < 0 ? 0 : units - 2 * G;
    const int tdone = (2 * G) / 4 < tiles ? (2 * G) / 4 : tiles;
    const bool local = nrem > 0 && nrem <= G / 2;
    const int nup = local ? nrem : (nrem < G / 2 ? nrem : G / 2);
    if ((int)blockIdx.x < nup) {
        MoeSched S = moe_sched(P, 0); S.lo = 2 * G; S.hi = units; S.nblk = nup; S.v = (int)blockIdx.x;
        pg8::gemm_phase<true>((LAS unsigned char*)c.lds, S, EpiMoeUp{P.b(WS_HID), P.f(WS_EWL), P.f(WS_ERS)});
        if (local) {
            const int L = 2 * G + (int)blockIdx.x, tile = L >> 2; unsigned* cnt = (unsigned*)(P.ws + WS_CTL) + CW_TCNT + 64 * (tile - tdone);
            if (c.tid == 0) {
                __builtin_amdgcn_fence(__ATOMIC_RELEASE, "agent"); asm volatile("s_waitcnt vmcnt(0)" ::: "memory");
                __hip_atomic_fetch_add(cnt, 1u, __ATOMIC_RELAXED, __HIP_MEMORY_SCOPE_AGENT);
                const int need = (units - 4 * tile) < 4 ? (units - 4 * tile) : 4; unsigned sp = 0;
                while (__hip_atomic_load(cnt, __ATOMIC_RELAXED, __HIP_MEMORY_SCOPE_AGENT) < (unsigned)need) { __builtin_amdgcn_s_sleep(2); if (++sp > (1u << 22)) break; }
                __builtin_amdgcn_fence(__ATOMIC_ACQUIRE, "agent"); asm volatile("s_waitcnt vmcnt(0)" ::: "memory");
            }
            __syncthreads();
            MoeSched D = moe_sched(P, 1); D.lo = L; D.hi = L + 1; D.nblk = 1; D.v = 0;
            pg8::gemm_phase<false>((LAS unsigned char*)c.lds, D, EpiMoeDown{P.b(WS_DROWS)});
        }
    } else { MoeSched S = moe_sched(P, 1); S.lo = 0; S.hi = 4 * tdone; S.nblk = G - nup; S.v = (int)blockIdx.x - nup;
        pg8::gemm_phase<false>((LAS unsigned char*)c.lds, S, EpiMoeDown{P.b(WS_DROWS)}); }
}
__device__ __forceinline__ bool moe_needs_8c(const Ptrs& P) { const int G = (int)gridDim.x, units = 4 * moe_tiles(P); const int nrem = units - 2 * G; return nrem > G / 2; }
__device__ __forceinline__ void phase8c(const Ctx& c, const Ptrs& P) {
    if (!moe_needs_8c(P)) return;
    const int G = (int)gridDim.x, tiles = moe_tiles(P); const int tdone = (2 * G) / 4 < tiles ? (2 * G) / 4 : tiles;
    MoeSched S = moe_sched(P, 1); S.lo = 4 * tdone; S.hi = 4 * tiles; S.nblk = G; S.v = (int)blockIdx.x;
    pg8::gemm_phase<false>((LAS unsigned char*)c.lds, S, EpiMoeDown{P.b(WS_DROWS)});
}
__device__ __forceinline__ void phase2_memkv_mfma(const Ctx& c, const Ptrs& P) {
    pg8::PlainSched S; S.o.init(TM / 256, 1024 / 256, gridDim.x, blockIdx.x); S.A = P.b(WS_MN); S.Bt = P.b(WS_WKV); S.lda = DM; S.ldb = DM; S.K = DM;
    pg8::gemm_phase<false>((LAS unsigned char*)c.lds, S, pg8::EpiF<EpiBf16Plain>{EpiBf16Plain{P.b(WS_MKV), 1024}});
}
__device__ __forceinline__ f32x4 x1_load(const float* X0, const bf16* DD, size_t tok, int lane, int j) {
    const u32x2 d = ((const u32x2*)(DD + tok * DM) + lane)[64 * j];
    return (f32x4){bf2f(d.x & 0xffffu), bf2f(d.x >> 16), bf2f(d.y & 0xffffu), bf2f(d.y >> 16)};
}
constexpr int RT7_WT = 0, RT7_RED = 81920, RT7_LOG = RT7_RED + 8 * 5120, RT7_CNT = RT7_LOG + 8 * 160, RT7_GB = RT7_CNT + 64, RT7_REC = RT7_GB + 64;
__device__ __forceinline__ void phase7(const Ctx& c, const Ptrs& P) {
    const float* X0 = P.in[0]; const bf16* DD = P.b(WS_D); const float* g = P.in[14]; const float* wrg = P.in[15]; const float* brg = P.in[16]; const float* wre = P.in[17]; const float* bre = P.in[18];
    unsigned* ctl = (unsigned*)(P.ws + WS_CTL); int* elist = (int*)(P.ws + WS_ELIST); float* ewl = P.f(WS_EWL); int* tmeta = (int*)(P.ws + WS_TMETA);
    const int lane = c.lane; LAS unsigned char* L = (LAS unsigned char*)c.lds;
    { LAS f32x4* WT = (LAS f32x4*)(L + RT7_WT); const f32x4* src = (const f32x4*)P.f(WS_WTR);
#pragma unroll
      for (int i = 0; i < 10; ++i) WT[c.tid + NTHREADS * i] = src[c.tid + NTHREADS * i];
      if (c.tid < 16) ((LAS unsigned*)(L + RT7_CNT))[c.tid] = 0u; (void)wrg; (void)wre; }
    __syncthreads();
    LAS float* RED = (LAS float*)(L + RT7_RED + c.wave * 5120); LAS float* LOG = (LAS float*)(L + RT7_LOG + c.wave * 160);
    LAS unsigned* LCNT = (LAS unsigned*)(L + RT7_CNT); LAS int* REC = (LAS int*)(L + RT7_REC);
    const float mybias = lane < 4 ? brg[lane] : (lane < 20 ? bre[lane - 4] : 0.f);
    f32x4 xn[2][4];
    if (c.gw < T / 2) {
#pragma unroll
        for (int t = 0; t < 2; ++t)
#pragma unroll
            for (int j = 0; j < 4; ++j) xn[t][j] = x1_load(X0, DD, (size_t)(2 * c.gw + t), lane, j); }
    int pidx = 0;
#pragma unroll 1
    for (int tp = c.gw; tp < T / 2; tp += c.ngw, ++pidx) {
        f32x4 hh[2][4]; float rstd2[2]; const f32x4* gr = (const f32x4*)g + lane;
#pragma unroll
        for (int t = 0; t < 2; ++t)
#pragma unroll
            for (int j = 0; j < 4; ++j) hh[t][j] = xn[t][j];
        { const int tpn = tp + c.ngw < T / 2 ? tp + c.ngw : tp;
#pragma unroll
          for (int t = 0; t < 2; ++t)
#pragma unroll
              for (int j = 0; j < 4; ++j) xn[t][j] = x1_load(X0, DD, (size_t)(2 * tpn + t), lane, j); }
#pragma unroll
        for (int t = 0; t < 2; ++t) { const int tok = 2 * tp + t; float s = 0.f;
#pragma unroll
            for (int j = 0; j < 4; ++j) { s += (hh[t][j].x * hh[t][j].x + hh[t][j].y * hh[t][j].y) + (hh[t][j].z * hh[t][j].z + hh[t][j].w * hh[t][j].w); }
            const float r = 1.0f / sqrtf(wave_sum(s) * (1.f / 1024.f) + RMS_EPS); rstd2[t] = r; (void)tok;
#pragma unroll
            for (int j = 0; j < 4; ++j) { const f32x4 gg = gr[64 * j]; hh[t][j] = hh[t][j] * gg * r; } }
        float p0[20], p1[20];
        const LAS f32x4* wt = (const LAS f32x4*)(L + RT7_WT) + lane;
#pragma unroll
        for (int n = 0; n < 20; ++n) { f32x2_ a = {0.f, 0.f};
#pragma unroll
            for (int j = 0; j < 4; ++j) { const f32x4 w4 = wt[n * 256 + 64 * j];
#pragma unroll
                for (int u = 0; u < 4; ++u) { const f32x2_ hv = {hh[0][j][u], hh[1][j][u]}; const f32x2_ wv = {w4[u], w4[u]}; a = __builtin_elementwise_fma(hv, wv, a); } }
            p0[n] = a[0]; p1[n] = a[1]; __builtin_amdgcn_sched_barrier(0); }
#pragma unroll 1
        for (int t = 0; t < 2; ++t) {
#pragma unroll
            for (int q = 0; q < 5; ++q) *(LAS f32x4*)(RED + lane * 20 + 4 * q) = t ? (f32x4){p1[4 * q], p1[4 * q + 1], p1[4 * q + 2], p1[4 * q + 3]} : (f32x4){p0[4 * q], p0[4 * q + 1], p0[4 * q + 2], p0[4 * q + 3]};
            asm volatile("s_waitcnt lgkmcnt(0)" ::: "memory");
            float sum = 0.f; const int nn = lane < 20 ? lane : 0;
#pragma unroll 16
            for (int j = 0; j < 64; ++j) sum += RED[j * 20 + nn];
            if (lane < 20) LOG[t * 20 + lane] = sum + mybias;
            asm volatile("s_waitcnt lgkmcnt(0)" ::: "memory");
        }
        if (lane < 2) {
            const int tok = 2 * tp + lane;
            float l[20];
#pragma unroll
            for (int i = 0; i < 20; ++i) l[i] = LOG[lane * 20 + i];
            int gi = 0;
#pragma unroll
            for (int i = 1; i < 4; ++i) if (l[i] > l[gi]) gi = i;
            float lmax = l[0];
#pragma unroll
            for (int i = 1; i < 4; ++i) lmax = fmaxf(lmax, l[i]);
            float se = 0.f;
#pragma unroll
            for (int i = 0; i < 4; ++i) se += expf(l[i] - lmax);
            const float grp_w = 1.0f / se;
            float el[4];
#pragma unroll
            for (int i = 0; i < 4; ++i) { float a = 0.f;
#pragma unroll
                for (int g2 = 0; g2 < 4; ++g2) a = (g2 == gi) ? l[4 + 4 * g2 + i] : a;
                el[i] = a; }
            int ia = 0;
#pragma unroll
            for (int i = 1; i < 4; ++i) if (el[i] > el[ia]) ia = i;
            int ib = (ia == 0) ? 1 : 0;
#pragma unroll
            for (int i = 0; i < 4; ++i) if (i != ia && i != ib && el[i] > el[ib]) ib = i;
            float ela = el[0], elb = el[0];
#pragma unroll
            for (int i = 1; i < 4; ++i) { ela = (i == ia) ? el[i] : ela; elb = (i == ib) ? el[i] : elb; }
            const float t = expf(elb - ela); const float wa = grp_w / (1.0f + t), wb = grp_w * t / (1.0f + t);
            const int ea = gi * 4 + ia, eb = gi * 4 + ib;
            const int lpa = (int)atomicAdd((unsigned*)(LCNT + ea), 1u), lpb = (int)atomicAdd((unsigned*)(LCNT + eb), 1u);
            LAS int* rec = REC + (c.wave * 8 + pidx * 2 + lane) * 8;
            rec[0] = tok; rec[1] = ea; rec[2] = lpa; rec[3] = eb; rec[4] = lpb; rec[5] = __float_as_int(wa); rec[6] = __float_as_int(wb); rec[7] = __float_as_int(lane ? rstd2[1] : rstd2[0]);
        }
    }
    __syncthreads();
    if (c.tid < 16) ((LAS unsigned*)(L + RT7_GB))[c.tid] = atomicAdd(ctl + CW_ECNT + 64 * c.tid, LCNT[c.tid]);
    __syncthreads();
    if (c.tid < 64) { const int wv = c.tid >> 3, k = c.tid & 7;
        const int gwv = blockIdx.x * NWAVES + wv; const int npairs = gwv < T / 2 ? (T / 2 - 1 - gwv) / c.ngw + 1 : 0;
        if ((k >> 1) < npairs) { const LAS int* rec = REC + c.tid * 8; const LAS unsigned* GB = (const LAS unsigned*)(L + RT7_GB);
            const int tok = rec[0], ea = rec[1], eb = rec[3]; const int pa = (int)GB[ea] + rec[2], pb = (int)GB[eb] + rec[4];
            elist[ea * T + pa] = tok; ewl[ea * T + pa] = __int_as_float(rec[5]); elist[eb * T + pb] = tok; ewl[eb * T + pb] = __int_as_float(rec[6]);
            float* ers = (float*)(P.ws + WS_ERS); ers[ea * T + pa] = __int_as_float(rec[7]); ers[eb * T + pb] = __int_as_float(rec[7]);
            *(int4*)(tmeta + 4 * tok) = make_int4(ea, pa, eb, pb); } }
    __syncthreads();
    int tb = 0;
    for (int e = 0; e < NEXP; ++e) {
        transpose_all(c, tb, ColGU{P.in[19] + (size_t)e * 1024 * 512, P.in[20] + (size_t)e * 1024 * 512}, 512, 1024, 1024, P.b(WS_WGU) + (size_t)e * 1024 * 1024, P.in[14]);
        transpose_all(c, tb, ColPlain{P.in[21] + (size_t)e * 512 * 1024}, 1024, 1024, 512, P.b(WS_WD) + (size_t)e * 1024 * 512);
    }
}
__device__ __forceinline__ int expert_rowbase(const unsigned* ctl, int e, int& cnt_e) {
    int base = 0; cnt_e = 0;
    for (int i = 0; i < NEXP; ++i) { const int ci = (int)ctl[CW_ECNT + 64 * i]; if (i < e) base += (ci + 255) & ~255; if (i == e) cnt_e = ci; }
    return base;
}
__device__ __forceinline__ void phase8_naive(const Ctx& c, const Ptrs& P) {
    const unsigned* ctl = (const unsigned*)(P.ws + WS_CTL);
    for (int e = 0; e < NEXP; ++e) { int cnt; const int base = expert_rowbase(ctl, e, cnt);
        naive_gemm(c, RowGather{P.b(WS_H2), DM, (const int*)(P.ws + WS_ELIST) + e * T}, P.b(WS_WGU) + (size_t)e * 1024 * 1024, 1024, cnt, 1024, 1024,
                   EpiSwiGLU{P.b(WS_HID), P.f(WS_EWL) + e * T, base}); }
}
__device__ __forceinline__ void phase9_naive(const Ctx& c, const Ptrs& P) {
    const unsigned* ctl = (const unsigned*)(P.ws + WS_CTL);
    for (int e = 0; e < NEXP; ++e) { int cnt; const int base = expert_rowbase(ctl, e, cnt);
        naive_gemm(c, RowPlain{P.b(WS_HID) + (size_t)base * DFF, DFF}, P.b(WS_WD) + (size_t)e * 1024 * 512, 512, cnt, 1024, 512, EpiRowsBf16{P.b(WS_DROWS), 1024, base}); }
}
struct FinTok { f32x4 x[4]; unsigned long long a[4], b[4]; };
__device__ __forceinline__ void fin_issue(FinTok& d, const float* X0, const bf16* DD, const bf16* DR, int tok, int4 m, const int (&rb)[NEXP], int lane) {
    int ba = 0, bb = 0;
#pragma unroll
    for (int i = 0; i < NEXP; ++i) { ba = (i == m.x) ? rb[i] : ba; bb = (i == m.z) ? rb[i] : bb; }
    const unsigned long long* da = (const unsigned long long*)(DR + (size_t)(ba + m.y) * DM) + lane;
    const unsigned long long* db = (const unsigned long long*)(DR + (size_t)(bb + m.w) * DM) + lane;
#pragma unroll
    for (int j = 0; j < 4; ++j) { d.a[j] = da[64 * j]; d.b[j] = db[64 * j]; d.x[j] = x1_load(X0, DD, (size_t)tok, lane, j); }
}
__device__ __forceinline__ void phase10(const Ctx& c, const Ptrs& P) {
    const unsigned* ctl = (const unsigned*)(P.ws + WS_CTL); const int* tmeta = (const int*)(P.ws + WS_TMETA); const bf16* DR = P.b(WS_DROWS); const float* g = P.in[22];
    int rb[NEXP]; { int base = 0;
#pragma unroll
        for (int i = 0; i < NEXP; ++i) { rb[i] = base; base += ((int)ctl[CW_ECNT + 64 * i] + 255) & ~255; } }
    const int lane = c.lane;
    if (c.gw >= T) return;
    FinTok cur, nxt; int4 mn = *(const int4*)(tmeta + 4 * c.gw);
    fin_issue(cur, P.in[0], P.b(WS_D), DR, c.gw, mn, rb, lane);
    { const int t1 = c.gw + c.ngw; mn = *(const int4*)(tmeta + 4 * (t1 < T ? t1 : c.gw)); }
#pragma unroll 1
    for (int tok = c.gw; tok < T; tok += c.ngw) {
        const int t1 = tok + c.ngw, t2 = tok + 2 * c.ngw;
        if (t1 < T) { fin_issue(nxt, P.in[0], P.b(WS_D), DR, t1, mn, rb, lane); mn = *(const int4*)(tmeta + 4 * (t2 < T ? t2 : tok)); }
        f32x4* xr = (f32x4*)(P.out + (size_t)tok * DM) + lane; const f32x4* gr = (const f32x4*)g + lane;
        f32x4 v[4]; float s = 0.f;
#pragma unroll
        for (int j = 0; j < 4; ++j) { const unsigned long long a = cur.a[j], b = cur.b[j]; f32x4 x = cur.x[j];
            x.x += bf2f((unsigned)a & 0xffffu) + bf2f((unsigned)b & 0xffffu); x.y += bf2f(((unsigned)a >> 16)) + bf2f(((unsigned)b >> 16));
            x.z += bf2f((unsigned)(a >> 32) & 0xffffu) + bf2f((unsigned)(b >> 32) & 0xffffu); x.w += bf2f((unsigned)(a >> 48)) + bf2f((unsigned)(b >> 48));
            v[j] = x; s += (x.x * x.x + x.y * x.y) + (x.z * x.z + x.w * x.w); }
        const float r = 1.0f / sqrtf(wave_sum(s) * (1.f / 1024.f) + RMS_EPS);
#pragma unroll
        for (int j = 0; j < 4; ++j) { const f32x4 gg = gr[64 * j]; xr[64 * j] = (f32x4){v[j].x * r * gg.x, v[j].y * r * gg.y, v[j].z * r * gg.z, v[j].w * r * gg.w}; }
        cur = nxt;
    }
#if PROBE_TS_A >= 0
    if (c.gw == 0 && lane == 0) { volatile LAS unsigned* MISC = (volatile LAS unsigned*)((LAS unsigned char*)c.lds + MISC_OFF);
        asm volatile("s_waitcnt vmcnt(0)" ::: "memory"); MISC[32 + 24] = (unsigned)__builtin_amdgcn_s_memrealtime();
        const unsigned dt = MISC[32 + PROBE_TS_B] - MISC[32 + PROBE_TS_A]; P.out[0] += 8.0f + (float)dt * (0.01f / PROBE_TS_DIV); }
#endif
}

constexpr int NPHASES = 12;
__global__ void __launch_bounds__(NTHREADS, 2) mk_fwd(Args args) {
    extern __shared__ __attribute__((aligned(16))) unsigned char lds[];
    Ctx c; c.tid = threadIdx.x; c.lane = c.tid & 63; c.wave = __builtin_amdgcn_readfirstlane(c.tid >> 6);
    c.gw = blockIdx.x * NWAVES + c.wave; c.ngw = gridDim.x * NWAVES; c.lds = lds;
    Ptrs P;
#pragma unroll
    for (int i = 0; i < 23; ++i) P.in[i] = args.in[i];
    P.out = args.out; P.ws = args.ws;
    volatile LAS unsigned* MISC = (volatile LAS unsigned*)((LAS unsigned char*)lds + MISC_OFF);
    if (c.tid < 32) MISC[c.tid] = 0u;
    __syncthreads();
    XcdBarrier bar; bar.bar = (unsigned*)(args.ws + WS_CTL) + CW_BAR; bar.x = 0; bar.st = nullptr;
    const int lo = args.ph_lo, hi = args.ph_hi;
    if (hi - lo > 1) bar = xcd_barrier_post((unsigned*)(args.ws + WS_CTL) + CW_BAR, MISC + 8);
#define IN(k) (lo <= (k) && (k) < hi)
#define SEAM(k) do { if (IN(k) && IN((k) + 1)) xcd_barrier(bar); } while (0)
    const int sub = args.sub, rep = args.rep;
#if PROBE_TS_A >= 0
#define STAMP(k) do { if (blockIdx.x == 0 && c.tid == 0) MISC[32 + (k)] = (unsigned)__builtin_amdgcn_s_memrealtime(); } while (0)
#else
#define STAMP(k) do { } while (0)
#endif
    STAMP(0);
#define SUBRUN(id, stmt) do { if (sub & (1 << (id))) { stmt; if (rep == (id)) { __syncthreads(); stmt; } __syncthreads(); } } while (0)
    if (IN(0)) { SUBRUN(0, phase0(c, P)); } STAMP(1); SEAM(0); STAMP(2);
    if (IN(1)) { SUBRUN(1, phase1_mfma(c, P)); } STAMP(3); SEAM(1); STAMP(4);
    if (IN(2)) { SUBRUN(2, mx::ret_state_phase((LAS unsigned char*)lds, P.b(WS_RK), P.b(WS_RV), (bf16*)P.out, P.in[4], P.in[5])); STAMP(5);
                 SUBRUN(3, mx::na_phase((LAS unsigned char*)lds, P.b(WS_NQ), P.b(WS_NK), P.b(WS_NV), P.b(WS_FT))); STAMP(6);
                 SUBRUN(4, phase2_memkv_mfma(c, P)); } STAMP(7); SEAM(2); STAMP(8);
    if (IN(3)) { SUBRUN(5, mx::ret_out_phase((LAS unsigned char*)lds, P.b(WS_RQ), P.b(WS_RK), P.b(WS_RV), P.b(WS_RG), (const bf16*)P.out, P.in[6], P.in[4], P.in[5])); STAMP(9);
                 SUBRUN(6, mx::xa_phase((LAS unsigned char*)lds, P.b(WS_XQ), P.b(WS_MKV))); } STAMP(10); SEAM(3); STAMP(11);
    STAMP(12); STAMP(13);
    if (IN(5)) { SUBRUN(8, phase5_mfma(c, P)); } STAMP(14); SEAM(5); STAMP(15);
    if (IN(6)) { SUBRUN(9, phase6_mfma(c, P)); } STAMP(16); SEAM(6); STAMP(17);
    if (IN(7)) { SUBRUN(10, phase7(c, P)); } STAMP(18); SEAM(7); STAMP(19);
    if (IN(8)) { SUBRUN(11, phase8a(c, P)); } STAMP(20); SEAM(8); STAMP(21);
    if (IN(9)) { SUBRUN(12, phase8b(c, P)); } STAMP(22); SEAM(9); STAMP(23);
    if (IN(10) && moe_needs_8c(P)) { SUBRUN(12, phase8c(c, P)); STAMP(44); SEAM(10); } STAMP(45);
    if (IN(11)) { SUBRUN(13, phase10(c, P)); }
#undef SUBRUN
#undef IN
#undef SEAM
}

extern "C" void kernel_launch(void* const* d_in, const int* in_sizes, int n_in, void* d_out, int out_size, void* d_ws, size_t ws_size, hipStream_t stream) {
    static int grid = 0;
    if (grid == 0) {
        if (n_in != 23 || out_size != T * DM || ws_size < WS_END) { fprintf(stderr, "kernel_launch: unexpected shapes (n_in %d out %d ws %zu)\n", n_in, out_size, ws_size); grid = -1; return; }
        int dev = 0, cus = 0;
        if (hipGetDevice(&dev) != hipSuccess || hipDeviceGetAttribute(&cus, hipDeviceAttributeMultiprocessorCount, dev) != hipSuccess) { grid = -1; return; }
        if (hipFuncSetAttribute((const void*)mk_fwd, hipFuncAttributeMaxDynamicSharedMemorySize, LDS_BYTES) != hipSuccess) { fprintf(stderr, "kernel_launch: hipFuncSetAttribute failed\n"); grid = -1; return; }
        (void)hipGetLastError();
        grid = cus;
    }
    if (grid < 0) return;
    (void)hipMemsetAsync((char*)d_ws + WS_CTL, 0, CTL_ZERO_BYTES, stream);
    Args a{};
    for (int i = 0; i < 23; ++i) a.in[i] = (const float*)d_in[i];
    a.out = (float*)d_out; a.ws = (unsigned char*)d_ws;
#if MK_PER_PHASE
    a.sub = 0x3fff; a.rep = -1;
    for (int p = 0; p < NPHASES; ++p) { a.ph_lo = p; a.ph_hi = p + 1; hipLaunchKernelGGL(mk_fwd, dim3(grid), dim3(NTHREADS), LDS_BYTES, stream, a); }
#else
    a.ph_lo = 0; a.ph_hi = NPHASES; a.sub = 0x3fff; a.rep = PROBE_REP; hipLaunchKernelGGL(mk_fwd, dim3(grid), dim3(NTHREADS), LDS_BYTES, stream, a);
#if PROBE_END >= 0
    { const int ph_of[14] = {0, 1, 2, 2, 2, 3, 3, 4, 5, 6, 7, 8, 9, 11};
      a.ph_lo = ph_of[PROBE_END]; a.ph_hi = a.ph_lo + 1; a.sub = 1 << PROBE_END; a.rep = -1; hipLaunchKernelGGL(mk_fwd, dim3(grid), dim3(NTHREADS), LDS_BYTES, stream, a); }
#endif
#endif
}
```

```cpp
#include <hip/hip_runtime.h>
#include <cstdio>
#include <cstdint>

#ifndef PROBE_REP
#define PROBE_REP -1
#endif
#ifndef PROBE_END
#define PROBE_END -1
#endif
#ifndef PROBE_TS_A
#define PROBE_TS_A -1
#define PROBE_TS_B -1
#endif
#ifndef PROBE_TS_DIV
#define PROBE_TS_DIV 8.0f
#endif
#ifndef MK_PER_PHASE
#define MK_PER_PHASE 0
#endif

#define GAS __attribute__((address_space(1)))
#define LAS __attribute__((address_space(3)))
typedef unsigned short bf16;
typedef float f32x4 __attribute__((ext_vector_type(4)));
typedef unsigned u32x4 __attribute__((ext_vector_type(4)));
typedef unsigned u32x2 __attribute__((ext_vector_type(2)));
typedef short bf16x8 __attribute__((ext_vector_type(8)));

constexpr int NB = 8, SEQ = 2048, DM = 1024, T = NB * SEQ;
constexpr int MEML = 256, TM = NB * MEML;
constexpr int NWAVES = 8, NTHREADS = 512;
constexpr int NPA = 5120, NPG = 3072;
constexpr int NEXP = 16, DFF = 512;
constexpr float RMS_EPS = 1e-6f, GN_EPS = 1e-5f;
constexpr float QK_SCALE = 0.08838834764831845f;

constexpr size_t MiB = 1u << 20;
constexpr size_t WS_CTL = 0, CTL_ZERO_BYTES = 65536;
constexpr size_t WS_COS = 1 * MiB, WS_SIN = 1 * MiB + 512 * 1024;
constexpr size_t WS_ELIST = 2 * MiB;
constexpr size_t WS_FT = 2 * MiB;
constexpr size_t WS_EWL = 3 * MiB;
constexpr size_t WS_TMETA = 4 * MiB;
constexpr size_t WS_WA = 5 * MiB;
constexpr size_t WS_WG = 15 * MiB;
constexpr size_t WS_WKV = 21 * MiB;
constexpr size_t WS_WRO = 23 * MiB;
constexpr size_t WS_WNO = 25 * MiB;
constexpr size_t WS_WXO = 26 * MiB;
constexpr size_t WS_WOUT = 27 * MiB;
constexpr size_t WS_XN = 29 * MiB;
constexpr size_t WS_H2 = WS_XN;
constexpr size_t WS_RQ = 61 * MiB;
constexpr size_t WS_RK = 77 * MiB;
constexpr size_t WS_RV = 93 * MiB;
constexpr size_t WS_NK = 125 * MiB;
constexpr size_t WS_NV = 141 * MiB;
constexpr size_t WS_GATES = 61 * MiB;
constexpr size_t WS_HID = 61 * MiB;
constexpr size_t WS_DROWS = 97 * MiB;
constexpr size_t WS_RG = 157 * MiB;
constexpr size_t WS_NQ = 189 * MiB;
constexpr size_t WS_XQ = 205 * MiB;
constexpr size_t WS_WD = 205 * MiB;
constexpr size_t WS_MN = 221 * MiB;
constexpr size_t WS_MKV = 225 * MiB;
constexpr size_t WS_MIX = 221 * MiB;
constexpr size_t WS_WGU = 221 * MiB;
constexpr size_t WS_D = 169 * MiB;
constexpr size_t WS_ERS = 1 * MiB;
constexpr size_t WS_WTR = 4 * MiB + 512 * 1024;
constexpr size_t WS_END = 256 * MiB;

constexpr int CW_ECNT = 64;
constexpr int CW_BAR = 4096;
constexpr int CW_PAN1 = 8192, CW_PAN2 = 10240;
constexpr int CW_TCNT = 1152;

constexpr int LDS_BYTES = 163840;
constexpr int MISC_OFF = 163840 - 512;

__device__ __forceinline__ float bf2f(unsigned v) { return __uint_as_float(v << 16); }
__device__ __forceinline__ unsigned f2bf(float f) { unsigned u = __float_as_uint(f); return (u + 0x7fffu + ((u >> 16) & 1u)) >> 16; }
typedef __bf16 hwbf16x2 __attribute__((ext_vector_type(2)));
typedef float f32x2_ __attribute__((ext_vector_type(2)));
__device__ __forceinline__ unsigned pk2(float lo, float hi) { const f32x2_ v = {lo, hi}; return __builtin_bit_cast(unsigned, __builtin_convertvector(v, hwbf16x2)); }
__device__ __forceinline__ void unpack8(const u32x4 v, float* o) {
    o[0] = __uint_as_float(v.x << 16); o[1] = __uint_as_float(v.x & 0xffff0000u);
    o[2] = __uint_as_float(v.y << 16); o[3] = __uint_as_float(v.y & 0xffff0000u);
    o[4] = __uint_as_float(v.z << 16); o[5] = __uint_as_float(v.z & 0xffff0000u);
    o[6] = __uint_as_float(v.w << 16); o[7] = __uint_as_float(v.w & 0xffff0000u);
}
__device__ __forceinline__ void store8(bf16* p, f32x4 a, f32x4 b) {
    u32x4 w; w.x = pk2(a[0], a[1]); w.y = pk2(a[2], a[3]); w.z = pk2(b[0], b[1]); w.w = pk2(b[2], b[3]);
    *(u32x4*)p = w;
}
__device__ __forceinline__ float wave_sum(float v) {
#pragma unroll
    for (int o = 1; o < 64; o <<= 1) v += __shfl_xor(v, o);
    return v;
}
__device__ __forceinline__ float wave_max(float v) {
#pragma unroll
    for (int o = 1; o < 64; o <<= 1) v = fmaxf(v, __shfl_xor(v, o));
    return v;
}
__device__ __forceinline__ float sigmoidf_(float x) { return __builtin_amdgcn_rcpf(1.0f + __expf(-x)); }
__device__ __forceinline__ float siluf_(float x) { return x * __builtin_amdgcn_rcpf(1.0f + __expf(-x)); }

#define XB_TMO      128
#define XB_XCNT(j)  (256  + 64 * (j))
#define XB_XSUB(j)  (1280 + 64 * (j))
#define XB_XGEN(j)  (2304 + 64 * (j))
#define XB_TOP      3328
#define XB_TOPGEN   3392
#define XCD_BAR_WORDS 3456
#define XB_SPIN_CAP (1u << 18)
__device__ __forceinline__ unsigned xb_ld(unsigned* p)              { return __hip_atomic_load(p, __ATOMIC_RELAXED, __HIP_MEMORY_SCOPE_AGENT); }
__device__ __forceinline__ unsigned xb_add(unsigned* p, unsigned v) { return __hip_atomic_fetch_add(p, v, __ATOMIC_RELAXED, __HIP_MEMORY_SCOPE_AGENT); }
__device__ __forceinline__ unsigned xb_xcc_id() { return (unsigned)__builtin_amdgcn_s_getreg((3 << 11) | 20) & 0xFu; }
#define XB_SPIN(cond, bar) do { unsigned _sp = 0; while (cond) { __builtin_amdgcn_s_sleep(1); \
    if ((++_sp & 255u) == 0u) { if (xb_ld(&(bar)[XB_TMO])) break; if (_sp > XB_SPIN_CAP) { atomicAdd(&(bar)[XB_TMO], 1u); break; } } } } while (0)
struct XcdBarrier { unsigned* bar; unsigned x; volatile LAS unsigned* st; };
__device__ __forceinline__ XcdBarrier xcd_barrier_post(unsigned* bar, volatile LAS unsigned* st) {
    XcdBarrier b; b.bar = bar; b.x = xb_xcc_id(); b.st = st;
    if (threadIdx.x == 0) (void)xb_add(&bar[XB_XCNT(b.x)], 1u);
    return b;
}
__device__ __forceinline__ void xcd_barrier_complete(unsigned* bar, unsigned x, unsigned& nloc, unsigned& nx) {
    const unsigned G = gridDim.x * gridDim.y * gridDim.z;
    unsigned sum, cnt, mine, sp = 0u;
    for (;;) {
        sum = 0u; cnt = 0u; mine = 0u;
#pragma unroll
        for (unsigned j = 0; j < 16; ++j) { const unsigned c = xb_ld(&bar[XB_XCNT(j)]); sum += c; cnt += (c > 0u) ? 1u : 0u; mine = (j == x) ? c : mine; }
        if (sum == G) break;
        __builtin_amdgcn_s_sleep(1);
        if ((++sp & 255u) == 0u) { if (xb_ld(&bar[XB_TMO])) break; if (sp > XB_SPIN_CAP) { atomicAdd(&bar[XB_TMO], 1u); break; } }
    }
    nloc = mine > 0u ? mine : 1u; nx = cnt > 0u ? cnt : 1u;
}
__device__ __forceinline__ void xcd_barrier(const XcdBarrier& b) {
    asm volatile("s_waitcnt vmcnt(0)" ::: "memory");
    __syncthreads();
    if (threadIdx.x == 0) {
        unsigned* bar = b.bar;
        __builtin_amdgcn_s_waitcnt(0);
        unsigned nloc = b.st[0], nx = b.st[1];
        if (nloc == 0u) { xcd_barrier_complete(bar, b.x, nloc, nx); b.st[0] = nloc; b.st[1] = nx; }
        const unsigned old = xb_add(&bar[XB_XSUB(b.x)], 1u);
        const unsigned gen = old / nloc;
        if (old + 1u == (gen + 1u) * nloc) {
            __builtin_amdgcn_fence(__ATOMIC_RELEASE, "agent");
            asm volatile("s_waitcnt vmcnt(0)" ::: "memory");
            const unsigned og = xb_add(&bar[XB_TOP], 1u);
            const unsigned tg = og / nx;
            if (og + 1u == (tg + 1u) * nx) xb_add(&bar[XB_TOPGEN], 1u);
            else XB_SPIN(xb_ld(&bar[XB_TOPGEN]) == tg, bar);
            __builtin_amdgcn_fence(__ATOMIC_ACQUIRE, "agent");
            xb_add(&bar[XB_XGEN(b.x)], 1u);
            asm volatile("s_waitcnt vmcnt(0)" ::: "memory");
        } else {
            XB_SPIN(xb_ld(&bar[XB_XGEN(b.x)]) == gen, bar);
            __builtin_amdgcn_fence(__ATOMIC_ACQUIRE, "agent");
            asm volatile("s_waitcnt vmcnt(0)" ::: "memory");
        }
    }
    __syncthreads();
}

struct Args { const float* in[23]; float* out; unsigned char* ws; int ph_lo, ph_hi; int sub, rep; };
struct Ctx {
    int tid, lane, wave, gw, ngw;
    unsigned char* lds;
};

template <class ColPtr>
__device__ __forceinline__ void transpose_all(const Ctx& c, int& base, ColPtr cp, int ldw, int P, int K, bf16* WT, const float* kscale = nullptr) {
    float* scr = (float*)(c.lds + c.wave * 16384);
    const int nkb = K / 64, npb = P / 32, lane = c.lane, nit = nkb * npb;
    int it0 = (c.gw - base) % c.ngw; it0 = it0 < 0 ? it0 + c.ngw : it0; base += nit;
    for (int it = it0; it < nit; it += c.ngw) {
        const int kb = it % nkb, pb = it / nkb, k0 = 64 * kb, p0 = 32 * pb;
        const float* colp = cp(p0 + (lane & 31));
        float tv[32];
#pragma unroll
        for (int i = 0; i < 32; ++i) tv[i] = colp[(size_t)(k0 + 2 * i + (lane >> 5)) * ldw];
#pragma unroll
        for (int i = 0; i < 32; ++i) scr[(2 * i + (lane >> 5)) * 33 + (lane & 31)] = tv[i];
        __builtin_amdgcn_s_waitcnt(0xC07F); asm volatile("" ::: "memory");
        const int cc = lane & 7;
        f32x4 ks0 = {1.f, 1.f, 1.f, 1.f}, ks1 = {1.f, 1.f, 1.f, 1.f};
        if (kscale) { ks0 = *(const f32x4*)(kscale + k0 + 8 * cc); ks1 = *(const f32x4*)(kscale + k0 + 8 * cc + 4); }
#pragma unroll
        for (int j = 0; j < 4; ++j) { const int n = (lane >> 3) + 8 * j; const float* s = scr + (8 * cc) * 33 + n;
            u32x4 o; o.x = pk2(s[0 * 33] * ks0[0], s[1 * 33] * ks0[1]); o.y = pk2(s[2 * 33] * ks0[2], s[3 * 33] * ks0[3]); o.z = pk2(s[4 * 33] * ks1[0], s[5 * 33] * ks1[1]); o.w = pk2(s[6 * 33] * ks1[2], s[7 * 33] * ks1[3]);
            *(u32x4*)(WT + (size_t)(p0 + n) * K + k0 + 8 * cc) = o; }
        __builtin_amdgcn_s_waitcnt(0xC07F); asm volatile("" ::: "memory");
    }
}
struct ColPlain { const float* W; __device__ const float* operator()(int p) const { return W + p; } };
struct ColOff { const float* W; int off; __device__ const float* operator()(int p) const { return W + off + p; } };
struct ColWA {
    const float* W;
    __device__ const float* operator()(int p) const {
        if (p < 1024) { const int pp = p & 127; const int d = ((pp & 4) ? 64 : 0) + 4 * (pp >> 3) + (pp & 3); return W + (p & ~127) + d; }
        return W + p;
    }
};
struct ColGU {
    const float* Wg; const float* Wu;
    __device__ const float* operator()(int p) const { const int f = 4 * (p >> 3) + (p & 3); return ((p >> 2) & 1) ? Wu + f : Wg + f; }
};
__device__ __forceinline__ void rms_row_to_bf16(const float* xrow, const float* g, bf16* orow, int lane) {
    const f32x4* xr = (const f32x4*)xrow + lane; const f32x4* gr = (const f32x4*)g + lane;
    f32x4 v[4]; float s = 0.f;
#pragma unroll
    for (int j = 0; j < 4; ++j) { v[j] = xr[64 * j]; s += (v[j].x * v[j].x + v[j].y * v[j].y) + (v[j].z * v[j].z + v[j].w * v[j].w); }
    const float r = 1.0f / sqrtf(wave_sum(s) * (1.f / 1024.f) + RMS_EPS);
    unsigned long long* o8 = (unsigned long long*)orow + lane;
#pragma unroll
    for (int j = 0; j < 4; ++j) { const f32x4 gg = gr[64 * j];
        o8[64 * j] = (unsigned long long)pk2(v[j].x * r * gg.x, v[j].y * r * gg.y) | ((unsigned long long)pk2(v[j].z * r * gg.z, v[j].w * r * gg.w) << 32); }
}

template <class RowPtr, class Epi>
__device__ __forceinline__ void naive_gemm(const Ctx& c, const RowPtr& rp, const bf16* Bt, int ldb, int M, int N, int K, const Epi& epi) {
    const int tilesN = N / 64, tilesM = (M + 7) / 8, lane = c.lane;
    for (int it = c.gw; it < tilesM * tilesN; it += c.ngw) {
        const int tm = it / tilesN, tn = it % tilesN;
        const int row = tm * 8 + (lane >> 3), col0 = tn * 64 + (lane & 7) * 8;
        const bool valid = row < M;
        const bf16* ap = rp(valid ? row : 0);
        float acc[8];
#pragma unroll
        for (int j = 0; j < 8; ++j) acc[j] = 0.f;
        for (int k = 0; k < K; k += 8) {
            float a[8]; unpack8(*(const u32x4*)(ap + k), a);
#pragma unroll
            for (int j = 0; j < 8; ++j) { float b[8]; unpack8(*(const u32x4*)(Bt + (size_t)(col0 + j) * ldb + k), b);
#pragma unroll
                for (int i = 0; i < 8; ++i) acc[j] += a[i] * b[i]; }
        }
        if (valid) epi(row, col0, (f32x4){acc[0], acc[1], acc[2], acc[3]}, (f32x4){acc[4], acc[5], acc[6], acc[7]});
    }
}
struct RowPlain { const bf16* A; int lda; __device__ const bf16* operator()(int r) const { return A + (size_t)r * lda; } };
struct RowGather { const bf16* A; int lda; const int* idx; __device__ const bf16* operator()(int r) const { return A + (size_t)idx[r] * lda; } };

struct EpiProjA {
    bf16 *RQ, *RK, *RV, *RG, *NQ, *NK, *NV, *XQ; const float *COS, *SIN;
    __device__ __forceinline__ void operator()(int row, int col0, f32x4 v0, f32x4 v1) const {
        if (col0 < 1024) {
            const int which = col0 >> 9, cc = col0 & 511, pos = row & (SEQ - 1), q = (cc & 127) >> 3;
            const f32x4 cs = *(const f32x4*)(COS + pos * 64 + 4 * q), sn = *(const f32x4*)(SIN + pos * 64 + 4 * q);
            f32x4 o1 = v0 * cs - v1 * sn, o2 = v0 * sn + v1 * cs;
            if (which == 0) { o1 = o1 * QK_SCALE; o2 = o2 * QK_SCALE; }
            store8((which ? RK : RQ) + (size_t)row * 512 + cc, o1, o2);
        } else if (col0 < 2048) { store8(RV + (size_t)row * 1024 + (col0 - 1024), v0, v1);
        } else if (col0 < 3072) {
            f32x4 a, b;
#pragma unroll
            for (int i = 0; i < 4; ++i) { a[i] = siluf_(v0[i]); b[i] = siluf_(v1[i]); }
            store8(RG + (size_t)row * 1024 + (col0 - 2048), a, b);
        } else if (col0 < 3584) { store8(NQ + (size_t)row * 512 + (col0 - 3072), v0 * 0.125f, v1 * 0.125f);
        } else if (col0 < 4096) { store8(NK + (size_t)row * 512 + (col0 - 3584), v0, v1);
        } else if (col0 < 4608) { store8(NV + (size_t)row * 512 + (col0 - 4096), v0, v1);
        } else { store8(XQ + (size_t)row * 512 + (col0 - 4608), v0 * QK_SCALE, v1 * QK_SCALE); }
    }
};
struct EpiBf16Plain { bf16* O; int ldc; __device__ __forceinline__ void operator()(int row, int col0, f32x4 v0, f32x4 v1) const { store8(O + (size_t)row * ldc + col0, v0, v1); } };
struct EpiSigmoid { bf16* O; int ldc;
    __device__ __forceinline__ void operator()(int row, int col0, f32x4 v0, f32x4 v1) const {
        f32x4 a, b;
#pragma unroll
        for (int i = 0; i < 4; ++i) { a[i] = sigmoidf_(v0[i]); b[i] = sigmoidf_(v1[i]); }
        store8(O + (size_t)row * ldc + col0, a, b); } };
template <int MODE> struct EpiMixNaive { float* TMP; bf16* MIX; const bf16* G;
    __device__ __forceinline__ void operator()(int row, int col0, f32x4 v0, f32x4 v1) const {
        float g[8]; unpack8(*(const u32x4*)(G + (size_t)row * NPG + col0), g);
        f32x4 a = {v0[0] * g[0], v0[1] * g[1], v0[2] * g[2], v0[3] * g[3]}, b = {v1[0] * g[4], v1[1] * g[5], v1[2] * g[6], v1[3] * g[7]};
        float* t = TMP + (size_t)row * DM + col0;
        if (MODE >= 1) { a = a + *(const f32x4*)t; b = b + *(const f32x4*)(t + 4); }
        if (MODE <= 1) { *(f32x4*)t = a; *(f32x4*)(t + 4) = b; } else store8(MIX + (size_t)row * DM + col0, a, b);
    } };
struct EpiResidBf16 { const float* X; bf16* O;
    __device__ __forceinline__ void operator()(int row, int col0, f32x4 v0, f32x4 v1) const {
        const float* x = X + (size_t)row * DM + col0; store8(O + (size_t)row * DM + col0, *(const f32x4*)x + v0, *(const f32x4*)(x + 4) + v1); } };
struct EpiResidF32 { const float* X; float* O;
    __device__ __forceinline__ void operator()(int row, int col0, f32x4 v0, f32x4 v1) const {
        const float* x = X + (size_t)row * DM + col0; float* o = O + (size_t)row * DM + col0;
        *(f32x4*)o = *(const f32x4*)x + v0; *(f32x4*)(o + 4) = *(const f32x4*)(x + 4) + v1; } };
struct EpiSwiGLU { bf16* HID; const float* wl; int rowbase;
    __device__ __forceinline__ void operator()(int row, int col0, f32x4 v0, f32x4 v1) const {
        const float w = wl[row]; f32x4 h;
#pragma unroll
        for (int i = 0; i < 4; ++i) h[i] = siluf_(v0[i]) * v1[i] * w;
        u32x2 o; o.x = pk2(h[0], h[1]); o.y = pk2(h[2], h[3]);
        *(u32x2*)(HID + (size_t)(rowbase + row) * DFF + (col0 >> 1)) = o; } };
struct EpiRowsBf16 { bf16* O; int ldc; int rowbase;
    __device__ __forceinline__ void operator()(int row, int col0, f32x4 v0, f32x4 v1) const { store8(O + (size_t)(rowbase + row) * ldc + col0, v0, v1); } };

namespace pg8 {
constexpr int BM = 256, BK = 64, HALF = 128, HTB = HALF * BK * 2, STAGE_BYTES = 8 * HTB;
__device__ __forceinline__ int lds_byte(int r, int c) { const int st = (r >> 4) * 2 + (c >> 5), rr = r & 15, cc = c & 31, ob = rr * 64 + cc * 2; return st * 1024 + (ob ^ (((ob >> 9) & 1) << 5)); }
__device__ __forceinline__ void stage_rc(int b, int& R, int& C) { const int st = b / 1024, sb = b % 1024, swz = sb ^ (((sb >> 9) & 1) << 5); R = (st >> 1) * 16 + swz / 64; C = (st & 1) * 32 + (swz % 64) / 2; }
__device__ __forceinline__ int perm32(int rho) { const int n = rho >> 4, i = rho & 15; return 8 * (i >> 2) + 4 * n + (i & 3); }

struct UnitDesc {
    const char* A; const char* B;
    unsigned lda2, ldb2;
    int nt;
    int row0, col0;
    int aux, aux2;
    const int* gidx; int gcnt;
    int chain;
};
__device__ __forceinline__ unsigned cvt_pk_bf16(float lo, float hi) { unsigned r; asm volatile("v_cvt_pk_bf16_f32 %0, %1, %2" : "=v"(r) : "v"(lo), "v"(hi)); return r; }

template <int GRP = 1, class F> __device__ __forceinline__ void epi_apply(const f32x4 (&acc)[2][2][4][2], const UnitDesc& u, int wr, int wc, int fr, int fq, const F& f) {
#pragma unroll
    for (int ai = 0; ai < 2; ++ai)
#pragma unroll
        for (int m = 0; m < 4; ++m) { const int row = u.row0 + ai * HALF + wr * 64 + m * 16 + fr;
#pragma unroll
            for (int bj = 0; bj < 2; ++bj) f(row, u.col0 + bj * HALF + wc * 32 + 8 * fq, acc[ai][bj][m][0], acc[ai][bj][m][1]);
            if (((ai * 4 + m) % GRP) == GRP - 1) { asm volatile("" ::: "memory"); __builtin_amdgcn_sched_barrier(0); } }
}

template <bool GATHER> __device__ __forceinline__ void unit_offs(const UnitDesc& u, int tid, unsigned (&oA0)[2], unsigned (&oA1)[2], unsigned (&oB)[2]) {
#pragma unroll
    for (int i = 0; i < 2; ++i) { int R, C; stage_rc(tid * 16 + i * 8192, R, C); const int Rb = (R & ~31) + perm32(R & 31);
        oB[i] = (unsigned)Rb * u.ldb2 + (unsigned)C * 2u;
        if (GATHER && u.gidx) { const int last = u.gcnt - 1; int r0 = u.row0 + R, r1 = r0 + HALF; r0 = r0 < last ? r0 : last; r1 = r1 < last ? r1 : last;
            oA0[i] = (unsigned)u.gidx[r0] * u.lda2 + (unsigned)C * 2u; oA1[i] = (unsigned)u.gidx[r1] * u.lda2 + (unsigned)C * 2u;
        } else { oA0[i] = (unsigned)R * u.lda2 + (unsigned)C * 2u; oA1[i] = 0u; } }
}

template <bool GATHER, class Sched, class Epi>
__device__ __forceinline__ void gemm_phase(LAS unsigned char* lds, const Sched& S, const Epi& E, int sb = 0) {
#if PROBE_TS_A >= 0
#define GSTAMP(k) do { if (sb && blockIdx.x == 0 && threadIdx.x == 0) ((volatile LAS unsigned*)(lds + MISC_OFF))[32 + sb + (k)] = (unsigned)__builtin_amdgcn_s_memrealtime(); } while (0)
#else
#define GSTAMP(k) do { } while (0)
#endif
    const int tid = threadIdx.x, wid = __builtin_amdgcn_readfirstlane(tid >> 6), lane = tid & 63, wr = wid >> 2, wc = wid & 3, fr = lane & 15, fq = lane >> 4;
    const unsigned ldsw = (unsigned)wid * 1024u;
    const int aoff = lds_byte(wr * 64 + fr, fq * 8), boff = lds_byte(wc * 32 + fr, fq * 8);
    const size_t kstep = (size_t)(BK * 2);
#define PG8_SA(b, h) (((b) * 2 + (h)) * HTB)
#define PG8_SB(b, h) ((4 + (b) * 2 + (h)) * HTB)
#define PG8_STAGE(bufoff, gbase, voff) do { _Pragma("unroll") for (int _i = 0; _i < 2; ++_i) \
        __builtin_amdgcn_global_load_lds((const unsigned*)((const char*)(gbase) + (voff)[_i]), (LAS unsigned*)(lds + (bufoff) + ldsw + _i * 8192), 16, 0, 0); } while (0)
#define PG8_LDA(dst, b, h) do { _Pragma("unroll") for (int m = 0; m < 4; ++m) _Pragma("unroll") for (int k = 0; k < 2; ++k) dst[m][k] = *(const LAS bf16x8*)(lds + PG8_SA(b, h) + aoff + m * 2048 + k * 1024); } while (0)
#define PG8_LDB(dst, b, h) do { _Pragma("unroll") for (int n = 0; n < 2; ++n) _Pragma("unroll") for (int k = 0; k < 2; ++k) dst[n][k] = *(const LAS bf16x8*)(lds + PG8_SB(b, h) + boff + n * 2048 + k * 1024); } while (0)
#define PG8_MMA(ai, bj, At, Bt) do { __builtin_amdgcn_s_setprio(1); _Pragma("unroll") for (int m = 0; m < 4; ++m) _Pragma("unroll") for (int n = 0; n < 2; ++n) _Pragma("unroll") for (int k = 0; k < 2; ++k) \
        acc[ai][bj][m][n] = __builtin_amdgcn_mfma_f32_16x16x32_bf16(Bt[n][k], At[m][k], acc[ai][bj][m][n], 0, 0, 0); __builtin_amdgcn_s_setprio(0); } while (0)
#define PG8_WAIT_V(n) asm volatile("s_waitcnt vmcnt(" #n ")" ::: "memory")
#define PG8_WAIT_L(n) asm volatile("s_waitcnt lgkmcnt(" #n ")" ::: "memory")
#define PG8_BAR __builtin_amdgcn_s_barrier()
#define PG8_SCHED __builtin_amdgcn_sched_barrier(0)
    UnitDesc cur, nxt; int ui = 0;
    if (!S.next(0, cur)) return;
    f32x4 acc[2][2][4][2];
#pragma unroll
    for (int a = 0; a < 2; ++a)
#pragma unroll
        for (int b = 0; b < 2; ++b)
#pragma unroll
            for (int m = 0; m < 4; ++m)
#pragma unroll
                for (int n = 0; n < 2; ++n) acc[a][b][m][n] = (f32x4){0.f, 0.f, 0.f, 0.f};
    bf16x8 At[4][2], B0[2][2], B1[2][2];
    unsigned cA0[2], cA1[2], cB[2], nA0[2], nA1[2], nB[2];
    unit_offs<GATHER>(cur, tid, cA0, cA1, cB);
    const char* pA = cur.A; const char* pB = cur.B; size_t hB = (size_t)HALF * cur.ldb2; size_t hA = GATHER ? 0 : (size_t)HALF * cur.lda2;
#define PG8_A1(arr1, arr0) (GATHER ? (arr1) : (arr0))
    PG8_STAGE(PG8_SB(0, 0), pB, cB); PG8_STAGE(PG8_SB(0, 1), pB + hB, cB); PG8_STAGE(PG8_SA(0, 0), pA, cA0); PG8_STAGE(PG8_SA(0, 1), pA + hA, PG8_A1(cA1, cA0));
    if (wr == 1) PG8_BAR;
    PG8_WAIT_V(2); PG8_BAR;
    PG8_STAGE(PG8_SB(1, 0), pB + kstep, cB); PG8_STAGE(PG8_SA(1, 0), pA + kstep, cA0); PG8_STAGE(PG8_SB(1, 1), pB + hB + kstep, cB);
    PG8_WAIT_V(6); PG8_BAR;
    GSTAMP(0);
    for (;;) {
        const bool has_next = S.next(ui + 1, nxt);
        const char* qA = pA; const char* qB = pB; size_t hBn = hB, hAn = hA;
        if (has_next) { unit_offs<GATHER>(nxt, tid, nA0, nA1, nB); qA = nxt.A; qB = nxt.B; hBn = (size_t)HALF * nxt.ldb2; hAn = GATHER ? 0 : (size_t)HALF * nxt.lda2; }
        else {
#pragma unroll
            for (int i = 0; i < 2; ++i) { nA0[i] = cA0[i]; nA1[i] = cA1[i]; nB[i] = cB[i]; } }
        const int nt = cur.nt;
        for (int t = 0; t < nt; t += 2) {
            const bool last = (t == nt - 2);
            const char* a1 = pA + (size_t)(t + 1) * kstep;
            const char* a2 = last ? qA : pA + (size_t)(t + 2) * kstep; const char* b2 = last ? qB : pB + (size_t)(t + 2) * kstep;
            const char* a3 = a2 + kstep; const char* b3 = b2 + kstep;
            unsigned sA0[2], sA1[2], sB[2];
#pragma unroll
            for (int i = 0; i < 2; ++i) { sA0[i] = last ? nA0[i] : cA0[i]; sA1[i] = last ? nA1[i] : cA1[i]; sB[i] = last ? nB[i] : cB[i]; }
            const size_t shB = last ? hBn : hB, shA = last ? hAn : hA;
            PG8_LDB(B0, 0, 0); PG8_LDB(B1, 0, 1); PG8_SCHED; PG8_LDA(At, 0, 0); PG8_STAGE(PG8_SA(1, 1), a1 + hA, PG8_A1(cA1, cA0));
            PG8_WAIT_V(8); PG8_WAIT_L(0); PG8_BAR; PG8_MMA(0, 0, At, B0); PG8_MMA(0, 1, At, B1); PG8_BAR; PG8_SCHED;
            PG8_LDA(At, 0, 1); PG8_STAGE(PG8_SB(0, 0), b2, sB); PG8_STAGE(PG8_SB(0, 1), b2 + shB, sB); PG8_STAGE(PG8_SA(0, 0), a2, sA0);
            PG8_WAIT_V(8); PG8_WAIT_L(0); PG8_BAR; PG8_MMA(1, 0, At, B0); PG8_MMA(1, 1, At, B1); PG8_BAR; PG8_SCHED;
            PG8_LDB(B0, 1, 0); PG8_LDB(B1, 1, 1); PG8_SCHED; PG8_LDA(At, 1, 0); PG8_STAGE(PG8_SA(0, 1), a2 + shA, PG8_A1(sA1, sA0));
            PG8_WAIT_V(8); PG8_WAIT_L(0); PG8_BAR; PG8_MMA(0, 0, At, B0); PG8_MMA(0, 1, At, B1); PG8_BAR; PG8_SCHED;
            PG8_LDA(At, 1, 1); PG8_STAGE(PG8_SB(1, 0), b3, sB); PG8_STAGE(PG8_SB(1, 1), b3 + shB, sB); PG8_STAGE(PG8_SA(1, 0), a3, sA0);
            PG8_WAIT_V(8); PG8_WAIT_L(0); PG8_BAR; PG8_MMA(1, 0, At, B0); PG8_MMA(1, 1, At, B1); PG8_BAR; PG8_SCHED;
        }
        if (wr == 0) PG8_BAR;
        if (ui == 0) GSTAMP(1);
        E.finish(acc, cur, wr, wc, fr, fq);
        if (ui == 0) GSTAMP(2);
        if (!has_next) break;
        cur = nxt; pA = qA; pB = qB; hB = hBn; hA = hAn; ++ui;
#pragma unroll
        for (int i = 0; i < 2; ++i) { cA0[i] = nA0[i]; cA1[i] = nA1[i]; cB[i] = nB[i]; }
        if (wr == 1) PG8_BAR;
    }
    PG8_WAIT_V(0);
    PG8_BAR;
    GSTAMP(3);
#undef GSTAMP
#undef PG8_A1
#undef PG8_SA
#undef PG8_SB
#undef PG8_STAGE
#undef PG8_LDA
#undef PG8_LDB
#undef PG8_MMA
#undef PG8_WAIT_V
#undef PG8_WAIT_L
#undef PG8_BAR
#undef PG8_SCHED
}

__device__ __forceinline__ void zero_acc(f32x4 (&acc)[2][2][4][2]) {
#pragma unroll
    for (int a = 0; a < 2; ++a)
#pragma unroll
        for (int b = 0; b < 2; ++b)
#pragma unroll
            for (int m = 0; m < 4; ++m)
#pragma unroll
                for (int n = 0; n < 2; ++n) acc[a][b][m][n] = (f32x4){0.f, 0.f, 0.f, 0.f};
}
template <class F, int GRP = 1> struct EpiF { F f;
    __device__ __forceinline__ void finish(f32x4 (&acc)[2][2][4][2], const UnitDesc& u, int wr, int wc, int fr, int fq) const { epi_apply<GRP>(acc, u, wr, wc, fr, fq, f); zero_acc(acc); } };

struct TileOrder {
    int nM, nN, nwg, G, c;
    __device__ __forceinline__ void init(int nM_, int nN_, int G_, int c_) { nM = nM_; nN = nN_; nwg = nM * nN; G = G_; c = c_; }
    __device__ __forceinline__ bool tile(int i, int& pm, int& pn) const {
        const long L = (long)i * G + c; if (L >= nwg) return false;
        int wgid = (int)L; { const int q = nwg / 8, r = nwg % 8, xcd = wgid % 8, off = wgid / 8; wgid = (xcd < r ? xcd * (q + 1) : r * (q + 1) + (xcd - r) * q) + off; }
        const int nig = 8 * nN, gid = wgid / nig, fm = gid * 8, gsz = (nM - fm) < 8 ? (nM - fm) : 8;
        pm = fm + ((wgid % nig) % gsz); pn = (wgid % nig) / gsz; return true;
    }
};
struct PlainSched { TileOrder o; const bf16* A; const bf16* Bt; int lda, ldb, K;
    __device__ __forceinline__ bool next(int i, UnitDesc& u) const { int pm, pn; if (!o.tile(i, pm, pn)) return false;
        u.A = (const char*)(A + (size_t)pm * BM * lda); u.B = (const char*)(Bt + (size_t)pn * BM * ldb); u.lda2 = lda * 2; u.ldb2 = ldb * 2; u.nt = K / BK;
        u.row0 = pm * BM; u.col0 = pn * BM; u.aux = 0; u.aux2 = 0; u.gidx = nullptr; u.gcnt = 0; u.chain = 0; return true; } };
}

#if PROBE_TS_A >= 0
#define MXSTAMP(k) do { if (blockIdx.x == 0 && threadIdx.x == 0) ((volatile LAS unsigned*)(lds + MISC_OFF))[32 + (k)] = (unsigned)__builtin_amdgcn_s_memrealtime(); } while (0)
#else
#define MXSTAMP(k) do { } while (0)
#endif
namespace mx {
typedef short s16x4 __attribute__((ext_vector_type(4)));
typedef __bf16 bf16x8_t __attribute__((ext_vector_type(8)));
typedef __bf16 bf16x4_t __attribute__((ext_vector_type(4)));
typedef float f32x8 __attribute__((ext_vector_type(8)));
__device__ __forceinline__ f32x4 mma(bf16x8 a, bf16x8 b, f32x4 c) { return __builtin_amdgcn_mfma_f32_16x16x32_bf16(a, b, c, 0, 0, 0); }
__device__ __forceinline__ bf16x8 ldsf(LAS unsigned char* p) { return *(LAS bf16x8*)p; }
__device__ __forceinline__ bf16x8 glbf(const bf16* p) { return *(const bf16x8*)p; }
__device__ __forceinline__ bf16x8 trf(LAS unsigned char* p0, LAS unsigned char* p1) {
    const s16x4 a = __builtin_amdgcn_ds_read_tr16_b64_v4i16((LAS s16x4*)p0), b = __builtin_amdgcn_ds_read_tr16_b64_v4i16((LAS s16x4*)p1);
    return __builtin_shufflevector(a, b, 0, 1, 2, 3, 4, 5, 6, 7);
}
__device__ __forceinline__ bf16x8 pack8(f32x4 a, f32x4 b) { const f32x8 v = {a[0], a[1], a[2], a[3], b[0], b[1], b[2], b[3]}; return __builtin_bit_cast(bf16x8, __builtin_convertvector(v, bf16x8_t)); }
__device__ __forceinline__ u32x2 pack4(f32x4 a) { return __builtin_bit_cast(u32x2, __builtin_convertvector(a, bf16x4_t)); }
__device__ __forceinline__ float red_g_max(float v) { v = fmaxf(v, __shfl_xor(v, 16)); return fmaxf(v, __shfl_xor(v, 32)); }
__device__ __forceinline__ float red_g_sum(float v) { v += __shfl_xor(v, 16); return v + __shfl_xor(v, 32); }

__device__ __forceinline__ int vblock() { const int G = (int)gridDim.x, bx = (int)blockIdx.x; return (G % 8 == 0) ? (bx % 8) * (G / 8) + bx / 8 : bx; }
constexpr int XA_KP = 272, XA_VP = 288, XA_VOFF = 256 * XA_KP;
__device__ __forceinline__ void xa_phase(LAS unsigned char* lds, bf16* XQ, const bf16* MKV) {
    const int tid = threadIdx.x, lane = tid & 63, wave = __builtin_amdgcn_readfirstlane(tid >> 6), g = lane >> 4, li = lane & 15, q4 = li >> 2, p4 = li & 3;
    for (int it = vblock(); it < NB * 4 * 8; it += gridDim.x) {
        const int b = it >> 5, h = (it >> 3) & 3, qb = it & 7;
        __syncthreads();
#pragma unroll
        for (int i = 0; i < 8; ++i) { const int id = tid + 512 * i, row = id >> 4, ch = id & 15; const bf16* src = MKV + (size_t)(b * MEML + row) * 1024 + h * 128 + ch * 8;
            *(LAS u32x4*)(lds + row * XA_KP + ch * 16) = *(const u32x4*)src; *(LAS u32x4*)(lds + XA_VOFF + row * XA_VP + ch * 16) = *(const u32x4*)(src + 512); }
        __syncthreads();
#pragma unroll 1
        for (int qi = 0; qi < 2; ++qi) {
            bf16* qrow = XQ + (size_t)(b * SEQ + qb * 256 + wave * 32 + qi * 16 + li) * 512 + h * 128;
            bf16x8 qf[4];
#pragma unroll
            for (int s = 0; s < 4; ++s) qf[s] = glbf(qrow + 32 * s + 8 * g);
            f32x4 st[16]; float mx = -3.0e38f;
#pragma unroll
            for (int kf = 0; kf < 16; ++kf) { f32x4 a = {0.f, 0.f, 0.f, 0.f};
#pragma unroll
                for (int s = 0; s < 4; ++s) a = mma(ldsf(lds + (16 * kf + li) * XA_KP + (32 * s + 8 * g) * 2), qf[s], a);
                st[kf] = a; mx = fmaxf(mx, fmaxf(fmaxf(a[0], a[1]), fmaxf(a[2], a[3]))); __builtin_amdgcn_sched_barrier(0); }
            mx = red_g_max(mx); float sum = 0.f;
#pragma unroll
            for (int kf = 0; kf < 16; ++kf) {
#pragma unroll
                for (int r = 0; r < 4; ++r) { const float e = __expf(st[kf][r] - mx); st[kf][r] = e; sum += e; } }
            sum = red_g_sum(sum); const float inv = 1.0f / sum;
            f32x4 o[8];
#pragma unroll
            for (int df = 0; df < 8; ++df) o[df] = (f32x4){0.f, 0.f, 0.f, 0.f};
#pragma unroll
            for (int x = 0; x < 8; ++x) { const bf16x8 pf = pack8(st[2 * x], st[2 * x + 1]);
                LAS unsigned char* vb = lds + XA_VOFF + (32 * x + 4 * g + q4) * XA_VP + 8 * p4;
#pragma unroll
                for (int df = 0; df < 8; ++df) o[df] = mma(trf(vb + 32 * df, vb + 16 * XA_VP + 32 * df), pf, o[df]); __builtin_amdgcn_sched_barrier(0); }
#pragma unroll
            for (int df = 0; df < 8; ++df) *(u32x2*)(qrow + 16 * df + 4 * g) = pack4(o[df] * inv);
        }
    }
}

constexpr int NA_KP = 144, NA_VP = 136, NA_VOFF = 576 * NA_KP;
struct NaItem { int b, h, krmin, r, rs; };
__device__ __forceinline__ NaItem na_item(int it, int ri) { NaItem a; a.b = it >> 7; a.h = (it >> 4) & 7; const int rp = it & 15;
    int k = 2 * rp - 4; a.krmin = k < 0 ? 0 : (k > 24 ? 24 : k); a.r = 2 * rp + ri; int rs = a.r - 4; a.rs = rs < 0 ? 0 : (rs > 24 ? 24 : rs); return a; }
__device__ __forceinline__ void na_load_kv(u32x4 (&kv)[9], u32x4 (&vv)[9], const NaItem& a, const bf16* NK, const bf16* NV, int tid) {
#pragma unroll
    for (int i = 0; i < 9; ++i) { const int id = tid + 512 * i, trow = id >> 3, ch = id & 7; int kr = a.krmin + (trow >> 6); kr = kr > 31 ? 31 : kr;
        const size_t off = (size_t)(a.b * SEQ + kr * 64 + (trow & 63)) * 512 + a.h * 64 + ch * 8; kv[i] = *(const u32x4*)(NK + off); vv[i] = *(const u32x4*)(NV + off); }
}
__device__ __forceinline__ void na_phase(LAS unsigned char* lds, bf16* NQ, const bf16* NK, const bf16* NV, const bf16* FT) {
    const int tid = threadIdx.x, lane = tid & 63, wave = __builtin_amdgcn_readfirstlane(tid >> 6), g = lane >> 4, li = lane & 15, q4 = li >> 2, p4 = li & 3;
    const int ri = wave >> 2, qf = wave & 3, c0 = 16 * qf, w0 = qf == 0 ? 0 : (qf == 1 ? 8 : (qf == 2 ? 24 : 32));
    const int G = (int)gridDim.x, lite = G > 64 ? 32 : 0; const bool isl = (int)blockIdx.x < lite;
    int vnl = (int)blockIdx.x - lite;
    if (lite && G % 8 == 0) { const int x = (int)blockIdx.x % 8, q = (int)blockIdx.x / 8 - lite / 8; vnl = x * ((G - lite) / 8) + q; }
    const int it0 = isl ? (int)blockIdx.x : lite + vnl, itstep = isl ? NB * 8 * 16 : G - lite;
    if (it0 >= NB * 8 * 16) return;
    NaItem cur = na_item(it0, ri);
    u32x4 kv[9], vv[9]; bf16x8 ff[16]; bf16x8 q0, q1;
    na_load_kv(kv, vv, cur, NK, NV, tid);
#pragma unroll
    for (int f = 0; f < 16; ++f) ff[f] = glbf(FT + ((size_t)((cur.h * 15 + (cur.rs + (f >> 1) - cur.r + 7)) * 64 + w0 + 16 * (f & 1) + li)) * 64 + (c0 & 32) + 8 * g);
    { const bf16* qr = NQ + (size_t)(cur.b * SEQ + cur.r * 64 + c0 + li) * 512 + cur.h * 64; q0 = glbf(qr + 8 * g); q1 = glbf(qr + 32 + 8 * g); }
    bf16x8 e1;
#pragma unroll
    for (int j = 0; j < 8; ++j) e1[j] = (8 * g + j == ((c0 + li) & 31)) ? (short)0x3F80 : (short)0;
#pragma unroll 1
    for (int it = it0;;) {
        __syncthreads();
#pragma unroll
        for (int i = 0; i < 9; ++i) { const int id = tid + 512 * i, trow = id >> 3, ch = id & 7;
            *(LAS u32x4*)(lds + trow * NA_KP + ch * 16) = kv[i];
            *(LAS u32x2*)(lds + NA_VOFF + trow * NA_VP + ch * 16) = (u32x2){vv[i].x, vv[i].y}; *(LAS u32x2*)(lds + NA_VOFF + trow * NA_VP + ch * 16 + 8) = (u32x2){vv[i].z, vv[i].w}; }
        __syncthreads();
        const int itn = it + itstep; const bool has_next = itn < NB * 8 * 16; const NaItem nx = na_item(has_next ? itn : it, ri);
        if (has_next) na_load_kv(kv, vv, nx, NK, NV, tid);
        const int rs = cur.rs, krmin = cur.krmin;
        f32x4 st[16]; float mx = -3.0e38f;
#pragma unroll
        for (int kri = 0; kri < 8; ++kri) {
#pragma unroll
            for (int cf = 0; cf < 2; ++cf) { LAS unsigned char* kp = lds + ((rs + kri - krmin) * 64 + w0 + 16 * cf + li) * NA_KP + 16 * g;
                f32x4 a = {0.f, 0.f, 0.f, 0.f};
                a = mma(ldsf(kp), q0, a); a = mma(ldsf(kp + 64), q1, a); a = mma(ff[kri * 2 + cf], e1, a);
                st[kri * 2 + cf] = a; mx = fmaxf(mx, fmaxf(fmaxf(a[0], a[1]), fmaxf(a[2], a[3]))); }
            __builtin_amdgcn_sched_barrier(0); }
        bf16* qrow = NQ + (size_t)(cur.b * SEQ + cur.r * 64 + c0 + li) * 512 + cur.h * 64;
        if (has_next) {
#pragma unroll
            for (int f = 0; f < 8; ++f) ff[f] = glbf(FT + ((size_t)((nx.h * 15 + (nx.rs + (f >> 1) - nx.r + 7)) * 64 + w0 + 16 * (f & 1) + li)) * 64 + (c0 & 32) + 8 * g);
            const bf16* qr = NQ + (size_t)(nx.b * SEQ + nx.r * 64 + c0 + li) * 512 + nx.h * 64; q0 = glbf(qr + 8 * g); q1 = glbf(qr + 32 + 8 * g); }
        mx = red_g_max(mx); float sum = 0.f;
#pragma unroll
        for (int f = 0; f < 16; ++f) {
#pragma unroll
            for (int rr = 0; rr < 4; ++rr) { const float e = __expf(st[f][rr] - mx); st[f][rr] = e; sum += e; } }
        sum = red_g_sum(sum); const float inv = 1.0f / sum;
        f32x4 o[4];
#pragma unroll
        for (int df = 0; df < 4; ++df) o[df] = (f32x4){0.f, 0.f, 0.f, 0.f};
#pragma unroll
        for (int x = 0; x < 8; ++x) { const bf16x8 pf = pack8(st[2 * x], st[2 * x + 1]);
            LAS unsigned char* vb = lds + NA_VOFF + ((rs + x - krmin) * 64 + w0 + 4 * g + q4) * NA_VP + 8 * p4;
#pragma unroll
            for (int df = 0; df < 4; ++df) o[df] = mma(trf(vb + 32 * df, vb + 16 * NA_VP + 32 * df), pf, o[df]); __builtin_amdgcn_sched_barrier(0); }
#pragma unroll
        for (int df = 0; df < 4; ++df) *(u32x2*)(qrow + 16 * df + 4 * g) = pack4(o[df] * inv);
        if (!has_next) break;
#pragma unroll
        for (int f = 8; f < 16; ++f) ff[f] = glbf(FT + ((size_t)((nx.h * 15 + (nx.rs + (f >> 1) - nx.r + 7)) * 64 + w0 + 16 * (f & 1) + li)) * 64 + (c0 & 32) + 8 * g);
        cur = nx; it = itn;
    }
}

constexpr int RT_P = 272, RT_VP = 544, RT_QOFF = 0, RT_KOFF = 128 * RT_P, RT_VOFF = 2 * 128 * RT_P, RT_RED = RT_VOFF + 128 * RT_VP, RT_STAT = RT_RED + 8 * 128 * 8;
__device__ __forceinline__ void ret_out_phase(LAS unsigned char* lds, const bf16* RQ, const bf16* RK, const bf16* RV, bf16* RG, const bf16* ST, const float* gain, const float* decf, const float* decb) {
    const int tid0 = threadIdx.x, lane = tid0 & 63, wave = __builtin_amdgcn_readfirstlane(tid0 >> 6), g = lane >> 4, li = lane & 15, q4 = li >> 2, p4 = li & 3;
    for (int it = blockIdx.x; it < NB * 4 * 16; it += gridDim.x) {
        const int b = it >> 6, h = (it >> 4) & 3, n = it & 15; const size_t tok0 = (size_t)b * SEQ + n * 128;
        int tid = tid0; asm volatile("" : "+v"(tid));
        const float lgf = -log1pf(expf(-decf[h])), lgb = -log1pf(expf(-decb[h]));
        const bf16* sfp = ST + ((size_t)(((b * 4 + h) * 2 + 0) * 16 + n) * 256 + 32 * wave + li) * 128 + 8 * g;
        const bf16* sbp = ST + ((size_t)(((b * 4 + h) * 2 + 1) * 16 + n) * 256 + 32 * wave + li) * 128 + 8 * g;
        __syncthreads();
#pragma unroll
        for (int i = 0; i < 4; ++i) { const int id = tid + 512 * i, row = id >> 4, ch = id & 15;
            *(LAS u32x4*)(lds + RT_QOFF + row * RT_P + ch * 16) = *(const u32x4*)(RQ + (tok0 + row) * 512 + h * 128 + ch * 8);
            *(LAS u32x4*)(lds + RT_KOFF + row * RT_P + ch * 16) = *(const u32x4*)(RK + (tok0 + row) * 512 + h * 128 + ch * 8); }
#pragma unroll
        for (int i = 0; i < 8; ++i) { const int id = tid + 512 * i, row = id >> 5, ch = id & 31;
            *(LAS u32x4*)(lds + RT_VOFF + row * RT_VP + ch * 16) = *(const u32x4*)(RV + (tok0 + row) * 1024 + h * 256 + ch * 8); }
        __builtin_amdgcn_sched_barrier(0);
        bf16x8 sf[2][4];
        if (it == (int)blockIdx.x) MXSTAMP(25);
#pragma unroll
        for (int a = 0; a < 2; ++a)
#pragma unroll
            for (int s = 0; s < 4; ++s) sf[a][s] = glbf(sfp + a * 16 * 128 + 32 * s);
        __syncthreads();
        if (it == (int)blockIdx.x) MXSTAMP(26);
        { bf16x8 qf[4];
#pragma unroll
          for (int s = 0; s < 4; ++s) qf[s] = ldsf(lds + RT_QOFF + (16 * wave + li) * RT_P + (32 * s + 8 * g) * 2);
          f32x4 st[8]; const int pi = 16 * wave + li;
#pragma unroll
          for (int jf = 0; jf < 8; ++jf) { f32x4 a = {0.f, 0.f, 0.f, 0.f};
#pragma unroll
              for (int s = 0; s < 4; ++s) a = mma(ldsf(lds + RT_KOFF + (16 * jf + li) * RT_P + (32 * s + 8 * g) * 2), qf[s], a);
#pragma unroll
              for (int r = 0; r < 4; ++r) { const int pj = 16 * jf + 4 * g + r; a[r] *= (pj <= pi) ? __expf((float)(pi - pj) * lgf) : __expf((float)(pj - pi) * lgb); }
              st[jf] = a; __builtin_amdgcn_sched_barrier(0); }
          __syncthreads();
#pragma unroll
          for (int jf = 0; jf < 8; ++jf) *(LAS u32x2*)(lds + RT_KOFF + pi * RT_P + (16 * jf + 4 * g) * 2) = pack4(st[jf]);
        }
        __syncthreads();
        if (it == (int)blockIdx.x) MXSTAMP(27);
        bf16x8 sb[2][4];
#pragma unroll
        for (int a = 0; a < 2; ++a)
#pragma unroll
            for (int s = 0; s < 4; ++s) sb[a][s] = glbf(sbp + a * 16 * 128 + 32 * s);
        f32x4 y[2][8];
#pragma unroll
        for (int a = 0; a < 2; ++a)
#pragma unroll
            for (int i = 0; i < 8; ++i) y[a][i] = (f32x4){0.f, 0.f, 0.f, 0.f};
        {
#pragma unroll
          for (int i = 0; i < 8; ++i) {
#pragma unroll
              for (int s = 0; s < 4; ++s) { const bf16x8 qfr = ldsf(lds + RT_QOFF + (16 * i + li) * RT_P + (32 * s + 8 * g) * 2); y[0][i] = mma(sf[0][s], qfr, y[0][i]); y[1][i] = mma(sf[1][s], qfr, y[1][i]); }
              const int pi = 16 * i + li; const float ratio = __expf((float)(pi + 1) * lgf - (float)(128 - pi) * lgb);
              y[0][i] = y[0][i] * ratio; y[1][i] = y[1][i] * ratio; __builtin_amdgcn_sched_barrier(0); } }
        if (it == (int)blockIdx.x) MXSTAMP(28);
        {
#pragma unroll
          for (int i = 0; i < 8; ++i) {
#pragma unroll
              for (int s = 0; s < 4; ++s) { const bf16x8 qfr = ldsf(lds + RT_QOFF + (16 * i + li) * RT_P + (32 * s + 8 * g) * 2); y[0][i] = mma(sb[0][s], qfr, y[0][i]); y[1][i] = mma(sb[1][s], qfr, y[1][i]); }
              const int pi = 16 * i + li; const float ab = __expf((float)(128 - pi) * lgb);
              y[0][i] = y[0][i] * ab; y[1][i] = y[1][i] * ab; __builtin_amdgcn_sched_barrier(0); } }
        if (it == (int)blockIdx.x) MXSTAMP(29);
#pragma unroll
        for (int x = 0; x < 4; ++x) {
            LAS unsigned char* vb = lds + RT_VOFF + (32 * x + 8 * g + q4) * RT_VP + (32 * wave) * 2 + 8 * p4;
            const bf16x8 v0 = trf(vb, vb + 4 * RT_VP), v1 = trf(vb + 32, vb + 4 * RT_VP + 32);
#pragma unroll
            for (int i = 0; i < 8; ++i) { const bf16x8 pfr = ldsf(lds + RT_KOFF + (16 * i + li) * RT_P + (32 * x + 8 * g) * 2); y[0][i] = mma(v0, pfr, y[0][i]); y[1][i] = mma(v1, pfr, y[1][i]); } __builtin_amdgcn_sched_barrier(0); }
        if (it == (int)blockIdx.x) MXSTAMP(30);
#pragma unroll
        for (int i = 0; i < 8; ++i) { float s1 = 0.f, s2 = 0.f;
#pragma unroll
            for (int a = 0; a < 2; ++a)
#pragma unroll
                for (int r = 0; r < 4; ++r) { const float v = y[a][i][r]; s1 += v; s2 += v * v; }
            s1 = red_g_sum(s1); s2 = red_g_sum(s2);
            if (g == 0) { LAS float* rp = (LAS float*)(lds + RT_RED) + (wave * 128 + 16 * i + li) * 2; rp[0] = s1; rp[1] = s2; } }
        __syncthreads();
        if (tid < 128) { float s1 = 0.f, s2 = 0.f;
#pragma unroll
            for (int w = 0; w < 8; ++w) { const LAS float* rp = (const LAS float*)(lds + RT_RED) + (w * 128 + tid) * 2; s1 += rp[0]; s2 += rp[1]; }
            const float mu = s1 * (1.f / 256.f); const float var = fmaxf(s2 * (1.f / 256.f) - mu * mu, 0.f);
            LAS float* sp = (LAS float*)(lds + RT_STAT) + tid * 2; sp[0] = mu; sp[1] = 1.0f / sqrtf(var + GN_EPS); }
        __syncthreads();
        if (it == (int)blockIdx.x) MXSTAMP(31);
        const f32x4 gn0 = *(const f32x4*)(gain + h * 256 + 32 * wave + 4 * g), gn1 = *(const f32x4*)(gain + h * 256 + 32 * wave + 16 + 4 * g);
#pragma unroll
        for (int i = 0; i < 8; ++i) { const LAS float* sp = (const LAS float*)(lds + RT_STAT) + (16 * i + li) * 2; const float mu = sp[0], rstd = sp[1];
            bf16* gp = RG + (tok0 + 16 * i + li) * 1024 + h * 256 + 32 * wave + 4 * g;
#pragma unroll
            for (int a = 0; a < 2; ++a) { const u32x2 gv = *(const u32x2*)(gp + 16 * a); const f32x4 gg = a ? gn1 : gn0;
                f32x4 o; o[0] = (y[a][i][0] - mu) * rstd * gg[0] * bf2f(gv.x & 0xffffu); o[1] = (y[a][i][1] - mu) * rstd * gg[1] * bf2f(gv.x >> 16);
                o[2] = (y[a][i][2] - mu) * rstd * gg[2] * bf2f(gv.y & 0xffffu); o[3] = (y[a][i][3] - mu) * rstd * gg[3] * bf2f(gv.y >> 16);
                *(u32x2*)(gp + 16 * a) = pack4(o); } }
    }
}

constexpr int RS_KP = 272, RS_VP = 144, RS_VOFF = 128 * RS_KP;
__device__ __forceinline__ void ret_state_phase(LAS unsigned char* lds, const bf16* RK, const bf16* RV, bf16* ST, const float* decf, const float* decb) {
    const int tid = threadIdx.x, lane = tid & 63, wave = __builtin_amdgcn_readfirstlane(tid >> 6), g = lane >> 4, li = lane & 15, q4 = li >> 2, p4 = li & 3;
    for (int it = vblock(); it < NB * 4 * 2 * 4; it += gridDim.x) {
        const int es = it & 3, dir = (it >> 2) & 1, h = (it >> 3) & 3, b = it >> 5;
        const float lg = -log1pf(expf(-(dir ? decb[h] : decf[h]))); const float cd = __expf(128.f * lg);
        f32x4 st[4];
#pragma unroll
        for (int ef = 0; ef < 4; ++ef) st[ef] = (f32x4){0.f, 0.f, 0.f, 0.f};
        u32x4 kq[4], vq[2];
        { const size_t tk = (size_t)b * SEQ + (dir ? 15 : 0) * 128;
#pragma unroll
          for (int i = 0; i < 4; ++i) { const int id = tid + 512 * i, row = id >> 4, ch = id & 15; kq[i] = *(const u32x4*)(RK + (tk + row) * 512 + h * 128 + ch * 8); }
#pragma unroll
          for (int i = 0; i < 2; ++i) { const int id = tid + 512 * i, row = id >> 3, ch = id & 7; vq[i] = *(const u32x4*)(RV + (tk + row) * 1024 + h * 256 + es * 64 + ch * 8); } }
#pragma unroll 1
        for (int cc = 0; cc < 16; ++cc) { const int n = dir ? 15 - cc : cc;
            bf16* sp = ST + ((size_t)(((b * 4 + h) * 2 + dir) * 16 + n) * 256 + es * 64 + li) * 128 + 16 * wave + 4 * g;
#pragma unroll
            for (int ef = 0; ef < 4; ++ef) *(u32x2*)(sp + (size_t)16 * ef * 128) = pack4(st[ef]);
            __syncthreads();
#pragma unroll
            for (int i = 0; i < 4; ++i) { const int id = tid + 512 * i, row = id >> 4, ch = id & 15;
                float v[8]; unpack8(kq[i], v);
                const float w = __expf((float)(dir ? row : 127 - row) * lg);
                u32x4 o; o.x = pk2(v[0] * w, v[1] * w); o.y = pk2(v[2] * w, v[3] * w); o.z = pk2(v[4] * w, v[5] * w); o.w = pk2(v[6] * w, v[7] * w);
                *(LAS u32x4*)(lds + row * RS_KP + ch * 16) = o; }
#pragma unroll
            for (int i = 0; i < 2; ++i) { const int id = tid + 512 * i, row = id >> 3, ch = id & 7; *(LAS u32x4*)(lds + RS_VOFF + row * RS_VP + ch * 16) = vq[i]; }
            if (cc < 15) { const int n2 = dir ? 14 - cc : cc + 1; const size_t tk = (size_t)b * SEQ + n2 * 128;
#pragma unroll
                for (int i = 0; i < 4; ++i) { const int id = tid + 512 * i, row = id >> 4, ch = id & 15; kq[i] = *(const u32x4*)(RK + (tk + row) * 512 + h * 128 + ch * 8); }
#pragma unroll
                for (int i = 0; i < 2; ++i) { const int id = tid + 512 * i, row = id >> 3, ch = id & 7; vq[i] = *(const u32x4*)(RV + (tk + row) * 1024 + h * 256 + es * 64 + ch * 8); } }
            __syncthreads();
#pragma unroll
            for (int ef = 0; ef < 4; ++ef) st[ef] = st[ef] * cd;
#pragma unroll
            for (int x = 0; x < 4; ++x) {
                LAS unsigned char* kb = lds + (32 * x + 8 * g + q4) * RS_KP + (16 * wave) * 2 + 8 * p4;
                const bf16x8 kfr = trf(kb, kb + 4 * RS_KP);
                LAS unsigned char* vb = lds + RS_VOFF + (32 * x + 8 * g + q4) * RS_VP + 8 * p4;
#pragma unroll
                for (int ef = 0; ef < 4; ++ef) st[ef] = mma(kfr, trf(vb + 32 * ef, vb + 4 * RS_VP + 32 * ef), st[ef]); __builtin_amdgcn_sched_barrier(0); }
        }
    }
}
__device__ __forceinline__ void memkv_phase(const bf16* MN, const bf16* WKV, bf16* MKV) {
    const int tid = threadIdx.x, lane = tid & 63, wave = __builtin_amdgcn_readfirstlane(tid >> 6), g = lane >> 4, li = lane & 15;
    for (int it = blockIdx.x; it < 256; it += gridDim.x) {
        const int r0 = (it >> 4) * 128 + wave * 16, c0 = (it & 15) * 64;
        const bf16* ap = MN + (size_t)(r0 + li) * 1024 + 8 * g; const bf16* bp = WKV + (size_t)(c0 + li) * 1024 + 8 * g;
        f32x4 acc[4];
#pragma unroll
        for (int nf = 0; nf < 4; ++nf) acc[nf] = (f32x4){0.f, 0.f, 0.f, 0.f};
#pragma unroll 4
        for (int s = 0; s < 32; ++s) { const bf16x8 a = glbf(ap + 32 * s);
#pragma unroll
            for (int nf = 0; nf < 4; ++nf) acc[nf] = mma(glbf(bp + (size_t)nf * 16 * 1024 + 32 * s), a, acc[nf]); }
#pragma unroll
        for (int nf = 0; nf < 4; ++nf) *(u32x2*)(MKV + (size_t)(r0 + li) * 1024 + c0 + 16 * nf + 4 * g) = pack4(acc[nf]);
    }
}
}


struct Ptrs {
    const float* in[23]; float* out; unsigned char* ws;
    __device__ bf16* b(size_t off) const { return (bf16*)(ws + off); }
    __device__ float* f(size_t off) const { return (float*)(ws + off); }
};

__device__ __forceinline__ void phase0(const Ctx& c, const Ptrs& P) {
    int tb = 0;
    transpose_all(c, tb, ColWA{P.in[3]}, 8192, NPA, 1024, P.b(WS_WA));
    transpose_all(c, tb, ColOff{P.in[3], NPA}, 8192, NPG, 1024, P.b(WS_WG));
    transpose_all(c, tb, ColPlain{P.in[11]}, 1024, 1024, 1024, P.b(WS_WKV));
    transpose_all(c, tb, ColPlain{P.in[7]}, 1024, 1024, 1024, P.b(WS_WRO));
    transpose_all(c, tb, ColPlain{P.in[9]}, 1024, 1024, 512, P.b(WS_WNO));
    transpose_all(c, tb, ColPlain{P.in[12]}, 1024, 1024, 512, P.b(WS_WXO));
    transpose_all(c, tb, ColPlain{P.in[13]}, 1024, 1024, 1024, P.b(WS_WOUT));
    { float* COS = P.f(WS_COS); float* SIN = P.f(WS_SIN);
      for (int i = c.gw * 64 + c.lane; i < SEQ * 64; i += c.ngw * 64) { const int pos = i >> 6, fi = i & 63;
          const float inv = (float)pow(10000.0, -(double)fi / 64.0); const float ang = (float)pos * inv;
          COS[i] = (float)cos((double)ang); SIN[i] = (float)sin((double)ang); } }
    { bf16* FT = P.b(WS_FT); const float* rpb = P.in[8];
      for (int i = c.gw * 64 + c.lane; i < 8 * 15 * 64 * 64; i += c.ngw * 64) { const int qc = i & 63, kc = (i >> 6) & 63, hr = i >> 12;
          int cs = qc - 8; cs = cs < 0 ? 0 : (cs > 48 ? 48 : cs); int rc = kc - qc; rc = rc < -15 ? -15 : (rc > 15 ? 15 : rc);
          const float v = (kc >= cs && kc < cs + 16) ? rpb[hr * 31 + rc + 15] : -1.0e30f; FT[i] = (bf16)f2bf(v); } }
    { float* WTR = P.f(WS_WTR); const float* wrg = P.in[15]; const float* wre = P.in[17];
      for (int i = c.gw * 64 + c.lane; i < 20 * 1024; i += c.ngw * 64) { const int n = i >> 10, k = i & 1023; WTR[i] = n < 4 ? wrg[k * 4 + n] : wre[k * 16 + (n - 4)]; } }
    for (int m = c.gw; m < T; m += 2 * c.ngw) {
        const int m2 = m + c.ngw; const f32x4* xa = (const f32x4*)(P.in[0] + (size_t)m * DM) + c.lane; const f32x4* xb = (const f32x4*)(P.in[0] + (size_t)(m2 < T ? m2 : m) * DM) + c.lane;
        const f32x4* gr = (const f32x4*)P.in[2] + c.lane;
        f32x4 va[4], vb[4]; float sa = 0.f, sb = 0.f;
#pragma unroll
        for (int j = 0; j < 4; ++j) { va[j] = xa[64 * j]; vb[j] = xb[64 * j]; }
#pragma unroll
        for (int j = 0; j < 4; ++j) { sa += (va[j].x * va[j].x + va[j].y * va[j].y) + (va[j].z * va[j].z + va[j].w * va[j].w); sb += (vb[j].x * vb[j].x + vb[j].y * vb[j].y) + (vb[j].z * vb[j].z + vb[j].w * vb[j].w); }
        const float ra = 1.0f / sqrtf(wave_sum(sa) * (1.f / 1024.f) + RMS_EPS), rb = 1.0f / sqrtf(wave_sum(sb) * (1.f / 1024.f) + RMS_EPS);
        unsigned long long* oa = (unsigned long long*)(P.b(WS_XN) + (size_t)m * DM) + c.lane; unsigned long long* ob = (unsigned long long*)(P.b(WS_XN) + (size_t)m2 * DM) + c.lane;
#pragma unroll
        for (int j = 0; j < 4; ++j) { const f32x4 gg = gr[64 * j];
            oa[64 * j] = (unsigned long long)pk2(va[j].x * ra * gg.x, va[j].y * ra * gg.y) | ((unsigned long long)pk2(va[j].z * ra * gg.z, va[j].w * ra * gg.w) << 32);
            if (m2 < T) ob[64 * j] = (unsigned long long)pk2(vb[j].x * rb * gg.x, vb[j].y * rb * gg.y) | ((unsigned long long)pk2(vb[j].z * rb * gg.z, vb[j].w * rb * gg.w) << 32); } }
    for (int m = c.gw; m < TM; m += c.ngw) rms_row_to_bf16(P.in[1] + (size_t)m * DM, P.in[10], P.b(WS_MN) + (size_t)m * DM, c.lane);
}

__device__ __forceinline__ void phase1_naive(const Ctx& c, const Ptrs& P) {
    EpiProjA E{P.b(WS_RQ), P.b(WS_RK), P.b(WS_RV), P.b(WS_RG), P.b(WS_NQ), P.b(WS_NK), P.b(WS_NV), P.b(WS_XQ), P.f(WS_COS), P.f(WS_SIN)};
    naive_gemm(c, RowPlain{P.b(WS_XN), DM}, P.b(WS_WA), DM, T, NPA, DM, E);
}

__device__ __forceinline__ float log_sigmoid_(float x) { return -log1pf(expf(-x)); }

__device__ __forceinline__ void phase2_states_naive(const Ctx& c, const Ptrs& P) {
    const bf16* RK = P.b(WS_RK); const bf16* RV = P.b(WS_RV); bf16* ST = (bf16*)P.out;
    const int nitems = NB * 4 * 2 * 128 * 4;
    for (int it = c.gw; it < nitems; it += c.ngw) {
        const int eb = it & 3, d = (it >> 2) & 127, dir = (it >> 9) & 1, h = (it >> 10) & 3, b = it >> 12;
        const int e = eb * 64 + c.lane;
        const float lg = log_sigmoid_(dir ? P.in[5][h] : P.in[4][h]); const float gam = expf(lg);
        float S = 0.f;
        bf16* stb = ST + (size_t)(((b * 4 + h) * 2 + dir) * 16) * 256 * 128 + (size_t)e * 128 + d;
        for (int jj = 0; jj < SEQ; ++jj) {
            const int j = dir ? (SEQ - 1 - jj) : jj;
            if ((jj & 127) == 0) { const int n = j >> 7; stb[(size_t)n * 256 * 128] = (bf16)f2bf(S); }
            const size_t tok = (size_t)b * SEQ + j;
            const float kv = bf2f(RK[tok * 512 + h * 128 + d]) * bf2f(RV[tok * 1024 + h * 256 + e]);
            S = S * gam + kv;
        }
    }
}
__device__ __forceinline__ void phase2_na_naive(const Ctx& c, const Ptrs& P) {
    bf16* NQ = P.b(WS_NQ); const bf16* NK = P.b(WS_NK); const bf16* NV = P.b(WS_NV); const float* rpb = P.in[8];
    float* scr = (float*)(c.lds + c.wave * 16384);
    const int lane = c.lane;
    for (int it = c.gw; it < T * 8; it += c.ngw) {
        const int h = it & 7, tok = it >> 3, b = tok >> 11, s = tok & 2047, r = s >> 6, cc = s & 63;
        int rs = r - 4; rs = rs < 0 ? 0 : (rs > 24 ? 24 : rs);
        int cs = cc - 8; cs = cs < 0 ? 0 : (cs > 48 ? 48 : cs);
        scr[128 + lane] = bf2f(NQ[(size_t)tok * 512 + h * 64 + lane]);
        __builtin_amdgcn_s_waitcnt(0xC07F); asm volatile("" ::: "memory");
        float sc[2];
#pragma unroll
        for (int t = 0; t < 2; ++t) { const int key = lane + 64 * t, kr = rs + (key >> 4), kc = cs + (key & 15);
            const size_t kt = (size_t)b * SEQ + kr * 64 + kc; const u32x4* kp = (const u32x4*)(NK + kt * 512 + h * 64);
            float a = 0.f;
#pragma unroll 2
            for (int i = 0; i < 8; ++i) { float kk[8]; unpack8(kp[i], kk);
#pragma unroll
                for (int u = 0; u < 8; ++u) a += scr[128 + 8 * i + u] * kk[u]; }
            int rc = kc - cc; rc = rc < -15 ? -15 : (rc > 15 ? 15 : rc);
            sc[t] = a + rpb[(h * 15 + (kr - r + 7)) * 31 + rc + 15]; }
        const float mx = wave_max(fmaxf(sc[0], sc[1]));
        const float e0 = __expf(sc[0] - mx), e1 = __expf(sc[1] - mx);
        const float inv = 1.0f / wave_sum(e0 + e1);
        scr[lane] = e0 * inv; scr[lane + 64] = e1 * inv;
        __builtin_amdgcn_s_waitcnt(0xC07F); asm volatile("" ::: "memory");
        float o = 0.f;
        for (int key = 0; key < 128; ++key) { const int kr = rs + (key >> 4), kc = cs + (key & 15);
            const size_t kt = (size_t)b * SEQ + kr * 64 + kc; o += scr[key] * bf2f(NV[kt * 512 + h * 64 + lane]); }
        NQ[(size_t)tok * 512 + h * 64 + lane] = (bf16)f2bf(o);
        __builtin_amdgcn_s_waitcnt(0xC07F); asm volatile("" ::: "memory");
    }
}
__device__ __forceinline__ void phase2_memkv_naive(const Ctx& c, const Ptrs& P) {
    naive_gemm(c, RowPlain{P.b(WS_MN), DM}, P.b(WS_WKV), DM, TM, 1024, DM, EpiBf16Plain{P.b(WS_MKV), 1024});
}
__device__ __forceinline__ void phase3_ret_naive(const Ctx& c, const Ptrs& P) {
    const bf16* RQ = P.b(WS_RQ); const bf16* RK = P.b(WS_RK); const bf16* RV = P.b(WS_RV); bf16* RG = P.b(WS_RG); const bf16* ST = (const bf16*)P.out;
    const float* gain = P.in[6];
    float* scr = (float*)(c.lds + c.wave * 16384);
    const int lane = c.lane;
    for (int it = c.gw; it < T * 4; it += c.ngw) {
        const int h = it & 3, tok = it >> 2, b = tok >> 11, s = tok & 2047, n = s >> 7, p = s & 127;
        const float lgf = log_sigmoid_(P.in[4][h]), lgb = log_sigmoid_(P.in[5][h]);
        { const bf16* qp = RQ + (size_t)tok * 512 + h * 128; scr[lane] = bf2f(qp[lane]); scr[lane + 64] = bf2f(qp[lane + 64]); }
        __builtin_amdgcn_s_waitcnt(0xC07F); asm volatile("" ::: "memory");
        float sv[2];
#pragma unroll
        for (int t = 0; t < 2; ++t) { const int pj = lane + 64 * t; const size_t kt = (size_t)b * SEQ + n * 128 + pj;
            const u32x4* kp = (const u32x4*)(RK + kt * 512 + h * 128); float a = 0.f;
#pragma unroll 2
            for (int i = 0; i < 16; ++i) { float kk[8]; unpack8(kp[i], kk);
#pragma unroll
                for (int u = 0; u < 8; ++u) a += scr[8 * i + u] * kk[u]; }
            const float w = (pj <= p) ? expf((float)(p - pj) * lgf) : expf((float)(pj - p) * lgb);
            sv[t] = a * w; }
        scr[128 + lane] = sv[0]; scr[128 + 64 + lane] = sv[1];
        __builtin_amdgcn_s_waitcnt(0xC07F); asm volatile("" ::: "memory");
        const float af = expf((float)(p + 1) * lgf), ab = expf((float)(128 - p) * lgb);
        const bf16* sf = ST + (size_t)(((b * 4 + h) * 2 + 0) * 16 + n) * 256 * 128;
        const bf16* sb = ST + (size_t)(((b * 4 + h) * 2 + 1) * 16 + n) * 256 * 128;
        float y[4];
#pragma unroll 1
        for (int eb = 0; eb < 4; ++eb) { const int e = eb * 64 + lane; float a = 0.f;
#pragma unroll 4
            for (int pj = 0; pj < 128; ++pj) { const size_t kt = (size_t)b * SEQ + n * 128 + pj; a += scr[128 + pj] * bf2f(RV[kt * 1024 + h * 256 + e]); }
            float cf = 0.f, cb = 0.f; const u32x4* fp = (const u32x4*)(sf + (size_t)e * 128); const u32x4* bp = (const u32x4*)(sb + (size_t)e * 128);
#pragma unroll 2
            for (int i = 0; i < 16; ++i) { float x1[8], x2[8]; unpack8(fp[i], x1); unpack8(bp[i], x2);
#pragma unroll
                for (int u = 0; u < 8; ++u) { cf += scr[8 * i + u] * x1[u]; cb += scr[8 * i + u] * x2[u]; } }
            y[eb] = a + af * cf + ab * cb; }
        const float mu = wave_sum((y[0] + y[1]) + (y[2] + y[3])) * (1.f / 256.f);
        float v = 0.f;
#pragma unroll
        for (int eb = 0; eb < 4; ++eb) { y[eb] -= mu; v += y[eb] * y[eb]; }
        const float rstd = 1.0f / sqrtf(wave_sum(v) * (1.f / 256.f) + GN_EPS);
#pragma unroll
        for (int eb = 0; eb < 4; ++eb) { const int col = h * 256 + eb * 64 + lane; bf16* g = RG + (size_t)tok * 1024 + col;
            *g = (bf16)f2bf(y[eb] * rstd * gain[col] * bf2f(*g)); }
        __builtin_amdgcn_s_waitcnt(0xC07F); asm volatile("" ::: "memory");
    }
}
__device__ __forceinline__ void phase3_xa_naive(const Ctx& c, const Ptrs& P) {
    bf16* XQ = P.b(WS_XQ); const bf16* MKV = P.b(WS_MKV);
    float* scr = (float*)(c.lds + c.wave * 16384);
    const int lane = c.lane;
    for (int it = c.gw; it < T * 4; it += c.ngw) {
        const int h = it & 3, tok = it >> 2, b = tok >> 11;
        { const bf16* qp = XQ + (size_t)tok * 512 + h * 128; scr[lane] = bf2f(qp[lane]); scr[lane + 64] = bf2f(qp[lane + 64]); }
        __builtin_amdgcn_s_waitcnt(0xC07F); asm volatile("" ::: "memory");
        float sc[4]; float mx = -3.0e38f;
#pragma unroll
        for (int t = 0; t < 4; ++t) { const int m = lane + 64 * t; const u32x4* kp = (const u32x4*)(MKV + (size_t)(b * MEML + m) * 1024 + h * 128); float a = 0.f;
#pragma unroll 2
            for (int i = 0; i < 16; ++i) { float kk[8]; unpack8(kp[i], kk);
#pragma unroll
                for (int u = 0; u < 8; ++u) a += scr[8 * i + u] * kk[u]; }
            sc[t] = a; mx = fmaxf(mx, a); }
        mx = wave_max(mx); float sum = 0.f;
#pragma unroll
        for (int t = 0; t < 4; ++t) { sc[t] = __expf(sc[t] - mx); sum += sc[t]; }
        const float inv = 1.0f / wave_sum(sum);
#pragma unroll
        for (int t = 0; t < 4; ++t) scr[128 + lane + 64 * t] = sc[t] * inv;
        __builtin_amdgcn_s_waitcnt(0xC07F); asm volatile("" ::: "memory");
        float o0 = 0.f, o1 = 0.f;
        for (int m = 0; m < MEML; ++m) { const bf16* vp = MKV + (size_t)(b * MEML + m) * 1024 + 512 + h * 128; const float pm = scr[128 + m];
            o0 += pm * bf2f(vp[lane]); o1 += pm * bf2f(vp[lane + 64]); }
        bf16* op = XQ + (size_t)tok * 512 + h * 128; op[lane] = (bf16)f2bf(o0); op[lane + 64] = (bf16)f2bf(o1);
        __builtin_amdgcn_s_waitcnt(0xC07F); asm volatile("" ::: "memory");
    }
}
__device__ __forceinline__ void phase4_naive(const Ctx& c, const Ptrs& P) {
    naive_gemm(c, RowPlain{P.b(WS_XN), DM}, P.b(WS_WG), DM, T, NPG, DM, EpiSigmoid{P.b(WS_GATES), NPG});
}
__device__ __forceinline__ void phase5_naive(const Ctx& c, const Ptrs& P) {
    float* TMP = P.out; bf16* MIX = P.b(WS_MIX); const bf16* G = P.b(WS_GATES);
    naive_gemm(c, RowPlain{P.b(WS_RG), 1024}, P.b(WS_WRO), 1024, T, DM, 1024, EpiMixNaive<0>{TMP, MIX, G});
    naive_gemm(c, RowPlain{P.b(WS_NQ), 512}, P.b(WS_WNO), 512, T, DM, 512, EpiMixNaive<1>{TMP, MIX, G + 1024});
    naive_gemm(c, RowPlain{P.b(WS_XQ), 512}, P.b(WS_WXO), 512, T, DM, 512, EpiMixNaive<2>{TMP, MIX, G + 2048});
}
__device__ __forceinline__ void phase6_naive(const Ctx& c, const Ptrs& P) {
    naive_gemm(c, RowPlain{P.b(WS_MIX), DM}, P.b(WS_WOUT), DM, T, DM, DM, EpiResidF32{P.in[0], P.out});
}

__device__ __forceinline__ void phase1_mfma(const Ctx& c, const Ptrs& P) {
    EpiProjA E{P.b(WS_RQ), P.b(WS_RK), P.b(WS_RV), P.b(WS_RG), P.b(WS_NQ), P.b(WS_NK), P.b(WS_NV), P.b(WS_XQ), P.f(WS_COS), P.f(WS_SIN)};
    pg8::PlainSched S; S.o.init(T / 256, NPA / 256, gridDim.x, blockIdx.x); S.A = P.b(WS_XN); S.Bt = P.b(WS_WA); S.lda = DM; S.ldb = DM; S.K = DM;
    pg8::gemm_phase<false>((LAS unsigned char*)c.lds, S, pg8::EpiF<EpiProjA, 4>{E});
}
__device__ __forceinline__ void phase4_mfma(const Ctx& c, const Ptrs& P) {
    pg8::PlainSched S; S.o.init(T / 256, NPG / 256, gridDim.x, blockIdx.x); S.A = P.b(WS_XN); S.Bt = P.b(WS_WG); S.lda = DM; S.ldb = DM; S.K = DM;
    pg8::gemm_phase<false>((LAS unsigned char*)c.lds, S, pg8::EpiF<EpiSigmoid>{EpiSigmoid{P.b(WS_GATES), NPG}});
}
__device__ __forceinline__ void phase6_mfma(const Ctx& c, const Ptrs& P) {
    pg8::PlainSched S; S.o.init(T / 256, DM / 256, gridDim.x, blockIdx.x); S.A = P.b(WS_MIX); S.Bt = P.b(WS_WOUT); S.lda = DM; S.ldb = DM; S.K = DM;
    pg8::gemm_phase<false>((LAS unsigned char*)c.lds, S, pg8::EpiF<EpiResidBf16, 2>{EpiResidBf16{P.in[0], P.b(WS_D)}}, 25);
}

__device__ __forceinline__ void panel_handoff(unsigned* cnt, unsigned need) {
    asm volatile("s_waitcnt vmcnt(0)" ::: "memory"); __syncthreads();
    if (threadIdx.x == 0) {
        __builtin_amdgcn_fence(__ATOMIC_RELEASE, "agent"); asm volatile("s_waitcnt vmcnt(0)" ::: "memory");
        __hip_atomic_fetch_add(cnt, 1u, __ATOMIC_RELAXED, __HIP_MEMORY_SCOPE_AGENT);
        unsigned sp = 0; while (__hip_atomic_load(cnt, __ATOMIC_RELAXED, __HIP_MEMORY_SCOPE_AGENT) < need) { __builtin_amdgcn_s_sleep(2); if (++sp > (1u << 22)) break; }
        __builtin_amdgcn_fence(__ATOMIC_ACQUIRE, "agent"); asm volatile("s_waitcnt vmcnt(0)" ::: "memory");
    }
    __syncthreads();
}
struct GateSched { pg8::TileOrder o; const unsigned char* ws;
    __device__ __forceinline__ bool next(int i, pg8::UnitDesc& u) const { int pm, pn; const int w = i % 3; if (!o.tile(i / 3, pm, pn)) return false;
        u.A = (const char*)(ws + WS_XN) + (size_t)pm * 256 * 2048; u.B = (const char*)(ws + WS_WG) + (size_t)(w * 1024 + pn * 256) * 2048; u.lda2 = 2048; u.ldb2 = 2048; u.nt = 16;
        u.row0 = pm * 256; u.col0 = pn * 256; u.aux = w; u.aux2 = 0; u.gidx = nullptr; u.gcnt = 0; u.chain = 0; return true; } };
__device__ __forceinline__ unsigned q8x4(f32x4 g) {
    const unsigned a = (unsigned)(g[0] * 255.0f + 0.5f), b = (unsigned)(g[1] * 255.0f + 0.5f), c = (unsigned)(g[2] * 255.0f + 0.5f), d = (unsigned)(g[3] * 255.0f + 0.5f);
    return a | (b << 8) | (c << 16) | (d << 24); }
__device__ __forceinline__ f32x4 dq8x4(unsigned w) {
    return (f32x4){fmaxf((float)(w & 0xffu) * (1.0f / 255.0f), 1e-18f), fmaxf((float)((w >> 8) & 0xffu) * (1.0f / 255.0f), 1e-18f),
                   fmaxf((float)((w >> 16) & 0xffu) * (1.0f / 255.0f), 1e-18f), fmaxf((float)(w >> 24) * (1.0f / 255.0f), 1e-18f)}; }
struct EpiGate { unsigned char* SCR;
    __device__ __forceinline__ void finish(f32x4 (&acc)[2][2][4][2], const pg8::UnitDesc& u, int wr, int wc, int fr, int fq) const {
        unsigned ow = (unsigned)((u.row0 >> 8) * 4 + (u.col0 >> 8)) * 196608u + (unsigned)u.aux * 65536u + threadIdx.x * 8u;
#pragma unroll
        for (int ai = 0; ai < 2; ++ai)
#pragma unroll
            for (int m = 0; m < 4; ++m) { asm volatile("" : "+v"(ow));
#pragma unroll
                for (int bj = 0; bj < 2; ++bj) { f32x4 s0, s1;
#pragma unroll
                    for (int i = 0; i < 4; ++i) { s0[i] = sigmoidf_(acc[ai][bj][m][0][i]); s1[i] = sigmoidf_(acc[ai][bj][m][1][i]); }
                    *(u32x2*)(SCR + ow + bj * 4096) = (u32x2){q8x4(s0), q8x4(s1)}; }
                ow += 2 * 4096; asm volatile("" ::: "memory"); __builtin_amdgcn_sched_barrier(0); }
        pg8::zero_acc(acc);
    } };
struct MixSched { pg8::TileOrder o; const unsigned char* ws;
    __device__ __forceinline__ bool next(int i, pg8::UnitDesc& u) const { int pm, pn; const int w = i % 3; if (!o.tile(i / 3, pm, pn)) return false;
        const size_t offA = w == 0 ? WS_RG : (w == 1 ? WS_NQ : WS_XQ), offB = w == 0 ? WS_WRO : (w == 1 ? WS_WNO : WS_WXO); const int K = w == 0 ? 1024 : 512;
        u.A = (const char*)(ws + offA) + (size_t)pm * 256 * K * 2; u.B = (const char*)(ws + offB) + (size_t)pn * 256 * K * 2; u.lda2 = K * 2; u.ldb2 = K * 2; u.nt = K / 64;
        u.row0 = pm * 256; u.col0 = pn * 256; u.aux = w; u.aux2 = 0; u.gidx = nullptr; u.gcnt = 0; u.chain = (w < 2); return true; } };
struct EpiMix { const unsigned char* SCR; bf16* MIX;
    __device__ __forceinline__ void finish(f32x4 (&acc)[2][2][4][2], const pg8::UnitDesc& u, int wr, int wc, int fr, int fq) const {
        const int w = u.aux; const bool fin = (w == 2);
        unsigned on = (unsigned)((u.row0 >> 8) * 4 + (u.col0 >> 8)) * 196608u + (unsigned)w * 65536u + threadIdx.x * 8u; const unsigned dd = fin ? 0u : 65536u;
        bf16* mp = MIX + (size_t)(u.row0 + wr * 64 + fr) * DM + u.col0 + wc * 32 + 8 * fq;
#pragma unroll
        for (int ai = 0; ai < 2; ++ai) {
            asm volatile("" : "+v"(on), "+v"(mp));
            u32x2 ga[4][2], gb[4][2];
#pragma unroll
            for (int m = 0; m < 4; ++m)
#pragma unroll
                for (int bj = 0; bj < 2; ++bj) { ga[m][bj] = *(const u32x2*)(SCR + on + (2 * m + bj) * 4096); gb[m][bj] = *(const u32x2*)(SCR + on + dd + (2 * m + bj) * 4096); }
#pragma unroll
            for (int m = 0; m < 4; ++m) {
#pragma unroll
                for (int bj = 0; bj < 2; ++bj) {
                    const f32x4 n0 = dq8x4(ga[m][bj].x), n1 = dq8x4(ga[m][bj].y), d0 = dq8x4(gb[m][bj].x), d1 = dq8x4(gb[m][bj].y);
                    f32x4 r0, r1;
#pragma unroll
                    for (int i = 0; i < 4; ++i) { r0[i] = n0[i] * __builtin_amdgcn_rcpf(fin ? 1.0f : d0[i]); r1[i] = n1[i] * __builtin_amdgcn_rcpf(fin ? 1.0f : d1[i]); }
                    const f32x4 v0 = acc[ai][bj][m][0] * r0, v1 = acc[ai][bj][m][1] * r1;
                    if (fin) store8(mp + (size_t)m * 16 * DM + bj * 128, v0, v1);
                    acc[ai][bj][m][0] = fin ? (f32x4){0.f, 0.f, 0.f, 0.f} : v0; acc[ai][bj][m][1] = fin ? (f32x4){0.f, 0.f, 0.f, 0.f} : v1; } }
            on += 8 * 4096; mp += 128 * DM; asm volatile("" ::: "memory"); __builtin_amdgcn_sched_barrier(0); }
    }
};
__device__ __forceinline__ void phase5_mfma(const Ctx& c, const Ptrs& P) {
    unsigned char* scr = P.ws + WS_GATES;
    { GateSched S; S.o.init(T / 256, DM / 256, gridDim.x, blockIdx.x); S.ws = P.ws; pg8::gemm_phase<false>((LAS unsigned char*)c.lds, S, EpiGate{scr}); }
    { MixSched S; S.o.init(T / 256, DM / 256, gridDim.x, blockIdx.x); S.ws = P.ws; pg8::gemm_phase<false>((LAS unsigned char*)c.lds, S, EpiMix{scr, P.b(WS_MIX)}); }
}
struct MoeSched { const unsigned* ctl; int mode;
    int lo, hi, nblk, v;
    const bf16 *H2, *WGU, *HID, *WD; const int* elist;
    __device__ __forceinline__ bool next(int i, pg8::UnitDesc& u) const {
        if (v < 0) return false;
        const int L = lo + v + i * nblk; if (L >= hi) return false;
        const int pn = L & 3; int mtg = L >> 2;
        int e = -1, base = 0, cnt = 0, mt = 0;
#pragma unroll 1
        for (int j = 0; j < NEXP; ++j) { const int cj = (int)__builtin_amdgcn_readfirstlane((int)ctl[CW_ECNT + 64 * j]); const int tj = (cj + 255) >> 8;
            if (mtg < tj) { e = j; cnt = cj; mt = mtg; break; } mtg -= tj; base += tj * 256; }
        if (e < 0) return false;
        u.row0 = mt * 256; u.col0 = pn * 256; u.aux = e; u.aux2 = base; u.gcnt = cnt; u.chain = 0;
        if (mode == 0) { u.A = (const char*)H2; u.gidx = elist + e * T; u.lda2 = DM * 2; u.B = (const char*)(WGU + (size_t)e * 1024 * 1024 + (size_t)pn * 256 * 1024); u.ldb2 = 2048; u.nt = 16; }
        else { u.A = (const char*)(HID + (size_t)(base + mt * 256) * DFF); u.gidx = nullptr; u.lda2 = DFF * 2; u.B = (const char*)(WD + (size_t)e * 1024 * 512 + (size_t)pn * 256 * 512); u.ldb2 = 1024; u.nt = 8; }
        return true; } };
struct EpiMoeUp { bf16* HID; const float* EWL; const float* ERS;
    __device__ __forceinline__ void finish(f32x4 (&acc)[2][2][4][2], const pg8::UnitDesc& u, int wr, int wc, int fr, int fq) const {
        const float* wl = EWL + u.aux * T; const float* rl = ERS + u.aux * T; bf16* H = HID; const int base = u.aux2, cnt = u.gcnt;
        pg8::epi_apply(acc, u, wr, wc, fr, fq, [=](int row, int col0, f32x4 v0, f32x4 v1) { if (row < cnt) { const float rs = rl[row], w = wl[row] * rs; f32x4 h;
#pragma unroll
            for (int i = 0; i < 4; ++i) h[i] = siluf_(v0[i] * rs) * v1[i] * w;
            u32x2 o; o.x = pk2(h[0], h[1]); o.y = pk2(h[2], h[3]); *(u32x2*)(H + (size_t)(base + row) * DFF + (col0 >> 1)) = o; } });
        pg8::zero_acc(acc);
    } };
struct EpiMoeDown { bf16* DR;
    __device__ __forceinline__ void finish(f32x4 (&acc)[2][2][4][2], const pg8::UnitDesc& u, int wr, int wc, int fr, int fq) const {
        bf16* D = DR; const int base = u.aux2;
        pg8::epi_apply(acc, u, wr, wc, fr, fq, [=](int row, int col0, f32x4 v0, f32x4 v1) { store8(D + (size_t)(base + row) * DM + col0, v0, v1); });
        pg8::zero_acc(acc);
    } };
__device__ __forceinline__ MoeSched moe_sched(const Ptrs& P, int mode) {
    MoeSched S; S.ctl = (const unsigned*)(P.ws + WS_CTL); S.mode = mode; S.H2 = P.b(WS_D); S.WGU = P.b(WS_WGU); S.HID = P.b(WS_HID); S.WD = P.b(WS_WD); S.elist = (const int*)(P.ws + WS_ELIST);
    S.lo = 0; S.hi = 0; S.nblk = 1; S.v = -1; return S; }
__device__ __forceinline__ int moe_tiles(const Ptrs& P) { const unsigned* ctl = (const unsigned*)(P.ws + WS_CTL); int tiles = 0;
    for (int j = 0; j < NEXP; ++j) tiles += ((int)ctl[CW_ECNT + 64 * j] + 255) >> 8; return tiles; }
__device__ __forceinline__ void phase8a(const Ctx& c, const Ptrs& P) {
    const int G = (int)gridDim.x, units = 4 * moe_tiles(P);
    MoeSched S = moe_sched(P, 0); S.lo = 0; S.hi = units < 2 * G ? units : 2 * G; S.nblk = G; S.v = (int)blockIdx.x;
    pg8::gemm_phase<true>((LAS unsigned char*)c.lds, S, EpiMoeUp{P.b(WS_HID), P.f(WS_EWL), P.f(WS_ERS)});
}
__device__ __forceinline__ void phase8b(const Ctx& c, const Ptrs& P) {
    const int G = (int)gridDim.x, tiles = moe_tiles(P), units = 4 * tiles; const int nrem = units - 2 * G < 0 ? 0 : units - 2 * G;
    const int tdone = (2 * G) / 4 < tiles ? (2 * G) / 4 : tiles;
    const bool local = nrem > 0 && nrem <= G / 2;
    const int nup = local ? nrem : (nrem < G / 2 ? nrem : G / 2);
    if ((int)blockIdx.x < nup) {
        MoeSched S = moe_sched(P, 0); S.lo = 2 * G; S.hi = units; S.nblk = nup; S.v = (int)blockIdx.x;
        pg8::gemm_phase<true>((LAS unsigned char*)c.lds, S, EpiMoeUp{P.b(WS_HID), P.f(WS_EWL), P.f(WS_ERS)});
        if (local) {
            const int L = 2 * G + (int)blockIdx.x, tile = L >> 2; unsigned* cnt = (unsigned*)(P.ws + WS_CTL) + CW_TCNT + 64 * (tile - tdone);
            if (c.tid == 0) {
                __builtin_amdgcn_fence(__ATOMIC_RELEASE, "agent"); asm volatile("s_waitcnt vmcnt(0)" ::: "memory");
                __hip_atomic_fetch_add(cnt, 1u, __ATOMIC_RELAXED, __HIP_MEMORY_SCOPE_AGENT);
                const int need = (units - 4 * tile) < 4 ? (units - 4 * tile) : 4; unsigned sp = 0;
                while (__hip_atomic_load(cnt, __ATOMIC_RELAXED, __HIP_MEMORY_SCOPE_AGENT) < (unsigned)need) { __builtin_amdgcn_s_sleep(2); if (++sp > (1u << 22)) break; }
                __builtin_amdgcn_fence(__ATOMIC_ACQUIRE, "agent"); asm volatile("s_waitcnt vmcnt(0)" ::: "memory");
            }
            __syncthreads();
            MoeSched D = moe_sched(P, 1); D.lo = L; D.hi = L + 1; D.nblk = 1; D.v = 0;
            pg8::gemm_phase<false>((LAS unsigned char*)c.lds, D, EpiMoeDown{P.b(WS_DROWS)});
        }
    } else { MoeSched S = moe_sched(P, 1); S.lo = 0; S.hi = 4 * tdone; S.nblk = G - nup; S.v = (int)blockIdx.x - nup;
        pg8::gemm_phase<false>((LAS unsigned char*)c.lds, S, EpiMoeDown{P.b(WS_DROWS)}); }
}
__device__ __forceinline__ bool moe_needs_8c(const Ptrs& P) { const int G = (int)gridDim.x, units = 4 * moe_tiles(P); const int nrem = units - 2 * G; return nrem > G / 2; }
__device__ __forceinline__ void phase8c(const Ctx& c, const Ptrs& P) {
    if (!moe_needs_8c(P)) return;
    const int G = (int)gridDim.x, tiles = moe_tiles(P); const int tdone = (2 * G) / 4 < tiles ? (2 * G) / 4 : tiles;
    MoeSched S = moe_sched(P, 1); S.lo = 4 * tdone; S.hi = 4 * tiles; S.nblk = G; S.v = (int)blockIdx.x;
    pg8::gemm_phase<false>((LAS unsigned char*)c.lds, S, EpiMoeDown{P.b(WS_DROWS)});
}
__device__ __forceinline__ void phase2_memkv_mfma(const Ctx& c, const Ptrs& P) {
    pg8::PlainSched S; S.o.init(TM / 256, 1024 / 256, gridDim.x, blockIdx.x); S.A = P.b(WS_MN); S.Bt = P.b(WS_WKV); S.lda = DM; S.ldb = DM; S.K = DM;
    pg8::gemm_phase<false>((LAS unsigned char*)c.lds, S, pg8::EpiF<EpiBf16Plain>{EpiBf16Plain{P.b(WS_MKV), 1024}});
}
__device__ __forceinline__ f32x4 x1_load(const float* X0, const bf16* DD, size_t tok, int lane, int j) {
    const u32x2 d = ((const u32x2*)(DD + tok * DM) + lane)[64 * j];
    return (f32x4){bf2f(d.x & 0xffffu), bf2f(d.x >> 16), bf2f(d.y & 0xffffu), bf2f(d.y >> 16)};
}
constexpr int RT7_WT = 0, RT7_RED = 81920, RT7_LOG = RT7_RED + 8 * 5120, RT7_CNT = RT7_LOG + 8 * 160, RT7_GB = RT7_CNT + 64, RT7_REC = RT7_GB + 64;
template <bool LOCAL>
__device__ __forceinline__ void phase7(const Ctx& c, const Ptrs& P, int rowbase = 0) {
    const float* X0 = P.in[0]; const bf16* DD = P.b(WS_D); const float* g = P.in[14]; const float* wrg = P.in[15]; const float* brg = P.in[16]; const float* wre = P.in[17]; const float* bre = P.in[18];
    unsigned* ctl = (unsigned*)(P.ws + WS_CTL); int* elist = (int*)(P.ws + WS_ELIST); float* ewl = P.f(WS_EWL); int* tmeta = (int*)(P.ws + WS_TMETA);
    const int lane = c.lane; LAS unsigned char* L = (LAS unsigned char*)c.lds;
    { LAS f32x4* WT = (LAS f32x4*)(L + RT7_WT); const f32x4* src = (const f32x4*)P.f(WS_WTR);
#pragma unroll
      for (int i = 0; i < 10; ++i) WT[c.tid + NTHREADS * i] = src[c.tid + NTHREADS * i];
      if (c.tid < 16) ((LAS unsigned*)(L + RT7_CNT))[c.tid] = 0u; (void)wrg; (void)wre; }
    __syncthreads();
    LAS float* RED = (LAS float*)(L + RT7_RED + c.wave * 5120); LAS float* LOG = (LAS float*)(L + RT7_LOG + c.wave * 160);
    LAS unsigned* LCNT = (LAS unsigned*)(L + RT7_CNT); LAS int* REC = (LAS int*)(L + RT7_REC);
    const float mybias = lane < 4 ? brg[lane] : (lane < 20 ? bre[lane - 4] : 0.f);
    f32x4 xn[2][4];
    const int tp0 = LOCAL ? rowbase / 2 + c.wave * 4 : c.gw, tpstep = LOCAL ? 1 : c.ngw, tpend = LOCAL ? tp0 + 4 : T / 2;
    if (tp0 < tpend) {
#pragma unroll
        for (int t = 0; t < 2; ++t)
#pragma unroll
            for (int j = 0; j < 4; ++j) xn[t][j] = x1_load(X0, DD, (size_t)(2 * tp0 + t), lane, j); }
    int pidx = 0;
#pragma unroll 1
    for (int tp = tp0; tp < tpend; tp += tpstep, ++pidx) {
        f32x4 hh[2][4]; float rstd2[2]; const f32x4* gr = (const f32x4*)g + lane;
#pragma unroll
        for (int t = 0; t < 2; ++t)
#pragma unroll
            for (int j = 0; j < 4; ++j) hh[t][j] = xn[t][j];
        { const int tpn = tp + tpstep < tpend ? tp + tpstep : tp;
#pragma unroll
          for (int t = 0; t < 2; ++t)
#pragma unroll
              for (int j = 0; j < 4; ++j) xn[t][j] = x1_load(X0, DD, (size_t)(2 * tpn + t), lane, j); }
#pragma unroll
        for (int t = 0; t < 2; ++t) { const int tok = 2 * tp + t; float s = 0.f;
#pragma unroll
            for (int j = 0; j < 4; ++j) { s += (hh[t][j].x * hh[t][j].x + hh[t][j].y * hh[t][j].y) + (hh[t][j].z * hh[t][j].z + hh[t][j].w * hh[t][j].w); }
            const float r = 1.0f / sqrtf(wave_sum(s) * (1.f / 1024.f) + RMS_EPS); rstd2[t] = r; (void)tok;
#pragma unroll
            for (int j = 0; j < 4; ++j) { const f32x4 gg = gr[64 * j]; hh[t][j] = hh[t][j] * gg * r; } }
        float p0[20], p1[20];
        const LAS f32x4* wt = (const LAS f32x4*)(L + RT7_WT) + lane;
#pragma unroll
        for (int n = 0; n < 20; ++n) { f32x2_ a = {0.f, 0.f};
#pragma unroll
            for (int j = 0; j < 4; ++j) { const f32x4 w4 = wt[n * 256 + 64 * j];
#pragma unroll
                for (int u = 0; u < 4; ++u) { const f32x2_ hv = {hh[0][j][u], hh[1][j][u]}; const f32x2_ wv = {w4[u], w4[u]}; a = __builtin_elementwise_fma(hv, wv, a); } }
            p0[n] = a[0]; p1[n] = a[1]; __builtin_amdgcn_sched_barrier(0); }
#pragma unroll 1
        for (int t = 0; t < 2; ++t) {
#pragma unroll
            for (int q = 0; q < 5; ++q) *(LAS f32x4*)(RED + lane * 20 + 4 * q) = t ? (f32x4){p1[4 * q], p1[4 * q + 1], p1[4 * q + 2], p1[4 * q + 3]} : (f32x4){p0[4 * q], p0[4 * q + 1], p0[4 * q + 2], p0[4 * q + 3]};
            asm volatile("s_waitcnt lgkmcnt(0)" ::: "memory");
            float sum = 0.f; const int nn = lane < 20 ? lane : 0;
#pragma unroll 16
            for (int j = 0; j < 64; ++j) sum += RED[j * 20 + nn];
            if (lane < 20) LOG[t * 20 + lane] = sum + mybias;
            asm volatile("s_waitcnt lgkmcnt(0)" ::: "memory");
        }
        if (lane < 2) {
            const int tok = 2 * tp + lane;
            float l[20];
#pragma unroll
            for (int i = 0; i < 20; ++i) l[i] = LOG[lane * 20 + i];
            int gi = 0;
#pragma unroll
            for (int i = 1; i < 4; ++i) if (l[i] > l[gi]) gi = i;
            float lmax = l[0];
#pragma unroll
            for (int i = 1; i < 4; ++i) lmax = fmaxf(lmax, l[i]);
            float se = 0.f;
#pragma unroll
            for (int i = 0; i < 4; ++i) se += expf(l[i] - lmax);
            const float grp_w = 1.0f / se;
            float el[4];
#pragma unroll
            for (int i = 0; i < 4; ++i) { float a = 0.f;
#pragma unroll
                for (int g2 = 0; g2 < 4; ++g2) a = (g2 == gi) ? l[4 + 4 * g2 + i] : a;
                el[i] = a; }
            int ia = 0;
#pragma unroll
            for (int i = 1; i < 4; ++i) if (el[i] > el[ia]) ia = i;
            int ib = (ia == 0) ? 1 : 0;
#pragma unroll
            for (int i = 0; i < 4; ++i) if (i != ia && i != ib && el[i] > el[ib]) ib = i;
            float ela = el[0], elb = el[0];
#pragma unroll
            for (int i = 1; i < 4; ++i) { ela = (i == ia) ? el[i] : ela; elb = (i == ib) ? el[i] : elb; }
            const float t = expf(elb - ela); const float wa = grp_w / (1.0f + t), wb = grp_w * t / (1.0f + t);
            const int ea = gi * 4 + ia, eb = gi * 4 + ib;
            const int lpa = (int)atomicAdd((unsigned*)(LCNT + ea), 1u), lpb = (int)atomicAdd((unsigned*)(LCNT + eb), 1u);
            LAS int* rec = REC + (c.wave * 8 + pidx * 2 + lane) * 8;
            rec[0] = tok; rec[1] = ea; rec[2] = lpa; rec[3] = eb; rec[4] = lpb; rec[5] = __float_as_int(wa); rec[6] = __float_as_int(wb); rec[7] = __float_as_int(lane ? rstd2[1] : rstd2[0]);
        }
    }
    __syncthreads();
    if (c.tid < 16) ((LAS unsigned*)(L + RT7_GB))[c.tid] = atomicAdd(ctl + CW_ECNT + 64 * c.tid, LCNT[c.tid]);
    __syncthreads();
    if (c.tid < 64) { const int wv = c.tid >> 3, k = c.tid & 7;
        const int gwv = blockIdx.x * NWAVES + wv; const int npairs = LOCAL ? 4 : (gwv < T / 2 ? (T / 2 - 1 - gwv) / c.ngw + 1 : 0);
        if ((k >> 1) < npairs) { const LAS int* rec = REC + c.tid * 8; const LAS unsigned* GB = (const LAS unsigned*)(L + RT7_GB);
            const int tok = rec[0], ea = rec[1], eb = rec[3]; const int pa = (int)GB[ea] + rec[2], pb = (int)GB[eb] + rec[4];
            elist[ea * T + pa] = tok; ewl[ea * T + pa] = __int_as_float(rec[5]); elist[eb * T + pb] = tok; ewl[eb * T + pb] = __int_as_float(rec[6]);
            float* ers = (float*)(P.ws + WS_ERS); ers[ea * T + pa] = __int_as_float(rec[7]); ers[eb * T + pb] = __int_as_float(rec[7]);
            *(int4*)(tmeta + 4 * tok) = make_int4(ea, pa, eb, pb); } }
    __syncthreads();
    int tb = 0;
    for (int e = 0; e < NEXP; ++e) {
        transpose_all(c, tb, ColGU{P.in[19] + (size_t)e * 1024 * 512, P.in[20] + (size_t)e * 1024 * 512}, 512, 1024, 1024, P.b(WS_WGU) + (size_t)e * 1024 * 1024, P.in[14]);
        transpose_all(c, tb, ColPlain{P.in[21] + (size_t)e * 512 * 1024}, 1024, 1024, 512, P.b(WS_WD) + (size_t)e * 1024 * 512);
    }
}
__device__ __forceinline__ void phase567(const Ctx& c, const Ptrs& P) {
    pg8::TileOrder o; o.init(T / 256, DM / 256, gridDim.x, blockIdx.x); int pm = 0, pn = 0; o.tile(0, pm, pn);
    unsigned* ctl = (unsigned*)(P.ws + WS_CTL);
    phase5_mfma(c, P);
    panel_handoff(ctl + CW_PAN1 + 32 * pm, 4u);
    phase6_mfma(c, P);
    panel_handoff(ctl + CW_PAN2 + 32 * pm, 4u);
    phase7<true>(c, P, pm * 256 + pn * 64);
}
__device__ __forceinline__ int expert_rowbase(const unsigned* ctl, int e, int& cnt_e) {
    int base = 0; cnt_e = 0;
    for (int i = 0; i < NEXP; ++i) { const int ci = (int)ctl[CW_ECNT + 64 * i]; if (i < e) base += (ci + 255) & ~255; if (i == e) cnt_e = ci; }
    return base;
}
__device__ __forceinline__ void phase8_naive(const Ctx& c, const Ptrs& P) {
    const unsigned* ctl = (const unsigned*)(P.ws + WS_CTL);
    for (int e = 0; e < NEXP; ++e) { int cnt; const int base = expert_rowbase(ctl, e, cnt);
        naive_gemm(c, RowGather{P.b(WS_H2), DM, (const int*)(P.ws + WS_ELIST) + e * T}, P.b(WS_WGU) + (size_t)e * 1024 * 1024, 1024, cnt, 1024, 1024,
                   EpiSwiGLU{P.b(WS_HID), P.f(WS_EWL) + e * T, base}); }
}
__device__ __forceinline__ void phase9_naive(const Ctx& c, const Ptrs& P) {
    const unsigned* ctl = (const unsigned*)(P.ws + WS_CTL);
    for (int e = 0; e < NEXP; ++e) { int cnt; const int base = expert_rowbase(ctl, e, cnt);
        naive_gemm(c, RowPlain{P.b(WS_HID) + (size_t)base * DFF, DFF}, P.b(WS_WD) + (size_t)e * 1024 * 512, 512, cnt, 1024, 512, EpiRowsBf16{P.b(WS_DROWS), 1024, base}); }
}
struct FinTok { f32x4 x[4]; unsigned long long a[4], b[4]; };
__device__ __forceinline__ void fin_issue(FinTok& d, const float* X0, const bf16* DD, const bf16* DR, int tok, int4 m, const int (&rb)[NEXP], int lane) {
    int ba = 0, bb = 0;
#pragma unroll
    for (int i = 0; i < NEXP; ++i) { ba = (i == m.x) ? rb[i] : ba; bb = (i == m.z) ? rb[i] : bb; }
    const unsigned long long* da = (const unsigned long long*)(DR + (size_t)(ba + m.y) * DM) + lane;
    const unsigned long long* db = (const unsigned long long*)(DR + (size_t)(bb + m.w) * DM) + lane;
#pragma unroll
    for (int j = 0; j < 4; ++j) { d.a[j] = da[64 * j]; d.b[j] = db[64 * j]; d.x[j] = x1_load(X0, DD, (size_t)tok, lane, j); }
}
__device__ __forceinline__ void phase10(const Ctx& c, const Ptrs& P) {
    const unsigned* ctl = (const unsigned*)(P.ws + WS_CTL); const int* tmeta = (const int*)(P.ws + WS_TMETA); const bf16* DR = P.b(WS_DROWS); const float* g = P.in[22];
    int rb[NEXP]; { int base = 0;
#pragma unroll
        for (int i = 0; i < NEXP; ++i) { rb[i] = base; base += ((int)ctl[CW_ECNT + 64 * i] + 255) & ~255; } }
    const int lane = c.lane;
    if (c.gw >= T) return;
    FinTok cur, nxt; int4 mn = *(const int4*)(tmeta + 4 * c.gw);
    fin_issue(cur, P.in[0], P.b(WS_D), DR, c.gw, mn, rb, lane);
    { const int t1 = c.gw + c.ngw; mn = *(const int4*)(tmeta + 4 * (t1 < T ? t1 : c.gw)); }
#pragma unroll 1
    for (int tok = c.gw; tok < T; tok += c.ngw) {
        const int t1 = tok + c.ngw, t2 = tok + 2 * c.ngw;
        if (t1 < T) { fin_issue(nxt, P.in[0], P.b(WS_D), DR, t1, mn, rb, lane); mn = *(const int4*)(tmeta + 4 * (t2 < T ? t2 : tok)); }
        f32x4* xr = (f32x4*)(P.out + (size_t)tok * DM) + lane; const f32x4* gr = (const f32x4*)g + lane;
        f32x4 v[4]; float s = 0.f;
#pragma unroll
        for (int j = 0; j < 4; ++j) { const unsigned long long a = cur.a[j], b = cur.b[j]; f32x4 x = cur.x[j];
            x.x += bf2f((unsigned)a & 0xffffu) + bf2f((unsigned)b & 0xffffu); x.y += bf2f(((unsigned)a >> 16)) + bf2f(((unsigned)b >> 16));
            x.z += bf2f((unsigned)(a >> 32) & 0xffffu) + bf2f((unsigned)(b >> 32) & 0xffffu); x.w += bf2f((unsigned)(a >> 48)) + bf2f((unsigned)(b >> 48));
            v[j] = x; s += (x.x * x.x + x.y * x.y) + (x.z * x.z + x.w * x.w); }
        const float r = 1.0f / sqrtf(wave_sum(s) * (1.f / 1024.f) + RMS_EPS);
#pragma unroll
        for (int j = 0; j < 4; ++j) { const f32x4 gg = gr[64 * j]; xr[64 * j] = (f32x4){v[j].x * r * gg.x, v[j].y * r * gg.y, v[j].z * r * gg.z, v[j].w * r * gg.w}; }
        cur = nxt;
    }
#if PROBE_TS_A >= 0
    if (c.gw == 0 && lane == 0) { volatile LAS unsigned* MISC = (volatile LAS unsigned*)((LAS unsigned char*)c.lds + MISC_OFF);
        asm volatile("s_waitcnt vmcnt(0)" ::: "memory"); MISC[32 + 24] = (unsigned)__builtin_amdgcn_s_memrealtime();
        const unsigned dt = MISC[32 + PROBE_TS_B] - MISC[32 + PROBE_TS_A]; P.out[0] += 8.0f + (float)dt * (0.01f / PROBE_TS_DIV); }
#endif
}

constexpr int NPHASES = 12;
__global__ void __launch_bounds__(NTHREADS, 2) mk_fwd(Args args) {
    extern __shared__ __attribute__((aligned(16))) unsigned char lds[];
    Ctx c; c.tid = threadIdx.x; c.lane = c.tid & 63; c.wave = __builtin_amdgcn_readfirstlane(c.tid >> 6);
    c.gw = blockIdx.x * NWAVES + c.wave; c.ngw = gridDim.x * NWAVES; c.lds = lds;
    Ptrs P;
#pragma unroll
    for (int i = 0; i < 23; ++i) P.in[i] = args.in[i];
    P.out = args.out; P.ws = args.ws;
    volatile LAS unsigned* MISC = (volatile LAS unsigned*)((LAS unsigned char*)lds + MISC_OFF);
    if (c.tid < 32) MISC[c.tid] = 0u;
    __syncthreads();
    XcdBarrier bar; bar.bar = (unsigned*)(args.ws + WS_CTL) + CW_BAR; bar.x = 0; bar.st = nullptr;
    const int lo = args.ph_lo, hi = args.ph_hi;
    if (hi - lo > 1) bar = xcd_barrier_post((unsigned*)(args.ws + WS_CTL) + CW_BAR, MISC + 8);
#define IN(k) (lo <= (k) && (k) < hi)
#define SEAM(k) do { if (IN(k) && IN((k) + 1)) xcd_barrier(bar); } while (0)
    const int sub = args.sub;
#if PROBE_TS_A >= 0
#define STAMP(k) do { if (blockIdx.x == 0 && c.tid == 0) MISC[32 + (k)] = (unsigned)__builtin_amdgcn_s_memrealtime(); } while (0)
#else
#define STAMP(k) do { } while (0)
#endif
    STAMP(0);
#define SUBRUN(id, stmt) do { if (sub & (1 << (id))) { stmt; __syncthreads(); } } while (0)
    if (IN(0)) { SUBRUN(0, phase0(c, P)); } STAMP(1); SEAM(0); STAMP(2);
    if (IN(1)) { SUBRUN(1, phase1_mfma(c, P)); } STAMP(3); SEAM(1); STAMP(4);
    if (IN(2)) { SUBRUN(2, mx::ret_state_phase((LAS unsigned char*)lds, P.b(WS_RK), P.b(WS_RV), (bf16*)P.out, P.in[4], P.in[5])); STAMP(5);
                 SUBRUN(3, mx::na_phase((LAS unsigned char*)lds, P.b(WS_NQ), P.b(WS_NK), P.b(WS_NV), P.b(WS_FT))); STAMP(6);
                 SUBRUN(4, phase2_memkv_mfma(c, P)); } STAMP(7); SEAM(2); STAMP(8);
    if (IN(3)) { SUBRUN(5, mx::ret_out_phase((LAS unsigned char*)lds, P.b(WS_RQ), P.b(WS_RK), P.b(WS_RV), P.b(WS_RG), (const bf16*)P.out, P.in[6], P.in[4], P.in[5])); STAMP(9);
                 SUBRUN(6, mx::xa_phase((LAS unsigned char*)lds, P.b(WS_XQ), P.b(WS_MKV))); } STAMP(10); SEAM(3); STAMP(11);
    STAMP(12); STAMP(13);
    if (gridDim.x == 256) {
        if (IN(5)) { SUBRUN(8, phase567(c, P)); } STAMP(18); if (IN(5) && IN(8)) xcd_barrier(bar); STAMP(19);
    } else {
        if (IN(5)) { SUBRUN(8, phase5_mfma(c, P)); if (IN(8)) xcd_barrier(bar); SUBRUN(9, phase6_mfma(c, P)); if (IN(8)) xcd_barrier(bar); SUBRUN(10, phase7<false>(c, P)); } if (IN(5) && IN(8)) xcd_barrier(bar);
    }
    if (IN(8)) { SUBRUN(11, phase8a(c, P)); } STAMP(20); SEAM(8); STAMP(21);
    if (IN(9)) { SUBRUN(12, phase8b(c, P)); } STAMP(22); SEAM(9); STAMP(23);
    if (IN(10) && moe_needs_8c(P)) { SUBRUN(12, phase8c(c, P)); STAMP(44); SEAM(10); } STAMP(45);
    if (IN(11)) { SUBRUN(13, phase10(c, P)); }
#undef SUBRUN
#undef IN
#undef SEAM
}

extern "C" void kernel_launch(void* const* d_in, const int* in_sizes, int n_in, void* d_out, int out_size, void* d_ws, size_t ws_size, hipStream_t stream) {
    static int grid = 0;
    if (grid == 0) {
        if (n_in != 23 || out_size != T * DM || ws_size < WS_END) { fprintf(stderr, "kernel_launch: unexpected shapes (n_in %d out %d ws %zu)\n", n_in, out_size, ws_size); grid = -1; return; }
        int dev = 0, cus = 0;
        if (hipGetDevice(&dev) != hipSuccess || hipDeviceGetAttribute(&cus, hipDeviceAttributeMultiprocessorCount, dev) != hipSuccess) { grid = -1; return; }
        if (hipFuncSetAttribute((const void*)mk_fwd, hipFuncAttributeMaxDynamicSharedMemorySize, LDS_BYTES) != hipSuccess) { fprintf(stderr, "kernel_launch: hipFuncSetAttribute failed\n"); grid = -1; return; }
        (void)hipGetLastError();
        grid = cus;
    }
    if (grid < 0) return;
    (void)hipMemsetAsync((char*)d_ws + WS_CTL, 0, CTL_ZERO_BYTES, stream);
    Args a{};
    for (int i = 0; i < 23; ++i) a.in[i] = (const float*)d_in[i];
    a.out = (float*)d_out; a.ws = (unsigned char*)d_ws;
#if MK_PER_PHASE
    a.sub = 0x3fff; a.rep = -1;
    for (int p = 0; p < NPHASES; ++p) { a.ph_lo = p; a.ph_hi = p + 1; hipLaunchKernelGGL(mk_fwd, dim3(grid), dim3(NTHREADS), LDS_BYTES, stream, a); }
#else
    a.ph_lo = 0; a.ph_hi = NPHASES; a.sub = 0x3fff; a.rep = PROBE_REP; hipLaunchKernelGGL(mk_fwd, dim3(grid), dim3(NTHREADS), LDS_BYTES, stream, a);
#if PROBE_END >= 0
    { const int ph_of[14] = {0, 1, 2, 2, 2, 3, 3, 4, 5, 6, 7, 8, 9, 11};
      a.ph_lo = ph_of[PROBE_END]; a.ph_hi = a.ph_lo + 1; a.sub = 1 << PROBE_END; a.rep = -1; hipLaunchKernelGGL(mk_fwd, dim3(grid), dim3(NTHREADS), LDS_BYTES, stream, a); }
#endif
#endif
}
```

```cpp
#include <hip/hip_runtime.h>
#include <cstdio>
#include <cstdint>

#ifndef PROBE_REP
#define PROBE_REP -1
#endif
#ifndef PROBE_END
#define PROBE_END -1
#endif
#ifndef PROBE_TS_A
#define PROBE_TS_A -1
#define PROBE_TS_B -1
#endif
#ifndef PROBE_TS_DIV
#define PROBE_TS_DIV 8.0f
#endif
#ifndef MK_PER_PHASE
#define MK_PER_PHASE 0
#endif

#define GAS __attribute__((address_space(1)))
#define LAS __attribute__((address_space(3)))
typedef unsigned short bf16;
typedef float f32x4 __attribute__((ext_vector_type(4)));
typedef unsigned u32x4 __attribute__((ext_vector_type(4)));
typedef unsigned u32x2 __attribute__((ext_vector_type(2)));
typedef short bf16x8 __attribute__((ext_vector_type(8)));

constexpr int NB = 8, SEQ = 2048, DM = 1024, T = NB * SEQ;
constexpr int MEML = 256, TM = NB * MEML;
constexpr int NWAVES = 8, NTHREADS = 512;
constexpr int NPA = 5120, NPG = 3072;
constexpr int NEXP = 16, DFF = 512;
constexpr float RMS_EPS = 1e-6f, GN_EPS = 1e-5f;
constexpr float QK_SCALE = 0.08838834764831845f;

constexpr size_t MiB = 1u << 20;
constexpr size_t WS_CTL = 0, CTL_ZERO_BYTES = 65536;
constexpr size_t WS_COS = 1 * MiB, WS_SIN = 1 * MiB + 512 * 1024;
constexpr size_t WS_ELIST = 2 * MiB;
constexpr size_t WS_FT = 2 * MiB;
constexpr size_t WS_EWL = 3 * MiB;
constexpr size_t WS_TMETA = 4 * MiB;
constexpr size_t WS_WA = 5 * MiB;
constexpr size_t WS_WG = 15 * MiB;
constexpr size_t WS_WKV = 21 * MiB;
constexpr size_t WS_WRO = 23 * MiB;
constexpr size_t WS_WNO = 25 * MiB;
constexpr size_t WS_WXO = 26 * MiB;
constexpr size_t WS_WOUT = 27 * MiB;
constexpr size_t WS_XN = 29 * MiB;
constexpr size_t WS_H2 = WS_XN;
constexpr size_t WS_RQ = 61 * MiB;
constexpr size_t WS_RK = 77 * MiB;
constexpr size_t WS_RV = 93 * MiB;
constexpr size_t WS_NK = 125 * MiB;
constexpr size_t WS_NV = 141 * MiB;
constexpr size_t WS_GATES = 61 * MiB;
constexpr size_t WS_HID = 61 * MiB;
constexpr size_t WS_DROWS = 97 * MiB;
constexpr size_t WS_RG = 157 * MiB;
constexpr size_t WS_NQ = 189 * MiB;
constexpr size_t WS_XQ = 205 * MiB;
constexpr size_t WS_WD = 205 * MiB;
constexpr size_t WS_MN = 221 * MiB;
constexpr size_t WS_MKV = 225 * MiB;
constexpr size_t WS_MIX = 221 * MiB;
constexpr size_t WS_WGU = 221 * MiB;
constexpr size_t WS_D = 169 * MiB;
constexpr size_t WS_ERS = 1 * MiB;
constexpr size_t WS_WTR = 4 * MiB + 512 * 1024;
constexpr size_t WS_END = 256 * MiB;

constexpr int CW_ECNT = 64;
constexpr int CW_BAR = 4096;
constexpr int CW_READY = 16;
constexpr unsigned READY_MAGIC = 0x600DF00Du;
constexpr int CW_PAN1 = 8192, CW_PAN2 = 10240;
constexpr int CW_TCNT = 1152;

constexpr int LDS_BYTES = 163840;
constexpr int MISC_OFF = 163840 - 512;

__device__ __forceinline__ float bf2f(unsigned v) { return __uint_as_float(v << 16); }
__device__ __forceinline__ unsigned f2bf(float f) { unsigned u = __float_as_uint(f); return (u + 0x7fffu + ((u >> 16) & 1u)) >> 16; }
typedef __bf16 hwbf16x2 __attribute__((ext_vector_type(2)));
typedef float f32x2_ __attribute__((ext_vector_type(2)));
__device__ __forceinline__ unsigned pk2(float lo, float hi) { const f32x2_ v = {lo, hi}; return __builtin_bit_cast(unsigned, __builtin_convertvector(v, hwbf16x2)); }
__device__ __forceinline__ void unpack8(const u32x4 v, float* o) {
    o[0] = __uint_as_float(v.x << 16); o[1] = __uint_as_float(v.x & 0xffff0000u);
    o[2] = __uint_as_float(v.y << 16); o[3] = __uint_as_float(v.y & 0xffff0000u);
    o[4] = __uint_as_float(v.z << 16); o[5] = __uint_as_float(v.z & 0xffff0000u);
    o[6] = __uint_as_float(v.w << 16); o[7] = __uint_as_float(v.w & 0xffff0000u);
}
__device__ __forceinline__ void store8(bf16* p, f32x4 a, f32x4 b) {
    u32x4 w; w.x = pk2(a[0], a[1]); w.y = pk2(a[2], a[3]); w.z = pk2(b[0], b[1]); w.w = pk2(b[2], b[3]);
    *(u32x4*)p = w;
}
__device__ __forceinline__ float wave_sum(float v) {
#pragma unroll
    for (int o = 1; o < 64; o <<= 1) v += __shfl_xor(v, o);
    return v;
}
__device__ __forceinline__ float wave_max(float v) {
#pragma unroll
    for (int o = 1; o < 64; o <<= 1) v = fmaxf(v, __shfl_xor(v, o));
    return v;
}
__device__ __forceinline__ float sigmoidf_(float x) { return __builtin_amdgcn_rcpf(1.0f + __expf(-x)); }
__device__ __forceinline__ float siluf_(float x) { return x * __builtin_amdgcn_rcpf(1.0f + __expf(-x)); }

#define XB_TMO      128
#define XB_XCNT(j)  (256  + 64 * (j))
#define XB_XSUB(j)  (1280 + 64 * (j))
#define XB_XGEN(j)  (2304 + 64 * (j))
#define XB_TOP      3328
#define XB_TOPGEN   3392
#define XCD_BAR_WORDS 3456
#define XB_SPIN_CAP (1u << 18)
__device__ __forceinline__ unsigned xb_ld(unsigned* p)              { return __hip_atomic_load(p, __ATOMIC_RELAXED, __HIP_MEMORY_SCOPE_AGENT); }
__device__ __forceinline__ unsigned xb_add(unsigned* p, unsigned v) { return __hip_atomic_fetch_add(p, v, __ATOMIC_RELAXED, __HIP_MEMORY_SCOPE_AGENT); }
__device__ __forceinline__ unsigned xb_xcc_id() { return (unsigned)__builtin_amdgcn_s_getreg((3 << 11) | 20) & 0xFu; }
#define XB_SPIN(cond, bar) do { unsigned _sp = 0; while (cond) { __builtin_amdgcn_s_sleep(1); \
    if ((++_sp & 255u) == 0u) { if (xb_ld(&(bar)[XB_TMO])) break; if (_sp > XB_SPIN_CAP) { atomicAdd(&(bar)[XB_TMO], 1u); break; } } } } while (0)
struct XcdBarrier { unsigned* bar; unsigned x; volatile LAS unsigned* st; };
__device__ __forceinline__ XcdBarrier xcd_barrier_post(unsigned* bar, volatile LAS unsigned* st) {
    XcdBarrier b; b.bar = bar; b.x = xb_xcc_id(); b.st = st;
    if (threadIdx.x == 0) (void)xb_add(&bar[XB_XCNT(b.x)], 1u);
    return b;
}
__device__ __forceinline__ void xcd_barrier_complete(unsigned* bar, unsigned x, unsigned& nloc, unsigned& nx) {
    const unsigned G = gridDim.x * gridDim.y * gridDim.z;
    unsigned sum, cnt, mine, sp = 0u;
    for (;;) {
        sum = 0u; cnt = 0u; mine = 0u;
#pragma unroll
        for (unsigned j = 0; j < 16; ++j) { const unsigned c = xb_ld(&bar[XB_XCNT(j)]); sum += c; cnt += (c > 0u) ? 1u : 0u; mine = (j == x) ? c : mine; }
        if (sum == G) break;
        __builtin_amdgcn_s_sleep(1);
        if ((++sp & 255u) == 0u) { if (xb_ld(&bar[XB_TMO])) break; if (sp > XB_SPIN_CAP) { atomicAdd(&bar[XB_TMO], 1u); break; } }
    }
    nloc = mine > 0u ? mine : 1u; nx = cnt > 0u ? cnt : 1u;
}
__device__ __forceinline__ void xcd_barrier(const XcdBarrier& b) {
    asm volatile("s_waitcnt vmcnt(0)" ::: "memory");
    __syncthreads();
    if (threadIdx.x == 0) {
        unsigned* bar = b.bar;
        __builtin_amdgcn_s_waitcnt(0);
        unsigned nloc = b.st[0], nx = b.st[1];
        if (nloc == 0u) { xcd_barrier_complete(bar, b.x, nloc, nx); b.st[0] = nloc; b.st[1] = nx; }
        const unsigned old = xb_add(&bar[XB_XSUB(b.x)], 1u);
        const unsigned gen = old / nloc;
        if (old + 1u == (gen + 1u) * nloc) {
            __builtin_amdgcn_fence(__ATOMIC_RELEASE, "agent");
            asm volatile("s_waitcnt vmcnt(0)" ::: "memory");
            const unsigned og = xb_add(&bar[XB_TOP], 1u);
            const unsigned tg = og / nx;
            if (og + 1u == (tg + 1u) * nx) xb_add(&bar[XB_TOPGEN], 1u);
            else XB_SPIN(xb_ld(&bar[XB_TOPGEN]) == tg, bar);
            __builtin_amdgcn_fence(__ATOMIC_ACQUIRE, "agent");
            xb_add(&bar[XB_XGEN(b.x)], 1u);
            asm volatile("s_waitcnt vmcnt(0)" ::: "memory");
        } else {
            XB_SPIN(xb_ld(&bar[XB_XGEN(b.x)]) == gen, bar);
            __builtin_amdgcn_fence(__ATOMIC_ACQUIRE, "agent");
            asm volatile("s_waitcnt vmcnt(0)" ::: "memory");
        }
    }
    __syncthreads();
}

struct Args { const float* in[23]; float* out; unsigned char* ws; int ph_lo, ph_hi; int sub, rep; };
struct Ctx {
    int tid, lane, wave, gw, ngw;
    unsigned char* lds;
};

template <class ColPtr>
__device__ __forceinline__ void transpose_all(const Ctx& c, int& base, ColPtr cp, int ldw, int P, int K, bf16* WT, const float* kscale = nullptr) {
    float* scr = (float*)(c.lds + c.wave * 16384);
    const int nkb = K / 64, npb = P / 32, lane = c.lane, nit = nkb * npb;
    int it0 = (c.gw - base) % c.ngw; it0 = it0 < 0 ? it0 + c.ngw : it0; base += nit;
    for (int it = it0; it < nit; it += c.ngw) {
        const int kb = it % nkb, pb = it / nkb, k0 = 64 * kb, p0 = 32 * pb;
        const float* colp = cp(p0 + (lane & 31));
        float tv[32];
#pragma unroll
        for (int i = 0; i < 32; ++i) tv[i] = colp[(size_t)(k0 + 2 * i + (lane >> 5)) * ldw];
#pragma unroll
        for (int i = 0; i < 32; ++i) scr[(2 * i + (lane >> 5)) * 33 + (lane & 31)] = tv[i];
        __builtin_amdgcn_s_waitcnt(0xC07F); asm volatile("" ::: "memory");
        const int cc = lane & 7;
        f32x4 ks0 = {1.f, 1.f, 1.f, 1.f}, ks1 = {1.f, 1.f, 1.f, 1.f};
        if (kscale) { ks0 = *(const f32x4*)(kscale + k0 + 8 * cc); ks1 = *(const f32x4*)(kscale + k0 + 8 * cc + 4); }
#pragma unroll
        for (int j = 0; j < 4; ++j) { const int n = (lane >> 3) + 8 * j; const float* s = scr + (8 * cc) * 33 + n;
            u32x4 o; o.x = pk2(s[0 * 33] * ks0[0], s[1 * 33] * ks0[1]); o.y = pk2(s[2 * 33] * ks0[2], s[3 * 33] * ks0[3]); o.z = pk2(s[4 * 33] * ks1[0], s[5 * 33] * ks1[1]); o.w = pk2(s[6 * 33] * ks1[2], s[7 * 33] * ks1[3]);
            *(u32x4*)(WT + (size_t)(p0 + n) * K + k0 + 8 * cc) = o; }
        __builtin_amdgcn_s_waitcnt(0xC07F); asm volatile("" ::: "memory");
    }
}
struct ColPlain { const float* W; __device__ const float* operator()(int p) const { return W + p; } };
struct ColOff { const float* W; int off; __device__ const float* operator()(int p) const { return W + off + p; } };
struct ColWA {
    const float* W;
    __device__ const float* operator()(int p) const {
        if (p < 1024) { const int pp = p & 127; const int d = ((pp & 4) ? 64 : 0) + 4 * (pp >> 3) + (pp & 3); return W + (p & ~127) + d; }
        return W + p;
    }
};
struct ColGU {
    const float* Wg; const float* Wu;
    __device__ const float* operator()(int p) const { const int f = 4 * (p >> 3) + (p & 3); return ((p >> 2) & 1) ? Wu + f : Wg + f; }
};
__device__ __forceinline__ void rms_row_to_bf16(const float* xrow, const float* g, bf16* orow, int lane) {
    const f32x4* xr = (const f32x4*)xrow + lane; const f32x4* gr = (const f32x4*)g + lane;
    f32x4 v[4]; float s = 0.f;
#pragma unroll
    for (int j = 0; j < 4; ++j) { v[j] = xr[64 * j]; s += (v[j].x * v[j].x + v[j].y * v[j].y) + (v[j].z * v[j].z + v[j].w * v[j].w); }
    const float r = 1.0f / sqrtf(wave_sum(s) * (1.f / 1024.f) + RMS_EPS);
    unsigned long long* o8 = (unsigned long long*)orow + lane;
#pragma unroll
    for (int j = 0; j < 4; ++j) { const f32x4 gg = gr[64 * j];
        o8[64 * j] = (unsigned long long)pk2(v[j].x * r * gg.x, v[j].y * r * gg.y) | ((unsigned long long)pk2(v[j].z * r * gg.z, v[j].w * r * gg.w) << 32); }
}

template <class RowPtr, class Epi>
__device__ __forceinline__ void naive_gemm(const Ctx& c, const RowPtr& rp, const bf16* Bt, int ldb, int M, int N, int K, const Epi& epi) {
    const int tilesN = N / 64, tilesM = (M + 7) / 8, lane = c.lane;
    for (int it = c.gw; it < tilesM * tilesN; it += c.ngw) {
        const int tm = it / tilesN, tn = it % tilesN;
        const int row = tm * 8 + (lane >> 3), col0 = tn * 64 + (lane & 7) * 8;
        const bool valid = row < M;
        const bf16* ap = rp(valid ? row : 0);
        float acc[8];
#pragma unroll
        for (int j = 0; j < 8; ++j) acc[j] = 0.f;
        for (int k = 0; k < K; k += 8) {
            float a[8]; unpack8(*(const u32x4*)(ap + k), a);
#pragma unroll
            for (int j = 0; j < 8; ++j) { float b[8]; unpack8(*(const u32x4*)(Bt + (size_t)(col0 + j) * ldb + k), b);
#pragma unroll
                for (int i = 0; i < 8; ++i) acc[j] += a[i] * b[i]; }
        }
        if (valid) epi(row, col0, (f32x4){acc[0], acc[1], acc[2], acc[3]}, (f32x4){acc[4], acc[5], acc[6], acc[7]});
    }
}
struct RowPlain { const bf16* A; int lda; __device__ const bf16* operator()(int r) const { return A + (size_t)r * lda; } };
struct RowGather { const bf16* A; int lda; const int* idx; __device__ const bf16* operator()(int r) const { return A + (size_t)idx[r] * lda; } };

struct EpiProjA {
    bf16 *RQ, *RK, *RV, *RG, *NQ, *NK, *NV, *XQ; const float *COS, *SIN;
    __device__ __forceinline__ void operator()(int row, int col0, f32x4 v0, f32x4 v1) const {
        if (col0 < 1024) {
            const int which = col0 >> 9, cc = col0 & 511, pos = row & (SEQ - 1), q = (cc & 127) >> 3;
            const f32x4 cs = *(const f32x4*)(COS + pos * 64 + 4 * q), sn = *(const f32x4*)(SIN + pos * 64 + 4 * q);
            f32x4 o1 = v0 * cs - v1 * sn, o2 = v0 * sn + v1 * cs;
            if (which == 0) { o1 = o1 * QK_SCALE; o2 = o2 * QK_SCALE; }
            store8((which ? RK : RQ) + (size_t)row * 512 + cc, o1, o2);
        } else if (col0 < 2048) { store8(RV + (size_t)row * 1024 + (col0 - 1024), v0, v1);
        } else if (col0 < 3072) {
            f32x4 a, b;
#pragma unroll
            for (int i = 0; i < 4; ++i) { a[i] = siluf_(v0[i]); b[i] = siluf_(v1[i]); }
            store8(RG + (size_t)row * 1024 + (col0 - 2048), a, b);
        } else if (col0 < 3584) { store8(NQ + (size_t)row * 512 + (col0 - 3072), v0 * 0.125f, v1 * 0.125f);
        } else if (col0 < 4096) { store8(NK + (size_t)row * 512 + (col0 - 3584), v0, v1);
        } else if (col0 < 4608) { store8(NV + (size_t)row * 512 + (col0 - 4096), v0, v1);
        } else { store8(XQ + (size_t)row * 512 + (col0 - 4608), v0 * QK_SCALE, v1 * QK_SCALE); }
    }
};
struct EpiBf16Plain { bf16* O; int ldc; __device__ __forceinline__ void operator()(int row, int col0, f32x4 v0, f32x4 v1) const { store8(O + (size_t)row * ldc + col0, v0, v1); } };
struct EpiSigmoid { bf16* O; int ldc;
    __device__ __forceinline__ void operator()(int row, int col0, f32x4 v0, f32x4 v1) const {
        f32x4 a, b;
#pragma unroll
        for (int i = 0; i < 4; ++i) { a[i] = sigmoidf_(v0[i]); b[i] = sigmoidf_(v1[i]); }
        store8(O + (size_t)row * ldc + col0, a, b); } };
template <int MODE> struct EpiMixNaive { float* TMP; bf16* MIX; const bf16* G;
    __device__ __forceinline__ void operator()(int row, int col0, f32x4 v0, f32x4 v1) const {
        float g[8]; unpack8(*(const u32x4*)(G + (size_t)row * NPG + col0), g);
        f32x4 a = {v0[0] * g[0], v0[1] * g[1], v0[2] * g[2], v0[3] * g[3]}, b = {v1[0] * g[4], v1[1] * g[5], v1[2] * g[6], v1[3] * g[7]};
        float* t = TMP + (size_t)row * DM + col0;
        if (MODE >= 1) { a = a + *(const f32x4*)t; b = b + *(const f32x4*)(t + 4); }
        if (MODE <= 1) { *(f32x4*)t = a; *(f32x4*)(t + 4) = b; } else store8(MIX + (size_t)row * DM + col0, a, b);
    } };
struct EpiResidBf16 { const float* X; bf16* O;
    __device__ __forceinline__ void operator()(int row, int col0, f32x4 v0, f32x4 v1) const {
        const float* x = X + (size_t)row * DM + col0; store8(O + (size_t)row * DM + col0, *(const f32x4*)x + v0, *(const f32x4*)(x + 4) + v1); } };
struct EpiResidF32 { const float* X; float* O;
    __device__ __forceinline__ void operator()(int row, int col0, f32x4 v0, f32x4 v1) const {
        const float* x = X + (size_t)row * DM + col0; float* o = O + (size_t)row * DM + col0;
        *(f32x4*)o = *(const f32x4*)x + v0; *(f32x4*)(o + 4) = *(const f32x4*)(x + 4) + v1; } };
struct EpiSwiGLU { bf16* HID; const float* wl; int rowbase;
    __device__ __forceinline__ void operator()(int row, int col0, f32x4 v0, f32x4 v1) const {
        const float w = wl[row]; f32x4 h;
#pragma unroll
        for (int i = 0; i < 4; ++i) h[i] = siluf_(v0[i]) * v1[i] * w;
        u32x2 o; o.x = pk2(h[0], h[1]); o.y = pk2(h[2], h[3]);
        *(u32x2*)(HID + (size_t)(rowbase + row) * DFF + (col0 >> 1)) = o; } };
struct EpiRowsBf16 { bf16* O; int ldc; int rowbase;
    __device__ __forceinline__ void operator()(int row, int col0, f32x4 v0, f32x4 v1) const { store8(O + (size_t)(rowbase + row) * ldc + col0, v0, v1); } };

namespace pg8 {
constexpr int BM = 256, BK = 64, HALF = 128, HTB = HALF * BK * 2, STAGE_BYTES = 8 * HTB;
__device__ __forceinline__ int lds_byte(int r, int c) { const int st = (r >> 4) * 2 + (c >> 5), rr = r & 15, cc = c & 31, ob = rr * 64 + cc * 2; return st * 1024 + (ob ^ (((ob >> 9) & 1) << 5)); }
__device__ __forceinline__ void stage_rc(int b, int& R, int& C) { const int st = b / 1024, sb = b % 1024, swz = sb ^ (((sb >> 9) & 1) << 5); R = (st >> 1) * 16 + swz / 64; C = (st & 1) * 32 + (swz % 64) / 2; }
__device__ __forceinline__ int perm32(int rho) { const int n = rho >> 4, i = rho & 15; return 8 * (i >> 2) + 4 * n + (i & 3); }

struct UnitDesc {
    const char* A; const char* B;
    unsigned lda2, ldb2;
    int nt;
    int row0, col0;
    int aux, aux2;
    const int* gidx; int gcnt;
    int chain;
};
__device__ __forceinline__ unsigned cvt_pk_bf16(float lo, float hi) { unsigned r; asm volatile("v_cvt_pk_bf16_f32 %0, %1, %2" : "=v"(r) : "v"(lo), "v"(hi)); return r; }

template <int GRP = 1, class F> __device__ __forceinline__ void epi_apply(const f32x4 (&acc)[2][2][4][2], const UnitDesc& u, int wr, int wc, int fr, int fq, const F& f) {
#pragma unroll
    for (int ai = 0; ai < 2; ++ai)
#pragma unroll
        for (int m = 0; m < 4; ++m) { const int row = u.row0 + ai * HALF + wr * 64 + m * 16 + fr;
#pragma unroll
            for (int bj = 0; bj < 2; ++bj) f(row, u.col0 + bj * HALF + wc * 32 + 8 * fq, acc[ai][bj][m][0], acc[ai][bj][m][1]);
            if (((ai * 4 + m) % GRP) == GRP - 1) { asm volatile("" ::: "memory"); __builtin_amdgcn_sched_barrier(0); } }
}

template <bool GATHER> __device__ __forceinline__ void unit_offs(const UnitDesc& u, int tid, unsigned (&oA0)[2], unsigned (&oA1)[2], unsigned (&oB)[2]) {
#pragma unroll
    for (int i = 0; i < 2; ++i) { int R, C; stage_rc(tid * 16 + i * 8192, R, C); const int Rb = (R & ~31) + perm32(R & 31);
        oB[i] = (unsigned)Rb * u.ldb2 + (unsigned)C * 2u;
        if (GATHER && u.gidx) { const int last = u.gcnt - 1; int r0 = u.row0 + R, r1 = r0 + HALF; r0 = r0 < last ? r0 : last; r1 = r1 < last ? r1 : last;
            oA0[i] = (unsigned)u.gidx[r0] * u.lda2 + (unsigned)C * 2u; oA1[i] = (unsigned)u.gidx[r1] * u.lda2 + (unsigned)C * 2u;
        } else { oA0[i] = (unsigned)R * u.lda2 + (unsigned)C * 2u; oA1[i] = 0u; } }
}

template <bool GATHER, class Sched, class Epi>
__device__ __forceinline__ void gemm_phase(LAS unsigned char* lds, const Sched& S, const Epi& E, int sb = 0) {
#if PROBE_TS_A >= 0
#define GSTAMP(k) do { if (sb && blockIdx.x == 0 && threadIdx.x == 0) ((volatile LAS unsigned*)(lds + MISC_OFF))[32 + sb + (k)] = (unsigned)__builtin_amdgcn_s_memrealtime(); } while (0)
#else
#define GSTAMP(k) do { } while (0)
#endif
    const int tid = threadIdx.x, wid = __builtin_amdgcn_readfirstlane(tid >> 6), lane = tid & 63, wr = wid >> 2, wc = wid & 3, fr = lane & 15, fq = lane >> 4;
    const unsigned ldsw = (unsigned)wid * 1024u;
    const int aoff = lds_byte(wr * 64 + fr, fq * 8), boff = lds_byte(wc * 32 + fr, fq * 8);
    const size_t kstep = (size_t)(BK * 2);
#define PG8_SA(b, h) (((b) * 2 + (h)) * HTB)
#define PG8_SB(b, h) ((4 + (b) * 2 + (h)) * HTB)
#define PG8_STAGE(bufoff, gbase, voff) do { _Pragma("unroll") for (int _i = 0; _i < 2; ++_i) \
        __builtin_amdgcn_global_load_lds((const unsigned*)((const char*)(gbase) + (voff)[_i]), (LAS unsigned*)(lds + (bufoff) + ldsw + _i * 8192), 16, 0, 0); } while (0)
#define PG8_LDA(dst, b, h) do { _Pragma("unroll") for (int m = 0; m < 4; ++m) _Pragma("unroll") for (int k = 0; k < 2; ++k) dst[m][k] = *(const LAS bf16x8*)(lds + PG8_SA(b, h) + aoff + m * 2048 + k * 1024); } while (0)
#define PG8_LDB(dst, b, h) do { _Pragma("unroll") for (int n = 0; n < 2; ++n) _Pragma("unroll") for (int k = 0; k < 2; ++k) dst[n][k] = *(const LAS bf16x8*)(lds + PG8_SB(b, h) + boff + n * 2048 + k * 1024); } while (0)
#define PG8_MMA(ai, bj, At, Bt) do { __builtin_amdgcn_s_setprio(1); _Pragma("unroll") for (int m = 0; m < 4; ++m) _Pragma("unroll") for (int n = 0; n < 2; ++n) _Pragma("unroll") for (int k = 0; k < 2; ++k) \
        acc[ai][bj][m][n] = __builtin_amdgcn_mfma_f32_16x16x32_bf16(Bt[n][k], At[m][k], acc[ai][bj][m][n], 0, 0, 0); __builtin_amdgcn_s_setprio(0); } while (0)
#define PG8_WAIT_V(n) asm volatile("s_waitcnt vmcnt(" #n ")" ::: "memory")
#define PG8_WAIT_L(n) asm volatile("s_waitcnt lgkmcnt(" #n ")" ::: "memory")
#define PG8_BAR __builtin_amdgcn_s_barrier()
#define PG8_SCHED __builtin_amdgcn_sched_barrier(0)
    UnitDesc cur, nxt; int ui = 0;
    if (!S.next(0, cur)) return;
    f32x4 acc[2][2][4][2];
#pragma unroll
    for (int a = 0; a < 2; ++a)
#pragma unroll
        for (int b = 0; b < 2; ++b)
#pragma unroll
            for (int m = 0; m < 4; ++m)
#pragma unroll
                for (int n = 0; n < 2; ++n) acc[a][b][m][n] = (f32x4){0.f, 0.f, 0.f, 0.f};
    bf16x8 At[4][2], B0[2][2], B1[2][2];
    unsigned cA0[2], cA1[2], cB[2], nA0[2], nA1[2], nB[2];
    unit_offs<GATHER>(cur, tid, cA0, cA1, cB);
    const char* pA = cur.A; const char* pB = cur.B; size_t hB = (size_t)HALF * cur.ldb2; size_t hA = GATHER ? 0 : (size_t)HALF * cur.lda2;
#define PG8_A1(arr1, arr0) (GATHER ? (arr1) : (arr0))
    PG8_STAGE(PG8_SB(0, 0), pB, cB); PG8_STAGE(PG8_SB(0, 1), pB + hB, cB); PG8_STAGE(PG8_SA(0, 0), pA, cA0); PG8_STAGE(PG8_SA(0, 1), pA + hA, PG8_A1(cA1, cA0));
    if (wr == 1) PG8_BAR;
    PG8_WAIT_V(2); PG8_BAR;
    PG8_STAGE(PG8_SB(1, 0), pB + kstep, cB); PG8_STAGE(PG8_SA(1, 0), pA + kstep, cA0); PG8_STAGE(PG8_SB(1, 1), pB + hB + kstep, cB);
    PG8_WAIT_V(6); PG8_BAR;
    GSTAMP(0);
    for (;;) {
        const bool has_next = S.next(ui + 1, nxt);
        const char* qA = pA; const char* qB = pB; size_t hBn = hB, hAn = hA;
        if (has_next) { unit_offs<GATHER>(nxt, tid, nA0, nA1, nB); qA = nxt.A; qB = nxt.B; hBn = (size_t)HALF * nxt.ldb2; hAn = GATHER ? 0 : (size_t)HALF * nxt.lda2; }
        else {
#pragma unroll
            for (int i = 0; i < 2; ++i) { nA0[i] = cA0[i]; nA1[i] = cA1[i]; nB[i] = cB[i]; } }
        const int nt = cur.nt;
        for (int t = 0; t < nt; t += 2) {
            const bool last = (t == nt - 2);
            const char* a1 = pA + (size_t)(t + 1) * kstep;
            const char* a2 = last ? qA : pA + (size_t)(t + 2) * kstep; const char* b2 = last ? qB : pB + (size_t)(t + 2) * kstep;
            const char* a3 = a2 + kstep; const char* b3 = b2 + kstep;
            unsigned sA0[2], sA1[2], sB[2];
#pragma unroll
            for (int i = 0; i < 2; ++i) { sA0[i] = last ? nA0[i] : cA0[i]; sA1[i] = last ? nA1[i] : cA1[i]; sB[i] = last ? nB[i] : cB[i]; }
            const size_t shB = last ? hBn : hB, shA = last ? hAn : hA;
            PG8_LDB(B0, 0, 0); PG8_LDB(B1, 0, 1); PG8_SCHED; PG8_LDA(At, 0, 0); PG8_STAGE(PG8_SA(1, 1), a1 + hA, PG8_A1(cA1, cA0));
            PG8_WAIT_V(8); PG8_WAIT_L(0); PG8_BAR; PG8_MMA(0, 0, At, B0); PG8_MMA(0, 1, At, B1); PG8_BAR; PG8_SCHED;
            PG8_LDA(At, 0, 1); PG8_STAGE(PG8_SB(0, 0), b2, sB); PG8_STAGE(PG8_SB(0, 1), b2 + shB, sB); PG8_STAGE(PG8_SA(0, 0), a2, sA0);
            PG8_WAIT_V(8); PG8_WAIT_L(0); PG8_BAR; PG8_MMA(1, 0, At, B0); PG8_MMA(1, 1, At, B1); PG8_BAR; PG8_SCHED;
            PG8_LDB(B0, 1, 0); PG8_LDB(B1, 1, 1); PG8_SCHED; PG8_LDA(At, 1, 0); PG8_STAGE(PG8_SA(0, 1), a2 + shA, PG8_A1(sA1, sA0));
            PG8_WAIT_V(8); PG8_WAIT_L(0); PG8_BAR; PG8_MMA(0, 0, At, B0); PG8_MMA(0, 1, At, B1); PG8_BAR; PG8_SCHED;
            PG8_LDA(At, 1, 1); PG8_STAGE(PG8_SB(1, 0), b3, sB); PG8_STAGE(PG8_SB(1, 1), b3 + shB, sB); PG8_STAGE(PG8_SA(1, 0), a3, sA0);
            PG8_WAIT_V(8); PG8_WAIT_L(0); PG8_BAR; PG8_MMA(1, 0, At, B0); PG8_MMA(1, 1, At, B1); PG8_BAR; PG8_SCHED;
        }
        if (wr == 0) PG8_BAR;
        if (ui == 0) GSTAMP(1);
        E.finish(acc, cur, wr, wc, fr, fq);
        if (ui == 0) GSTAMP(2);
        if (!has_next) break;
        cur = nxt; pA = qA; pB = qB; hB = hBn; hA = hAn; ++ui;
#pragma unroll
        for (int i = 0; i < 2; ++i) { cA0[i] = nA0[i]; cA1[i] = nA1[i]; cB[i] = nB[i]; }
        if (wr == 1) PG8_BAR;
    }
    PG8_WAIT_V(0);
    PG8_BAR;
    GSTAMP(3);
#undef GSTAMP
#undef PG8_A1
#undef PG8_SA
#undef PG8_SB
#undef PG8_STAGE
#undef PG8_LDA
#undef PG8_LDB
#undef PG8_MMA
#undef PG8_WAIT_V
#undef PG8_WAIT_L
#undef PG8_BAR
#undef PG8_SCHED
}

__device__ __forceinline__ void zero_acc(f32x4 (&acc)[2][2][4][2]) {
#pragma unroll
    for (int a = 0; a < 2; ++a)
#pragma unroll
        for (int b = 0; b < 2; ++b)
#pragma unroll
            for (int m = 0; m < 4; ++m)
#pragma unroll
                for (int n = 0; n < 2; ++n) acc[a][b][m][n] = (f32x4){0.f, 0.f, 0.f, 0.f};
}
template <class F, int GRP = 1> struct EpiF { F f;
    __device__ __forceinline__ void finish(f32x4 (&acc)[2][2][4][2], const UnitDesc& u, int wr, int wc, int fr, int fq) const { epi_apply<GRP>(acc, u, wr, wc, fr, fq, f); zero_acc(acc); } };

struct TileOrder {
    int nM, nN, nwg, G, c;
    __device__ __forceinline__ void init(int nM_, int nN_, int G_, int c_) { nM = nM_; nN = nN_; nwg = nM * nN; G = G_; c = c_; }
    __device__ __forceinline__ bool tile(int i, int& pm, int& pn) const {
        const long L = (long)i * G + c; if (L >= nwg) return false;
        int wgid = (int)L; { const int q = nwg / 8, r = nwg % 8, xcd = wgid % 8, off = wgid / 8; wgid = (xcd < r ? xcd * (q + 1) : r * (q + 1) + (xcd - r) * q) + off; }
        const int nig = 8 * nN, gid = wgid / nig, fm = gid * 8, gsz = (nM - fm) < 8 ? (nM - fm) : 8;
        pm = fm + ((wgid % nig) % gsz); pn = (wgid % nig) / gsz; return true;
    }
};
struct PlainSched { TileOrder o; const bf16* A; const bf16* Bt; int lda, ldb, K;
    __device__ __forceinline__ bool next(int i, UnitDesc& u) const { int pm, pn; if (!o.tile(i, pm, pn)) return false;
        u.A = (const char*)(A + (size_t)pm * BM * lda); u.B = (const char*)(Bt + (size_t)pn * BM * ldb); u.lda2 = lda * 2; u.ldb2 = ldb * 2; u.nt = K / BK;
        u.row0 = pm * BM; u.col0 = pn * BM; u.aux = 0; u.aux2 = 0; u.gidx = nullptr; u.gcnt = 0; u.chain = 0; return true; } };
}

#if PROBE_TS_A >= 0
#define MXSTAMP(k) do { if (blockIdx.x == 0 && threadIdx.x == 0) ((volatile LAS unsigned*)(lds + MISC_OFF))[32 + (k)] = (unsigned)__builtin_amdgcn_s_memrealtime(); } while (0)
#else
#define MXSTAMP(k) do { } while (0)
#endif
namespace mx {
typedef short s16x4 __attribute__((ext_vector_type(4)));
typedef __bf16 bf16x8_t __attribute__((ext_vector_type(8)));
typedef __bf16 bf16x4_t __attribute__((ext_vector_type(4)));
typedef float f32x8 __attribute__((ext_vector_type(8)));
__device__ __forceinline__ f32x4 mma(bf16x8 a, bf16x8 b, f32x4 c) { return __builtin_amdgcn_mfma_f32_16x16x32_bf16(a, b, c, 0, 0, 0); }
__device__ __forceinline__ bf16x8 ldsf(LAS unsigned char* p) { return *(LAS bf16x8*)p; }
__device__ __forceinline__ bf16x8 glbf(const bf16* p) { return *(const bf16x8*)p; }
__device__ __forceinline__ bf16x8 trf(LAS unsigned char* p0, LAS unsigned char* p1) {
    const s16x4 a = __builtin_amdgcn_ds_read_tr16_b64_v4i16((LAS s16x4*)p0), b = __builtin_amdgcn_ds_read_tr16_b64_v4i16((LAS s16x4*)p1);
    return __builtin_shufflevector(a, b, 0, 1, 2, 3, 4, 5, 6, 7);
}
__device__ __forceinline__ bf16x8 pack8(f32x4 a, f32x4 b) { const f32x8 v = {a[0], a[1], a[2], a[3], b[0], b[1], b[2], b[3]}; return __builtin_bit_cast(bf16x8, __builtin_convertvector(v, bf16x8_t)); }
__device__ __forceinline__ u32x2 pack4(f32x4 a) { return __builtin_bit_cast(u32x2, __builtin_convertvector(a, bf16x4_t)); }
__device__ __forceinline__ float red_g_max(float v) { v = fmaxf(v, __shfl_xor(v, 16)); return fmaxf(v, __shfl_xor(v, 32)); }
__device__ __forceinline__ float red_g_sum(float v) { v += __shfl_xor(v, 16); return v + __shfl_xor(v, 32); }

__device__ __forceinline__ int vblock() { const int G = (int)gridDim.x, bx = (int)blockIdx.x; return (G % 8 == 0) ? (bx % 8) * (G / 8) + bx / 8 : bx; }
constexpr int XA_KP = 272, XA_VP = 288, XA_VOFF = 256 * XA_KP;
__device__ __forceinline__ void xa_phase(LAS unsigned char* lds, bf16* XQ, const bf16* MKV) {
    const int tid = threadIdx.x, lane = tid & 63, wave = __builtin_amdgcn_readfirstlane(tid >> 6), g = lane >> 4, li = lane & 15, q4 = li >> 2, p4 = li & 3;
    for (int it = vblock(); it < NB * 4 * 8; it += gridDim.x) {
        const int b = it >> 5, h = (it >> 3) & 3, qb = it & 7;
        __syncthreads();
#pragma unroll
        for (int i = 0; i < 8; ++i) { const int id = tid + 512 * i, row = id >> 4, ch = id & 15; const bf16* src = MKV + (size_t)(b * MEML + row) * 1024 + h * 128 + ch * 8;
            *(LAS u32x4*)(lds + row * XA_KP + ch * 16) = *(const u32x4*)src; *(LAS u32x4*)(lds + XA_VOFF + row * XA_VP + ch * 16) = *(const u32x4*)(src + 512); }
        __syncthreads();
#pragma unroll 1
        for (int qi = 0; qi < 2; ++qi) {
            bf16* qrow = XQ + (size_t)(b * SEQ + qb * 256 + wave * 32 + qi * 16 + li) * 512 + h * 128;
            bf16x8 qf[4];
#pragma unroll
            for (int s = 0; s < 4; ++s) qf[s] = glbf(qrow + 32 * s + 8 * g);
            f32x4 st[16]; float mx = -3.0e38f;
#pragma unroll
            for (int kf = 0; kf < 16; ++kf) { f32x4 a = {0.f, 0.f, 0.f, 0.f};
#pragma unroll
                for (int s = 0; s < 4; ++s) a = mma(ldsf(lds + (16 * kf + li) * XA_KP + (32 * s + 8 * g) * 2), qf[s], a);
                st[kf] = a; mx = fmaxf(mx, fmaxf(fmaxf(a[0], a[1]), fmaxf(a[2], a[3]))); __builtin_amdgcn_sched_barrier(0); }
            mx = red_g_max(mx); float sum = 0.f;
#pragma unroll
            for (int kf = 0; kf < 16; ++kf) {
#pragma unroll
                for (int r = 0; r < 4; ++r) { const float e = __expf(st[kf][r] - mx); st[kf][r] = e; sum += e; } }
            sum = red_g_sum(sum); const float inv = 1.0f / sum;
            f32x4 o[8];
#pragma unroll
            for (int df = 0; df < 8; ++df) o[df] = (f32x4){0.f, 0.f, 0.f, 0.f};
#pragma unroll
            for (int x = 0; x < 8; ++x) { const bf16x8 pf = pack8(st[2 * x], st[2 * x + 1]);
                LAS unsigned char* vb = lds + XA_VOFF + (32 * x + 4 * g + q4) * XA_VP + 8 * p4;
#pragma unroll
                for (int df = 0; df < 8; ++df) o[df] = mma(trf(vb + 32 * df, vb + 16 * XA_VP + 32 * df), pf, o[df]); __builtin_amdgcn_sched_barrier(0); }
#pragma unroll
            for (int df = 0; df < 8; ++df) *(u32x2*)(qrow + 16 * df + 4 * g) = pack4(o[df] * inv);
        }
    }
}

constexpr int NA_KP = 144, NA_VP = 136, NA_VOFF = 576 * NA_KP;
struct NaItem { int b, h, krmin, r, rs; };
__device__ __forceinline__ NaItem na_item(int it, int ri) { NaItem a; a.b = it >> 7; a.h = (it >> 4) & 7; const int rp = it & 15;
    int k = 2 * rp - 4; a.krmin = k < 0 ? 0 : (k > 24 ? 24 : k); a.r = 2 * rp + ri; int rs = a.r - 4; a.rs = rs < 0 ? 0 : (rs > 24 ? 24 : rs); return a; }
__device__ __forceinline__ void na_load_kv(u32x4 (&kv)[9], u32x4 (&vv)[9], const NaItem& a, const bf16* NK, const bf16* NV, int tid) {
#pragma unroll
    for (int i = 0; i < 9; ++i) { const int id = tid + 512 * i, trow = id >> 3, ch = id & 7; int kr = a.krmin + (trow >> 6); kr = kr > 31 ? 31 : kr;
        const size_t off = (size_t)(a.b * SEQ + kr * 64 + (trow & 63)) * 512 + a.h * 64 + ch * 8; kv[i] = *(const u32x4*)(NK + off); vv[i] = *(const u32x4*)(NV + off); }
}
__device__ __forceinline__ void na_phase(LAS unsigned char* lds, bf16* NQ, const bf16* NK, const bf16* NV, const bf16* FT) {
    const int tid = threadIdx.x, lane = tid & 63, wave = __builtin_amdgcn_readfirstlane(tid >> 6), g = lane >> 4, li = lane & 15, q4 = li >> 2, p4 = li & 3;
    const int ri = wave >> 2, qf = wave & 3, c0 = 16 * qf, w0 = qf == 0 ? 0 : (qf == 1 ? 8 : (qf == 2 ? 24 : 32));
    const int G = (int)gridDim.x, lite = G > 64 ? 32 : 0; const bool isl = (int)blockIdx.x < lite;
    int vnl = (int)blockIdx.x - lite;
    if (lite && G % 8 == 0) { const int x = (int)blockIdx.x % 8, q = (int)blockIdx.x / 8 - lite / 8; vnl = x * ((G - lite) / 8) + q; }
    const int it0 = isl ? (int)blockIdx.x : lite + vnl, itstep = isl ? NB * 8 * 16 : G - lite;
    if (it0 >= NB * 8 * 16) return;
    NaItem cur = na_item(it0, ri);
    u32x4 kv[9], vv[9]; bf16x8 ff[16]; bf16x8 q0, q1;
    na_load_kv(kv, vv, cur, NK, NV, tid);
#pragma unroll
    for (int f = 0; f < 16; ++f) ff[f] = glbf(FT + ((size_t)((cur.h * 15 + (cur.rs + (f >> 1) - cur.r + 7)) * 64 + w0 + 16 * (f & 1) + li)) * 64 + (c0 & 32) + 8 * g);
    { const bf16* qr = NQ + (size_t)(cur.b * SEQ + cur.r * 64 + c0 + li) * 512 + cur.h * 64; q0 = glbf(qr + 8 * g); q1 = glbf(qr + 32 + 8 * g); }
    bf16x8 e1;
#pragma unroll
    for (int j = 0; j < 8; ++j) e1[j] = (8 * g + j == ((c0 + li) & 31)) ? (short)0x3F80 : (short)0;
#pragma unroll 1
    for (int it = it0;;) {
        __syncthreads();
#pragma unroll
        for (int i = 0; i < 9; ++i) { const int id = tid + 512 * i, trow = id >> 3, ch = id & 7;
            *(LAS u32x4*)(lds + trow * NA_KP + ch * 16) = kv[i];
            *(LAS u32x2*)(lds + NA_VOFF + trow * NA_VP + ch * 16) = (u32x2){vv[i].x, vv[i].y}; *(LAS u32x2*)(lds + NA_VOFF + trow * NA_VP + ch * 16 + 8) = (u32x2){vv[i].z, vv[i].w}; }
        __syncthreads();
        const int itn = it + itstep; const bool has_next = itn < NB * 8 * 16; const NaItem nx = na_item(has_next ? itn : it, ri);
        if (has_next) na_load_kv(kv, vv, nx, NK, NV, tid);
        const int rs = cur.rs, krmin = cur.krmin;
        f32x4 st[16]; float mx = -3.0e38f;
#pragma unroll
        for (int kri = 0; kri < 8; ++kri) {
#pragma unroll
            for (int cf = 0; cf < 2; ++cf) { LAS unsigned char* kp = lds + ((rs + kri - krmin) * 64 + w0 + 16 * cf + li) * NA_KP + 16 * g;
                f32x4 a = {0.f, 0.f, 0.f, 0.f};
                a = mma(ldsf(kp), q0, a); a = mma(ldsf(kp + 64), q1, a); a = mma(ff[kri * 2 + cf], e1, a);
                st[kri * 2 + cf] = a; mx = fmaxf(mx, fmaxf(fmaxf(a[0], a[1]), fmaxf(a[2], a[3]))); }
            __builtin_amdgcn_sched_barrier(0); }
        bf16* qrow = NQ + (size_t)(cur.b * SEQ + cur.r * 64 + c0 + li) * 512 + cur.h * 64;
        if (has_next) {
#pragma unroll
            for (int f = 0; f < 8; ++f) ff[f] = glbf(FT + ((size_t)((nx.h * 15 + (nx.rs + (f >> 1) - nx.r + 7)) * 64 + w0 + 16 * (f & 1) + li)) * 64 + (c0 & 32) + 8 * g);
            const bf16* qr = NQ + (size_t)(nx.b * SEQ + nx.r * 64 + c0 + li) * 512 + nx.h * 64; q0 = glbf(qr + 8 * g); q1 = glbf(qr + 32 + 8 * g); }
        mx = red_g_max(mx); float sum = 0.f;
#pragma unroll
        for (int f = 0; f < 16; ++f) {
#pragma unroll
            for (int rr = 0; rr < 4; ++rr) { const float e = __expf(st[f][rr] - mx); st[f][rr] = e; sum += e; } }
        sum = red_g_sum(sum); const float inv = 1.0f / sum;
        f32x4 o[4];
#pragma unroll
        for (int df = 0; df < 4; ++df) o[df] = (f32x4){0.f, 0.f, 0.f, 0.f};
#pragma unroll
        for (int x = 0; x < 8; ++x) { const bf16x8 pf = pack8(st[2 * x], st[2 * x + 1]);
            LAS unsigned char* vb = lds + NA_VOFF + ((rs + x - krmin) * 64 + w0 + 4 * g + q4) * NA_VP + 8 * p4;
#pragma unroll
            for (int df = 0; df < 4; ++df) o[df] = mma(trf(vb + 32 * df, vb + 16 * NA_VP + 32 * df), pf, o[df]); __builtin_amdgcn_sched_barrier(0); }
#pragma unroll
        for (int df = 0; df < 4; ++df) *(u32x2*)(qrow + 16 * df + 4 * g) = pack4(o[df] * inv);
        if (!has_next) break;
#pragma unroll
        for (int f = 8; f < 16; ++f) ff[f] = glbf(FT + ((size_t)((nx.h * 15 + (nx.rs + (f >> 1) - nx.r + 7)) * 64 + w0 + 16 * (f & 1) + li)) * 64 + (c0 & 32) + 8 * g);
        cur = nx; it = itn;
    }
}

constexpr int RT_P = 272, RT_VP = 544, RT_QOFF = 0, RT_KOFF = 128 * RT_P, RT_VOFF = 2 * 128 * RT_P, RT_RED = RT_VOFF + 128 * RT_VP, RT_STAT = RT_RED + 8 * 128 * 8;
__device__ __forceinline__ void ret_out_phase(LAS unsigned char* lds, const bf16* RQ, const bf16* RK, const bf16* RV, bf16* RG, const bf16* ST, const float* gain, const float* decf, const float* decb) {
    const int tid0 = threadIdx.x, lane = tid0 & 63, wave = __builtin_amdgcn_readfirstlane(tid0 >> 6), g = lane >> 4, li = lane & 15, q4 = li >> 2, p4 = li & 3;
    for (int it = blockIdx.x; it < NB * 4 * 16; it += gridDim.x) {
        const int b = it >> 6, h = (it >> 4) & 3, n = it & 15; const size_t tok0 = (size_t)b * SEQ + n * 128;
        int tid = tid0; asm volatile("" : "+v"(tid));
        const float lgf = -log1pf(expf(-decf[h])), lgb = -log1pf(expf(-decb[h]));
        const bf16* sfp = ST + ((size_t)(((b * 4 + h) * 2 + 0) * 16 + n) * 256 + 32 * wave + li) * 128 + 8 * g;
        const bf16* sbp = ST + ((size_t)(((b * 4 + h) * 2 + 1) * 16 + n) * 256 + 32 * wave + li) * 128 + 8 * g;
        __syncthreads();
#pragma unroll
        for (int i = 0; i < 4; ++i) { const int id = tid + 512 * i, row = id >> 4, ch = id & 15;
            *(LAS u32x4*)(lds + RT_QOFF + row * RT_P + ch * 16) = *(const u32x4*)(RQ + (tok0 + row) * 512 + h * 128 + ch * 8);
            *(LAS u32x4*)(lds + RT_KOFF + row * RT_P + ch * 16) = *(const u32x4*)(RK + (tok0 + row) * 512 + h * 128 + ch * 8); }
#pragma unroll
        for (int i = 0; i < 8; ++i) { const int id = tid + 512 * i, row = id >> 5, ch = id & 31;
            *(LAS u32x4*)(lds + RT_VOFF + row * RT_VP + ch * 16) = *(const u32x4*)(RV + (tok0 + row) * 1024 + h * 256 + ch * 8); }
        __builtin_amdgcn_sched_barrier(0);
        bf16x8 sf[2][4];
        if (it == (int)blockIdx.x) MXSTAMP(25);
#pragma unroll
        for (int a = 0; a < 2; ++a)
#pragma unroll
            for (int s = 0; s < 4; ++s) sf[a][s] = glbf(sfp + a * 16 * 128 + 32 * s);
        __syncthreads();
        if (it == (int)blockIdx.x) MXSTAMP(26);
        { bf16x8 qf[4];
#pragma unroll
          for (int s = 0; s < 4; ++s) qf[s] = ldsf(lds + RT_QOFF + (16 * wave + li) * RT_P + (32 * s + 8 * g) * 2);
          f32x4 st[8]; const int pi = 16 * wave + li;
#pragma unroll
          for (int jf = 0; jf < 8; ++jf) { f32x4 a = {0.f, 0.f, 0.f, 0.f};
#pragma unroll
              for (int s = 0; s < 4; ++s) a = mma(ldsf(lds + RT_KOFF + (16 * jf + li) * RT_P + (32 * s + 8 * g) * 2), qf[s], a);
#pragma unroll
              for (int r = 0; r < 4; ++r) { const int pj = 16 * jf + 4 * g + r; a[r] *= (pj <= pi) ? __expf((float)(pi - pj) * lgf) : __expf((float)(pj - pi) * lgb); }
              st[jf] = a; __builtin_amdgcn_sched_barrier(0); }
          __syncthreads();
#pragma unroll
          for (int jf = 0; jf < 8; ++jf) *(LAS u32x2*)(lds + RT_KOFF + pi * RT_P + (16 * jf + 4 * g) * 2) = pack4(st[jf]);
        }
        __syncthreads();
        if (it == (int)blockIdx.x) MXSTAMP(27);
        bf16x8 sb[2][4];
#pragma unroll
        for (int a = 0; a < 2; ++a)
#pragma unroll
            for (int s = 0; s < 4; ++s) sb[a][s] = glbf(sbp + a * 16 * 128 + 32 * s);
        f32x4 y[2][8];
#pragma unroll
        for (int a = 0; a < 2; ++a)
#pragma unroll
            for (int i = 0; i < 8; ++i) y[a][i] = (f32x4){0.f, 0.f, 0.f, 0.f};
        {
#pragma unroll
          for (int i = 0; i < 8; ++i) {
#pragma unroll
              for (int s = 0; s < 4; ++s) { const bf16x8 qfr = ldsf(lds + RT_QOFF + (16 * i + li) * RT_P + (32 * s + 8 * g) * 2); y[0][i] = mma(sf[0][s], qfr, y[0][i]); y[1][i] = mma(sf[1][s], qfr, y[1][i]); }
              const int pi = 16 * i + li; const float ratio = __expf((float)(pi + 1) * lgf - (float)(128 - pi) * lgb);
              y[0][i] = y[0][i] * ratio; y[1][i] = y[1][i] * ratio; __builtin_amdgcn_sched_barrier(0); } }
        if (it == (int)blockIdx.x) MXSTAMP(28);
        {
#pragma unroll
          for (int i = 0; i < 8; ++i) {
#pragma unroll
              for (int s = 0; s < 4; ++s) { const bf16x8 qfr = ldsf(lds + RT_QOFF + (16 * i + li) * RT_P + (32 * s + 8 * g) * 2); y[0][i] = mma(sb[0][s], qfr, y[0][i]); y[1][i] = mma(sb[1][s], qfr, y[1][i]); }
              const int pi = 16 * i + li; const float ab = __expf((float)(128 - pi) * lgb);
              y[0][i] = y[0][i] * ab; y[1][i] = y[1][i] * ab; __builtin_amdgcn_sched_barrier(0); } }
        if (it == (int)blockIdx.x) MXSTAMP(29);
#pragma unroll
        for (int x = 0; x < 4; ++x) {
            LAS unsigned char* vb = lds + RT_VOFF + (32 * x + 8 * g + q4) * RT_VP + (32 * wave) * 2 + 8 * p4;
            const bf16x8 v0 = trf(vb, vb + 4 * RT_VP), v1 = trf(vb + 32, vb + 4 * RT_VP + 32);
#pragma unroll
            for (int i = 0; i < 8; ++i) { const bf16x8 pfr = ldsf(lds + RT_KOFF + (16 * i + li) * RT_P + (32 * x + 8 * g) * 2); y[0][i] = mma(v0, pfr, y[0][i]); y[1][i] = mma(v1, pfr, y[1][i]); } __builtin_amdgcn_sched_barrier(0); }
        if (it == (int)blockIdx.x) MXSTAMP(30);
#pragma unroll
        for (int i = 0; i < 8; ++i) { float s1 = 0.f, s2 = 0.f;
#pragma unroll
            for (int a = 0; a < 2; ++a)
#pragma unroll
                for (int r = 0; r < 4; ++r) { const float v = y[a][i][r]; s1 += v; s2 += v * v; }
            s1 = red_g_sum(s1); s2 = red_g_sum(s2);
            if (g == 0) { LAS float* rp = (LAS float*)(lds + RT_RED) + (wave * 128 + 16 * i + li) * 2; rp[0] = s1; rp[1] = s2; } }
        __syncthreads();
        if (tid < 128) { float s1 = 0.f, s2 = 0.f;
#pragma unroll
            for (int w = 0; w < 8; ++w) { const LAS float* rp = (const LAS float*)(lds + RT_RED) + (w * 128 + tid) * 2; s1 += rp[0]; s2 += rp[1]; }
            const float mu = s1 * (1.f / 256.f); const float var = fmaxf(s2 * (1.f / 256.f) - mu * mu, 0.f);
            LAS float* sp = (LAS float*)(lds + RT_STAT) + tid * 2; sp[0] = mu; sp[1] = 1.0f / sqrtf(var + GN_EPS); }
        __syncthreads();
        if (it == (int)blockIdx.x) MXSTAMP(31);
        const f32x4 gn0 = *(const f32x4*)(gain + h * 256 + 32 * wave + 4 * g), gn1 = *(const f32x4*)(gain + h * 256 + 32 * wave + 16 + 4 * g);
#pragma unroll
        for (int i = 0; i < 8; ++i) { const LAS float* sp = (const LAS float*)(lds + RT_STAT) + (16 * i + li) * 2; const float mu = sp[0], rstd = sp[1];
            bf16* gp = RG + (tok0 + 16 * i + li) * 1024 + h * 256 + 32 * wave + 4 * g;
#pragma unroll
            for (int a = 0; a < 2; ++a) { const u32x2 gv = *(const u32x2*)(gp + 16 * a); const f32x4 gg = a ? gn1 : gn0;
                f32x4 o; o[0] = (y[a][i][0] - mu) * rstd * gg[0] * bf2f(gv.x & 0xffffu); o[1] = (y[a][i][1] - mu) * rstd * gg[1] * bf2f(gv.x >> 16);
                o[2] = (y[a][i][2] - mu) * rstd * gg[2] * bf2f(gv.y & 0xffffu); o[3] = (y[a][i][3] - mu) * rstd * gg[3] * bf2f(gv.y >> 16);
                *(u32x2*)(gp + 16 * a) = pack4(o); } }
    }
}

constexpr int RS_KP = 272, RS_VP = 144, RS_VOFF = 128 * RS_KP;
__device__ __forceinline__ void ret_state_phase(LAS unsigned char* lds, const bf16* RK, const bf16* RV, bf16* ST, const float* decf, const float* decb) {
    const int tid = threadIdx.x, lane = tid & 63, wave = __builtin_amdgcn_readfirstlane(tid >> 6), g = lane >> 4, li = lane & 15, q4 = li >> 2, p4 = li & 3;
    for (int it = vblock(); it < NB * 4 * 2 * 4; it += gridDim.x) {
        const int es = it & 3, dir = (it >> 2) & 1, h = (it >> 3) & 3, b = it >> 5;
        const float lg = -log1pf(expf(-(dir ? decb[h] : decf[h]))); const float cd = __expf(128.f * lg);
        f32x4 st[4];
#pragma unroll
        for (int ef = 0; ef < 4; ++ef) st[ef] = (f32x4){0.f, 0.f, 0.f, 0.f};
        u32x4 kq[4], vq[2];
        { const size_t tk = (size_t)b * SEQ + (dir ? 15 : 0) * 128;
#pragma unroll
          for (int i = 0; i < 4; ++i) { const int id = tid + 512 * i, row = id >> 4, ch = id & 15; kq[i] = *(const u32x4*)(RK + (tk + row) * 512 + h * 128 + ch * 8); }
#pragma unroll
          for (int i = 0; i < 2; ++i) { const int id = tid + 512 * i, row = id >> 3, ch = id & 7; vq[i] = *(const u32x4*)(RV + (tk + row) * 1024 + h * 256 + es * 64 + ch * 8); } }
#pragma unroll 1
        for (int cc = 0; cc < 16; ++cc) { const int n = dir ? 15 - cc : cc;
            bf16* sp = ST + ((size_t)(((b * 4 + h) * 2 + dir) * 16 + n) * 256 + es * 64 + li) * 128 + 16 * wave + 4 * g;
#pragma unroll
            for (int ef = 0; ef < 4; ++ef) *(u32x2*)(sp + (size_t)16 * ef * 128) = pack4(st[ef]);
            __syncthreads();
#pragma unroll
            for (int i = 0; i < 4; ++i) { const int id = tid + 512 * i, row = id >> 4, ch = id & 15;
                float v[8]; unpack8(kq[i], v);
                const float w = __expf((float)(dir ? row : 127 - row) * lg);
                u32x4 o; o.x = pk2(v[0] * w, v[1] * w); o.y = pk2(v[2] * w, v[3] * w); o.z = pk2(v[4] * w, v[5] * w); o.w = pk2(v[6] * w, v[7] * w);
                *(LAS u32x4*)(lds + row * RS_KP + ch * 16) = o; }
#pragma unroll
            for (int i = 0; i < 2; ++i) { const int id = tid + 512 * i, row = id >> 3, ch = id & 7; *(LAS u32x4*)(lds + RS_VOFF + row * RS_VP + ch * 16) = vq[i]; }
            if (cc < 15) { const int n2 = dir ? 14 - cc : cc + 1; const size_t tk = (size_t)b * SEQ + n2 * 128;
#pragma unroll
                for (int i = 0; i < 4; ++i) { const int id = tid + 512 * i, row = id >> 4, ch = id & 15; kq[i] = *(const u32x4*)(RK + (tk + row) * 512 + h * 128 + ch * 8); }
#pragma unroll
                for (int i = 0; i < 2; ++i) { const int id = tid + 512 * i, row = id >> 3, ch = id & 7; vq[i] = *(const u32x4*)(RV + (tk + row) * 1024 + h * 256 + es * 64 + ch * 8); } }
            __syncthreads();
#pragma unroll
            for (int ef = 0; ef < 4; ++ef) st[ef] = st[ef] * cd;
#pragma unroll
            for (int x = 0; x < 4; ++x) {
                LAS unsigned char* kb = lds + (32 * x + 8 * g + q4) * RS_KP + (16 * wave) * 2 + 8 * p4;
                const bf16x8 kfr = trf(kb, kb + 4 * RS_KP);
                LAS unsigned char* vb = lds + RS_VOFF + (32 * x + 8 * g + q4) * RS_VP + 8 * p4;
#pragma unroll
                for (int ef = 0; ef < 4; ++ef) st[ef] = mma(kfr, trf(vb + 32 * ef, vb + 4 * RS_VP + 32 * ef), st[ef]); __builtin_amdgcn_sched_barrier(0); }
        }
    }
}
__device__ __forceinline__ void memkv_phase(const bf16* MN, const bf16* WKV, bf16* MKV) {
    const int tid = threadIdx.x, lane = tid & 63, wave = __builtin_amdgcn_readfirstlane(tid >> 6), g = lane >> 4, li = lane & 15;
    for (int it = blockIdx.x; it < 256; it += gridDim.x) {
        const int r0 = (it >> 4) * 128 + wave * 16, c0 = (it & 15) * 64;
        const bf16* ap = MN + (size_t)(r0 + li) * 1024 + 8 * g; const bf16* bp = WKV + (size_t)(c0 + li) * 1024 + 8 * g;
        f32x4 acc[4];
#pragma unroll
        for (int nf = 0; nf < 4; ++nf) acc[nf] = (f32x4){0.f, 0.f, 0.f, 0.f};
#pragma unroll 4
        for (int s = 0; s < 32; ++s) { const bf16x8 a = glbf(ap + 32 * s);
#pragma unroll
            for (int nf = 0; nf < 4; ++nf) acc[nf] = mma(glbf(bp + (size_t)nf * 16 * 1024 + 32 * s), a, acc[nf]); }
#pragma unroll
        for (int nf = 0; nf < 4; ++nf) *(u32x2*)(MKV + (size_t)(r0 + li) * 1024 + c0 + 16 * nf + 4 * g) = pack4(acc[nf]);
    }
}
}


struct Ptrs {
    const float* in[23]; float* out; unsigned char* ws;
    __device__ bf16* b(size_t off) const { return (bf16*)(ws + off); }
    __device__ float* f(size_t off) const { return (float*)(ws + off); }
};

__device__ __forceinline__ void phase0(const Ctx& c, const Ptrs& P) {
    int tb = 0;
    transpose_all(c, tb, ColWA{P.in[3]}, 8192, NPA, 1024, P.b(WS_WA));
    transpose_all(c, tb, ColOff{P.in[3], NPA}, 8192, NPG, 1024, P.b(WS_WG));
    transpose_all(c, tb, ColPlain{P.in[11]}, 1024, 1024, 1024, P.b(WS_WKV));
    transpose_all(c, tb, ColPlain{P.in[7]}, 1024, 1024, 1024, P.b(WS_WRO));
    transpose_all(c, tb, ColPlain{P.in[9]}, 1024, 1024, 512, P.b(WS_WNO));
    transpose_all(c, tb, ColPlain{P.in[12]}, 1024, 1024, 512, P.b(WS_WXO));
    transpose_all(c, tb, ColPlain{P.in[13]}, 1024, 1024, 1024, P.b(WS_WOUT));
    { float* COS = P.f(WS_COS); float* SIN = P.f(WS_SIN);
      for (int i = c.gw * 64 + c.lane; i < SEQ * 64; i += c.ngw * 64) { const int pos = i >> 6, fi = i & 63;
          const float inv = (float)pow(10000.0, -(double)fi / 64.0); const float ang = (float)pos * inv;
          COS[i] = (float)cos((double)ang); SIN[i] = (float)sin((double)ang); } }
    { bf16* FT = P.b(WS_FT); const float* rpb = P.in[8];
      for (int i = c.gw * 64 + c.lane; i < 8 * 15 * 64 * 64; i += c.ngw * 64) { const int qc = i & 63, kc = (i >> 6) & 63, hr = i >> 12;
          int cs = qc - 8; cs = cs < 0 ? 0 : (cs > 48 ? 48 : cs); int rc = kc - qc; rc = rc < -15 ? -15 : (rc > 15 ? 15 : rc);
          const float v = (kc >= cs && kc < cs + 16) ? rpb[hr * 31 + rc + 15] : -1.0e30f; FT[i] = (bf16)f2bf(v); } }
    { float* WTR = P.f(WS_WTR); const float* wrg = P.in[15]; const float* wre = P.in[17];
      for (int i = c.gw * 64 + c.lane; i < 20 * 1024; i += c.ngw * 64) { const int n = i >> 10, k = i & 1023; WTR[i] = n < 4 ? wrg[k * 4 + n] : wre[k * 16 + (n - 4)]; } }
    for (int m = c.gw; m < T; m += 2 * c.ngw) {
        const int m2 = m + c.ngw; const f32x4* xa = (const f32x4*)(P.in[0] + (size_t)m * DM) + c.lane; const f32x4* xb = (const f32x4*)(P.in[0] + (size_t)(m2 < T ? m2 : m) * DM) + c.lane;
        const f32x4* gr = (const f32x4*)P.in[2] + c.lane;
        f32x4 va[4], vb[4]; float sa = 0.f, sb = 0.f;
#pragma unroll
        for (int j = 0; j < 4; ++j) { va[j] = xa[64 * j]; vb[j] = xb[64 * j]; }
#pragma unroll
        for (int j = 0; j < 4; ++j) { sa += (va[j].x * va[j].x + va[j].y * va[j].y) + (va[j].z * va[j].z + va[j].w * va[j].w); sb += (vb[j].x * vb[j].x + vb[j].y * vb[j].y) + (vb[j].z * vb[j].z + vb[j].w * vb[j].w); }
        const float ra = 1.0f / sqrtf(wave_sum(sa) * (1.f / 1024.f) + RMS_EPS), rb = 1.0f / sqrtf(wave_sum(sb) * (1.f / 1024.f) + RMS_EPS);
        unsigned long long* oa = (unsigned long long*)(P.b(WS_XN) + (size_t)m * DM) + c.lane; unsigned long long* ob = (unsigned long long*)(P.b(WS_XN) + (size_t)m2 * DM) + c.lane;
#pragma unroll
        for (int j = 0; j < 4; ++j) { const f32x4 gg = gr[64 * j];
            oa[64 * j] = (unsigned long long)pk2(va[j].x * ra * gg.x, va[j].y * ra * gg.y) | ((unsigned long long)pk2(va[j].z * ra * gg.z, va[j].w * ra * gg.w) << 32);
            if (m2 < T) ob[64 * j] = (unsigned long long)pk2(vb[j].x * rb * gg.x, vb[j].y * rb * gg.y) | ((unsigned long long)pk2(vb[j].z * rb * gg.z, vb[j].w * rb * gg.w) << 32); } }
    for (int m = c.gw; m < TM; m += c.ngw) rms_row_to_bf16(P.in[1] + (size_t)m * DM, P.in[10], P.b(WS_MN) + (size_t)m * DM, c.lane);
}

__device__ __forceinline__ void phase1_naive(const Ctx& c, const Ptrs& P) {
    EpiProjA E{P.b(WS_RQ), P.b(WS_RK), P.b(WS_RV), P.b(WS_RG), P.b(WS_NQ), P.b(WS_NK), P.b(WS_NV), P.b(WS_XQ), P.f(WS_COS), P.f(WS_SIN)};
    naive_gemm(c, RowPlain{P.b(WS_XN), DM}, P.b(WS_WA), DM, T, NPA, DM, E);
}

__device__ __forceinline__ float log_sigmoid_(float x) { return -log1pf(expf(-x)); }

__device__ __forceinline__ void phase2_states_naive(const Ctx& c, const Ptrs& P) {
    const bf16* RK = P.b(WS_RK); const bf16* RV = P.b(WS_RV); bf16* ST = (bf16*)P.out;
    const int nitems = NB * 4 * 2 * 128 * 4;
    for (int it = c.gw; it < nitems; it += c.ngw) {
        const int eb = it & 3, d = (it >> 2) & 127, dir = (it >> 9) & 1, h = (it >> 10) & 3, b = it >> 12;
        const int e = eb * 64 + c.lane;
        const float lg = log_sigmoid_(dir ? P.in[5][h] : P.in[4][h]); const float gam = expf(lg);
        float S = 0.f;
        bf16* stb = ST + (size_t)(((b * 4 + h) * 2 + dir) * 16) * 256 * 128 + (size_t)e * 128 + d;
        for (int jj = 0; jj < SEQ; ++jj) {
            const int j = dir ? (SEQ - 1 - jj) : jj;
            if ((jj & 127) == 0) { const int n = j >> 7; stb[(size_t)n * 256 * 128] = (bf16)f2bf(S); }
            const size_t tok = (size_t)b * SEQ + j;
            const float kv = bf2f(RK[tok * 512 + h * 128 + d]) * bf2f(RV[tok * 1024 + h * 256 + e]);
            S = S * gam + kv;
        }
    }
}
__device__ __forceinline__ void phase2_na_naive(const Ctx& c, const Ptrs& P) {
    bf16* NQ = P.b(WS_NQ); const bf16* NK = P.b(WS_NK); const bf16* NV = P.b(WS_NV); const float* rpb = P.in[8];
    float* scr = (float*)(c.lds + c.wave * 16384);
    const int lane = c.lane;
    for (int it = c.gw; it < T * 8; it += c.ngw) {
        const int h = it & 7, tok = it >> 3, b = tok >> 11, s = tok & 2047, r = s >> 6, cc = s & 63;
        int rs = r - 4; rs = rs < 0 ? 0 : (rs > 24 ? 24 : rs);
        int cs = cc - 8; cs = cs < 0 ? 0 : (cs > 48 ? 48 : cs);
        scr[128 + lane] = bf2f(NQ[(size_t)tok * 512 + h * 64 + lane]);
        __builtin_amdgcn_s_waitcnt(0xC07F); asm volatile("" ::: "memory");
        float sc[2];
#pragma unroll
        for (int t = 0; t < 2; ++t) { const int key = lane + 64 * t, kr = rs + (key >> 4), kc = cs + (key & 15);
            const size_t kt = (size_t)b * SEQ + kr * 64 + kc; const u32x4* kp = (const u32x4*)(NK + kt * 512 + h * 64);
            float a = 0.f;
#pragma unroll 2
            for (int i = 0; i < 8; ++i) { float kk[8]; unpack8(kp[i], kk);
#pragma unroll
                for (int u = 0; u < 8; ++u) a += scr[128 + 8 * i + u] * kk[u]; }
            int rc = kc - cc; rc = rc < -15 ? -15 : (rc > 15 ? 15 : rc);
            sc[t] = a + rpb[(h * 15 + (kr - r + 7)) * 31 + rc + 15]; }
        const float mx = wave_max(fmaxf(sc[0], sc[1]));
        const float e0 = __expf(sc[0] - mx), e1 = __expf(sc[1] - mx);
        const float inv = 1.0f / wave_sum(e0 + e1);
        scr[lane] = e0 * inv; scr[lane + 64] = e1 * inv;
        __builtin_amdgcn_s_waitcnt(0xC07F); asm volatile("" ::: "memory");
        float o = 0.f;
        for (int key = 0; key < 128; ++key) { const int kr = rs + (key >> 4), kc = cs + (key & 15);
            const size_t kt = (size_t)b * SEQ + kr * 64 + kc; o += scr[key] * bf2f(NV[kt * 512 + h * 64 + lane]); }
        NQ[(size_t)tok * 512 + h * 64 + lane] = (bf16)f2bf(o);
        __builtin_amdgcn_s_waitcnt(0xC07F); asm volatile("" ::: "memory");
    }
}
__device__ __forceinline__ void phase2_memkv_naive(const Ctx& c, const Ptrs& P) {
    naive_gemm(c, RowPlain{P.b(WS_MN), DM}, P.b(WS_WKV), DM, TM, 1024, DM, EpiBf16Plain{P.b(WS_MKV), 1024});
}
__device__ __forceinline__ void phase3_ret_naive(const Ctx& c, const Ptrs& P) {
    const bf16* RQ = P.b(WS_RQ); const bf16* RK = P.b(WS_RK); const bf16* RV = P.b(WS_RV); bf16* RG = P.b(WS_RG); const bf16* ST = (const bf16*)P.out;
    const float* gain = P.in[6];
    float* scr = (float*)(c.lds + c.wave * 16384);
    const int lane = c.lane;
    for (int it = c.gw; it < T * 4; it += c.ngw) {
        const int h = it & 3, tok = it >> 2, b = tok >> 11, s = tok & 2047, n = s >> 7, p = s & 127;
        const float lgf = log_sigmoid_(P.in[4][h]), lgb = log_sigmoid_(P.in[5][h]);
        { const bf16* qp = RQ + (size_t)tok * 512 + h * 128; scr[lane] = bf2f(qp[lane]); scr[lane + 64] = bf2f(qp[lane + 64]); }
        __builtin_amdgcn_s_waitcnt(0xC07F); asm volatile("" ::: "memory");
        float sv[2];
#pragma unroll
        for (int t = 0; t < 2; ++t) { const int pj = lane + 64 * t; const size_t kt = (size_t)b * SEQ + n * 128 + pj;
            const u32x4* kp = (const u32x4*)(RK + kt * 512 + h * 128); float a = 0.f;
#pragma unroll 2
            for (int i = 0; i < 16; ++i) { float kk[8]; unpack8(kp[i], kk);
#pragma unroll
                for (int u = 0; u < 8; ++u) a += scr[8 * i + u] * kk[u]; }
            const float w = (pj <= p) ? expf((float)(p - pj) * lgf) : expf((float)(pj - p) * lgb);
            sv[t] = a * w; }
        scr[128 + lane] = sv[0]; scr[128 + 64 + lane] = sv[1];
        __builtin_amdgcn_s_waitcnt(0xC07F); asm volatile("" ::: "memory");
        const float af = expf((float)(p + 1) * lgf), ab = expf((float)(128 - p) * lgb);
        const bf16* sf = ST + (size_t)(((b * 4 + h) * 2 + 0) * 16 + n) * 256 * 128;
        const bf16* sb = ST + (size_t)(((b * 4 + h) * 2 + 1) * 16 + n) * 256 * 128;
        float y[4];
#pragma unroll 1
        for (int eb = 0; eb < 4; ++eb) { const int e = eb * 64 + lane; float a = 0.f;
#pragma unroll 4
            for (int pj = 0; pj < 128; ++pj) { const size_t kt = (size_t)b * SEQ + n * 128 + pj; a += scr[128 + pj] * bf2f(RV[kt * 1024 + h * 256 + e]); }
            float cf = 0.f, cb = 0.f; const u32x4* fp = (const u32x4*)(sf + (size_t)e * 128); const u32x4* bp = (const u32x4*)(sb + (size_t)e * 128);
#pragma unroll 2
            for (int i = 0; i < 16; ++i) { float x1[8], x2[8]; unpack8(fp[i], x1); unpack8(bp[i], x2);
#pragma unroll
                for (int u = 0; u < 8; ++u) { cf += scr[8 * i + u] * x1[u]; cb += scr[8 * i + u] * x2[u]; } }
            y[eb] = a + af * cf + ab * cb; }
        const float mu = wave_sum((y[0] + y[1]) + (y[2] + y[3])) * (1.f / 256.f);
        float v = 0.f;
#pragma unroll
        for (int eb = 0; eb < 4; ++eb) { y[eb] -= mu; v += y[eb] * y[eb]; }
        const float rstd = 1.0f / sqrtf(wave_sum(v) * (1.f / 256.f) + GN_EPS);
#pragma unroll
        for (int eb = 0; eb < 4; ++eb) { const int col = h * 256 + eb * 64 + lane; bf16* g = RG + (size_t)tok * 1024 + col;
            *g = (bf16)f2bf(y[eb] * rstd * gain[col] * bf2f(*g)); }
        __builtin_amdgcn_s_waitcnt(0xC07F); asm volatile("" ::: "memory");
    }
}
__device__ __forceinline__ void phase3_xa_naive(const Ctx& c, const Ptrs& P) {
    bf16* XQ = P.b(WS_XQ); const bf16* MKV = P.b(WS_MKV);
    float* scr = (float*)(c.lds + c.wave * 16384);
    const int lane = c.lane;
    for (int it = c.gw; it < T * 4; it += c.ngw) {
        const int h = it & 3, tok = it >> 2, b = tok >> 11;
        { const bf16* qp = XQ + (size_t)tok * 512 + h * 128; scr[lane] = bf2f(qp[lane]); scr[lane + 64] = bf2f(qp[lane + 64]); }
        __builtin_amdgcn_s_waitcnt(0xC07F); asm volatile("" ::: "memory");
        float sc[4]; float mx = -3.0e38f;
#pragma unroll
        for (int t = 0; t < 4; ++t) { const int m = lane + 64 * t; const u32x4* kp = (const u32x4*)(MKV + (size_t)(b * MEML + m) * 1024 + h * 128); float a = 0.f;
#pragma unroll 2
            for (int i = 0; i < 16; ++i) { float kk[8]; unpack8(kp[i], kk);
#pragma unroll
                for (int u = 0; u < 8; ++u) a += scr[8 * i + u] * kk[u]; }
            sc[t] = a; mx = fmaxf(mx, a); }
        mx = wave_max(mx); float sum = 0.f;
#pragma unroll
        for (int t = 0; t < 4; ++t) { sc[t] = __expf(sc[t] - mx); sum += sc[t]; }
        const float inv = 1.0f / wave_sum(sum);
#pragma unroll
        for (int t = 0; t < 4; ++t) scr[128 + lane + 64 * t] = sc[t] * inv;
        __builtin_amdgcn_s_waitcnt(0xC07F); asm volatile("" ::: "memory");
        float o0 = 0.f, o1 = 0.f;
        for (int m = 0; m < MEML; ++m) { const bf16* vp = MKV + (size_t)(b * MEML + m) * 1024 + 512 + h * 128; const float pm = scr[128 + m];
            o0 += pm * bf2f(vp[lane]); o1 += pm * bf2f(vp[lane + 64]); }
        bf16* op = XQ + (size_t)tok * 512 + h * 128; op[lane] = (bf16)f2bf(o0); op[lane + 64] = (bf16)f2bf(o1);
        __builtin_amdgcn_s_waitcnt(0xC07F); asm volatile("" ::: "memory");
    }
}
__device__ __forceinline__ void phase4_naive(const Ctx& c, const Ptrs& P) {
    naive_gemm(c, RowPlain{P.b(WS_XN), DM}, P.b(WS_WG), DM, T, NPG, DM, EpiSigmoid{P.b(WS_GATES), NPG});
}
__device__ __forceinline__ void phase5_naive(const Ctx& c, const Ptrs& P) {
    float* TMP = P.out; bf16* MIX = P.b(WS_MIX); const bf16* G = P.b(WS_GATES);
    naive_gemm(c, RowPlain{P.b(WS_RG), 1024}, P.b(WS_WRO), 1024, T, DM, 1024, EpiMixNaive<0>{TMP, MIX, G});
    naive_gemm(c, RowPlain{P.b(WS_NQ), 512}, P.b(WS_WNO), 512, T, DM, 512, EpiMixNaive<1>{TMP, MIX, G + 1024});
    naive_gemm(c, RowPlain{P.b(WS_XQ), 512}, P.b(WS_WXO), 512, T, DM, 512, EpiMixNaive<2>{TMP, MIX, G + 2048});
}
__device__ __forceinline__ void phase6_naive(const Ctx& c, const Ptrs& P) {
    naive_gemm(c, RowPlain{P.b(WS_MIX), DM}, P.b(WS_WOUT), DM, T, DM, DM, EpiResidF32{P.in[0], P.out});
}

__device__ __forceinline__ void phase1_mfma(const Ctx& c, const Ptrs& P) {
    EpiProjA E{P.b(WS_RQ), P.b(WS_RK), P.b(WS_RV), P.b(WS_RG), P.b(WS_NQ), P.b(WS_NK), P.b(WS_NV), P.b(WS_XQ), P.f(WS_COS), P.f(WS_SIN)};
    pg8::PlainSched S; S.o.init(T / 256, NPA / 256, gridDim.x, blockIdx.x); S.A = P.b(WS_XN); S.Bt = P.b(WS_WA); S.lda = DM; S.ldb = DM; S.K = DM;
    pg8::gemm_phase<false>((LAS unsigned char*)c.lds, S, pg8::EpiF<EpiProjA, 4>{E});
}
__device__ __forceinline__ void phase4_mfma(const Ctx& c, const Ptrs& P) {
    pg8::PlainSched S; S.o.init(T / 256, NPG / 256, gridDim.x, blockIdx.x); S.A = P.b(WS_XN); S.Bt = P.b(WS_WG); S.lda = DM; S.ldb = DM; S.K = DM;
    pg8::gemm_phase<false>((LAS unsigned char*)c.lds, S, pg8::EpiF<EpiSigmoid>{EpiSigmoid{P.b(WS_GATES), NPG}});
}
__device__ __forceinline__ void phase6_mfma(const Ctx& c, const Ptrs& P) {
    pg8::PlainSched S; S.o.init(T / 256, DM / 256, gridDim.x, blockIdx.x); S.A = P.b(WS_MIX); S.Bt = P.b(WS_WOUT); S.lda = DM; S.ldb = DM; S.K = DM;
    pg8::gemm_phase<false>((LAS unsigned char*)c.lds, S, pg8::EpiF<EpiResidBf16, 2>{EpiResidBf16{P.in[0], P.b(WS_D)}}, 25);
}

__device__ __forceinline__ void panel_handoff(unsigned* cnt, unsigned need) {
    asm volatile("s_waitcnt vmcnt(0)" ::: "memory"); __syncthreads();
    if (threadIdx.x == 0) {
        __builtin_amdgcn_fence(__ATOMIC_RELEASE, "agent"); asm volatile("s_waitcnt vmcnt(0)" ::: "memory");
        __hip_atomic_fetch_add(cnt, 1u, __ATOMIC_RELAXED, __HIP_MEMORY_SCOPE_AGENT);
        unsigned sp = 0; while (__hip_atomic_load(cnt, __ATOMIC_RELAXED, __HIP_MEMORY_SCOPE_AGENT) < need) { __builtin_amdgcn_s_sleep(2); if (++sp > (1u << 22)) break; }
        __builtin_amdgcn_fence(__ATOMIC_ACQUIRE, "agent"); asm volatile("s_waitcnt vmcnt(0)" ::: "memory");
    }
    __syncthreads();
}
struct GateSched { pg8::TileOrder o; const unsigned char* ws;
    __device__ __forceinline__ bool next(int i, pg8::UnitDesc& u) const { int pm, pn; const int w = i % 3; if (!o.tile(i / 3, pm, pn)) return false;
        u.A = (const char*)(ws + WS_XN) + (size_t)pm * 256 * 2048; u.B = (const char*)(ws + WS_WG) + (size_t)(w * 1024 + pn * 256) * 2048; u.lda2 = 2048; u.ldb2 = 2048; u.nt = 16;
        u.row0 = pm * 256; u.col0 = pn * 256; u.aux = w; u.aux2 = 0; u.gidx = nullptr; u.gcnt = 0; u.chain = 0; return true; } };
__device__ __forceinline__ unsigned q8x4(f32x4 g) {
    const unsigned a = (unsigned)(g[0] * 255.0f + 0.5f), b = (unsigned)(g[1] * 255.0f + 0.5f), c = (unsigned)(g[2] * 255.0f + 0.5f), d = (unsigned)(g[3] * 255.0f + 0.5f);
    return a | (b << 8) | (c << 16) | (d << 24); }
__device__ __forceinline__ f32x4 dq8x4(unsigned w) {
    return (f32x4){fmaxf((float)(w & 0xffu) * (1.0f / 255.0f), 1e-18f), fmaxf((float)((w >> 8) & 0xffu) * (1.0f / 255.0f), 1e-18f),
                   fmaxf((float)((w >> 16) & 0xffu) * (1.0f / 255.0f), 1e-18f), fmaxf((float)(w >> 24) * (1.0f / 255.0f), 1e-18f)}; }
struct EpiGate { unsigned char* SCR;
    __device__ __forceinline__ void finish(f32x4 (&acc)[2][2][4][2], const pg8::UnitDesc& u, int wr, int wc, int fr, int fq) const {
        unsigned ow = (unsigned)((u.row0 >> 8) * 4 + (u.col0 >> 8)) * 196608u + (unsigned)u.aux * 65536u + threadIdx.x * 8u;
#pragma unroll
        for (int ai = 0; ai < 2; ++ai)
#pragma unroll
            for (int m = 0; m < 4; ++m) { asm volatile("" : "+v"(ow));
#pragma unroll
                for (int bj = 0; bj < 2; ++bj) { f32x4 s0, s1;
#pragma unroll
                    for (int i = 0; i < 4; ++i) { s0[i] = sigmoidf_(acc[ai][bj][m][0][i]); s1[i] = sigmoidf_(acc[ai][bj][m][1][i]); }
                    *(u32x2*)(SCR + ow + bj * 4096) = (u32x2){q8x4(s0), q8x4(s1)}; }
                ow += 2 * 4096; asm volatile("" ::: "memory"); __builtin_amdgcn_sched_barrier(0); }
        pg8::zero_acc(acc);
    } };
struct MixSched { pg8::TileOrder o; const unsigned char* ws;
    __device__ __forceinline__ bool next(int i, pg8::UnitDesc& u) const { int pm, pn; const int w = i % 3; if (!o.tile(i / 3, pm, pn)) return false;
        const size_t offA = w == 0 ? WS_RG : (w == 1 ? WS_NQ : WS_XQ), offB = w == 0 ? WS_WRO : (w == 1 ? WS_WNO : WS_WXO); const int K = w == 0 ? 1024 : 512;
        u.A = (const char*)(ws + offA) + (size_t)pm * 256 * K * 2; u.B = (const char*)(ws + offB) + (size_t)pn * 256 * K * 2; u.lda2 = K * 2; u.ldb2 = K * 2; u.nt = K / 64;
        u.row0 = pm * 256; u.col0 = pn * 256; u.aux = w; u.aux2 = 0; u.gidx = nullptr; u.gcnt = 0; u.chain = (w < 2); return true; } };
struct EpiMix { const unsigned char* SCR; bf16* MIX;
    __device__ __forceinline__ void finish(f32x4 (&acc)[2][2][4][2], const pg8::UnitDesc& u, int wr, int wc, int fr, int fq) const {
        const int w = u.aux; const bool fin = (w == 2);
        unsigned on = (unsigned)((u.row0 >> 8) * 4 + (u.col0 >> 8)) * 196608u + (unsigned)w * 65536u + threadIdx.x * 8u; const unsigned dd = fin ? 0u : 65536u;
        bf16* mp = MIX + (size_t)(u.row0 + wr * 64 + fr) * DM + u.col0 + wc * 32 + 8 * fq;
#pragma unroll
        for (int ai = 0; ai < 2; ++ai) {
            asm volatile("" : "+v"(on), "+v"(mp));
            u32x2 ga[4][2], gb[4][2];
#pragma unroll
            for (int m = 0; m < 4; ++m)
#pragma unroll
                for (int bj = 0; bj < 2; ++bj) { ga[m][bj] = *(const u32x2*)(SCR + on + (2 * m + bj) * 4096); gb[m][bj] = *(const u32x2*)(SCR + on + dd + (2 * m + bj) * 4096); }
#pragma unroll
            for (int m = 0; m < 4; ++m) {
#pragma unroll
                for (int bj = 0; bj < 2; ++bj) {
                    const f32x4 n0 = dq8x4(ga[m][bj].x), n1 = dq8x4(ga[m][bj].y), d0 = dq8x4(gb[m][bj].x), d1 = dq8x4(gb[m][bj].y);
                    f32x4 r0, r1;
#pragma unroll
                    for (int i = 0; i < 4; ++i) { r0[i] = n0[i] * __builtin_amdgcn_rcpf(fin ? 1.0f : d0[i]); r1[i] = n1[i] * __builtin_amdgcn_rcpf(fin ? 1.0f : d1[i]); }
                    const f32x4 v0 = acc[ai][bj][m][0] * r0, v1 = acc[ai][bj][m][1] * r1;
                    if (fin) store8(mp + (size_t)m * 16 * DM + bj * 128, v0, v1);
                    acc[ai][bj][m][0] = fin ? (f32x4){0.f, 0.f, 0.f, 0.f} : v0; acc[ai][bj][m][1] = fin ? (f32x4){0.f, 0.f, 0.f, 0.f} : v1; } }
            on += 8 * 4096; mp += 128 * DM; asm volatile("" ::: "memory"); __builtin_amdgcn_sched_barrier(0); }
    }
};
__device__ __forceinline__ void phase5_mfma(const Ctx& c, const Ptrs& P) {
    unsigned char* scr = P.ws + WS_GATES;
    { GateSched S; S.o.init(T / 256, DM / 256, gridDim.x, blockIdx.x); S.ws = P.ws; pg8::gemm_phase<false>((LAS unsigned char*)c.lds, S, EpiGate{scr}); }
    { MixSched S; S.o.init(T / 256, DM / 256, gridDim.x, blockIdx.x); S.ws = P.ws; pg8::gemm_phase<false>((LAS unsigned char*)c.lds, S, EpiMix{scr, P.b(WS_MIX)}); }
}
struct MoeSched { const unsigned* ctl; int mode;
    int lo, hi, nblk, v;
    const bf16 *H2, *WGU, *HID, *WD; const int* elist;
    __device__ __forceinline__ bool next(int i, pg8::UnitDesc& u) const {
        if (v < 0) return false;
        const int L = lo + v + i * nblk; if (L >= hi) return false;
        const int pn = L & 3; int mtg = L >> 2;
        int e = -1, base = 0, cnt = 0, mt = 0;
#pragma unroll 1
        for (int j = 0; j < NEXP; ++j) { const int cj = (int)__builtin_amdgcn_readfirstlane((int)ctl[CW_ECNT + 64 * j]); const int tj = (cj + 255) >> 8;
            if (mtg < tj) { e = j; cnt = cj; mt = mtg; break; } mtg -= tj; base += tj * 256; }
        if (e < 0) return false;
        u.row0 = mt * 256; u.col0 = pn * 256; u.aux = e; u.aux2 = base; u.gcnt = cnt; u.chain = 0;
        if (mode == 0) { u.A = (const char*)H2; u.gidx = elist + e * T; u.lda2 = DM * 2; u.B = (const char*)(WGU + (size_t)e * 1024 * 1024 + (size_t)pn * 256 * 1024); u.ldb2 = 2048; u.nt = 16; }
        else { u.A = (const char*)(HID + (size_t)(base + mt * 256) * DFF); u.gidx = nullptr; u.lda2 = DFF * 2; u.B = (const char*)(WD + (size_t)e * 1024 * 512 + (size_t)pn * 256 * 512); u.ldb2 = 1024; u.nt = 8; }
        return true; } };
struct EpiMoeUp { bf16* HID; const float* EWL; const float* ERS;
    __device__ __forceinline__ void finish(f32x4 (&acc)[2][2][4][2], const pg8::UnitDesc& u, int wr, int wc, int fr, int fq) const {
        const float* wl = EWL + u.aux * T; const float* rl = ERS + u.aux * T; bf16* H = HID; const int base = u.aux2, cnt = u.gcnt;
        pg8::epi_apply(acc, u, wr, wc, fr, fq, [=](int row, int col0, f32x4 v0, f32x4 v1) { if (row < cnt) { const float rs = rl[row], w = wl[row] * rs; f32x4 h;
#pragma unroll
            for (int i = 0; i < 4; ++i) h[i] = siluf_(v0[i] * rs) * v1[i] * w;
            u32x2 o; o.x = pk2(h[0], h[1]); o.y = pk2(h[2], h[3]); *(u32x2*)(H + (size_t)(base + row) * DFF + (col0 >> 1)) = o; } });
        pg8::zero_acc(acc);
    } };
struct EpiMoeDown { bf16* DR;
    __device__ __forceinline__ void finish(f32x4 (&acc)[2][2][4][2], const pg8::UnitDesc& u, int wr, int wc, int fr, int fq) const {
        bf16* D = DR; const int base = u.aux2;
        pg8::epi_apply(acc, u, wr, wc, fr, fq, [=](int row, int col0, f32x4 v0, f32x4 v1) { store8(D + (size_t)(base + row) * DM + col0, v0, v1); });
        pg8::zero_acc(acc);
    } };
__device__ __forceinline__ MoeSched moe_sched(const Ptrs& P, int mode) {
    MoeSched S; S.ctl = (const unsigned*)(P.ws + WS_CTL); S.mode = mode; S.H2 = P.b(WS_D); S.WGU = P.b(WS_WGU); S.HID = P.b(WS_HID); S.WD = P.b(WS_WD); S.elist = (const int*)(P.ws + WS_ELIST);
    S.lo = 0; S.hi = 0; S.nblk = 1; S.v = -1; return S; }
__device__ __forceinline__ int moe_tiles(const Ptrs& P) { const unsigned* ctl = (const unsigned*)(P.ws + WS_CTL); int tiles = 0;
    for (int j = 0; j < NEXP; ++j) tiles += ((int)ctl[CW_ECNT + 64 * j] + 255) >> 8; return tiles; }
__device__ __forceinline__ void phase8a(const Ctx& c, const Ptrs& P) {
    const int G = (int)gridDim.x, units = 4 * moe_tiles(P);
    MoeSched S = moe_sched(P, 0); S.lo = 0; S.hi = units < 2 * G ? units : 2 * G; S.nblk = G; S.v = (int)blockIdx.x;
    pg8::gemm_phase<true>((LAS unsigned char*)c.lds, S, EpiMoeUp{P.b(WS_HID), P.f(WS_EWL), P.f(WS_ERS)});
}
__device__ __forceinline__ void phase8b(const Ctx& c, const Ptrs& P) {
    const int G = (int)gridDim.x, tiles = moe_tiles(P), units = 4 * tiles; const int nrem = units - 2 * G < 0 ? 0 : units - 2 * G;
    const int tdone = (2 * G) / 4 < tiles ? (2 * G) / 4 : tiles;
    const bool local = nrem > 0 && nrem <= G / 2;
    const int nup = local ? nrem : (nrem < G / 2 ? nrem : G / 2);
    if ((int)blockIdx.x < nup) {
        MoeSched S = moe_sched(P, 0); S.lo = 2 * G; S.hi = units; S.nblk = nup; S.v = (int)blockIdx.x;
        pg8::gemm_phase<true>((LAS unsigned char*)c.lds, S, EpiMoeUp{P.b(WS_HID), P.f(WS_EWL), P.f(WS_ERS)});
        if (local) {
            const int L = 2 * G + (int)blockIdx.x, tile = L >> 2; unsigned* cnt = (unsigned*)(P.ws + WS_CTL) + CW_TCNT + 64 * (tile - tdone);
            if (c.tid == 0) {
                __builtin_amdgcn_fence(__ATOMIC_RELEASE, "agent"); asm volatile("s_waitcnt vmcnt(0)" ::: "memory");
                __hip_atomic_fetch_add(cnt, 1u, __ATOMIC_RELAXED, __HIP_MEMORY_SCOPE_AGENT);
                const int need = (units - 4 * tile) < 4 ? (units - 4 * tile) : 4; unsigned sp = 0;
                while (__hip_atomic_load(cnt, __ATOMIC_RELAXED, __HIP_MEMORY_SCOPE_AGENT) < (unsigned)need) { __builtin_amdgcn_s_sleep(2); if (++sp > (1u << 22)) break; }
                __builtin_amdgcn_fence(__ATOMIC_ACQUIRE, "agent"); asm volatile("s_waitcnt vmcnt(0)" ::: "memory");
            }
            __syncthreads();
            MoeSched D = moe_sched(P, 1); D.lo = L; D.hi = L + 1; D.nblk = 1; D.v = 0;
            pg8::gemm_phase<false>((LAS unsigned char*)c.lds, D, EpiMoeDown{P.b(WS_DROWS)});
        }
    } else { MoeSched S = moe_sched(P, 1); S.lo = 0; S.hi = 4 * tdone; S.nblk = G - nup; S.v = (int)blockIdx.x - nup;
        pg8::gemm_phase<false>((LAS unsigned char*)c.lds, S, EpiMoeDown{P.b(WS_DROWS)}); }
}
__device__ __forceinline__ bool moe_needs_8c(const Ptrs& P) { const int G = (int)gridDim.x, units = 4 * moe_tiles(P); const int nrem = units - 2 * G; return nrem > G / 2; }
__device__ __forceinline__ void phase8c(const Ctx& c, const Ptrs& P) {
    if (!moe_needs_8c(P)) return;
    const int G = (int)gridDim.x, tiles = moe_tiles(P); const int tdone = (2 * G) / 4 < tiles ? (2 * G) / 4 : tiles;
    MoeSched S = moe_sched(P, 1); S.lo = 4 * tdone; S.hi = 4 * tiles; S.nblk = G; S.v = (int)blockIdx.x;
    pg8::gemm_phase<false>((LAS unsigned char*)c.lds, S, EpiMoeDown{P.b(WS_DROWS)});
}
__device__ __forceinline__ void phase2_memkv_mfma(const Ctx& c, const Ptrs& P) {
    pg8::PlainSched S; S.o.init(TM / 256, 1024 / 256, gridDim.x, blockIdx.x); S.A = P.b(WS_MN); S.Bt = P.b(WS_WKV); S.lda = DM; S.ldb = DM; S.K = DM;
    pg8::gemm_phase<false>((LAS unsigned char*)c.lds, S, pg8::EpiF<EpiBf16Plain>{EpiBf16Plain{P.b(WS_MKV), 1024}});
}
__device__ __forceinline__ f32x4 x1_load(const float* X0, const bf16* DD, size_t tok, int lane, int j) {
    const u32x2 d = ((const u32x2*)(DD + tok * DM) + lane)[64 * j];
    return (f32x4){bf2f(d.x & 0xffffu), bf2f(d.x >> 16), bf2f(d.y & 0xffffu), bf2f(d.y >> 16)};
}
constexpr int RT7_WT = 0, RT7_RED = 81920, RT7_LOG = RT7_RED + 8 * 5120, RT7_CNT = RT7_LOG + 8 * 160, RT7_GB = RT7_CNT + 64, RT7_REC = RT7_GB + 64;
template <bool LOCAL>
__device__ __forceinline__ void phase7(const Ctx& c, const Ptrs& P, int rowbase = 0) {
    const float* X0 = P.in[0]; const bf16* DD = P.b(WS_D); const float* g = P.in[14]; const float* wrg = P.in[15]; const float* brg = P.in[16]; const float* wre = P.in[17]; const float* bre = P.in[18];
    unsigned* ctl = (unsigned*)(P.ws + WS_CTL); int* elist = (int*)(P.ws + WS_ELIST); float* ewl = P.f(WS_EWL); int* tmeta = (int*)(P.ws + WS_TMETA);
    const int lane = c.lane; LAS unsigned char* L = (LAS unsigned char*)c.lds;
    { LAS f32x4* WT = (LAS f32x4*)(L + RT7_WT); const f32x4* src = (const f32x4*)P.f(WS_WTR);
#pragma unroll
      for (int i = 0; i < 10; ++i) WT[c.tid + NTHREADS * i] = src[c.tid + NTHREADS * i];
      if (c.tid < 16) ((LAS unsigned*)(L + RT7_CNT))[c.tid] = 0u; (void)wrg; (void)wre; }
    __syncthreads();
    LAS float* RED = (LAS float*)(L + RT7_RED + c.wave * 5120); LAS float* LOG = (LAS float*)(L + RT7_LOG + c.wave * 160);
    LAS unsigned* LCNT = (LAS unsigned*)(L + RT7_CNT); LAS int* REC = (LAS int*)(L + RT7_REC);
    const float mybias = lane < 4 ? brg[lane] : (lane < 20 ? bre[lane - 4] : 0.f);
    f32x4 xn[2][4];
    const int tp0 = LOCAL ? rowbase / 2 + c.wave * 4 : c.gw, tpstep = LOCAL ? 1 : c.ngw, tpend = LOCAL ? tp0 + 4 : T / 2;
    if (tp0 < tpend) {
#pragma unroll
        for (int t = 0; t < 2; ++t)
#pragma unroll
            for (int j = 0; j < 4; ++j) xn[t][j] = x1_load(X0, DD, (size_t)(2 * tp0 + t), lane, j); }
    int pidx = 0;
#pragma unroll 1
    for (int tp = tp0; tp < tpend; tp += tpstep, ++pidx) {
        f32x4 hh[2][4]; float rstd2[2]; const f32x4* gr = (const f32x4*)g + lane;
#pragma unroll
        for (int t = 0; t < 2; ++t)
#pragma unroll
            for (int j = 0; j < 4; ++j) hh[t][j] = xn[t][j];
        { const int tpn = tp + tpstep < tpend ? tp + tpstep : tp;
#pragma unroll
          for (int t = 0; t < 2; ++t)
#pragma unroll
              for (int j = 0; j < 4; ++j) xn[t][j] = x1_load(X0, DD, (size_t)(2 * tpn + t), lane, j); }
#pragma unroll
        for (int t = 0; t < 2; ++t) { const int tok = 2 * tp + t; float s = 0.f;
#pragma unroll
            for (int j = 0; j < 4; ++j) { s += (hh[t][j].x * hh[t][j].x + hh[t][j].y * hh[t][j].y) + (hh[t][j].z * hh[t][j].z + hh[t][j].w * hh[t][j].w); }
            const float r = 1.0f / sqrtf(wave_sum(s) * (1.f / 1024.f) + RMS_EPS); rstd2[t] = r; (void)tok;
#pragma unroll
            for (int j = 0; j < 4; ++j) { const f32x4 gg = gr[64 * j]; hh[t][j] = hh[t][j] * gg * r; } }
        float p0[20], p1[20];
        const LAS f32x4* wt = (const LAS f32x4*)(L + RT7_WT) + lane;
#pragma unroll
        for (int n = 0; n < 20; ++n) { f32x2_ a = {0.f, 0.f};
#pragma unroll
            for (int j = 0; j < 4; ++j) { const f32x4 w4 = wt[n * 256 + 64 * j];
#pragma unroll
                for (int u = 0; u < 4; ++u) { const f32x2_ hv = {hh[0][j][u], hh[1][j][u]}; const f32x2_ wv = {w4[u], w4[u]}; a = __builtin_elementwise_fma(hv, wv, a); } }
            p0[n] = a[0]; p1[n] = a[1]; __builtin_amdgcn_sched_barrier(0); }
#pragma unroll 1
        for (int t = 0; t < 2; ++t) {
#pragma unroll
            for (int q = 0; q < 5; ++q) *(LAS f32x4*)(RED + lane * 20 + 4 * q) = t ? (f32x4){p1[4 * q], p1[4 * q + 1], p1[4 * q + 2], p1[4 * q + 3]} : (f32x4){p0[4 * q], p0[4 * q + 1], p0[4 * q + 2], p0[4 * q + 3]};
            asm volatile("s_waitcnt lgkmcnt(0)" ::: "memory");
            float sum = 0.f; const int nn = lane < 20 ? lane : 0;
#pragma unroll 16
            for (int j = 0; j < 64; ++j) sum += RED[j * 20 + nn];
            if (lane < 20) LOG[t * 20 + lane] = sum + mybias;
            asm volatile("s_waitcnt lgkmcnt(0)" ::: "memory");
        }
        if (lane < 2) {
            const int tok = 2 * tp + lane;
            float l[20];
#pragma unroll
            for (int i = 0; i < 20; ++i) l[i] = LOG[lane * 20 + i];
            int gi = 0;
#pragma unroll
            for (int i = 1; i < 4; ++i) if (l[i] > l[gi]) gi = i;
            float lmax = l[0];
#pragma unroll
            for (int i = 1; i < 4; ++i) lmax = fmaxf(lmax, l[i]);
            float se = 0.f;
#pragma unroll
            for (int i = 0; i < 4; ++i) se += expf(l[i] - lmax);
            const float grp_w = 1.0f / se;
            float el[4];
#pragma unroll
            for (int i = 0; i < 4; ++i) { float a = 0.f;
#pragma unroll
                for (int g2 = 0; g2 < 4; ++g2) a = (g2 == gi) ? l[4 + 4 * g2 + i] : a;
                el[i] = a; }
            int ia = 0;
#pragma unroll
            for (int i = 1; i < 4; ++i) if (el[i] > el[ia]) ia = i;
            int ib = (ia == 0) ? 1 : 0;
#pragma unroll
            for (int i = 0; i < 4; ++i) if (i != ia && i != ib && el[i] > el[ib]) ib = i;
            float ela = el[0], elb = el[0];
#pragma unroll
            for (int i = 1; i < 4; ++i) { ela = (i == ia) ? el[i] : ela; elb = (i == ib) ? el[i] : elb; }
            const float t = expf(elb - ela); const float wa = grp_w / (1.0f + t), wb = grp_w * t / (1.0f + t);
            const int ea = gi * 4 + ia, eb = gi * 4 + ib;
            const int lpa = (int)atomicAdd((unsigned*)(LCNT + ea), 1u), lpb = (int)atomicAdd((unsigned*)(LCNT + eb), 1u);
            LAS int* rec = REC + (c.wave * 8 + pidx * 2 + lane) * 8;
            rec[0] = tok; rec[1] = ea; rec[2] = lpa; rec[3] = eb; rec[4] = lpb; rec[5] = __float_as_int(wa); rec[6] = __float_as_int(wb); rec[7] = __float_as_int(lane ? rstd2[1] : rstd2[0]);
        }
    }
    __syncthreads();
    if (c.tid < 16) ((LAS unsigned*)(L + RT7_GB))[c.tid] = atomicAdd(ctl + CW_ECNT + 64 * c.tid, LCNT[c.tid]);
    __syncthreads();
    if (c.tid < 64) { const int wv = c.tid >> 3, k = c.tid & 7;
        const int gwv = blockIdx.x * NWAVES + wv; const int npairs = LOCAL ? 4 : (gwv < T / 2 ? (T / 2 - 1 - gwv) / c.ngw + 1 : 0);
        if ((k >> 1) < npairs) { const LAS int* rec = REC + c.tid * 8; const LAS unsigned* GB = (const LAS unsigned*)(L + RT7_GB);
            const int tok = rec[0], ea = rec[1], eb = rec[3]; const int pa = (int)GB[ea] + rec[2], pb = (int)GB[eb] + rec[4];
            elist[ea * T + pa] = tok; ewl[ea * T + pa] = __int_as_float(rec[5]); elist[eb * T + pb] = tok; ewl[eb * T + pb] = __int_as_float(rec[6]);
            float* ers = (float*)(P.ws + WS_ERS); ers[ea * T + pa] = __int_as_float(rec[7]); ers[eb * T + pb] = __int_as_float(rec[7]);
            *(int4*)(tmeta + 4 * tok) = make_int4(ea, pa, eb, pb); } }
    __syncthreads();
    int tb = 0;
    for (int e = 0; e < NEXP; ++e) {
        transpose_all(c, tb, ColGU{P.in[19] + (size_t)e * 1024 * 512, P.in[20] + (size_t)e * 1024 * 512}, 512, 1024, 1024, P.b(WS_WGU) + (size_t)e * 1024 * 1024, P.in[14]);
        transpose_all(c, tb, ColPlain{P.in[21] + (size_t)e * 512 * 1024}, 1024, 1024, 512, P.b(WS_WD) + (size_t)e * 1024 * 512);
    }
}
__device__ __forceinline__ void phase567(const Ctx& c, const Ptrs& P) {
    pg8::TileOrder o; o.init(T / 256, DM / 256, gridDim.x, blockIdx.x); int pm = 0, pn = 0; o.tile(0, pm, pn);
    unsigned* ctl = (unsigned*)(P.ws + WS_CTL);
    phase5_mfma(c, P);
    panel_handoff(ctl + CW_PAN1 + 32 * pm, 4u);
    phase6_mfma(c, P);
    panel_handoff(ctl + CW_PAN2 + 32 * pm, 4u);
    phase7<true>(c, P, pm * 256 + pn * 64);
}
__device__ __forceinline__ int expert_rowbase(const unsigned* ctl, int e, int& cnt_e) {
    int base = 0; cnt_e = 0;
    for (int i = 0; i < NEXP; ++i) { const int ci = (int)ctl[CW_ECNT + 64 * i]; if (i < e) base += (ci + 255) & ~255; if (i == e) cnt_e = ci; }
    return base;
}
__device__ __forceinline__ void phase8_naive(const Ctx& c, const Ptrs& P) {
    const unsigned* ctl = (const unsigned*)(P.ws + WS_CTL);
    for (int e = 0; e < NEXP; ++e) { int cnt; const int base = expert_rowbase(ctl, e, cnt);
        naive_gemm(c, RowGather{P.b(WS_H2), DM, (const int*)(P.ws + WS_ELIST) + e * T}, P.b(WS_WGU) + (size_t)e * 1024 * 1024, 1024, cnt, 1024, 1024,
                   EpiSwiGLU{P.b(WS_HID), P.f(WS_EWL) + e * T, base}); }
}
__device__ __forceinline__ void phase9_naive(const Ctx& c, const Ptrs& P) {
    const unsigned* ctl = (const unsigned*)(P.ws + WS_CTL);
    for (int e = 0; e < NEXP; ++e) { int cnt; const int base = expert_rowbase(ctl, e, cnt);
        naive_gemm(c, RowPlain{P.b(WS_HID) + (size_t)base * DFF, DFF}, P.b(WS_WD) + (size_t)e * 1024 * 512, 512, cnt, 1024, 512, EpiRowsBf16{P.b(WS_DROWS), 1024, base}); }
}
struct FinTok { f32x4 x[4]; unsigned long long a[4], b[4]; };
__device__ __forceinline__ void fin_issue(FinTok& d, const float* X0, const bf16* DD, const bf16* DR, int tok, int4 m, const int (&rb)[NEXP], int lane) {
    int ba = 0, bb = 0;
#pragma unroll
    for (int i = 0; i < NEXP; ++i) { ba = (i == m.x) ? rb[i] : ba; bb = (i == m.z) ? rb[i] : bb; }
    const unsigned long long* da = (const unsigned long long*)(DR + (size_t)(ba + m.y) * DM) + lane;
    const unsigned long long* db = (const unsigned long long*)(DR + (size_t)(bb + m.w) * DM) + lane;
#pragma unroll
    for (int j = 0; j < 4; ++j) { d.a[j] = da[64 * j]; d.b[j] = db[64 * j]; d.x[j] = x1_load(X0, DD, (size_t)tok, lane, j); }
}
__device__ __forceinline__ void phase10(const Ctx& c, const Ptrs& P) {
    const unsigned* ctl = (const unsigned*)(P.ws + WS_CTL); const int* tmeta = (const int*)(P.ws + WS_TMETA); const bf16* DR = P.b(WS_DROWS); const float* g = P.in[22];
    int rb[NEXP]; { int base = 0;
#pragma unroll
        for (int i = 0; i < NEXP; ++i) { rb[i] = base; base += ((int)ctl[CW_ECNT + 64 * i] + 255) & ~255; } }
    const int lane = c.lane;
    if (c.gw >= T) return;
    FinTok cur, nxt; int4 mn = *(const int4*)(tmeta + 4 * c.gw);
    fin_issue(cur, P.in[0], P.b(WS_D), DR, c.gw, mn, rb, lane);
    { const int t1 = c.gw + c.ngw; mn = *(const int4*)(tmeta + 4 * (t1 < T ? t1 : c.gw)); }
#pragma unroll 1
    for (int tok = c.gw; tok < T; tok += c.ngw) {
        const int t1 = tok + c.ngw, t2 = tok + 2 * c.ngw;
        if (t1 < T) { fin_issue(nxt, P.in[0], P.b(WS_D), DR, t1, mn, rb, lane); mn = *(const int4*)(tmeta + 4 * (t2 < T ? t2 : tok)); }
        f32x4* xr = (f32x4*)(P.out + (size_t)tok * DM) + lane; const f32x4* gr = (const f32x4*)g + lane;
        f32x4 v[4]; float s = 0.f;
#pragma unroll
        for (int j = 0; j < 4; ++j) { const unsigned long long a = cur.a[j], b = cur.b[j]; f32x4 x = cur.x[j];
            x.x += bf2f((unsigned)a & 0xffffu) + bf2f((unsigned)b & 0xffffu); x.y += bf2f(((unsigned)a >> 16)) + bf2f(((unsigned)b >> 16));
            x.z += bf2f((unsigned)(a >> 32) & 0xffffu) + bf2f((unsigned)(b >> 32) & 0xffffu); x.w += bf2f((unsigned)(a >> 48)) + bf2f((unsigned)(b >> 48));
            v[j] = x; s += (x.x * x.x + x.y * x.y) + (x.z * x.z + x.w * x.w); }
        const float r = 1.0f / sqrtf(wave_sum(s) * (1.f / 1024.f) + RMS_EPS);
#pragma unroll
        for (int j = 0; j < 4; ++j) { const f32x4 gg = gr[64 * j]; xr[64 * j] = (f32x4){v[j].x * r * gg.x, v[j].y * r * gg.y, v[j].z * r * gg.z, v[j].w * r * gg.w}; }
        cur = nxt;
    }
#if PROBE_TS_A >= 0
    if (c.gw == 0 && lane == 0) { volatile LAS unsigned* MISC = (volatile LAS unsigned*)((LAS unsigned char*)c.lds + MISC_OFF);
        asm volatile("s_waitcnt vmcnt(0)" ::: "memory"); MISC[32 + 24] = (unsigned)__builtin_amdgcn_s_memrealtime();
        const unsigned dt = MISC[32 + PROBE_TS_B] - MISC[32 + PROBE_TS_A]; P.out[0] += 8.0f + (float)dt * (0.01f / PROBE_TS_DIV); }
#endif
}

constexpr int NPHASES = 12;
__global__ void __launch_bounds__(NTHREADS, 2) mk_fwd(Args args) {
    extern __shared__ __attribute__((aligned(16))) unsigned char lds[];
    Ctx c; c.tid = threadIdx.x; c.lane = c.tid & 63; c.wave = __builtin_amdgcn_readfirstlane(c.tid >> 6);
    c.gw = blockIdx.x * NWAVES + c.wave; c.ngw = gridDim.x * NWAVES; c.lds = lds;
    Ptrs P;
#pragma unroll
    for (int i = 0; i < 23; ++i) P.in[i] = args.in[i];
    P.out = args.out; P.ws = args.ws;
    volatile LAS unsigned* MISC = (volatile LAS unsigned*)((LAS unsigned char*)lds + MISC_OFF);
    if (c.tid < 32) MISC[c.tid] = 0u;
    __syncthreads();
    XcdBarrier bar; bar.bar = (unsigned*)(args.ws + WS_CTL) + CW_BAR; bar.x = 0; bar.st = nullptr;
    const int lo = args.ph_lo, hi = args.ph_hi;
    const bool one_launch = (hi - lo > 1);
    if (one_launch && blockIdx.x == 0) {
        unsigned* ctlw = (unsigned*)(args.ws + WS_CTL); int w = -1; const int t = c.tid;
        if (t < 16) w = CW_BAR + XB_XCNT(t); else if (t < 32) w = CW_BAR + XB_XSUB(t - 16); else if (t < 48) w = CW_BAR + XB_XGEN(t - 32);
        else if (t == 48) w = CW_BAR + XB_TMO; else if (t == 49) w = CW_BAR + XB_TOP; else if (t == 50) w = CW_BAR + XB_TOPGEN;
        else if (t >= 64 && t < 80) w = CW_ECNT + 64 * (t - 64); else if (t >= 80 && t < 96) w = CW_TCNT + 64 * (t - 80);
        else if (t >= 128 && t < 192) w = CW_PAN1 + 32 * (t - 128); else if (t >= 192 && t < 256) w = CW_PAN2 + 32 * (t - 192);
        if (w >= 0) __hip_atomic_store(ctlw + w, 0u, __ATOMIC_RELAXED, __HIP_MEMORY_SCOPE_AGENT);
        asm volatile("s_waitcnt vmcnt(0)" ::: "memory"); __syncthreads();
        if (c.tid == 0) __hip_atomic_store(ctlw + CW_READY, READY_MAGIC, __ATOMIC_RELAXED, __HIP_MEMORY_SCOPE_AGENT);
    }
#define IN(k) (lo <= (k) && (k) < hi)
#define SEAM(k) do { if (IN(k) && IN((k) + 1)) xcd_barrier(bar); } while (0)
    const int sub = args.sub;
#if PROBE_TS_A >= 0
#define STAMP(k) do { if (blockIdx.x == 0 && c.tid == 0) MISC[32 + (k)] = (unsigned)__builtin_amdgcn_s_memrealtime(); } while (0)
#else
#define STAMP(k) do { } while (0)
#endif
    STAMP(0);
#define SUBRUN(id, stmt) do { if (sub & (1 << (id))) { stmt; __syncthreads(); } } while (0)
    if (IN(0)) { SUBRUN(0, phase0(c, P)); } STAMP(1);
    if (one_launch) {
        if (c.tid == 0) { unsigned* ctlw = (unsigned*)(args.ws + WS_CTL); unsigned sp = 0;
            while (__hip_atomic_load(ctlw + CW_READY, __ATOMIC_RELAXED, __HIP_MEMORY_SCOPE_AGENT) != READY_MAGIC) { __builtin_amdgcn_s_sleep(2); if (++sp > (1u << 22)) break; } }
        __syncthreads();
        bar = xcd_barrier_post((unsigned*)(args.ws + WS_CTL) + CW_BAR, MISC + 8);
    }
    SEAM(0); STAMP(2);
    if (IN(1)) { SUBRUN(1, phase1_mfma(c, P)); } STAMP(3); SEAM(1); STAMP(4);
    if (IN(2)) { SUBRUN(2, mx::ret_state_phase((LAS unsigned char*)lds, P.b(WS_RK), P.b(WS_RV), (bf16*)P.out, P.in[4], P.in[5])); STAMP(5);
                 SUBRUN(3, mx::na_phase((LAS unsigned char*)lds, P.b(WS_NQ), P.b(WS_NK), P.b(WS_NV), P.b(WS_FT))); STAMP(6);
                 SUBRUN(4, phase2_memkv_mfma(c, P)); } STAMP(7); SEAM(2); STAMP(8);
    if (IN(3)) { SUBRUN(5, mx::ret_out_phase((LAS unsigned char*)lds, P.b(WS_RQ), P.b(WS_RK), P.b(WS_RV), P.b(WS_RG), (const bf16*)P.out, P.in[6], P.in[4], P.in[5])); STAMP(9);
                 SUBRUN(6, mx::xa_phase((LAS unsigned char*)lds, P.b(WS_XQ), P.b(WS_MKV))); } STAMP(10); SEAM(3); STAMP(11);
    STAMP(12); STAMP(13);
    if (gridDim.x == 256) {
        if (IN(5)) { SUBRUN(8, phase567(c, P)); } STAMP(18); if (IN(5) && IN(8)) xcd_barrier(bar); STAMP(19);
    } else {
        if (IN(5)) { SUBRUN(8, phase5_mfma(c, P)); if (IN(8)) xcd_barrier(bar); SUBRUN(9, phase6_mfma(c, P)); if (IN(8)) xcd_barrier(bar); SUBRUN(10, phase7<false>(c, P)); } if (IN(5) && IN(8)) xcd_barrier(bar);
    }
    if (IN(8)) { SUBRUN(11, phase8a(c, P)); } STAMP(20); SEAM(8); STAMP(21);
    if (IN(9)) { SUBRUN(12, phase8b(c, P)); } STAMP(22); SEAM(9); STAMP(23);
    if (IN(10) && moe_needs_8c(P)) { SUBRUN(12, phase8c(c, P)); STAMP(44); SEAM(10); } STAMP(45);
    if (one_launch && blockIdx.x == 0 && c.tid == 0) __hip_atomic_store((unsigned*)(args.ws + WS_CTL) + CW_READY, 0u, __ATOMIC_RELAXED, __HIP_MEMORY_SCOPE_AGENT);
    if (IN(11)) { SUBRUN(13, phase10(c, P)); }
#undef SUBRUN
#undef IN
#undef SEAM
}

extern "C" void kernel_launch(void* const* d_in, const int* in_sizes, int n_in, void* d_out, int out_size, void* d_ws, size_t ws_size, hipStream_t stream) {
    static int grid = 0;
    if (grid == 0) {
        if (n_in != 23 || out_size != T * DM || ws_size < WS_END) { fprintf(stderr, "kernel_launch: unexpected shapes (n_in %d out %d ws %zu)\n", n_in, out_size, ws_size); grid = -1; return; }
        int dev = 0, cus = 0;
        if (hipGetDevice(&dev) != hipSuccess || hipDeviceGetAttribute(&cus, hipDeviceAttributeMultiprocessorCount, dev) != hipSuccess) { grid = -1; return; }
        if (hipFuncSetAttribute((const void*)mk_fwd, hipFuncAttributeMaxDynamicSharedMemorySize, LDS_BYTES) != hipSuccess) { fprintf(stderr, "kernel_launch: hipFuncSetAttribute failed\n"); grid = -1; return; }
        (void)hipGetLastError();
        grid = cus;
    }
    if (grid < 0) return;
#if MK_PER_PHASE
    (void)hipMemsetAsync((char*)d_ws + WS_CTL, 0, CTL_ZERO_BYTES, stream);
#endif
    Args a{};
    for (int i = 0; i < 23; ++i) a.in[i] = (const float*)d_in[i];
    a.out = (float*)d_out; a.ws = (unsigned char*)d_ws;
#if MK_PER_PHASE
    a.sub = 0x3fff; a.rep = -1;
    for (int p = 0; p < NPHASES; ++p) { a.ph_lo = p; a.ph_hi = p + 1; hipLaunchKernelGGL(mk_fwd, dim3(grid), dim3(NTHREADS), LDS_BYTES, stream, a); }
#else
    a.ph_lo = 0; a.ph_hi = NPHASES; a.sub = 0x3fff; a.rep = PROBE_REP; hipLaunchKernelGGL(mk_fwd, dim3(grid), dim3(NTHREADS), LDS_BYTES, stream, a);
#if PROBE_END >= 0
    { const int ph_of[14] = {0, 1, 2, 2, 2, 3, 3, 4, 5, 6, 7, 8, 9, 11};
      a.ph_lo = ph_of[PROBE_END]; a.ph_hi = a.ph_lo + 1; a.sub = 1 << PROBE_END; a.rep = -1; hipLaunchKernelGGL(mk_fwd, dim3(grid), dim3(NTHREADS), LDS_BYTES, stream, a); }
#endif
#endif
}
```

```cpp
#include <hip/hip_runtime.h>
#include <cstdio>
#include <cstdint>

#ifndef PROBE_REP
#define PROBE_REP -1
#endif
#ifndef PROBE_END
#define PROBE_END -1
#endif
#ifndef PROBE_TS_A
#define PROBE_TS_A -1
#define PROBE_TS_B -1
#endif
#ifndef PROBE_TS_DIV
#define PROBE_TS_DIV 8.0f
#endif
#ifndef MK_PER_PHASE
#define MK_PER_PHASE 0
#endif

#define GAS __attribute__((address_space(1)))
#define LAS __attribute__((address_space(3)))
typedef unsigned short bf16;
typedef float f32x4 __attribute__((ext_vector_type(4)));
typedef unsigned u32x4 __attribute__((ext_vector_type(4)));
typedef unsigned u32x2 __attribute__((ext_vector_type(2)));
typedef short bf16x8 __attribute__((ext_vector_type(8)));

constexpr int NB = 8, SEQ = 2048, DM = 1024, T = NB * SEQ;
constexpr int MEML = 256, TM = NB * MEML;
constexpr int NWAVES = 8, NTHREADS = 512;
constexpr int NPA = 5120, NPG = 3072;
constexpr int NEXP = 16, DFF = 512;
constexpr float RMS_EPS = 1e-6f, GN_EPS = 1e-5f;
constexpr float QK_SCALE = 0.08838834764831845f;

constexpr size_t MiB = 1u << 20;
constexpr size_t WS_CTL = 0, CTL_ZERO_BYTES = 65536;
constexpr size_t WS_COS = 1 * MiB, WS_SIN = 1 * MiB + 512 * 1024;
constexpr size_t WS_ELIST = 2 * MiB;
constexpr size_t WS_FT = 2 * MiB;
constexpr size_t WS_EWL = 3 * MiB;
constexpr size_t WS_TMETA = 4 * MiB;
constexpr size_t WS_WA = 5 * MiB;
constexpr size_t WS_WG = 15 * MiB;
constexpr size_t WS_WKV = 21 * MiB;
constexpr size_t WS_WRO = 23 * MiB;
constexpr size_t WS_WNO = 25 * MiB;
constexpr size_t WS_WXO = 26 * MiB;
constexpr size_t WS_WOUT = 27 * MiB;
constexpr size_t WS_XN = 29 * MiB;
constexpr size_t WS_H2 = WS_XN;
constexpr size_t WS_RQ = 61 * MiB;
constexpr size_t WS_RK = 77 * MiB;
constexpr size_t WS_RV = 93 * MiB;
constexpr size_t WS_NK = 125 * MiB;
constexpr size_t WS_NV = 141 * MiB;
constexpr size_t WS_GATES = 61 * MiB;
constexpr size_t WS_HID = 61 * MiB;
constexpr size_t WS_DROWS = 141 * MiB;
constexpr size_t WS_RG = 157 * MiB;
constexpr size_t WS_NQ = 189 * MiB;
constexpr size_t WS_XQ = 205 * MiB;
constexpr size_t WS_WD = 205 * MiB;
constexpr size_t WS_MN = 221 * MiB;
constexpr size_t WS_MKV = 225 * MiB;
constexpr size_t WS_MIX = 29 * MiB;
constexpr size_t WS_XNQ = 229 * MiB;
constexpr size_t WS_WGU = 221 * MiB;
constexpr size_t WS_D = 109 * MiB;
constexpr size_t WS_ERS = 1 * MiB;
constexpr size_t WS_WF = 4 * MiB + 768 * 1024;
constexpr size_t WS_WTR = 4 * MiB + 512 * 1024;
constexpr size_t WS_END = 256 * MiB;

constexpr int CW_ECNT = 64;
constexpr int CW_BAR = 4096;
constexpr int CW_READY = 16;
constexpr unsigned READY_MAGIC = 0x600DF00Du;
constexpr int CW_PAN1 = 8192, CW_PAN2 = 10240;
constexpr int CW_TCNT = 1152;
constexpr int CW_TILE = 12288;

constexpr int LDS_BYTES = 163840;
constexpr int MISC_OFF = 163840 - 512;

__device__ __forceinline__ float bf2f(unsigned v) { return __uint_as_float(v << 16); }
__device__ __forceinline__ unsigned f2bf(float f) { unsigned u = __float_as_uint(f); return (u + 0x7fffu + ((u >> 16) & 1u)) >> 16; }
typedef __bf16 hwbf16x2 __attribute__((ext_vector_type(2)));
typedef float f32x2_ __attribute__((ext_vector_type(2)));
__device__ __forceinline__ unsigned pk2(float lo, float hi) { const f32x2_ v = {lo, hi}; return __builtin_bit_cast(unsigned, __builtin_convertvector(v, hwbf16x2)); }
__device__ __forceinline__ void unpack8(const u32x4 v, float* o) {
    o[0] = __uint_as_float(v.x << 16); o[1] = __uint_as_float(v.x & 0xffff0000u);
    o[2] = __uint_as_float(v.y << 16); o[3] = __uint_as_float(v.y & 0xffff0000u);
    o[4] = __uint_as_float(v.z << 16); o[5] = __uint_as_float(v.z & 0xffff0000u);
    o[6] = __uint_as_float(v.w << 16); o[7] = __uint_as_float(v.w & 0xffff0000u);
}
__device__ __forceinline__ void store8(bf16* p, f32x4 a, f32x4 b) {
    u32x4 w; w.x = pk2(a[0], a[1]); w.y = pk2(a[2], a[3]); w.z = pk2(b[0], b[1]); w.w = pk2(b[2], b[3]);
    *(u32x4*)p = w;
}
__device__ __forceinline__ __amdgpu_buffer_rsrc_t wt_rsrc(void* base, unsigned bytes) { return __builtin_amdgcn_make_buffer_rsrc(base, 0, bytes, 0x00020000); }
__device__ __forceinline__ void store8_wt(__amdgpu_buffer_rsrc_t r, unsigned byteoff, f32x4 a, f32x4 b) {
    u32x4 w; w.x = pk2(a[0], a[1]); w.y = pk2(a[2], a[3]); w.z = pk2(b[0], b[1]); w.w = pk2(b[2], b[3]);
    __builtin_amdgcn_raw_buffer_store_b128(w, r, byteoff, 0, 16);
}
__device__ __forceinline__ unsigned q8pk4(f32x4 v) {
#pragma unroll
    for (int i = 0; i < 4; ++i) v[i] = __builtin_amdgcn_fmed3f(v[i], -448.0f, 448.0f);
    unsigned w = 0; w = __builtin_amdgcn_cvt_pk_fp8_f32(v[0], v[1], w, false); w = __builtin_amdgcn_cvt_pk_fp8_f32(v[2], v[3], w, true); return w; }
__device__ __forceinline__ float wave_sum(float v) {
#pragma unroll
    for (int o = 1; o < 64; o <<= 1) v += __shfl_xor(v, o);
    return v;
}
__device__ __forceinline__ float wave_max(float v) {
#pragma unroll
    for (int o = 1; o < 64; o <<= 1) v = fmaxf(v, __shfl_xor(v, o));
    return v;
}
__device__ __forceinline__ float sigmoidf_(float x) { return __builtin_amdgcn_rcpf(1.0f + __expf(-x)); }
__device__ __forceinline__ float siluf_(float x) { return x * __builtin_amdgcn_rcpf(1.0f + __expf(-x)); }

#define XB_TMO      128
#define XB_XCNT(j)  (256  + 64 * (j))
#define XB_XSUB(j)  (1280 + 64 * (j))
#define XB_XGEN(j)  (2304 + 64 * (j))
#define XB_TOP      3328
#define XB_TOPGEN   3392
#define XCD_BAR_WORDS 3456
#define XB_SPIN_CAP (1u << 18)
__device__ __forceinline__ unsigned xb_ld(unsigned* p)              { return __hip_atomic_load(p, __ATOMIC_RELAXED, __HIP_MEMORY_SCOPE_AGENT); }
__device__ __forceinline__ unsigned xb_add(unsigned* p, unsigned v) { return __hip_atomic_fetch_add(p, v, __ATOMIC_RELAXED, __HIP_MEMORY_SCOPE_AGENT); }
__device__ __forceinline__ unsigned xb_xcc_id() { return (unsigned)__builtin_amdgcn_s_getreg((3 << 11) | 20) & 0xFu; }
#define XB_SPIN(cond, bar) do { unsigned _sp = 0; while (cond) { __builtin_amdgcn_s_sleep(1); \
    if ((++_sp & 255u) == 0u) { if (xb_ld(&(bar)[XB_TMO])) break; if (_sp > XB_SPIN_CAP) { atomicAdd(&(bar)[XB_TMO], 1u); break; } } } } while (0)
struct XcdBarrier { unsigned* bar; unsigned x; volatile LAS unsigned* st; };
__device__ __forceinline__ XcdBarrier xcd_barrier_post(unsigned* bar, volatile LAS unsigned* st) {
    XcdBarrier b; b.bar = bar; b.x = xb_xcc_id(); b.st = st;
    if (threadIdx.x == 0) (void)xb_add(&bar[XB_XCNT(b.x)], 1u);
    return b;
}
__device__ __forceinline__ void xcd_barrier_complete(unsigned* bar, unsigned x, unsigned& nloc, unsigned& nx) {
    const unsigned G = gridDim.x * gridDim.y * gridDim.z;
    unsigned sum, cnt, mine, sp = 0u;
    for (;;) {
        sum = 0u; cnt = 0u; mine = 0u;
#pragma unroll
        for (unsigned j = 0; j < 16; ++j) { const unsigned c = xb_ld(&bar[XB_XCNT(j)]); sum += c; cnt += (c > 0u) ? 1u : 0u; mine = (j == x) ? c : mine; }
        if (sum == G) break;
        __builtin_amdgcn_s_sleep(1);
        if ((++sp & 255u) == 0u) { if (xb_ld(&bar[XB_TMO])) break; if (sp > XB_SPIN_CAP) { atomicAdd(&bar[XB_TMO], 1u); break; } }
    }
    nloc = mine > 0u ? mine : 1u; nx = cnt > 0u ? cnt : 1u;
}
__device__ __forceinline__ void xcd_barrier(const XcdBarrier& b) {
    asm volatile("s_waitcnt vmcnt(0)" ::: "memory");
    __syncthreads();
    if (threadIdx.x == 0) {
        unsigned* bar = b.bar;
        __builtin_amdgcn_s_waitcnt(0);
        unsigned nloc = b.st[0], nx = b.st[1];
        if (nloc == 0u) { xcd_barrier_complete(bar, b.x, nloc, nx); b.st[0] = nloc; b.st[1] = nx; }
        const unsigned old = xb_add(&bar[XB_XSUB(b.x)], 1u);
        const unsigned gen = old / nloc;
        if (old + 1u == (gen + 1u) * nloc) {
            __builtin_amdgcn_fence(__ATOMIC_RELEASE, "agent");
            asm volatile("s_waitcnt vmcnt(0)" ::: "memory");
            const unsigned og = xb_add(&bar[XB_TOP], 1u);
            const unsigned tg = og / nx;
            if (og + 1u == (tg + 1u) * nx) xb_add(&bar[XB_TOPGEN], 1u);
            else XB_SPIN(xb_ld(&bar[XB_TOPGEN]) == tg, bar);
            __builtin_amdgcn_fence(__ATOMIC_ACQUIRE, "agent");
            xb_add(&bar[XB_XGEN(b.x)], 1u);
            asm volatile("s_waitcnt vmcnt(0)" ::: "memory");
        } else {
            XB_SPIN(xb_ld(&bar[XB_XGEN(b.x)]) == gen, bar);
            __builtin_amdgcn_fence(__ATOMIC_ACQUIRE, "agent");
            asm volatile("s_waitcnt vmcnt(0)" ::: "memory");
        }
    }
    __syncthreads();
}

struct Args { const float* in[23]; float* out; unsigned char* ws; int ph_lo, ph_hi; int sub, rep; };
struct Ctx {
    int tid, lane, wave, gw, ngw;
    unsigned char* lds;
};

template <class ColPtr, bool OUT8 = false>
__device__ __forceinline__ void transpose_all(const Ctx& c, int& base, ColPtr cp, int ldw, int P, int K, bf16* WT, const float* kscale = nullptr, float oscale = 1.0f) {
    float* scr = (float*)(c.lds + c.wave * 16384);
    const int nkb = K / 64, npb = P / 32, lane = c.lane, nit = nkb * npb;
    int it0 = (c.gw - base) % c.ngw; it0 = it0 < 0 ? it0 + c.ngw : it0; base += nit;
    for (int it = it0; it < nit; it += c.ngw) {
        const int kb = it % nkb, pb = it / nkb, k0 = 64 * kb, p0 = 32 * pb;
        const float* colp = cp(p0 + (lane & 31));
        float tv[32];
#pragma unroll
        for (int i = 0; i < 32; ++i) tv[i] = __builtin_nontemporal_load(colp + (size_t)(k0 + 2 * i + (lane >> 5)) * ldw);
#pragma unroll
        for (int i = 0; i < 32; ++i) scr[(2 * i + (lane >> 5)) * 33 + (lane & 31)] = tv[i];
        __builtin_amdgcn_s_waitcnt(0xC07F); asm volatile("" ::: "memory");
        const int cc = lane & 7;
        f32x4 ks0 = {1.f, 1.f, 1.f, 1.f}, ks1 = {1.f, 1.f, 1.f, 1.f};
        if (kscale) { ks0 = *(const f32x4*)(kscale + k0 + 8 * cc); ks1 = *(const f32x4*)(kscale + k0 + 8 * cc + 4); }
#pragma unroll
        for (int j = 0; j < 4; ++j) { const int n = (lane >> 3) + 8 * j; const float* s = scr + (8 * cc) * 33 + n;
            if constexpr (OUT8) { const f32x4 a = {s[0 * 33] * ks0[0] * oscale, s[1 * 33] * ks0[1] * oscale, s[2 * 33] * ks0[2] * oscale, s[3 * 33] * ks0[3] * oscale},
                                              b = {s[4 * 33] * ks1[0] * oscale, s[5 * 33] * ks1[1] * oscale, s[6 * 33] * ks1[2] * oscale, s[7 * 33] * ks1[3] * oscale};
                *(u32x2*)((unsigned char*)WT + (size_t)(p0 + n) * K + k0 + 8 * cc) = (u32x2){q8pk4(a), q8pk4(b)}; }
            else {
            u32x4 o; o.x = pk2(s[0 * 33] * ks0[0], s[1 * 33] * ks0[1]); o.y = pk2(s[2 * 33] * ks0[2], s[3 * 33] * ks0[3]); o.z = pk2(s[4 * 33] * ks1[0], s[5 * 33] * ks1[1]); o.w = pk2(s[6 * 33] * ks1[2], s[7 * 33] * ks1[3]);
            *(u32x4*)(WT + (size_t)(p0 + n) * K + k0 + 8 * cc) = o; } }
        __builtin_amdgcn_s_waitcnt(0xC07F); asm volatile("" ::: "memory");
    }
}
struct ColPlain { const float* W; __device__ const float* operator()(int p) const { return W + p; } };
struct ColOff { const float* W; int off; __device__ const float* operator()(int p) const { return W + off + p; } };
struct ColWA {
    const float* W;
    __device__ const float* operator()(int p) const {
        if (p < 1024) { const int pp = p & 127; const int d = ((pp & 4) ? 64 : 0) + 4 * (pp >> 3) + (pp & 3); return W + (p & ~127) + d; }
        return W + p;
    }
};
struct ColGU8 { const float* Wg; const float* Wu;
    __device__ const float* operator()(int p) const { const int f = 128 * (p >> 8) + (p & 127); return ((p >> 7) & 1) ? Wu + f : Wg + f; } };
struct ColGU {
    const float* Wg; const float* Wu;
    __device__ const float* operator()(int p) const { const int f = 4 * (p >> 3) + (p & 3); return ((p >> 2) & 1) ? Wu + f : Wg + f; }
};
__device__ __forceinline__ void rms_row_to_bf16(const float* xrow, const float* g, bf16* orow, int lane) {
    const f32x4* xr = (const f32x4*)xrow + lane; const f32x4* gr = (const f32x4*)g + lane;
    f32x4 v[4]; float s = 0.f;
#pragma unroll
    for (int j = 0; j < 4; ++j) { v[j] = xr[64 * j]; s += (v[j].x * v[j].x + v[j].y * v[j].y) + (v[j].z * v[j].z + v[j].w * v[j].w); }
    const float r = 1.0f / sqrtf(wave_sum(s) * (1.f / 1024.f) + RMS_EPS);
    unsigned long long* o8 = (unsigned long long*)orow + lane;
#pragma unroll
    for (int j = 0; j < 4; ++j) { const f32x4 gg = gr[64 * j];
        o8[64 * j] = (unsigned long long)pk2(v[j].x * r * gg.x, v[j].y * r * gg.y) | ((unsigned long long)pk2(v[j].z * r * gg.z, v[j].w * r * gg.w) << 32); }
}

template <class RowPtr, class Epi>
__device__ __forceinline__ void naive_gemm(const Ctx& c, const RowPtr& rp, const bf16* Bt, int ldb, int M, int N, int K, const Epi& epi) {
    const int tilesN = N / 64, tilesM = (M + 7) / 8, lane = c.lane;
    for (int it = c.gw; it < tilesM * tilesN; it += c.ngw) {
        const int tm = it / tilesN, tn = it % tilesN;
        const int row = tm * 8 + (lane >> 3), col0 = tn * 64 + (lane & 7) * 8;
        const bool valid = row < M;
        const bf16* ap = rp(valid ? row : 0);
        float acc[8];
#pragma unroll
        for (int j = 0; j < 8; ++j) acc[j] = 0.f;
        for (int k = 0; k < K; k += 8) {
            float a[8]; unpack8(*(const u32x4*)(ap + k), a);
#pragma unroll
            for (int j = 0; j < 8; ++j) { float b[8]; unpack8(*(const u32x4*)(Bt + (size_t)(col0 + j) * ldb + k), b);
#pragma unroll
                for (int i = 0; i < 8; ++i) acc[j] += a[i] * b[i]; }
        }
        if (valid) epi(row, col0, (f32x4){acc[0], acc[1], acc[2], acc[3]}, (f32x4){acc[4], acc[5], acc[6], acc[7]});
    }
}
struct RowPlain { const bf16* A; int lda; __device__ const bf16* operator()(int r) const { return A + (size_t)r * lda; } };
struct RowGather { const bf16* A; int lda; const int* idx; __device__ const bf16* operator()(int r) const { return A + (size_t)idx[r] * lda; } };

struct EpiProjA {
    bf16 *RQ, *RK, *RV, *RG, *NQ, *NK, *NV, *XQ; const float *COS, *SIN;
    __device__ __forceinline__ void operator()(int row, int col0, f32x4 v0, f32x4 v1) const {
        if (col0 < 1024) {
            const int which = col0 >> 9, cc = col0 & 511, pos = row & (SEQ - 1), q = (cc & 127) >> 3;
            const f32x4 cs = *(const f32x4*)(COS + pos * 64 + 4 * q), sn = *(const f32x4*)(SIN + pos * 64 + 4 * q);
            f32x4 o1 = v0 * cs - v1 * sn, o2 = v0 * sn + v1 * cs;
            if (which == 0) { o1 = o1 * QK_SCALE; o2 = o2 * QK_SCALE; }
            store8((which ? RK : RQ) + (size_t)row * 512 + cc, o1, o2);
        } else if (col0 < 2048) { store8(RV + (size_t)row * 1024 + (col0 - 1024), v0, v1);
        } else if (col0 < 3072) {
            f32x4 a, b;
#pragma unroll
            for (int i = 0; i < 4; ++i) { a[i] = siluf_(v0[i]); b[i] = siluf_(v1[i]); }
            store8(RG + (size_t)row * 1024 + (col0 - 2048), a, b);
        } else if (col0 < 3584) { store8(NQ + (size_t)row * 512 + (col0 - 3072), v0 * 0.125f, v1 * 0.125f);
        } else if (col0 < 4096) { store8(NK + (size_t)row * 512 + (col0 - 3584), v0, v1);
        } else if (col0 < 4608) { store8(NV + (size_t)row * 512 + (col0 - 4096), v0, v1);
        } else { store8(XQ + (size_t)row * 512 + (col0 - 4608), v0 * QK_SCALE, v1 * QK_SCALE); }
    }
};
struct EpiBf16Plain { bf16* O; int ldc; __device__ __forceinline__ void operator()(int row, int col0, f32x4 v0, f32x4 v1) const { store8(O + (size_t)row * ldc + col0, v0, v1); } };
struct EpiSigmoid { bf16* O; int ldc;
    __device__ __forceinline__ void operator()(int row, int col0, f32x4 v0, f32x4 v1) const {
        f32x4 a, b;
#pragma unroll
        for (int i = 0; i < 4; ++i) { a[i] = sigmoidf_(v0[i]); b[i] = sigmoidf_(v1[i]); }
        store8(O + (size_t)row * ldc + col0, a, b); } };
template <int MODE> struct EpiMixNaive { float* TMP; bf16* MIX; const bf16* G;
    __device__ __forceinline__ void operator()(int row, int col0, f32x4 v0, f32x4 v1) const {
        float g[8]; unpack8(*(const u32x4*)(G + (size_t)row * NPG + col0), g);
        f32x4 a = {v0[0] * g[0], v0[1] * g[1], v0[2] * g[2], v0[3] * g[3]}, b = {v1[0] * g[4], v1[1] * g[5], v1[2] * g[6], v1[3] * g[7]};
        float* t = TMP + (size_t)row * DM + col0;
        if (MODE >= 1) { a = a + *(const f32x4*)t; b = b + *(const f32x4*)(t + 4); }
        if (MODE <= 1) { *(f32x4*)t = a; *(f32x4*)(t + 4) = b; } else store8(MIX + (size_t)row * DM + col0, a, b);
    } };
struct EpiResidBf16 { const float* X; bf16* O; unsigned char* Q8;
    __device__ __forceinline__ void operator()(int row, int col0, f32x4 v0, f32x4 v1) const {
        const float* x = X + (size_t)row * DM + col0; const f32x4 a = __builtin_nontemporal_load((const f32x4*)x) + v0, b = __builtin_nontemporal_load((const f32x4*)(x + 4)) + v1;
        const __amdgpu_buffer_rsrc_t ro = wt_rsrc(O, (unsigned)(T * DM * 2));
        const unsigned e = (unsigned)row * DM + (unsigned)col0;
        store8_wt(ro, e * 2u, a, b); *(u32x2*)(Q8 + e) = (u32x2){q8pk4(a), q8pk4(b)}; } };
struct EpiResidF32 { const float* X; float* O;
    __device__ __forceinline__ void operator()(int row, int col0, f32x4 v0, f32x4 v1) const {
        const float* x = X + (size_t)row * DM + col0; float* o = O + (size_t)row * DM + col0;
        *(f32x4*)o = *(const f32x4*)x + v0; *(f32x4*)(o + 4) = *(const f32x4*)(x + 4) + v1; } };
struct EpiSwiGLU { bf16* HID; const float* wl; int rowbase;
    __device__ __forceinline__ void operator()(int row, int col0, f32x4 v0, f32x4 v1) const {
        const float w = wl[row]; f32x4 h;
#pragma unroll
        for (int i = 0; i < 4; ++i) h[i] = siluf_(v0[i]) * v1[i] * w;
        u32x2 o; o.x = pk2(h[0], h[1]); o.y = pk2(h[2], h[3]);
        *(u32x2*)(HID + (size_t)(rowbase + row) * DFF + (col0 >> 1)) = o; } };
struct EpiRowsBf16 { bf16* O; int ldc; int rowbase;
    __device__ __forceinline__ void operator()(int row, int col0, f32x4 v0, f32x4 v1) const { store8(O + (size_t)(rowbase + row) * ldc + col0, v0, v1); } };

namespace pg8 {
constexpr int BM = 256, BK = 64, HALF = 128, HTB = HALF * BK * 2, STAGE_BYTES = 8 * HTB;
__device__ __forceinline__ int lds_byte(int r, int c) { const int st = (r >> 4) * 2 + (c >> 5), rr = r & 15, cc = c & 31, ob = rr * 64 + cc * 2; return st * 1024 + (ob ^ (((ob >> 9) & 1) << 5)); }
__device__ __forceinline__ void stage_rc(int b, int& R, int& C) { const int st = b / 1024, sb = b % 1024, swz = sb ^ (((sb >> 9) & 1) << 5); R = (st >> 1) * 16 + swz / 64; C = (st & 1) * 32 + (swz % 64) / 2; }
__device__ __forceinline__ int perm32(int rho) { const int n = rho >> 4, i = rho & 15; return 8 * (i >> 2) + 4 * n + (i & 3); }

struct UnitDesc {
    const char* A; const char* B;
    unsigned lda2, ldb2;
    int nt;
    int row0, col0;
    int aux, aux2;
    const int* gidx; int gcnt;
    int chain;
};
__device__ __forceinline__ unsigned cvt_pk_bf16(float lo, float hi) { unsigned r; asm volatile("v_cvt_pk_bf16_f32 %0, %1, %2" : "=v"(r) : "v"(lo), "v"(hi)); return r; }

template <int GRP = 1, class F> __device__ __forceinline__ void epi_apply(const f32x4 (&acc)[2][2][4][2], const UnitDesc& u, int wr, int wc, int fr, int fq, const F& f) {
#pragma unroll
    for (int ai = 0; ai < 2; ++ai)
#pragma unroll
        for (int m = 0; m < 4; ++m) { const int row = u.row0 + ai * HALF + wr * 64 + m * 16 + fr;
#pragma unroll
            for (int bj = 0; bj < 2; ++bj) f(row, u.col0 + bj * HALF + wc * 32 + 8 * fq, acc[ai][bj][m][0], acc[ai][bj][m][1]);
            if (((ai * 4 + m) % GRP) == GRP - 1) { asm volatile("" ::: "memory"); __builtin_amdgcn_sched_barrier(0); } }
}

template <bool GATHER> __device__ __forceinline__ void unit_offs(const UnitDesc& u, int tid, unsigned (&oA0)[2], unsigned (&oA1)[2], unsigned (&oB)[2]) {
#pragma unroll
    for (int i = 0; i < 2; ++i) { int R, C; stage_rc(tid * 16 + i * 8192, R, C); const int Rb = (R & ~31) + perm32(R & 31);
        oB[i] = (unsigned)Rb * u.ldb2 + (unsigned)C * 2u;
        if (GATHER && u.gidx) { const int last = u.gcnt - 1; int r0 = u.row0 + R, r1 = r0 + HALF; r0 = r0 < last ? r0 : last; r1 = r1 < last ? r1 : last;
            oA0[i] = (unsigned)u.gidx[r0] * u.lda2 + (unsigned)C * 2u; oA1[i] = (unsigned)u.gidx[r1] * u.lda2 + (unsigned)C * 2u;
        } else { oA0[i] = (unsigned)R * u.lda2 + (unsigned)C * 2u; oA1[i] = 0u; } }
}

typedef int v8i __attribute__((ext_vector_type(8)));
typedef int v4i __attribute__((ext_vector_type(4)));
template <class E> struct EpiSig { static constexpr bool value = false; };
template <bool GATHER, class Sched, class Epi, bool FP8 = false, int AUXA = 0>
__device__ __forceinline__ void gemm_phase(LAS unsigned char* lds, const Sched& S, const Epi& E, int sb = 0, int sclw = 0x7f7f7f7f, int sclx = 0x7f7f7f7f) {
#if PROBE_TS_A >= 0
#define GSTAMP(k) do { if (sb && blockIdx.x == 0 && threadIdx.x == 0) ((volatile LAS unsigned*)(lds + MISC_OFF))[32 + sb + (k)] = (unsigned)__builtin_amdgcn_s_memrealtime(); } while (0)
#else
#define GSTAMP(k) do { } while (0)
#endif
    const int tid = threadIdx.x, wid = __builtin_amdgcn_readfirstlane(tid >> 6), lane = tid & 63, wr = wid >> 2, wc = wid & 3, fr = lane & 15, fq = lane >> 4;
    const unsigned ldsw = (unsigned)wid * 1024u;
    const int aoff = lds_byte(wr * 64 + fr, fq * 8), boff = lds_byte(wc * 32 + fr, fq * 8);
    const int aoff8 = aoff, boff8 = boff;
    const size_t kstep = (size_t)(BK * 2);
#define PG8_SA(b, h) (((b) * 2 + (h)) * HTB)
#define PG8_SB(b, h) ((4 + (b) * 2 + (h)) * HTB)
#define PG8_STAGEX(bufoff, gbase, voff, aux) do { _Pragma("unroll") for (int _i = 0; _i < 2; ++_i) \
        __builtin_amdgcn_global_load_lds((const unsigned*)((const char*)(gbase) + (voff)[_i]), (LAS unsigned*)(lds + (bufoff) + ldsw + _i * 8192), 16, 0, aux); } while (0)
#define PG8_STAGE(bufoff, gbase, voff) PG8_STAGEX(bufoff, gbase, voff, 0)
#define PG8_STAGEA(bufoff, gbase, voff) PG8_STAGEX(bufoff, gbase, voff, AUXA)
#define PG8_LD8(p) __builtin_shufflevector(*(const LAS v4i*)(p), *(const LAS v4i*)((p) + 1024), 0, 1, 2, 3, 4, 5, 6, 7)
#define PG8_LDA(dst, b, h) do { if constexpr (FP8) { _Pragma("unroll") for (int m = 0; m < 4; ++m) dst##8[m] = PG8_LD8(lds + PG8_SA(b, h) + aoff8 + m * 2048); } \
        else { _Pragma("unroll") for (int m = 0; m < 4; ++m) _Pragma("unroll") for (int k = 0; k < 2; ++k) dst[m][k] = *(const LAS bf16x8*)(lds + PG8_SA(b, h) + aoff + m * 2048 + k * 1024); } } while (0)
#define PG8_LDB(dst, b, h) do { if constexpr (FP8) { _Pragma("unroll") for (int n = 0; n < 2; ++n) dst##8[n] = PG8_LD8(lds + PG8_SB(b, h) + boff8 + n * 2048); } \
        else { _Pragma("unroll") for (int n = 0; n < 2; ++n) _Pragma("unroll") for (int k = 0; k < 2; ++k) dst[n][k] = *(const LAS bf16x8*)(lds + PG8_SB(b, h) + boff + n * 2048 + k * 1024); } } while (0)
#define PG8_MMA(ai, bj, At, Bt) do { __builtin_amdgcn_s_setprio(1); \
        if constexpr (FP8) { _Pragma("unroll") for (int m = 0; m < 4; ++m) _Pragma("unroll") for (int n = 0; n < 2; ++n) \
            asm volatile("v_mfma_scale_f32_16x16x128_f8f6f4 %0, %1, %2, %0, %3, %4 op_sel_hi:[0,0,0]" : "+v"(acc[ai][bj][m][n]) : "v"(Bt##8[n]), "v"(At##8[m]), "v"(sclw), "v"(sclx)); } \
        else { _Pragma("unroll") for (int m = 0; m < 4; ++m) _Pragma("unroll") for (int n = 0; n < 2; ++n) _Pragma("unroll") for (int k = 0; k < 2; ++k) \
            acc[ai][bj][m][n] = __builtin_amdgcn_mfma_f32_16x16x32_bf16(Bt[n][k], At[m][k], acc[ai][bj][m][n], 0, 0, 0); } \
        __builtin_amdgcn_s_setprio(0); } while (0)
#define PG8_WAIT_V(n) asm volatile("s_waitcnt vmcnt(" #n ")" ::: "memory")
#define PG8_WAIT_L(n) asm volatile("s_waitcnt lgkmcnt(" #n ")" ::: "memory")
#define PG8_BAR __builtin_amdgcn_s_barrier()
#define PG8_SCHED __builtin_amdgcn_sched_barrier(0)
    UnitDesc cur, nxt; int ui = 0;
    if (!S.next(0, cur)) return;
    f32x4 acc[2][2][4][2];
#pragma unroll
    for (int a = 0; a < 2; ++a)
#pragma unroll
        for (int b = 0; b < 2; ++b)
#pragma unroll
            for (int m = 0; m < 4; ++m)
#pragma unroll
                for (int n = 0; n < 2; ++n) acc[a][b][m][n] = (f32x4){0.f, 0.f, 0.f, 0.f};
    bf16x8 At[4][2], B0[2][2], B1[2][2]; v8i At8[4], B08[2], B18[2];
    unsigned cA0[2], cA1[2], cB[2], nA0[2], nA1[2], nB[2];
    unit_offs<GATHER>(cur, tid, cA0, cA1, cB);
    const char* pA = cur.A; const char* pB = cur.B; size_t hB = (size_t)HALF * cur.ldb2; size_t hA = GATHER ? 0 : (size_t)HALF * cur.lda2;
#define PG8_A1(arr1, arr0) (GATHER ? (arr1) : (arr0))
    PG8_STAGE(PG8_SB(0, 0), pB, cB); PG8_STAGE(PG8_SB(0, 1), pB + hB, cB); PG8_STAGEA(PG8_SA(0, 0), pA, cA0); PG8_STAGEA(PG8_SA(0, 1), pA + hA, PG8_A1(cA1, cA0));
    if (wr == 1) PG8_BAR;
    PG8_WAIT_V(2); PG8_BAR;
    PG8_STAGE(PG8_SB(1, 0), pB + kstep, cB); PG8_STAGEA(PG8_SA(1, 0), pA + kstep, cA0); PG8_STAGE(PG8_SB(1, 1), pB + hB + kstep, cB);
    PG8_WAIT_V(6); PG8_BAR;
    GSTAMP(0);
    for (;;) {
        const bool has_next = S.next(ui + 1, nxt);
        const char* qA = pA; const char* qB = pB; size_t hBn = hB, hAn = hA;
        if (has_next) { unit_offs<GATHER>(nxt, tid, nA0, nA1, nB); qA = nxt.A; qB = nxt.B; hBn = (size_t)HALF * nxt.ldb2; hAn = GATHER ? 0 : (size_t)HALF * nxt.lda2; }
        else {
#pragma unroll
            for (int i = 0; i < 2; ++i) { nA0[i] = cA0[i]; nA1[i] = cA1[i]; nB[i] = cB[i]; } }
        const int nt = cur.nt;
        for (int t = 0; t < nt; t += 2) {
            const bool last = (t == nt - 2);
            const char* a1 = pA + (size_t)(t + 1) * kstep;
            const char* a2 = last ? qA : pA + (size_t)(t + 2) * kstep; const char* b2 = last ? qB : pB + (size_t)(t + 2) * kstep;
            const char* a3 = a2 + kstep; const char* b3 = b2 + kstep;
            unsigned sA0[2], sA1[2], sB[2];
#pragma unroll
            for (int i = 0; i < 2; ++i) { sA0[i] = last ? nA0[i] : cA0[i]; sA1[i] = last ? nA1[i] : cA1[i]; sB[i] = last ? nB[i] : cB[i]; }
            const size_t shB = last ? hBn : hB, shA = last ? hAn : hA;
            PG8_LDB(B0, 0, 0); PG8_LDB(B1, 0, 1); PG8_SCHED; PG8_LDA(At, 0, 0); PG8_STAGEA(PG8_SA(1, 1), a1 + hA, PG8_A1(cA1, cA0));
            PG8_WAIT_V(8); PG8_WAIT_L(0); PG8_BAR; PG8_MMA(0, 0, At, B0); PG8_MMA(0, 1, At, B1); PG8_BAR; PG8_SCHED;
            PG8_LDA(At, 0, 1); PG8_STAGE(PG8_SB(0, 0), b2, sB); PG8_STAGE(PG8_SB(0, 1), b2 + shB, sB); PG8_STAGEA(PG8_SA(0, 0), a2, sA0);
            PG8_WAIT_V(8); PG8_WAIT_L(0); PG8_BAR; PG8_MMA(1, 0, At, B0); PG8_MMA(1, 1, At, B1); PG8_BAR; PG8_SCHED;
            PG8_LDB(B0, 1, 0); PG8_LDB(B1, 1, 1); PG8_SCHED; PG8_LDA(At, 1, 0); PG8_STAGEA(PG8_SA(0, 1), a2 + shA, PG8_A1(sA1, sA0));
            PG8_WAIT_V(8); PG8_WAIT_L(0); PG8_BAR; PG8_MMA(0, 0, At, B0); PG8_MMA(0, 1, At, B1); PG8_BAR; PG8_SCHED;
            PG8_LDA(At, 1, 1); PG8_STAGE(PG8_SB(1, 0), b3, sB); PG8_STAGE(PG8_SB(1, 1), b3 + shB, sB); PG8_STAGEA(PG8_SA(1, 0), a3, sA0);
            PG8_WAIT_V(8); PG8_WAIT_L(0); PG8_BAR; PG8_MMA(1, 0, At, B0); PG8_MMA(1, 1, At, B1); PG8_BAR; PG8_SCHED;
        }
        if (wr == 0) PG8_BAR;
        if constexpr (FP8) asm volatile("s_nop 15\n\ts_nop 15" ::: "memory");
        if (ui == 0) GSTAMP(1);
        E.finish(acc, cur, wr, wc, fr, fq);
        if (ui == 0) GSTAMP(2);
        if constexpr (EpiSig<Epi>::value) { PG8_WAIT_V(0); PG8_BAR; E.signal(cur); }
        if (!has_next) break;
        cur = nxt; pA = qA; pB = qB; hB = hBn; hA = hAn; ++ui;
#pragma unroll
        for (int i = 0; i < 2; ++i) { cA0[i] = nA0[i]; cA1[i] = nA1[i]; cB[i] = nB[i]; }
        if (wr == 1) PG8_BAR;
    }
    PG8_WAIT_V(0);
    PG8_BAR;
    GSTAMP(3);
#undef GSTAMP
#undef PG8_A1
#undef PG8_SA
#undef PG8_SB
#undef PG8_STAGE
#undef PG8_STAGEA
#undef PG8_STAGEX
#undef PG8_LDA
#undef PG8_LD8
#undef PG8_LDB
#undef PG8_MMA
#undef PG8_WAIT_V
#undef PG8_WAIT_L
#undef PG8_BAR
#undef PG8_SCHED
}

__device__ __forceinline__ void zero_acc(f32x4 (&acc)[2][2][4][2]) {
#pragma unroll
    for (int a = 0; a < 2; ++a)
#pragma unroll
        for (int b = 0; b < 2; ++b)
#pragma unroll
            for (int m = 0; m < 4; ++m)
#pragma unroll
                for (int n = 0; n < 2; ++n) acc[a][b][m][n] = (f32x4){0.f, 0.f, 0.f, 0.f};
}
template <class F, int GRP = 1> struct EpiF { F f;
    __device__ __forceinline__ void finish(f32x4 (&acc)[2][2][4][2], const UnitDesc& u, int wr, int wc, int fr, int fq) const { epi_apply<GRP>(acc, u, wr, wc, fr, fq, f); zero_acc(acc); } };

struct TileOrder {
    int nM, nN, nwg, G, c;
    __device__ __forceinline__ void init(int nM_, int nN_, int G_, int c_) { nM = nM_; nN = nN_; nwg = nM * nN; G = G_; c = c_; }
    __device__ __forceinline__ bool tile(int i, int& pm, int& pn) const {
        const long L = (long)i * G + c; if (L >= nwg) return false;
        int wgid = (int)L; { const int q = nwg / 8, r = nwg % 8, xcd = wgid % 8, off = wgid / 8; wgid = (xcd < r ? xcd * (q + 1) : r * (q + 1) + (xcd - r) * q) + off; }
        const int nig = 8 * nN, gid = wgid / nig, fm = gid * 8, gsz = (nM - fm) < 8 ? (nM - fm) : 8;
        pm = fm + ((wgid % nig) % gsz); pn = (wgid % nig) / gsz; return true;
    }
};
struct PlainSched { TileOrder o; const bf16* A; const bf16* Bt; int lda, ldb, K;
    __device__ __forceinline__ bool next(int i, UnitDesc& u) const { int pm, pn; if (!o.tile(i, pm, pn)) return false;
        u.A = (const char*)(A + (size_t)pm * BM * lda); u.B = (const char*)(Bt + (size_t)pn * BM * ldb); u.lda2 = lda * 2; u.ldb2 = ldb * 2; u.nt = K / BK;
        u.row0 = pm * BM; u.col0 = pn * BM; u.aux = 0; u.aux2 = 0; u.gidx = nullptr; u.gcnt = 0; u.chain = 0; return true; } };
}

#if PROBE_TS_A >= 0
#define MXSTAMP(k) do { if (blockIdx.x == 0 && threadIdx.x == 0) ((volatile LAS unsigned*)(lds + MISC_OFF))[32 + (k)] = (unsigned)__builtin_amdgcn_s_memrealtime(); } while (0)
#else
#define MXSTAMP(k) do { } while (0)
#endif
namespace mx {
typedef short s16x4 __attribute__((ext_vector_type(4)));
typedef __bf16 bf16x8_t __attribute__((ext_vector_type(8)));
typedef __bf16 bf16x4_t __attribute__((ext_vector_type(4)));
typedef float f32x8 __attribute__((ext_vector_type(8)));
__device__ __forceinline__ f32x4 mma(bf16x8 a, bf16x8 b, f32x4 c) { return __builtin_amdgcn_mfma_f32_16x16x32_bf16(a, b, c, 0, 0, 0); }
__device__ __forceinline__ bf16x8 ldsf(LAS unsigned char* p) { return *(LAS bf16x8*)p; }
__device__ __forceinline__ bf16x8 glbf(const bf16* p) { return *(const bf16x8*)p; }
__device__ __forceinline__ bf16x8 glbf_nt(const bf16* p) { return __builtin_nontemporal_load((const bf16x8*)p); }
__device__ __forceinline__ bf16x8 trf(LAS unsigned char* p0, LAS unsigned char* p1) {
    const s16x4 a = __builtin_amdgcn_ds_read_tr16_b64_v4i16((LAS s16x4*)p0), b = __builtin_amdgcn_ds_read_tr16_b64_v4i16((LAS s16x4*)p1);
    return __builtin_shufflevector(a, b, 0, 1, 2, 3, 4, 5, 6, 7);
}
__device__ __forceinline__ bf16x8 pack8(f32x4 a, f32x4 b) { const f32x8 v = {a[0], a[1], a[2], a[3], b[0], b[1], b[2], b[3]}; return __builtin_bit_cast(bf16x8, __builtin_convertvector(v, bf16x8_t)); }
__device__ __forceinline__ u32x2 pack4(f32x4 a) { return __builtin_bit_cast(u32x2, __builtin_convertvector(a, bf16x4_t)); }
__device__ __forceinline__ float red_g_max(float v) { v = fmaxf(v, __shfl_xor(v, 16)); return fmaxf(v, __shfl_xor(v, 32)); }
__device__ __forceinline__ float red_g_sum(float v) { v += __shfl_xor(v, 16); return v + __shfl_xor(v, 32); }

__device__ __forceinline__ int vblock() { const int G = (int)gridDim.x, bx = (int)blockIdx.x; return (G % 8 == 0) ? (bx % 8) * (G / 8) + bx / 8 : bx; }
constexpr int XA_KP = 272, XA_VP = 288, XA_VOFF = 256 * XA_KP;
__device__ __forceinline__ void xa_phase(LAS unsigned char* lds, bf16* XQ, const bf16* MKV) {
    const int tid = threadIdx.x, lane = tid & 63, wave = __builtin_amdgcn_readfirstlane(tid >> 6), g = lane >> 4, li = lane & 15, q4 = li >> 2, p4 = li & 3;
    for (int it = vblock(); it < NB * 4 * 8; it += gridDim.x) {
        const int b = it >> 5, h = (it >> 3) & 3, qb = it & 7;
        __syncthreads();
        bf16x8 qfa[2][4];
#pragma unroll
        for (int qi = 0; qi < 2; ++qi) { const bf16* qr = XQ + (size_t)(b * SEQ + qb * 256 + wave * 32 + qi * 16 + li) * 512 + h * 128;
#pragma unroll
            for (int s = 0; s < 4; ++s) qfa[qi][s] = glbf(qr + 32 * s + 8 * g); }
#pragma unroll
        for (int i = 0; i < 8; ++i) { const int id = tid + 512 * i, row = id >> 4, ch = id & 15; const bf16* src = MKV + (size_t)(b * MEML + row) * 1024 + h * 128 + ch * 8;
            *(LAS u32x4*)(lds + row * XA_KP + ch * 16) = *(const u32x4*)src; *(LAS u32x4*)(lds + XA_VOFF + row * XA_VP + ch * 16) = *(const u32x4*)(src + 512); }
        __syncthreads();
#pragma unroll 1
        for (int qi = 0; qi < 2; ++qi) {
            bf16* qrow = XQ + (size_t)(b * SEQ + qb * 256 + wave * 32 + qi * 16 + li) * 512 + h * 128;
            bf16x8 qf[4];
#pragma unroll
            for (int s = 0; s < 4; ++s) qf[s] = qi ? qfa[1][s] : qfa[0][s];
            f32x4 st[16]; float mx = -3.0e38f;
#pragma unroll
            for (int kf = 0; kf < 16; ++kf) { f32x4 a = {0.f, 0.f, 0.f, 0.f};
#pragma unroll
                for (int s = 0; s < 4; ++s) a = mma(ldsf(lds + (16 * kf + li) * XA_KP + (32 * s + 8 * g) * 2), qf[s], a);
                st[kf] = a; mx = fmaxf(mx, fmaxf(fmaxf(a[0], a[1]), fmaxf(a[2], a[3]))); __builtin_amdgcn_sched_barrier(0); }
            mx = red_g_max(mx); float sum = 0.f;
#pragma unroll
            for (int kf = 0; kf < 16; ++kf) {
#pragma unroll
                for (int r = 0; r < 4; ++r) { const float e = __expf(st[kf][r] - mx); st[kf][r] = e; sum += e; } }
            sum = red_g_sum(sum); const float inv = 1.0f / sum;
            f32x4 o[8];
#pragma unroll
            for (int df = 0; df < 8; ++df) o[df] = (f32x4){0.f, 0.f, 0.f, 0.f};
#pragma unroll
            for (int x = 0; x < 8; ++x) { const bf16x8 pf = pack8(st[2 * x], st[2 * x + 1]);
                LAS unsigned char* vb = lds + XA_VOFF + (32 * x + 4 * g + q4) * XA_VP + 8 * p4;
#pragma unroll
                for (int df = 0; df < 8; ++df) o[df] = mma(trf(vb + 32 * df, vb + 16 * XA_VP + 32 * df), pf, o[df]); __builtin_amdgcn_sched_barrier(0); }
#pragma unroll
            for (int df = 0; df < 8; ++df) *(u32x2*)(qrow + 16 * df + 4 * g) = pack4(o[df] * inv);
        }
    }
}

constexpr int NA_KP = 144, NA_VP = 136, NA_VOFF = 576 * NA_KP;
struct NaItem { int b, h, krmin, r, rs; };
__device__ __forceinline__ NaItem na_item(int it, int ri) { NaItem a; a.b = it >> 7; a.h = (it >> 4) & 7; const int rp = it & 15;
    int k = 2 * rp - 4; a.krmin = k < 0 ? 0 : (k > 24 ? 24 : k); a.r = 2 * rp + ri; int rs = a.r - 4; a.rs = rs < 0 ? 0 : (rs > 24 ? 24 : rs); return a; }
__device__ __forceinline__ void na_load_kv(u32x4 (&kv)[9], u32x4 (&vv)[9], const NaItem& a, const bf16* NK, const bf16* NV, int tid) {
#pragma unroll
    for (int i = 0; i < 9; ++i) { const int id = tid + 512 * i, trow = id >> 3, ch = id & 7; int kr = a.krmin + (trow >> 6); kr = kr > 31 ? 31 : kr;
        const size_t off = (size_t)(a.b * SEQ + kr * 64 + (trow & 63)) * 512 + a.h * 64 + ch * 8; kv[i] = *(const u32x4*)(NK + off); vv[i] = *(const u32x4*)(NV + off); }
}
__device__ __forceinline__ void na_phase(LAS unsigned char* lds, bf16* NQ, const bf16* NK, const bf16* NV, const bf16* FT) {
    const int tid = threadIdx.x, lane = tid & 63, wave = __builtin_amdgcn_readfirstlane(tid >> 6), g = lane >> 4, li = lane & 15, q4 = li >> 2, p4 = li & 3;
    const int ri = wave >> 2, qf = wave & 3, c0 = 16 * qf, w0 = qf == 0 ? 0 : (qf == 1 ? 8 : (qf == 2 ? 24 : 32));
    const int G = (int)gridDim.x, lite = G > 64 ? 32 : 0; const bool isl = (int)blockIdx.x < lite;
    int vnl = (int)blockIdx.x - lite;
    if (lite && G % 8 == 0) { const int x = (int)blockIdx.x % 8, q = (int)blockIdx.x / 8 - lite / 8; vnl = x * ((G - lite) / 8) + q; }
    const int it0 = isl ? (int)blockIdx.x : lite + vnl, itstep = isl ? NB * 8 * 16 : G - lite;
    if (it0 >= NB * 8 * 16) return;
    NaItem cur = na_item(it0, ri);
    u32x4 kv[9], vv[9]; bf16x8 ff[16]; bf16x8 q0, q1;
    na_load_kv(kv, vv, cur, NK, NV, tid);
#pragma unroll
    for (int f = 0; f < 16; ++f) ff[f] = glbf(FT + ((size_t)((cur.h * 15 + (cur.rs + (f >> 1) - cur.r + 7)) * 64 + w0 + 16 * (f & 1) + li)) * 64 + (c0 & 32) + 8 * g);
    { const bf16* qr = NQ + (size_t)(cur.b * SEQ + cur.r * 64 + c0 + li) * 512 + cur.h * 64; q0 = glbf(qr + 8 * g); q1 = glbf(qr + 32 + 8 * g); }
    bf16x8 e1;
#pragma unroll
    for (int j = 0; j < 8; ++j) e1[j] = (8 * g + j == ((c0 + li) & 31)) ? (short)0x3F80 : (short)0;
#pragma unroll 1
    for (int it = it0;;) {
        __syncthreads();
#pragma unroll
        for (int i = 0; i < 9; ++i) { const int id = tid + 512 * i, trow = id >> 3, ch = id & 7;
            *(LAS u32x4*)(lds + trow * NA_KP + ch * 16) = kv[i];
            *(LAS u32x2*)(lds + NA_VOFF + trow * NA_VP + ch * 16) = (u32x2){vv[i].x, vv[i].y}; *(LAS u32x2*)(lds + NA_VOFF + trow * NA_VP + ch * 16 + 8) = (u32x2){vv[i].z, vv[i].w}; }
        __syncthreads();
        const int itn = it + itstep; const bool has_next = itn < NB * 8 * 16; const NaItem nx = na_item(has_next ? itn : it, ri);
        if (has_next) na_load_kv(kv, vv, nx, NK, NV, tid);
        const int rs = cur.rs, krmin = cur.krmin;
        f32x4 st[16]; float mx = -3.0e38f;
#pragma unroll
        for (int kri = 0; kri < 8; ++kri) {
#pragma unroll
            for (int cf = 0; cf < 2; ++cf) { LAS unsigned char* kp = lds + ((rs + kri - krmin) * 64 + w0 + 16 * cf + li) * NA_KP + 16 * g;
                f32x4 a = {0.f, 0.f, 0.f, 0.f};
                a = mma(ldsf(kp), q0, a); a = mma(ldsf(kp + 64), q1, a); a = mma(ff[kri * 2 + cf], e1, a);
                st[kri * 2 + cf] = a; mx = fmaxf(mx, fmaxf(fmaxf(a[0], a[1]), fmaxf(a[2], a[3]))); }
            __builtin_amdgcn_sched_barrier(0); }
        bf16* qrow = NQ + (size_t)(cur.b * SEQ + cur.r * 64 + c0 + li) * 512 + cur.h * 64;
        if (has_next) {
#pragma unroll
            for (int f = 0; f < 8; ++f) ff[f] = glbf(FT + ((size_t)((nx.h * 15 + (nx.rs + (f >> 1) - nx.r + 7)) * 64 + w0 + 16 * (f & 1) + li)) * 64 + (c0 & 32) + 8 * g);
            const bf16* qr = NQ + (size_t)(nx.b * SEQ + nx.r * 64 + c0 + li) * 512 + nx.h * 64; q0 = glbf(qr + 8 * g); q1 = glbf(qr + 32 + 8 * g); }
        mx = red_g_max(mx); float sum = 0.f;
#pragma unroll
        for (int f = 0; f < 16; ++f) {
#pragma unroll
            for (int rr = 0; rr < 4; ++rr) { const float e = __expf(st[f][rr] - mx); st[f][rr] = e; sum += e; } }
        sum = red_g_sum(sum); const float inv = 1.0f / sum;
        f32x4 o[4];
#pragma unroll
        for (int df = 0; df < 4; ++df) o[df] = (f32x4){0.f, 0.f, 0.f, 0.f};
#pragma unroll
        for (int x = 0; x < 8; ++x) { const bf16x8 pf = pack8(st[2 * x], st[2 * x + 1]);
            LAS unsigned char* vb = lds + NA_VOFF + ((rs + x - krmin) * 64 + w0 + 4 * g + q4) * NA_VP + 8 * p4;
#pragma unroll
            for (int df = 0; df < 4; ++df) o[df] = mma(trf(vb + 32 * df, vb + 16 * NA_VP + 32 * df), pf, o[df]); __builtin_amdgcn_sched_barrier(0); }
#pragma unroll
        for (int df = 0; df < 4; ++df) *(u32x2*)(qrow + 16 * df + 4 * g) = pack4(o[df] * inv);
        if (!has_next) break;
#pragma unroll
        for (int f = 8; f < 16; ++f) ff[f] = glbf(FT + ((size_t)((nx.h * 15 + (nx.rs + (f >> 1) - nx.r + 7)) * 64 + w0 + 16 * (f & 1) + li)) * 64 + (c0 & 32) + 8 * g);
        cur = nx; it = itn;
    }
}

constexpr int RT_P = 272, RT_VP = 544, RT_QOFF = 0, RT_KOFF = 128 * RT_P, RT_VOFF = 2 * 128 * RT_P, RT_RED = RT_VOFF + 128 * RT_VP, RT_STAT = RT_RED + 8 * 128 * 8;
__device__ __forceinline__ void ret_out_phase(LAS unsigned char* lds, const bf16* RQ, const bf16* RK, const bf16* RV, bf16* RG, const bf16* ST, const float* gain, const float* decf, const float* decb) {
    const int tid0 = threadIdx.x, lane = tid0 & 63, wave = __builtin_amdgcn_readfirstlane(tid0 >> 6), g = lane >> 4, li = lane & 15, q4 = li >> 2, p4 = li & 3;
    u32x4 qreg[4], kreg[4];
    if ((int)blockIdx.x < NB * 4 * 16) { const int it = blockIdx.x, b = it >> 6, h = (it >> 4) & 3, n = it & 15; const size_t tok0 = (size_t)b * SEQ + n * 128;
        const bf16* qb = RQ + tok0 * 512 + h * 128; const bf16* kb = RK + tok0 * 512 + h * 128;
#pragma unroll
        for (int i = 0; i < 4; ++i) { const unsigned id = (unsigned)tid0 + 512u * i, off = (id >> 4) * 512u + (id & 15u) * 8u; qreg[i] = __builtin_nontemporal_load((const u32x4*)(qb + off)); kreg[i] = __builtin_nontemporal_load((const u32x4*)(kb + off)); } }
    for (int it = blockIdx.x; it < NB * 4 * 16; it += gridDim.x) {
        const int b = it >> 6, h = (it >> 4) & 3, n = it & 15; const size_t tok0 = (size_t)b * SEQ + n * 128;
        int tid = tid0; asm volatile("" : "+v"(tid));
        int lio = li; asm volatile("" : "+v"(lio));
        const float lgf = -log1pf(expf(-decf[h])), lgb = -log1pf(expf(-decb[h]));
        const bf16* sfb = ST + ((size_t)(((b * 4 + h) * 2 + 0) * 16 + n) * 256 + 32 * wave) * 128;
        const bf16* sbb = ST + ((size_t)(((b * 4 + h) * 2 + 1) * 16 + n) * 256 + 32 * wave) * 128;
        const unsigned soff = (unsigned)li * 128u + 8u * (unsigned)g;
        __syncthreads();
        u32x4 vreg[8];
        { const bf16* vb0 = RV + tok0 * 1024 + h * 256;
#pragma unroll
          for (int i = 0; i < 8; ++i) { const unsigned id = (unsigned)tid + 512u * i, off = (id >> 5) * 1024u + (id & 31u) * 8u; vreg[i] = __builtin_nontemporal_load((const u32x4*)(vb0 + off)); } }
        __builtin_amdgcn_sched_barrier(0);
#pragma unroll
        for (int i = 0; i < 4; ++i) { const int id = tid + 512 * i, row = id >> 4, ch = id & 15;
            *(LAS u32x4*)(lds + RT_QOFF + row * RT_P + ch * 16) = qreg[i]; *(LAS u32x4*)(lds + RT_KOFF + row * RT_P + ch * 16) = kreg[i]; }
        __builtin_amdgcn_sched_barrier(0);
        bf16x8 sf[2][4];
        if (it == (int)blockIdx.x) MXSTAMP(25);
#pragma unroll
        for (int a = 0; a < 2; ++a)
#pragma unroll
            for (int s = 0; s < 4; ++s) sf[a][s] = glbf_nt(sfb + (soff + a * 16 * 128 + 32 * s));
        __syncthreads();
        if (it == (int)blockIdx.x) MXSTAMP(26);
        bf16x8 sb[2][4];
        { bf16x8 qf[4];
#pragma unroll
          for (int s = 0; s < 4; ++s) qf[s] = ldsf(lds + RT_QOFF + (16 * wave + li) * RT_P + (32 * s + 8 * g) * 2);
          f32x4 st[8]; const int pi = 16 * wave + lio;
#pragma unroll
          for (int jf = 0; jf < 8; ++jf) { f32x4 a = {0.f, 0.f, 0.f, 0.f};
#pragma unroll
              for (int s = 0; s < 4; ++s) a = mma(ldsf(lds + RT_KOFF + (16 * jf + li) * RT_P + (32 * s + 8 * g) * 2), qf[s], a);
#pragma unroll
              for (int r = 0; r < 4; ++r) { const int pj = 16 * jf + 4 * g + r; a[r] *= (pj <= pi) ? __expf((float)(pi - pj) * lgf) : __expf((float)(pj - pi) * lgb); }
              st[jf] = a; __builtin_amdgcn_sched_barrier(0); }
#pragma unroll
          for (int i = 0; i < 8; ++i) { const int id = tid + 512 * i, row = id >> 5, ch = id & 31; *(LAS u32x4*)(lds + RT_VOFF + row * RT_VP + ch * 16) = vreg[i]; }
          __syncthreads();
#pragma unroll
          for (int a = 0; a < 2; ++a)
#pragma unroll
              for (int s = 0; s < 4; ++s) sb[a][s] = glbf_nt(sbb + (soff + a * 16 * 128 + 32 * s));
#pragma unroll
          for (int jf = 0; jf < 8; ++jf) *(LAS u32x2*)(lds + RT_KOFF + pi * RT_P + (16 * jf + 4 * g) * 2) = pack4(st[jf]);
        }
        __syncthreads();
        if (it == (int)blockIdx.x) MXSTAMP(27);
        f32x4 y[2][8];
#pragma unroll
        for (int a = 0; a < 2; ++a)
#pragma unroll
            for (int i = 0; i < 8; ++i) y[a][i] = (f32x4){0.f, 0.f, 0.f, 0.f};
        {
#pragma unroll
          for (int i = 0; i < 8; ++i) {
#pragma unroll
              for (int s = 0; s < 4; ++s) { const bf16x8 qfr = ldsf(lds + RT_QOFF + (16 * i + li) * RT_P + (32 * s + 8 * g) * 2); y[0][i] = mma(sf[0][s], qfr, y[0][i]); y[1][i] = mma(sf[1][s], qfr, y[1][i]); }
              const int pi = 16 * i + lio; const float ratio = __expf((float)(pi + 1) * lgf - (float)(128 - pi) * lgb);
              y[0][i] = y[0][i] * ratio; y[1][i] = y[1][i] * ratio; __builtin_amdgcn_sched_barrier(0); } }
        if (it == (int)blockIdx.x) MXSTAMP(28);
        { const int itn = it + (int)gridDim.x < NB * 4 * 16 ? it + (int)gridDim.x : it;
            const int bn = itn >> 6, hn = (itn >> 4) & 3, nn = itn & 15; const size_t tokn = (size_t)bn * SEQ + nn * 128;
            const bf16* qb = RQ + tokn * 512 + hn * 128; const bf16* kb = RK + tokn * 512 + hn * 128;
#pragma unroll
            for (int i = 0; i < 4; ++i) { const unsigned id = (unsigned)tid + 512u * i, off = (id >> 4) * 512u + (id & 15u) * 8u; qreg[i] = __builtin_nontemporal_load((const u32x4*)(qb + off)); kreg[i] = __builtin_nontemporal_load((const u32x4*)(kb + off)); } }
        {
#pragma unroll
          for (int i = 0; i < 8; ++i) {
#pragma unroll
              for (int s = 0; s < 4; ++s) { const bf16x8 qfr = ldsf(lds + RT_QOFF + (16 * i + li) * RT_P + (32 * s + 8 * g) * 2); y[0][i] = mma(sb[0][s], qfr, y[0][i]); y[1][i] = mma(sb[1][s], qfr, y[1][i]); }
              const int pi = 16 * i + lio; const float ab = __expf((float)(128 - pi) * lgb);
              y[0][i] = y[0][i] * ab; y[1][i] = y[1][i] * ab; __builtin_amdgcn_sched_barrier(0); } }
        if (it == (int)blockIdx.x) MXSTAMP(29);
#pragma unroll
        for (int x = 0; x < 4; ++x) {
            LAS unsigned char* vb = lds + RT_VOFF + (32 * x + 8 * g + q4) * RT_VP + (32 * wave) * 2 + 8 * p4;
            const bf16x8 v0 = trf(vb, vb + 4 * RT_VP), v1 = trf(vb + 32, vb + 4 * RT_VP + 32);
#pragma unroll
            for (int i = 0; i < 8; ++i) { const bf16x8 pfr = ldsf(lds + RT_KOFF + (16 * i + li) * RT_P + (32 * x + 8 * g) * 2); y[0][i] = mma(v0, pfr, y[0][i]); y[1][i] = mma(v1, pfr, y[1][i]); } __builtin_amdgcn_sched_barrier(0); }
        if (it == (int)blockIdx.x) MXSTAMP(30);
        u32x2 gvv[8][2];
        { const bf16* gb = RG + tok0 * 1024 + h * 256 + 32 * wave;
#pragma unroll
          for (int i = 0; i < 8; ++i)
#pragma unroll
              for (int a = 0; a < 2; ++a) gvv[i][a] = __builtin_nontemporal_load((const u32x2*)(gb + ((unsigned)(16 * i + li) * 1024u + 4u * (unsigned)g + 16u * a))); }
#pragma unroll
        for (int i = 0; i < 8; ++i) { float s1 = 0.f, s2 = 0.f;
#pragma unroll
            for (int a = 0; a < 2; ++a)
#pragma unroll
                for (int r = 0; r < 4; ++r) { const float v = y[a][i][r]; s1 += v; s2 += v * v; }
            s1 = red_g_sum(s1); s2 = red_g_sum(s2);
            if (g == 0) { LAS float* rp = (LAS float*)(lds + RT_RED) + (wave * 128 + 16 * i + li) * 2; rp[0] = s1; rp[1] = s2; } }
        __syncthreads();
        if (tid < 128) { float s1 = 0.f, s2 = 0.f;
#pragma unroll
            for (int w = 0; w < 8; ++w) { const LAS float* rp = (const LAS float*)(lds + RT_RED) + (w * 128 + tid) * 2; s1 += rp[0]; s2 += rp[1]; }
            const float mu = s1 * (1.f / 256.f); const float var = fmaxf(s2 * (1.f / 256.f) - mu * mu, 0.f);
            LAS float* sp = (LAS float*)(lds + RT_STAT) + tid * 2; sp[0] = mu; sp[1] = 1.0f / sqrtf(var + GN_EPS); }
        __syncthreads();
        if (it == (int)blockIdx.x) MXSTAMP(31);
        const f32x4 gn0 = *(const f32x4*)(gain + h * 256 + 32 * wave + 4 * g), gn1 = *(const f32x4*)(gain + h * 256 + 32 * wave + 16 + 4 * g);
#pragma unroll
        for (int i = 0; i < 8; ++i) { const LAS float* sp = (const LAS float*)(lds + RT_STAT) + (16 * i + li) * 2; const float mu = sp[0], rstd = sp[1];
            bf16* gp = (RG + tok0 * 1024 + h * 256 + 32 * wave) + ((unsigned)(16 * i + li) * 1024u + 4u * (unsigned)g);
#pragma unroll
            for (int a = 0; a < 2; ++a) { const u32x2 gv = gvv[i][a]; const f32x4 gg = a ? gn1 : gn0;
                f32x4 o; o[0] = (y[a][i][0] - mu) * rstd * gg[0] * bf2f(gv.x & 0xffffu); o[1] = (y[a][i][1] - mu) * rstd * gg[1] * bf2f(gv.x >> 16);
                o[2] = (y[a][i][2] - mu) * rstd * gg[2] * bf2f(gv.y & 0xffffu); o[3] = (y[a][i][3] - mu) * rstd * gg[3] * bf2f(gv.y >> 16);
                *(u32x2*)(gp + 16 * a) = pack4(o); } }
    }
}

constexpr int RS_KP = 272, RS_VP = 144, RS_VOFF = 128 * RS_KP;
__device__ __forceinline__ void ret_state_phase(LAS unsigned char* lds, const bf16* RK, const bf16* RV, bf16* ST, const float* decf, const float* decb) {
    const int tid = threadIdx.x, lane = tid & 63, wave = __builtin_amdgcn_readfirstlane(tid >> 6), g = lane >> 4, li = lane & 15, q4 = li >> 2, p4 = li & 3;
    for (int it = vblock(); it < NB * 4 * 2 * 4; it += gridDim.x) {
        const int es = it & 3, dir = (it >> 2) & 1, h = (it >> 3) & 3, b = it >> 5;
        const float lg = -log1pf(expf(-(dir ? decb[h] : decf[h]))); const float cd = __expf(128.f * lg);
        f32x4 st[4];
#pragma unroll
        for (int ef = 0; ef < 4; ++ef) st[ef] = (f32x4){0.f, 0.f, 0.f, 0.f};
        u32x4 kq[4], vq[2];
        { const size_t tk = (size_t)b * SEQ + (dir ? 15 : 0) * 128;
#pragma unroll
          for (int i = 0; i < 4; ++i) { const int id = tid + 512 * i, row = id >> 4, ch = id & 15; kq[i] = __builtin_nontemporal_load((const u32x4*)(RK + (tk + row) * 512 + h * 128 + ch * 8)); }
#pragma unroll
          for (int i = 0; i < 2; ++i) { const int id = tid + 512 * i, row = id >> 3, ch = id & 7; vq[i] = __builtin_nontemporal_load((const u32x4*)(RV + (tk + row) * 1024 + h * 256 + es * 64 + ch * 8)); } }
#pragma unroll 1
        for (int cc = 0; cc < 16; ++cc) { const int n = dir ? 15 - cc : cc;
            bf16* sp = ST + ((size_t)(((b * 4 + h) * 2 + dir) * 16 + n) * 256 + es * 64 + li) * 128 + 16 * wave + 4 * g;
#pragma unroll
            for (int ef = 0; ef < 4; ++ef) *(u32x2*)(sp + (size_t)16 * ef * 128) = pack4(st[ef]);
            __syncthreads();
#pragma unroll
            for (int i = 0; i < 4; ++i) { const int id = tid + 512 * i, row = id >> 4, ch = id & 15;
                float v[8]; unpack8(kq[i], v);
                const float w = __expf((float)(dir ? row : 127 - row) * lg);
                u32x4 o; o.x = pk2(v[0] * w, v[1] * w); o.y = pk2(v[2] * w, v[3] * w); o.z = pk2(v[4] * w, v[5] * w); o.w = pk2(v[6] * w, v[7] * w);
                *(LAS u32x4*)(lds + row * RS_KP + ch * 16) = o; }
#pragma unroll
            for (int i = 0; i < 2; ++i) { const int id = tid + 512 * i, row = id >> 3, ch = id & 7; *(LAS u32x4*)(lds + RS_VOFF + row * RS_VP + ch * 16) = vq[i]; }
            if (cc < 15) { const int n2 = dir ? 14 - cc : cc + 1; const size_t tk = (size_t)b * SEQ + n2 * 128;
#pragma unroll
                for (int i = 0; i < 4; ++i) { const int id = tid + 512 * i, row = id >> 4, ch = id & 15; kq[i] = __builtin_nontemporal_load((const u32x4*)(RK + (tk + row) * 512 + h * 128 + ch * 8)); }
#pragma unroll
                for (int i = 0; i < 2; ++i) { const int id = tid + 512 * i, row = id >> 3, ch = id & 7; vq[i] = __builtin_nontemporal_load((const u32x4*)(RV + (tk + row) * 1024 + h * 256 + es * 64 + ch * 8)); } }
            __syncthreads();
#pragma unroll
            for (int ef = 0; ef < 4; ++ef) st[ef] = st[ef] * cd;
#pragma unroll
            for (int x = 0; x < 4; ++x) {
                LAS unsigned char* kb = lds + (32 * x + 8 * g + q4) * RS_KP + (16 * wave) * 2 + 8 * p4;
                const bf16x8 kfr = trf(kb, kb + 4 * RS_KP);
                LAS unsigned char* vb = lds + RS_VOFF + (32 * x + 8 * g + q4) * RS_VP + 8 * p4;
#pragma unroll
                for (int ef = 0; ef < 4; ++ef) st[ef] = mma(kfr, trf(vb + 32 * ef, vb + 4 * RS_VP + 32 * ef), st[ef]); __builtin_amdgcn_sched_barrier(0); }
        }
    }
}
__device__ __forceinline__ void memkv_phase(const bf16* MN, const bf16* WKV, bf16* MKV) {
    const int tid = threadIdx.x, lane = tid & 63, wave = __builtin_amdgcn_readfirstlane(tid >> 6), g = lane >> 4, li = lane & 15;
    for (int it = blockIdx.x; it < 256; it += gridDim.x) {
        const int r0 = (it >> 4) * 128 + wave * 16, c0 = (it & 15) * 64;
        const bf16* ap = MN + (size_t)(r0 + li) * 1024 + 8 * g; const bf16* bp = WKV + (size_t)(c0 + li) * 1024 + 8 * g;
        f32x4 acc[4];
#pragma unroll
        for (int nf = 0; nf < 4; ++nf) acc[nf] = (f32x4){0.f, 0.f, 0.f, 0.f};
#pragma unroll 4
        for (int s = 0; s < 32; ++s) { const bf16x8 a = glbf(ap + 32 * s);
#pragma unroll
            for (int nf = 0; nf < 4; ++nf) acc[nf] = mma(glbf(bp + (size_t)nf * 16 * 1024 + 32 * s), a, acc[nf]); }
#pragma unroll
        for (int nf = 0; nf < 4; ++nf) *(u32x2*)(MKV + (size_t)(r0 + li) * 1024 + c0 + 16 * nf + 4 * g) = pack4(acc[nf]);
    }
}
}


struct Ptrs {
    const float* in[23]; float* out; unsigned char* ws;
    __device__ bf16* b(size_t off) const { return (bf16*)(ws + off); }
    __device__ unsigned char* wguq() const { return (unsigned char*)out; }
    __device__ unsigned char* wdq() const { return (unsigned char*)out + 16 * MiB; }
    __device__ unsigned char* x1q() const { return (unsigned char*)out + 24 * MiB; }
    __device__ bf16* wgu() const { return (bf16*)out; }
    __device__ bf16* wd() const { return (bf16*)((unsigned char*)out + 32 * MiB); }
    __device__ float* f(size_t off) const { return (float*)(ws + off); }
};

__device__ __forceinline__ void phase0(const Ctx& c, const Ptrs& P) {
    int tb = 0;
    transpose_all(c, tb, ColWA{P.in[3]}, 8192, NPA, 1024, P.b(WS_WA));
    transpose_all<ColOff, true>(c, tb, ColOff{P.in[3], NPA}, 8192, NPG, 1024, P.b(WS_WG), nullptr, 32.0f);
    transpose_all(c, tb, ColPlain{P.in[11]}, 1024, 1024, 1024, P.b(WS_WKV));
    transpose_all(c, tb, ColPlain{P.in[7]}, 1024, 1024, 1024, P.b(WS_WRO));
    transpose_all(c, tb, ColPlain{P.in[9]}, 1024, 1024, 512, P.b(WS_WNO));
    transpose_all(c, tb, ColPlain{P.in[12]}, 1024, 1024, 512, P.b(WS_WXO));
    transpose_all(c, tb, ColPlain{P.in[13]}, 1024, 1024, 1024, P.b(WS_WOUT));
    { float* COS = P.f(WS_COS); float* SIN = P.f(WS_SIN);
      for (int i = c.gw * 64 + c.lane; i < SEQ * 64; i += c.ngw * 64) { const int pos = i >> 6, fi = i & 63;
          const float inv = (float)pow(10000.0, -(double)fi / 64.0); const float ang = (float)pos * inv;
          COS[i] = (float)cos((double)ang); SIN[i] = (float)sin((double)ang); } }
    { bf16* FT = P.b(WS_FT); const float* rpb = P.in[8];
      for (int i = c.gw * 64 + c.lane; i < 8 * 15 * 64 * 64; i += c.ngw * 64) { const int qc = i & 63, kc = (i >> 6) & 63, hr = i >> 12;
          int cs = qc - 8; cs = cs < 0 ? 0 : (cs > 48 ? 48 : cs); int rc = kc - qc; rc = rc < -15 ? -15 : (rc > 15 ? 15 : rc);
          const float v = (kc >= cs && kc < cs + 16) ? rpb[hr * 31 + rc + 15] : -1.0e30f; FT[i] = (bf16)f2bf(v); } }
    { float* WTR = P.f(WS_WTR); const float* wrg = P.in[15]; const float* wre = P.in[17];
      for (int i = c.gw * 64 + c.lane; i < 20 * 1024; i += c.ngw * 64) { const int n = i >> 10, k = i & 1023; WTR[i] = n < 4 ? wrg[k * 4 + n] : wre[k * 16 + (n - 4)]; } }
    { bf16* WF = P.b(WS_WF); const float* wrg = P.in[15]; const float* wre = P.in[17]; const float* gf = P.in[14];
      for (int i = c.gw * 64 + c.lane; i < 2 * 2 * 32 * 64 * 8; i += c.ngw * 64) { const int j = i & 7, ln = (i >> 3) & 63, ks = (i >> 9) & 31, part = (i >> 14) & 1, mf = i >> 15;
          const int n = 16 * mf + (ln & 15), k = 32 * ks + 8 * (ln >> 4) + j;
          const float w = n < 20 ? gf[k] * (n < 4 ? wrg[k * 4 + n] : wre[k * 16 + (n - 4)]) : 0.f;
          const unsigned hi = f2bf(w); const float lo = w - bf2f(hi); WF[i] = (bf16)(part ? f2bf(lo) : hi); } }
    for (int m = c.gw; m < T; m += 2 * c.ngw) {
        const int m2 = m + c.ngw; const f32x4* xa = (const f32x4*)(P.in[0] + (size_t)m * DM) + c.lane; const f32x4* xb = (const f32x4*)(P.in[0] + (size_t)(m2 < T ? m2 : m) * DM) + c.lane;
        const f32x4* gr = (const f32x4*)P.in[2] + c.lane;
        f32x4 va[4], vb[4]; float sa = 0.f, sb = 0.f;
#pragma unroll
        for (int j = 0; j < 4; ++j) { va[j] = __builtin_nontemporal_load(xa + 64 * j); vb[j] = __builtin_nontemporal_load(xb + 64 * j); }
#pragma unroll
        for (int j = 0; j < 4; ++j) { sa += (va[j].x * va[j].x + va[j].y * va[j].y) + (va[j].z * va[j].z + va[j].w * va[j].w); sb += (vb[j].x * vb[j].x + vb[j].y * vb[j].y) + (vb[j].z * vb[j].z + vb[j].w * vb[j].w); }
        const float ra = 1.0f / sqrtf(wave_sum(sa) * (1.f / 1024.f) + RMS_EPS), rb = 1.0f / sqrtf(wave_sum(sb) * (1.f / 1024.f) + RMS_EPS);
        unsigned long long* oa = (unsigned long long*)(P.b(WS_XN) + (size_t)m * DM) + c.lane; unsigned long long* ob = (unsigned long long*)(P.b(WS_XN) + (size_t)m2 * DM) + c.lane;
        unsigned* qa = (unsigned*)(P.ws + WS_XNQ + (size_t)m * DM) + c.lane; unsigned* qb = (unsigned*)(P.ws + WS_XNQ + (size_t)m2 * DM) + c.lane;
#pragma unroll
        for (int j = 0; j < 4; ++j) { const f32x4 gg = gr[64 * j]; const f32x4 ha = va[j] * gg * ra, hb = vb[j] * gg * rb;
            oa[64 * j] = (unsigned long long)pk2(ha.x, ha.y) | ((unsigned long long)pk2(ha.z, ha.w) << 32); qa[64 * j] = q8pk4(ha * 8.0f);
            if (m2 < T) { ob[64 * j] = (unsigned long long)pk2(hb.x, hb.y) | ((unsigned long long)pk2(hb.z, hb.w) << 32); qb[64 * j] = q8pk4(hb * 8.0f); } } }
    for (int m = c.gw; m < TM; m += c.ngw) rms_row_to_bf16(P.in[1] + (size_t)m * DM, P.in[10], P.b(WS_MN) + (size_t)m * DM, c.lane);
}

__device__ __forceinline__ void phase1_naive(const Ctx& c, const Ptrs& P) {
    EpiProjA E{P.b(WS_RQ), P.b(WS_RK), P.b(WS_RV), P.b(WS_RG), P.b(WS_NQ), P.b(WS_NK), P.b(WS_NV), P.b(WS_XQ), P.f(WS_COS), P.f(WS_SIN)};
    naive_gemm(c, RowPlain{P.b(WS_XN), DM}, P.b(WS_WA), DM, T, NPA, DM, E);
}

__device__ __forceinline__ float log_sigmoid_(float x) { return -log1pf(expf(-x)); }

__device__ __forceinline__ void phase2_states_naive(const Ctx& c, const Ptrs& P) {
    const bf16* RK = P.b(WS_RK); const bf16* RV = P.b(WS_RV); bf16* ST = (bf16*)P.out;
    const int nitems = NB * 4 * 2 * 128 * 4;
    for (int it = c.gw; it < nitems; it += c.ngw) {
        const int eb = it & 3, d = (it >> 2) & 127, dir = (it >> 9) & 1, h = (it >> 10) & 3, b = it >> 12;
        const int e = eb * 64 + c.lane;
        const float lg = log_sigmoid_(dir ? P.in[5][h] : P.in[4][h]); const float gam = expf(lg);
        float S = 0.f;
        bf16* stb = ST + (size_t)(((b * 4 + h) * 2 + dir) * 16) * 256 * 128 + (size_t)e * 128 + d;
        for (int jj = 0; jj < SEQ; ++jj) {
            const int j = dir ? (SEQ - 1 - jj) : jj;
            if ((jj & 127) == 0) { const int n = j >> 7; stb[(size_t)n * 256 * 128] = (bf16)f2bf(S); }
            const size_t tok = (size_t)b * SEQ + j;
            const float kv = bf2f(RK[tok * 512 + h * 128 + d]) * bf2f(RV[tok * 1024 + h * 256 + e]);
            S = S * gam + kv;
        }
    }
}
__device__ __forceinline__ void phase2_na_naive(const Ctx& c, const Ptrs& P) {
    bf16* NQ = P.b(WS_NQ); const bf16* NK = P.b(WS_NK); const bf16* NV = P.b(WS_NV); const float* rpb = P.in[8];
    float* scr = (float*)(c.lds + c.wave * 16384);
    const int lane = c.lane;
    for (int it = c.gw; it < T * 8; it += c.ngw) {
        const int h = it & 7, tok = it >> 3, b = tok >> 11, s = tok & 2047, r = s >> 6, cc = s & 63;
        int rs = r - 4; rs = rs < 0 ? 0 : (rs > 24 ? 24 : rs);
        int cs = cc - 8; cs = cs < 0 ? 0 : (cs > 48 ? 48 : cs);
        scr[128 + lane] = bf2f(NQ[(size_t)tok * 512 + h * 64 + lane]);
        __builtin_amdgcn_s_waitcnt(0xC07F); asm volatile("" ::: "memory");
        float sc[2];
#pragma unroll
        for (int t = 0; t < 2; ++t) { const int key = lane + 64 * t, kr = rs + (key >> 4), kc = cs + (key & 15);
            const size_t kt = (size_t)b * SEQ + kr * 64 + kc; const u32x4* kp = (const u32x4*)(NK + kt * 512 + h * 64);
            float a = 0.f;
#pragma unroll 2
            for (int i = 0; i < 8; ++i) { float kk[8]; unpack8(kp[i], kk);
#pragma unroll
                for (int u = 0; u < 8; ++u) a += scr[128 + 8 * i + u] * kk[u]; }
            int rc = kc - cc; rc = rc < -15 ? -15 : (rc > 15 ? 15 : rc);
            sc[t] = a + rpb[(h * 15 + (kr - r + 7)) * 31 + rc + 15]; }
        const float mx = wave_max(fmaxf(sc[0], sc[1]));
        const float e0 = __expf(sc[0] - mx), e1 = __expf(sc[1] - mx);
        const float inv = 1.0f / wave_sum(e0 + e1);
        scr[lane] = e0 * inv; scr[lane + 64] = e1 * inv;
        __builtin_amdgcn_s_waitcnt(0xC07F); asm volatile("" ::: "memory");
        float o = 0.f;
        for (int key = 0; key < 128; ++key) { const int kr = rs + (key >> 4), kc = cs + (key & 15);
            const size_t kt = (size_t)b * SEQ + kr * 64 + kc; o += scr[key] * bf2f(NV[kt * 512 + h * 64 + lane]); }
        NQ[(size_t)tok * 512 + h * 64 + lane] = (bf16)f2bf(o);
        __builtin_amdgcn_s_waitcnt(0xC07F); asm volatile("" ::: "memory");
    }
}
__device__ __forceinline__ void phase2_memkv_naive(const Ctx& c, const Ptrs& P) {
    naive_gemm(c, RowPlain{P.b(WS_MN), DM}, P.b(WS_WKV), DM, TM, 1024, DM, EpiBf16Plain{P.b(WS_MKV), 1024});
}
__device__ __forceinline__ void phase3_ret_naive(const Ctx& c, const Ptrs& P) {
    const bf16* RQ = P.b(WS_RQ); const bf16* RK = P.b(WS_RK); const bf16* RV = P.b(WS_RV); bf16* RG = P.b(WS_RG); const bf16* ST = (const bf16*)P.out;
    const float* gain = P.in[6];
    float* scr = (float*)(c.lds + c.wave * 16384);
    const int lane = c.lane;
    for (int it = c.gw; it < T * 4; it += c.ngw) {
        const int h = it & 3, tok = it >> 2, b = tok >> 11, s = tok & 2047, n = s >> 7, p = s & 127;
        const float lgf = log_sigmoid_(P.in[4][h]), lgb = log_sigmoid_(P.in[5][h]);
        { const bf16* qp = RQ + (size_t)tok * 512 + h * 128; scr[lane] = bf2f(qp[lane]); scr[lane + 64] = bf2f(qp[lane + 64]); }
        __builtin_amdgcn_s_waitcnt(0xC07F); asm volatile("" ::: "memory");
        float sv[2];
#pragma unroll
        for (int t = 0; t < 2; ++t) { const int pj = lane + 64 * t; const size_t kt = (size_t)b * SEQ + n * 128 + pj;
            const u32x4* kp = (const u32x4*)(RK + kt * 512 + h * 128); float a = 0.f;
#pragma unroll 2
            for (int i = 0; i < 16; ++i) { float kk[8]; unpack8(kp[i], kk);
#pragma unroll
                for (int u = 0; u < 8; ++u) a += scr[8 * i + u] * kk[u]; }
            const float w = (pj <= p) ? expf((float)(p - pj) * lgf) : expf((float)(pj - p) * lgb);
            sv[t] = a * w; }
        scr[128 + lane] = sv[0]; scr[128 + 64 + lane] = sv[1];
        __builtin_amdgcn_s_waitcnt(0xC07F); asm volatile("" ::: "memory");
        const float af = expf((float)(p + 1) * lgf), ab = expf((float)(128 - p) * lgb);
        const bf16* sf = ST + (size_t)(((b * 4 + h) * 2 + 0) * 16 + n) * 256 * 128;
        const bf16* sb = ST + (size_t)(((b * 4 + h) * 2 + 1) * 16 + n) * 256 * 128;
        float y[4];
#pragma unroll 1
        for (int eb = 0; eb < 4; ++eb) { const int e = eb * 64 + lane; float a = 0.f;
#pragma unroll 4
            for (int pj = 0; pj < 128; ++pj) { const size_t kt = (size_t)b * SEQ + n * 128 + pj; a += scr[128 + pj] * bf2f(RV[kt * 1024 + h * 256 + e]); }
            float cf = 0.f, cb = 0.f; const u32x4* fp = (const u32x4*)(sf + (size_t)e * 128); const u32x4* bp = (const u32x4*)(sb + (size_t)e * 128);
#pragma unroll 2
            for (int i = 0; i < 16; ++i) { float x1[8], x2[8]; unpack8(fp[i], x1); unpack8(bp[i], x2);
#pragma unroll
                for (int u = 0; u < 8; ++u) { cf += scr[8 * i + u] * x1[u]; cb += scr[8 * i + u] * x2[u]; } }
            y[eb] = a + af * cf + ab * cb; }
        const float mu = wave_sum((y[0] + y[1]) + (y[2] + y[3])) * (1.f / 256.f);
        float v = 0.f;
#pragma unroll
        for (int eb = 0; eb < 4; ++eb) { y[eb] -= mu; v += y[eb] * y[eb]; }
        const float rstd = 1.0f / sqrtf(wave_sum(v) * (1.f / 256.f) + GN_EPS);
#pragma unroll
        for (int eb = 0; eb < 4; ++eb) { const int col = h * 256 + eb * 64 + lane; bf16* g = RG + (size_t)tok * 1024 + col;
            *g = (bf16)f2bf(y[eb] * rstd * gain[col] * bf2f(*g)); }
        __builtin_amdgcn_s_waitcnt(0xC07F); asm volatile("" ::: "memory");
    }
}
__device__ __forceinline__ void phase3_xa_naive(const Ctx& c, const Ptrs& P) {
    bf16* XQ = P.b(WS_XQ); const bf16* MKV = P.b(WS_MKV);
    float* scr = (float*)(c.lds + c.wave * 16384);
    const int lane = c.lane;
    for (int it = c.gw; it < T * 4; it += c.ngw) {
        const int h = it & 3, tok = it >> 2, b = tok >> 11;
        { const bf16* qp = XQ + (size_t)tok * 512 + h * 128; scr[lane] = bf2f(qp[lane]); scr[lane + 64] = bf2f(qp[lane + 64]); }
        __builtin_amdgcn_s_waitcnt(0xC07F); asm volatile("" ::: "memory");
        float sc[4]; float mx = -3.0e38f;
#pragma unroll
        for (int t = 0; t < 4; ++t) { const int m = lane + 64 * t; const u32x4* kp = (const u32x4*)(MKV + (size_t)(b * MEML + m) * 1024 + h * 128); float a = 0.f;
#pragma unroll 2
            for (int i = 0; i < 16; ++i) { float kk[8]; unpack8(kp[i], kk);
#pragma unroll
                for (int u = 0; u < 8; ++u) a += scr[8 * i + u] * kk[u]; }
            sc[t] = a; mx = fmaxf(mx, a); }
        mx = wave_max(mx); float sum = 0.f;
#pragma unroll
        for (int t = 0; t < 4; ++t) { sc[t] = __expf(sc[t] - mx); sum += sc[t]; }
        const float inv = 1.0f / wave_sum(sum);
#pragma unroll
        for (int t = 0; t < 4; ++t) scr[128 + lane + 64 * t] = sc[t] * inv;
        __builtin_amdgcn_s_waitcnt(0xC07F); asm volatile("" ::: "memory");
        float o0 = 0.f, o1 = 0.f;
        for (int m = 0; m < MEML; ++m) { const bf16* vp = MKV + (size_t)(b * MEML + m) * 1024 + 512 + h * 128; const float pm = scr[128 + m];
            o0 += pm * bf2f(vp[lane]); o1 += pm * bf2f(vp[lane + 64]); }
        bf16* op = XQ + (size_t)tok * 512 + h * 128; op[lane] = (bf16)f2bf(o0); op[lane + 64] = (bf16)f2bf(o1);
        __builtin_amdgcn_s_waitcnt(0xC07F); asm volatile("" ::: "memory");
    }
}
__device__ __forceinline__ void phase4_naive(const Ctx& c, const Ptrs& P) {
    naive_gemm(c, RowPlain{P.b(WS_XN), DM}, P.b(WS_WG), DM, T, NPG, DM, EpiSigmoid{P.b(WS_GATES), NPG});
}
__device__ __forceinline__ void phase5_naive(const Ctx& c, const Ptrs& P) {
    float* TMP = P.out; bf16* MIX = P.b(WS_MIX); const bf16* G = P.b(WS_GATES);
    naive_gemm(c, RowPlain{P.b(WS_RG), 1024}, P.b(WS_WRO), 1024, T, DM, 1024, EpiMixNaive<0>{TMP, MIX, G});
    naive_gemm(c, RowPlain{P.b(WS_NQ), 512}, P.b(WS_WNO), 512, T, DM, 512, EpiMixNaive<1>{TMP, MIX, G + 1024});
    naive_gemm(c, RowPlain{P.b(WS_XQ), 512}, P.b(WS_WXO), 512, T, DM, 512, EpiMixNaive<2>{TMP, MIX, G + 2048});
}
__device__ __forceinline__ void phase6_naive(const Ctx& c, const Ptrs& P) {
    naive_gemm(c, RowPlain{P.b(WS_MIX), DM}, P.b(WS_WOUT), DM, T, DM, DM, EpiResidF32{P.in[0], P.out});
}

__device__ __forceinline__ void phase1_mfma(const Ctx& c, const Ptrs& P) {
    EpiProjA E{P.b(WS_RQ), P.b(WS_RK), P.b(WS_RV), P.b(WS_RG), P.b(WS_NQ), P.b(WS_NK), P.b(WS_NV), P.b(WS_XQ), P.f(WS_COS), P.f(WS_SIN)};
    pg8::PlainSched S; S.o.init(T / 256, NPA / 256, gridDim.x, blockIdx.x); S.A = P.b(WS_XN); S.Bt = P.b(WS_WA); S.lda = DM; S.ldb = DM; S.K = DM;
    pg8::gemm_phase<false>((LAS unsigned char*)c.lds, S, pg8::EpiF<EpiProjA, 4>{E});
}
__device__ __forceinline__ void phase4_mfma(const Ctx& c, const Ptrs& P) {
    pg8::PlainSched S; S.o.init(T / 256, NPG / 256, gridDim.x, blockIdx.x); S.A = P.b(WS_XN); S.Bt = P.b(WS_WG); S.lda = DM; S.ldb = DM; S.K = DM;
    pg8::gemm_phase<false>((LAS unsigned char*)c.lds, S, pg8::EpiF<EpiSigmoid>{EpiSigmoid{P.b(WS_GATES), NPG}});
}
__device__ __forceinline__ void phase6_mfma(const Ctx& c, const Ptrs& P) {
    pg8::PlainSched S; S.o.init(T / 256, DM / 256, gridDim.x, blockIdx.x); S.A = P.b(WS_MIX); S.Bt = P.b(WS_WOUT); S.lda = DM; S.ldb = DM; S.K = DM;
    pg8::gemm_phase<false>((LAS unsigned char*)c.lds, S, pg8::EpiF<EpiResidBf16, 2>{EpiResidBf16{P.in[0], P.b(WS_D), P.x1q()}}, 25);
}

__device__ __forceinline__ void panel_handoff(unsigned* cnt, unsigned need, bool release = true) {
    asm volatile("s_waitcnt vmcnt(0)" ::: "memory"); __syncthreads();
    if (threadIdx.x == 0) {
        if (release) { __builtin_amdgcn_fence(__ATOMIC_RELEASE, "agent"); asm volatile("s_waitcnt vmcnt(0)" ::: "memory"); }
        __hip_atomic_fetch_add(cnt, 1u, __ATOMIC_RELAXED, __HIP_MEMORY_SCOPE_AGENT);
        unsigned sp = 0; while (__hip_atomic_load(cnt, __ATOMIC_RELAXED, __HIP_MEMORY_SCOPE_AGENT) < need) { __builtin_amdgcn_s_sleep(2); if (++sp > (1u << 22)) break; }
        __builtin_amdgcn_fence(__ATOMIC_ACQUIRE, "agent"); asm volatile("s_waitcnt vmcnt(0)" ::: "memory");
    }
    __syncthreads();
}
struct GateSched { pg8::TileOrder o; const unsigned char* ws;
    __device__ __forceinline__ bool next(int i, pg8::UnitDesc& u) const { int pm, pn; const int w = i % 3; if (!o.tile(i / 3, pm, pn)) return false;
        u.A = (const char*)(ws + WS_XNQ) + (size_t)pm * 256 * 1024; u.B = (const char*)(ws + WS_WG) + (size_t)(w * 1024 + pn * 256) * 1024; u.lda2 = 1024; u.ldb2 = 1024; u.nt = 8;
        u.row0 = pm * 256; u.col0 = pn * 256; u.aux = w; u.aux2 = 0; u.gidx = nullptr; u.gcnt = 0; u.chain = 0; return true; } };
__device__ __forceinline__ unsigned q8x4(f32x4 g) {
    const unsigned a = (unsigned)(g[0] * 255.0f + 0.5f), b = (unsigned)(g[1] * 255.0f + 0.5f), c = (unsigned)(g[2] * 255.0f + 0.5f), d = (unsigned)(g[3] * 255.0f + 0.5f);
    return a | (b << 8) | (c << 16) | (d << 24); }
__device__ __forceinline__ f32x4 dq8x4(unsigned w) {
    return (f32x4){fmaxf((float)(w & 0xffu) * (1.0f / 255.0f), 1e-18f), fmaxf((float)((w >> 8) & 0xffu) * (1.0f / 255.0f), 1e-18f),
                   fmaxf((float)((w >> 16) & 0xffu) * (1.0f / 255.0f), 1e-18f), fmaxf((float)(w >> 24) * (1.0f / 255.0f), 1e-18f)}; }
struct EpiGate { unsigned char* SCR;
    __device__ __forceinline__ void finish(f32x4 (&acc)[2][2][4][2], const pg8::UnitDesc& u, int wr, int wc, int fr, int fq) const {
        unsigned ow = (unsigned)((u.row0 >> 8) * 4 + (u.col0 >> 8)) * 196608u + (unsigned)u.aux * 65536u + threadIdx.x * 16u;
#pragma unroll
        for (int ai = 0; ai < 2; ++ai)
#pragma unroll
            for (int m = 0; m < 4; ++m) { asm volatile("" : "+v"(ow)); u32x4 o;
#pragma unroll
                for (int bj = 0; bj < 2; ++bj) { f32x4 s0, s1;
#pragma unroll
                    for (int i = 0; i < 4; ++i) { s0[i] = sigmoidf_(acc[ai][bj][m][0][i]); s1[i] = sigmoidf_(acc[ai][bj][m][1][i]); }
                    if (bj == 0) { o.x = q8x4(s0); o.y = q8x4(s1); } else { o.z = q8x4(s0); o.w = q8x4(s1); } }
                *(u32x4*)(SCR + ow) = o;
                ow += 8192; asm volatile("" ::: "memory"); __builtin_amdgcn_sched_barrier(0); }
        pg8::zero_acc(acc);
    } };
struct MixSched { pg8::TileOrder o; const unsigned char* ws;
    __device__ __forceinline__ bool next(int i, pg8::UnitDesc& u) const { int pm, pn; const int w = i % 3; if (!o.tile(i / 3, pm, pn)) return false;
        const size_t offA = w == 0 ? WS_RG : (w == 1 ? WS_NQ : WS_XQ), offB = w == 0 ? WS_WRO : (w == 1 ? WS_WNO : WS_WXO); const int K = w == 0 ? 1024 : 512;
        u.A = (const char*)(ws + offA) + (size_t)pm * 256 * K * 2; u.B = (const char*)(ws + offB) + (size_t)pn * 256 * K * 2; u.lda2 = K * 2; u.ldb2 = K * 2; u.nt = K / 64;
        u.row0 = pm * 256; u.col0 = pn * 256; u.aux = w; u.aux2 = 0; u.gidx = nullptr; u.gcnt = 0; u.chain = (w < 2); return true; } };
struct EpiMix { const unsigned char* SCR; bf16* MIX;
    __device__ __forceinline__ void finish(f32x4 (&acc)[2][2][4][2], const pg8::UnitDesc& u, int wr, int wc, int fr, int fq) const {
        const int w = u.aux; const bool fin = (w == 2);
        unsigned on = (unsigned)((u.row0 >> 8) * 4 + (u.col0 >> 8)) * 196608u + (unsigned)w * 65536u + threadIdx.x * 16u; const unsigned dd = fin ? 0u : 65536u;
        const __amdgpu_buffer_rsrc_t rmix = wt_rsrc(MIX, (unsigned)(T * DM * 2));
        unsigned mp = ((unsigned)(u.row0 + wr * 64 + fr) * DM + (unsigned)(u.col0 + wc * 32 + 8 * fq)) * 2u;
#pragma unroll
        for (int ai = 0; ai < 2; ++ai) {
            asm volatile("" : "+v"(on), "+v"(mp));
            u32x2 ga[4][2], gb[4][2];
#pragma unroll
            for (int m = 0; m < 4; ++m) { const u32x4 a4 = *(const u32x4*)(SCR + on + m * 8192), b4 = *(const u32x4*)(SCR + on + dd + m * 8192);
                ga[m][0] = (u32x2){a4.x, a4.y}; ga[m][1] = (u32x2){a4.z, a4.w}; gb[m][0] = (u32x2){b4.x, b4.y}; gb[m][1] = (u32x2){b4.z, b4.w}; }
#pragma unroll
            for (int m = 0; m < 4; ++m) {
#pragma unroll
                for (int bj = 0; bj < 2; ++bj) {
                    const f32x4 n0 = dq8x4(ga[m][bj].x), n1 = dq8x4(ga[m][bj].y), d0 = dq8x4(gb[m][bj].x), d1 = dq8x4(gb[m][bj].y);
                    f32x4 r0, r1;
#pragma unroll
                    for (int i = 0; i < 4; ++i) { r0[i] = n0[i] * __builtin_amdgcn_rcpf(fin ? 1.0f : d0[i]); r1[i] = n1[i] * __builtin_amdgcn_rcpf(fin ? 1.0f : d1[i]); }
                    const f32x4 v0 = acc[ai][bj][m][0] * r0, v1 = acc[ai][bj][m][1] * r1;
                    if (fin) store8_wt(rmix, mp + (unsigned)(m * 16 * DM + bj * 128) * 2u, v0, v1);
                    acc[ai][bj][m][0] = fin ? (f32x4){0.f, 0.f, 0.f, 0.f} : v0; acc[ai][bj][m][1] = fin ? (f32x4){0.f, 0.f, 0.f, 0.f} : v1; } }
            on += 4 * 8192; mp += 128u * DM * 2u; asm volatile("" ::: "memory"); __builtin_amdgcn_sched_barrier(0); }
    }
};
__device__ __forceinline__ void phase5_mfma(const Ctx& c, const Ptrs& P) {
    unsigned char* scr = P.ws + WS_GATES;
    { GateSched S; S.o.init(T / 256, DM / 256, gridDim.x, blockIdx.x); S.ws = P.ws; pg8::gemm_phase<false, GateSched, EpiGate, true>((LAS unsigned char*)c.lds, S, EpiGate{scr}, 0, 0x7a7a7a7a, 0x7c7c7c7c); }
    { MixSched S; S.o.init(T / 256, DM / 256, gridDim.x, blockIdx.x); S.ws = P.ws; pg8::gemm_phase<false>((LAS unsigned char*)c.lds, S, EpiMix{scr, P.b(WS_MIX)}); }
}
struct MoeSched { const unsigned* ctl; int mode;
    int ln, cj, pe;
    int lo, hi, nblk, v;
    const unsigned char *X1Q, *WGUQ, *HIDQ, *WDQ; const int* elist;
    const unsigned* tcnt;
    __device__ __forceinline__ bool next(int i, pg8::UnitDesc& u) const {
        if (v < 0) return false;
        const int L = lo + v + i * nblk; if (L >= hi) return false;
        const int pn = L & 3, mtg = L >> 2;
        const int e = __popcll(__ballot(ln < NEXP && pe <= mtg));
        if (e >= NEXP) return false;
        const int pprev = e ? __builtin_amdgcn_readlane(pe, e - 1) : 0; const int cnt = __builtin_amdgcn_readlane(cj, e), base = pprev * 256, mt = mtg - pprev;
        u.row0 = mt * 256; u.col0 = pn * 256; u.aux = e; u.aux2 = base; u.gcnt = cnt; u.chain = 0;
        if (mode == 0) { u.A = (const char*)X1Q; u.gidx = elist + e * T; u.lda2 = 1024; u.B = (const char*)(WGUQ + (size_t)e * 1024 * 1024 + (size_t)pn * 256 * 1024); u.ldb2 = 1024; u.nt = 8; }
        else { if (tcnt) { if (ln == 0) { unsigned sp = 0; while (__hip_atomic_load(tcnt + 16 * mtg, __ATOMIC_RELAXED, __HIP_MEMORY_SCOPE_AGENT) < 4u) { __builtin_amdgcn_s_sleep(1); if (++sp > (1u << 22)) break; } }
                           asm volatile("" ::: "memory"); }
               u.A = (const char*)(HIDQ + (size_t)(base + mt * 256) * DFF); u.gidx = nullptr; u.lda2 = DFF; u.B = (const char*)(WDQ + (size_t)e * 1024 * 512 + (size_t)pn * 256 * 512); u.ldb2 = DFF; u.nt = 4; }
        return true; } };
struct EpiMoeUp { unsigned char* HIDQ; const float* EWL; const float* ERS; unsigned* tcnt;
    __device__ __forceinline__ void signal(const pg8::UnitDesc& u) const {
        if (tcnt && threadIdx.x == 0) {
            __hip_atomic_fetch_add(tcnt + 16 * ((u.aux2 >> 8) + (u.row0 >> 8)), 1u, __ATOMIC_RELAXED, __HIP_MEMORY_SCOPE_AGENT); } }
    __device__ __forceinline__ void finish(f32x4 (&acc)[2][2][4][2], const pg8::UnitDesc& u, int wr, int wc, int fr, int fq) const {
        const float* wl = EWL + u.aux * T; const float* rl = ERS + u.aux * T; const int base = u.aux2, cnt = u.gcnt; const int f0 = (u.col0 >> 1) + wc * 32 + 8 * fq;
        float w8[2][4], r8[2][4];
#pragma unroll
        for (int ai = 0; ai < 2; ++ai)
#pragma unroll
            for (int m = 0; m < 4; ++m) { const int row = u.row0 + ai * 128 + wr * 64 + m * 16 + fr; const int rr = row < cnt ? row : 0; w8[ai][m] = wl[rr]; r8[ai][m] = rl[rr]; }
        const __amdgpu_buffer_rsrc_t rh = wt_rsrc(HIDQ, 20u * 1024u * 1024u); const bool odd = (fq & 1) != 0; const int f16 = f0 & ~15;
#pragma unroll
        for (int ai = 0; ai < 2; ++ai)
#pragma unroll
            for (int mp = 0; mp < 2; ++mp) { u32x2 q[2];
#pragma unroll
                for (int k = 0; k < 2; ++k) { const int m = 2 * mp + k; const float rs = r8[ai][m], w = w8[ai][m] * rs * 8.0f; f32x4 h0, h1;
#pragma unroll
                    for (int i = 0; i < 4; ++i) { h0[i] = siluf_(acc[ai][0][m][0][i] * rs) * acc[ai][1][m][0][i] * w; h1[i] = siluf_(acc[ai][0][m][1][i] * rs) * acc[ai][1][m][1][i] * w; }
                    q[k] = (u32x2){q8pk4(h0), q8pk4(h1)}; }
                const u32x2 snd = odd ? q[0] : q[1]; const u32x2 rcv = {(unsigned)__shfl_xor((int)snd.x, 16), (unsigned)__shfl_xor((int)snd.y, 16)};
                const int row = u.row0 + ai * 128 + wr * 64 + (2 * mp + (odd ? 1 : 0)) * 16 + fr;
                const u32x4 o = odd ? (u32x4){rcv.x, rcv.y, q[1].x, q[1].y} : (u32x4){q[0].x, q[0].y, rcv.x, rcv.y};
                if (row < cnt) __builtin_amdgcn_raw_buffer_store_b128(o, rh, (unsigned)(base + row) * DFF + (unsigned)f16, 0, 16); }
        pg8::zero_acc(acc);
    } };
namespace pg8 { template <> struct EpiSig<EpiMoeUp> { static constexpr bool value = true; }; }
struct EpiMoeDown { bf16* DR;
    __device__ __forceinline__ void finish(f32x4 (&acc)[2][2][4][2], const pg8::UnitDesc& u, int wr, int wc, int fr, int fq) const {
        unsigned char* D = (unsigned char*)DR; const int base = u.aux2;
        pg8::epi_apply(acc, u, wr, wc, fr, fq, [=](int row, int col0, f32x4 v0, f32x4 v1) { *(u32x2*)(D + (size_t)(base + row) * DM + col0) = (u32x2){q8pk4(v0 * 8.0f), q8pk4(v1 * 8.0f)}; });
        pg8::zero_acc(acc);
    } };
__device__ __forceinline__ MoeSched moe_sched(const Ptrs& P, int mode) {
    MoeSched S; S.ctl = (const unsigned*)(P.ws + WS_CTL); S.mode = mode; S.X1Q = P.x1q(); S.WGUQ = P.wguq(); S.HIDQ = P.ws + WS_HID; S.WDQ = P.wdq(); S.elist = (const int*)(P.ws + WS_ELIST);
    S.ln = (int)(threadIdx.x & 63); S.cj = S.ln < NEXP ? (int)S.ctl[CW_ECNT + 64 * S.ln] : 0; S.pe = (S.cj + 255) >> 8;
#pragma unroll
    for (int d = 1; d < NEXP; d <<= 1) { const int o = __shfl_up(S.pe, d); if (S.ln >= d) S.pe += o; }
    S.lo = 0; S.hi = 0; S.nblk = 1; S.v = -1; S.tcnt = nullptr; return S; }
__device__ __forceinline__ int moe_tiles(const Ptrs& P) { const unsigned* ctl = (const unsigned*)(P.ws + WS_CTL); int tiles = 0;
    for (int j = 0; j < NEXP; ++j) tiles += ((int)ctl[CW_ECNT + 64 * j] + 255) >> 8; return tiles; }
__device__ __forceinline__ void phase8a(const Ctx& c, const Ptrs& P) {
    const int bx = mx::vblock();
    const int G = (int)gridDim.x, units = 4 * moe_tiles(P);
    MoeSched S = moe_sched(P, 0); S.lo = 0; S.hi = units < 2 * G ? units : 2 * G; S.nblk = G; S.v = bx;
    pg8::gemm_phase<true, MoeSched, EpiMoeUp, true>((LAS unsigned char*)c.lds, S, EpiMoeUp{P.ws + WS_HID, P.f(WS_EWL), P.f(WS_ERS)}, 0, 0x7a7a7a7a, 0x7f7f7f7f);
}
__device__ __forceinline__ void phase8b(const Ctx& c, const Ptrs& P) {
    const int bx = mx::vblock();
    const int G = (int)gridDim.x, tiles = moe_tiles(P), units = 4 * tiles; const int nrem = units - 2 * G < 0 ? 0 : units - 2 * G;
    const int tdone = (2 * G) / 4 < tiles ? (2 * G) / 4 : tiles;
    const bool local = nrem > 0 && nrem <= G / 2;
    const int nup = local ? nrem : (nrem < G / 2 ? nrem : G / 2);
    if (bx < nup) {
        MoeSched S = moe_sched(P, 0); S.lo = 2 * G; S.hi = units; S.nblk = nup; S.v = bx;
        pg8::gemm_phase<true, MoeSched, EpiMoeUp, true>((LAS unsigned char*)c.lds, S, EpiMoeUp{P.ws + WS_HID, P.f(WS_EWL), P.f(WS_ERS)}, 0, 0x7a7a7a7a, 0x7f7f7f7f);
        if (local) {
            const int L = 2 * G + bx, tile = L >> 2; unsigned* cnt = (unsigned*)(P.ws + WS_CTL) + CW_TCNT + 64 * (tile - tdone);
            if (c.tid == 0) {
                __builtin_amdgcn_fence(__ATOMIC_RELEASE, "agent"); asm volatile("s_waitcnt vmcnt(0)" ::: "memory");
                __hip_atomic_fetch_add(cnt, 1u, __ATOMIC_RELAXED, __HIP_MEMORY_SCOPE_AGENT);
                const int need = (units - 4 * tile) < 4 ? (units - 4 * tile) : 4; unsigned sp = 0;
                while (__hip_atomic_load(cnt, __ATOMIC_RELAXED, __HIP_MEMORY_SCOPE_AGENT) < (unsigned)need) { __builtin_amdgcn_s_sleep(2); if (++sp > (1u << 22)) break; }
                __builtin_amdgcn_fence(__ATOMIC_ACQUIRE, "agent"); asm volatile("s_waitcnt vmcnt(0)" ::: "memory");
            }
            __syncthreads();
            MoeSched D = moe_sched(P, 1); D.lo = L; D.hi = L + 1; D.nblk = 1; D.v = 0;
            pg8::gemm_phase<false, MoeSched, EpiMoeDown, true>((LAS unsigned char*)c.lds, D, EpiMoeDown{P.b(WS_DROWS)}, 0, 0x7b7b7b7b, 0x7c7c7c7c);
        }
    } else { MoeSched S = moe_sched(P, 1); S.lo = 0; S.hi = 4 * tdone; S.nblk = G - nup; S.v = bx - nup;
        pg8::gemm_phase<false, MoeSched, EpiMoeDown, true>((LAS unsigned char*)c.lds, S, EpiMoeDown{P.b(WS_DROWS)}, 0, 0x7b7b7b7b, 0x7c7c7c7c); }
}
__device__ __forceinline__ bool moe_merged(const Ptrs& P) { const int G = (int)gridDim.x, units = 4 * moe_tiles(P); return units >= 2 * G && units - 2 * G <= G / 2; }
__device__ __forceinline__ void phase8m(const Ctx& c, const Ptrs& P) {
    const int bx = mx::vblock();
    const int G = (int)gridDim.x, tiles = moe_tiles(P), units = 4 * tiles, nrem = units - 2 * G, tdone = (2 * G) / 4;
    unsigned* tcnt = (unsigned*)(P.ws + WS_CTL) + CW_TILE;
    MoeSched S = moe_sched(P, 0); S.lo = 0; S.hi = units; S.nblk = G; S.v = bx;
    pg8::gemm_phase<true, MoeSched, EpiMoeUp, true>((LAS unsigned char*)c.lds, S, EpiMoeUp{P.ws + WS_HID, P.f(WS_EWL), P.f(WS_ERS), tcnt}, 0, 0x7a7a7a7a, 0x7f7f7f7f);
    { MoeSched D = S; D.mode = 1; D.tcnt = tcnt;
      if (bx < nrem) { D.lo = 2 * G + bx; D.hi = D.lo + 1; D.nblk = 1; D.v = 0; }
      else { D.lo = 0; D.hi = 4 * tdone; D.nblk = G - nrem; D.v = bx - nrem; }
      pg8::gemm_phase<false, MoeSched, EpiMoeDown, true, 16>((LAS unsigned char*)c.lds, D, EpiMoeDown{P.b(WS_DROWS)}, 0, 0x7b7b7b7b, 0x7c7c7c7c); }
}
__device__ __forceinline__ bool moe_needs_8c(const Ptrs& P) { const int G = (int)gridDim.x, units = 4 * moe_tiles(P); const int nrem = units - 2 * G; return nrem > G / 2; }
__device__ __forceinline__ void phase8c(const Ctx& c, const Ptrs& P) {
    const int bx = mx::vblock();
    if (!moe_needs_8c(P)) return;
    const int G = (int)gridDim.x, tiles = moe_tiles(P); const int tdone = (2 * G) / 4 < tiles ? (2 * G) / 4 : tiles;
    MoeSched S = moe_sched(P, 1); S.lo = 4 * tdone; S.hi = 4 * tiles; S.nblk = G; S.v = bx;
    pg8::gemm_phase<false, MoeSched, EpiMoeDown, true>((LAS unsigned char*)c.lds, S, EpiMoeDown{P.b(WS_DROWS)}, 0, 0x7b7b7b7b, 0x7c7c7c7c);
}
__device__ __forceinline__ void phase2_memkv_mfma(const Ctx& c, const Ptrs& P) {
    pg8::PlainSched S; S.o.init(TM / 256, 1024 / 256, gridDim.x, blockIdx.x); S.A = P.b(WS_MN); S.Bt = P.b(WS_WKV); S.lda = DM; S.ldb = DM; S.K = DM;
    pg8::gemm_phase<false>((LAS unsigned char*)c.lds, S, pg8::EpiF<EpiBf16Plain>{EpiBf16Plain{P.b(WS_MKV), 1024}});
}
__device__ __forceinline__ f32x4 x1_load(const float* X0, const bf16* DD, size_t tok, int lane, int j) {
    const u32x2 d = __builtin_nontemporal_load((const u32x2*)(DD + tok * DM) + lane + 64 * j);
    return (f32x4){bf2f(d.x & 0xffffu), bf2f(d.x >> 16), bf2f(d.y & 0xffffu), bf2f(d.y >> 16)};
}
struct CvItem { const float* colp; unsigned char* WT; const float* ks; int ldw, k0, p0, K; float oscale; };
__device__ __forceinline__ void cv_decode(const Ptrs& P, int it, int lane, CvItem& d) {
    const int e = it / 768, r = it - e * 768;
    if (r < 512) { const int kb = r & 15, pb = r >> 4; d.k0 = 64 * kb; d.p0 = 32 * pb; d.K = 1024; d.ldw = 512;
        const int p = d.p0 + (lane & 31), f = 128 * (p >> 8) + (p & 127);
        d.colp = (((p >> 7) & 1) ? P.in[20] : P.in[19]) + (size_t)e * 1024 * 512 + f;
        d.WT = P.wguq() + (size_t)e * 1024 * 1024; d.ks = P.in[14]; d.oscale = 32.0f; }
    else { const int r2 = r - 512, kb = r2 & 7, pb = r2 >> 3; d.k0 = 64 * kb; d.p0 = 32 * pb; d.K = 512; d.ldw = 1024;
        d.colp = P.in[21] + (size_t)e * 512 * 1024 + d.p0 + (lane & 31); d.WT = P.wdq() + (size_t)e * 1024 * 512; d.ks = nullptr; d.oscale = 16.0f; }
}
__device__ __forceinline__ void moe_convert(const Ctx& c, const Ptrs& P) {
    constexpr int NIT = NEXP * 768;
    float* scr = (float*)(c.lds + c.wave * 16384); const int lane = c.lane;
    int it = c.gw; if (it >= NIT) return;
    CvItem cur, nx; float tv[32], tn[32];
    cv_decode(P, it, lane, cur);
#pragma unroll
    for (int i = 0; i < 32; ++i) tv[i] = __builtin_nontemporal_load(cur.colp + (size_t)(cur.k0 + 2 * i + (lane >> 5)) * cur.ldw);
    for (;;) {
        const int itn = it + c.ngw; const bool hn = itn < NIT;
        if (hn) { cv_decode(P, itn, lane, nx);
#pragma unroll
            for (int i = 0; i < 32; ++i) tn[i] = __builtin_nontemporal_load(nx.colp + (size_t)(nx.k0 + 2 * i + (lane >> 5)) * nx.ldw); }
        __builtin_amdgcn_sched_barrier(0);
#pragma unroll
        for (int i = 0; i < 32; ++i) scr[(2 * i + (lane >> 5)) * 33 + (lane & 31)] = tv[i];
        __builtin_amdgcn_s_waitcnt(0xC07F); asm volatile("" ::: "memory");
        const int cc = lane & 7;
        f32x4 ks0 = {1.f, 1.f, 1.f, 1.f}, ks1 = {1.f, 1.f, 1.f, 1.f};
        if (cur.ks) { ks0 = *(const f32x4*)(cur.ks + cur.k0 + 8 * cc); ks1 = *(const f32x4*)(cur.ks + cur.k0 + 8 * cc + 4); }
        ks0 = ks0 * cur.oscale; ks1 = ks1 * cur.oscale;
#pragma unroll
        for (int j = 0; j < 4; ++j) { const int n = (lane >> 3) + 8 * j; const float* sp = scr + (8 * cc) * 33 + n;
            const f32x4 a = {sp[0 * 33] * ks0[0], sp[1 * 33] * ks0[1], sp[2 * 33] * ks0[2], sp[3 * 33] * ks0[3]}, b = {sp[4 * 33] * ks1[0], sp[5 * 33] * ks1[1], sp[6 * 33] * ks1[2], sp[7 * 33] * ks1[3]};
            *(u32x2*)(cur.WT + (size_t)(cur.p0 + n) * cur.K + cur.k0 + 8 * cc) = (u32x2){q8pk4(a), q8pk4(b)}; }
        __builtin_amdgcn_s_waitcnt(0xC07F); asm volatile("" ::: "memory");
        if (!hn) break;
        cur = nx; it = itn;
#pragma unroll
        for (int i = 0; i < 32; ++i) tv[i] = tn[i];
    }
}
constexpr int RT7_WT = 0, RT7_RED = 81920, RT7_LOG = RT7_RED + 8 * 5120, RT7_CNT = RT7_LOG + 8 * 160, RT7_GB = RT7_CNT + 64, RT7_REC = RT7_GB + 64;
template <bool LOCAL>
__device__ __forceinline__ void phase7(const Ctx& c, const Ptrs& P, int rowbase = 0) {
    const float* X0 = P.in[0]; const bf16* DD = P.b(WS_D); const float* g = P.in[14]; const float* wrg = P.in[15]; const float* brg = P.in[16]; const float* wre = P.in[17]; const float* bre = P.in[18];
    unsigned* ctl = (unsigned*)(P.ws + WS_CTL); int* elist = (int*)(P.ws + WS_ELIST); float* ewl = P.f(WS_EWL); int* tmeta = (int*)(P.ws + WS_TMETA);
    const int lane = c.lane; LAS unsigned char* L = (LAS unsigned char*)c.lds;
    { LAS f32x4* WT = (LAS f32x4*)(L + RT7_WT); const f32x4* src = (const f32x4*)P.f(WS_WTR);
#pragma unroll
      for (int i = 0; i < 10; ++i) WT[c.tid + NTHREADS * i] = src[c.tid + NTHREADS * i];
      if (c.tid < 16) ((LAS unsigned*)(L + RT7_CNT))[c.tid] = 0u; (void)wrg; (void)wre; }
    __syncthreads();
    LAS float* RED = (LAS float*)(L + RT7_RED + c.wave * 5120); LAS float* LOG = (LAS float*)(L + RT7_LOG + c.wave * 160);
    LAS unsigned* LCNT = (LAS unsigned*)(L + RT7_CNT); LAS int* REC = (LAS int*)(L + RT7_REC);
    const float mybias = lane < 4 ? brg[lane] : (lane < 20 ? bre[lane - 4] : 0.f);
    f32x4 xn[2][4];
    const int tp0 = LOCAL ? rowbase / 2 + c.wave * 4 : c.gw, tpstep = LOCAL ? 1 : c.ngw, tpend = LOCAL ? tp0 + 4 : T / 2;
    if (tp0 < tpend) {
#pragma unroll
        for (int t = 0; t < 2; ++t)
#pragma unroll
            for (int j = 0; j < 4; ++j) xn[t][j] = x1_load(X0, DD, (size_t)(2 * tp0 + t), lane, j); }
    int pidx = 0;
#pragma unroll 1
    for (int tp = tp0; tp < tpend; tp += tpstep, ++pidx) {
        f32x4 hh[2][4]; float rstd2[2]; const f32x4* gr = (const f32x4*)g + lane;
#pragma unroll
        for (int t = 0; t < 2; ++t)
#pragma unroll
            for (int j = 0; j < 4; ++j) hh[t][j] = xn[t][j];
        { const int tpn = tp + tpstep < tpend ? tp + tpstep : tp;
#pragma unroll
          for (int t = 0; t < 2; ++t)
#pragma unroll
              for (int j = 0; j < 4; ++j) xn[t][j] = x1_load(X0, DD, (size_t)(2 * tpn + t), lane, j); }
#pragma unroll
        for (int t = 0; t < 2; ++t) { const int tok = 2 * tp + t; float s = 0.f;
#pragma unroll
            for (int j = 0; j < 4; ++j) { s += (hh[t][j].x * hh[t][j].x + hh[t][j].y * hh[t][j].y) + (hh[t][j].z * hh[t][j].z + hh[t][j].w * hh[t][j].w); }
            const float r = 1.0f / sqrtf(wave_sum(s) * (1.f / 1024.f) + RMS_EPS); rstd2[t] = r; (void)tok;
#pragma unroll
            for (int j = 0; j < 4; ++j) { const f32x4 gg = gr[64 * j]; hh[t][j] = hh[t][j] * gg * r; } }
        float p0[20], p1[20];
        const LAS f32x4* wt = (const LAS f32x4*)(L + RT7_WT) + lane;
#pragma unroll
        for (int n = 0; n < 20; ++n) { f32x2_ a = {0.f, 0.f};
#pragma unroll
            for (int j = 0; j < 4; ++j) { const f32x4 w4 = wt[n * 256 + 64 * j];
#pragma unroll
                for (int u = 0; u < 4; ++u) { const f32x2_ hv = {hh[0][j][u], hh[1][j][u]}; const f32x2_ wv = {w4[u], w4[u]}; a = __builtin_elementwise_fma(hv, wv, a); } }
            p0[n] = a[0]; p1[n] = a[1]; __builtin_amdgcn_sched_barrier(0); }
#pragma unroll 1
        for (int t = 0; t < 2; ++t) {
#pragma unroll
            for (int q = 0; q < 5; ++q) *(LAS f32x4*)(RED + lane * 20 + 4 * q) = t ? (f32x4){p1[4 * q], p1[4 * q + 1], p1[4 * q + 2], p1[4 * q + 3]} : (f32x4){p0[4 * q], p0[4 * q + 1], p0[4 * q + 2], p0[4 * q + 3]};
            asm volatile("s_waitcnt lgkmcnt(0)" ::: "memory");
            float sum = 0.f; const int nn = lane < 20 ? lane : 0;
#pragma unroll 16
            for (int j = 0; j < 64; ++j) sum += RED[j * 20 + nn];
            if (lane < 20) LOG[t * 20 + lane] = sum + mybias;
            asm volatile("s_waitcnt lgkmcnt(0)" ::: "memory");
        }
        if (lane < 2) {
            const int tok = 2 * tp + lane;
            float l[20];
#pragma unroll
            for (int i = 0; i < 20; ++i) l[i] = LOG[lane * 20 + i];
            int gi = 0;
#pragma unroll
            for (int i = 1; i < 4; ++i) if (l[i] > l[gi]) gi = i;
            float lmax = l[0];
#pragma unroll
            for (int i = 1; i < 4; ++i) lmax = fmaxf(lmax, l[i]);
            float se = 0.f;
#pragma unroll
            for (int i = 0; i < 4; ++i) se += expf(l[i] - lmax);
            const float grp_w = 1.0f / se;
            float el[4];
#pragma unroll
            for (int i = 0; i < 4; ++i) { float a = 0.f;
#pragma unroll
                for (int g2 = 0; g2 < 4; ++g2) a = (g2 == gi) ? l[4 + 4 * g2 + i] : a;
                el[i] = a; }
            int ia = 0;
#pragma unroll
            for (int i = 1; i < 4; ++i) if (el[i] > el[ia]) ia = i;
            int ib = (ia == 0) ? 1 : 0;
#pragma unroll
            for (int i = 0; i < 4; ++i) if (i != ia && i != ib && el[i] > el[ib]) ib = i;
            float ela = el[0], elb = el[0];
#pragma unroll
            for (int i = 1; i < 4; ++i) { ela = (i == ia) ? el[i] : ela; elb = (i == ib) ? el[i] : elb; }
            const float t = expf(elb - ela); const float wa = grp_w / (1.0f + t), wb = grp_w * t / (1.0f + t);
            const int ea = gi * 4 + ia, eb = gi * 4 + ib;
            const int lpa = (int)atomicAdd((unsigned*)(LCNT + ea), 1u), lpb = (int)atomicAdd((unsigned*)(LCNT + eb), 1u);
            LAS int* rec = REC + (c.wave * 8 + pidx * 2 + lane) * 8;
            rec[0] = tok; rec[1] = ea; rec[2] = lpa; rec[3] = eb; rec[4] = lpb; rec[5] = __float_as_int(wa); rec[6] = __float_as_int(wb); rec[7] = __float_as_int(lane ? rstd2[1] : rstd2[0]);
        }
    }
    __syncthreads();
    if (c.tid < 16) ((LAS unsigned*)(L + RT7_GB))[c.tid] = atomicAdd(ctl + CW_ECNT + 64 * c.tid, LCNT[c.tid]);
    __syncthreads();
    if (c.tid < 64) { const int wv = c.tid >> 3, k = c.tid & 7;
        const int gwv = blockIdx.x * NWAVES + wv; const int npairs = LOCAL ? 4 : (gwv < T / 2 ? (T / 2 - 1 - gwv) / c.ngw + 1 : 0);
        if ((k >> 1) < npairs) { const LAS int* rec = REC + c.tid * 8; const LAS unsigned* GB = (const LAS unsigned*)(L + RT7_GB);
            const int tok = rec[0], ea = rec[1], eb = rec[3]; const int pa = (int)GB[ea] + rec[2], pb = (int)GB[eb] + rec[4];
            elist[ea * T + pa] = tok; ewl[ea * T + pa] = __int_as_float(rec[5]); elist[eb * T + pb] = tok; ewl[eb * T + pb] = __int_as_float(rec[6]);
            float* ers = (float*)(P.ws + WS_ERS); ers[ea * T + pa] = __int_as_float(rec[7]); ers[eb * T + pb] = __int_as_float(rec[7]);
            *(int4*)(tmeta + 4 * tok) = make_int4(ea, pa, eb, pb); } }
    __syncthreads();
    moe_convert(c, P);
}
__device__ __forceinline__ void phase7_mfma(const Ctx& c, const Ptrs& P, int rowbase, bool convert) {
    const bf16* DD = P.b(WS_D); const float* brg = P.in[16]; const float* bre = P.in[18];
    unsigned* ctl = (unsigned*)(P.ws + WS_CTL); int* elist = (int*)(P.ws + WS_ELIST); float* ewl = P.f(WS_EWL); int* tmeta = (int*)(P.ws + WS_TMETA);
    const int lane = c.lane, li = lane & 15, g = lane >> 4; LAS unsigned char* L = (LAS unsigned char*)c.lds;
    constexpr int RM_LOG = 131072, RM_RS = RM_LOG + 5632, RM_CNT = RM_RS + 256, RM_GB = RM_CNT + 64, RM_REC = RM_GB + 64;
    LAS float* LOG = (LAS float*)(L + RM_LOG); LAS float* RS = (LAS float*)(L + RM_RS);
    LAS unsigned* LCNT = (LAS unsigned*)(L + RM_CNT); LAS int* REC = (LAS int*)(L + RM_REC);
    if (c.tid < 16) LCNT[c.tid] = 0u;
    const int wv = __builtin_amdgcn_readfirstlane((int)(threadIdx.x >> 6)); const int tg = wv & 3, mf = wv >> 2;
    { const unsigned char* wsrc = P.ws + WS_WF + (size_t)wv * 16384 + lane * 16;
#pragma unroll
      for (int i = 0; i < 16; ++i) __builtin_amdgcn_global_load_lds((const unsigned*)(wsrc + i * 1024), (LAS unsigned*)(L + wv * 16384 + i * 1024), 16, 0, 0); }
    const bf16* xr = DD + (size_t)(rowbase + 16 * tg + li) * DM + 8 * g;
    bf16x8 xf[32];
#pragma unroll
    for (int ks = 0; ks < 32; ++ks) xf[ks] = mx::glbf(xr + 32 * ks);
    asm volatile("s_waitcnt vmcnt(0)" ::: "memory"); __syncthreads();
    f32x4 acc = {0.f, 0.f, 0.f, 0.f}, sq = {0.f, 0.f, 0.f, 0.f};
    { LAS unsigned char* wf = L + (mf * 2 * 32) * 1024 + lane * 16;
#pragma unroll
      for (int ks = 0; ks < 32; ++ks) { const bf16x8 wh = *(const LAS bf16x8*)(wf + ks * 1024), wl = *(const LAS bf16x8*)(wf + (32 + ks) * 1024);
          acc = mx::mma(wh, xf[ks], acc); acc = mx::mma(wl, xf[ks], acc); sq = mx::mma(xf[ks], xf[ks], sq); } }
    { float d = sq[0]; d = (li & 3) == 1 ? sq[1] : d; d = (li & 3) == 2 ? sq[2] : d; d = (li & 3) == 3 ? sq[3] : d;
      const float ss = __shfl(d, (li >> 2) * 16 + li);
      const float r = 1.0f / sqrtf(ss * (1.f / 1024.f) + RMS_EPS);
      const int t = 16 * tg + li;
#pragma unroll
      for (int q = 0; q < 4; ++q) { const int n = 16 * mf + 4 * g + q;
          if (n < 20) LOG[t * 21 + n] = acc[q] * r + (n < 4 ? brg[n] : bre[n - 4]); }
      if (mf == 0 && g == 0) RS[t] = r; }
    __syncthreads();
    if (c.tid < 64) {
        const int tok = rowbase + c.tid;
        float l[20];
#pragma unroll
        for (int i = 0; i < 20; ++i) l[i] = LOG[c.tid * 21 + i];
        int gi = 0;
#pragma unroll
        for (int i = 1; i < 4; ++i) if (l[i] > l[gi]) gi = i;
        float lmax = l[0];
#pragma unroll
        for (int i = 1; i < 4; ++i) lmax = fmaxf(lmax, l[i]);
        float se = 0.f;
#pragma unroll
        for (int i = 0; i < 4; ++i) se += expf(l[i] - lmax);
        const float grp_w = 1.0f / se;
        float el[4];
#pragma unroll
        for (int i = 0; i < 4; ++i) { float a = 0.f;
#pragma unroll
            for (int g2 = 0; g2 < 4; ++g2) a = (g2 == gi) ? l[4 + 4 * g2 + i] : a;
            el[i] = a; }
        int ia = 0;
#pragma unroll
        for (int i = 1; i < 4; ++i) if (el[i] > el[ia]) ia = i;
        int ib = (ia == 0) ? 1 : 0;
#pragma unroll
        for (int i = 0; i < 4; ++i) if (i != ia && i != ib && el[i] > el[ib]) ib = i;
        float ela = el[0], elb = el[0];
#pragma unroll
        for (int i = 1; i < 4; ++i) { ela = (i == ia) ? el[i] : ela; elb = (i == ib) ? el[i] : elb; }
        const float t = expf(elb - ela); const float wa = grp_w / (1.0f + t), wb = grp_w * t / (1.0f + t);
        const int ea = gi * 4 + ia, eb = gi * 4 + ib;
        const int lpa = (int)atomicAdd((unsigned*)(LCNT + ea), 1u), lpb = (int)atomicAdd((unsigned*)(LCNT + eb), 1u);
        LAS int* rec = REC + c.tid * 8;
        rec[0] = tok; rec[1] = ea; rec[2] = lpa; rec[3] = eb; rec[4] = lpb; rec[5] = __float_as_int(wa); rec[6] = __float_as_int(wb); rec[7] = __float_as_int(RS[c.tid]);
    }
    __syncthreads();
    if (c.tid < 16) ((LAS unsigned*)(L + RM_GB))[c.tid] = atomicAdd(ctl + CW_ECNT + 64 * c.tid, LCNT[c.tid]);
    __syncthreads();
    if (c.tid < 64) { const LAS int* rec = REC + c.tid * 8; const LAS unsigned* GB = (const LAS unsigned*)(L + RM_GB);
        const int tok = rec[0], ea = rec[1], eb = rec[3]; const int pa = (int)GB[ea] + rec[2], pb = (int)GB[eb] + rec[4];
        elist[ea * T + pa] = tok; ewl[ea * T + pa] = __int_as_float(rec[5]); elist[eb * T + pb] = tok; ewl[eb * T + pb] = __int_as_float(rec[6]);
        float* ers = (float*)(P.ws + WS_ERS); ers[ea * T + pa] = __int_as_float(rec[7]); ers[eb * T + pb] = __int_as_float(rec[7]);
        *(int4*)(tmeta + 4 * tok) = make_int4(ea, pa, eb, pb); }
    __syncthreads();
    if (convert) moe_convert(c, P);
}
__device__ __forceinline__ void phase567(const Ctx& c, const Ptrs& P) {
    pg8::TileOrder o; o.init(T / 256, DM / 256, gridDim.x, blockIdx.x); int pm = 0, pn = 0; o.tile(0, pm, pn);
    unsigned* ctl = (unsigned*)(P.ws + WS_CTL);
    const bool conv_first = (pm & 1) != 0;
    if (conv_first) { moe_convert(c, P); __syncthreads(); }
    phase5_mfma(c, P);
    panel_handoff(ctl + CW_PAN1 + 32 * pm, 4u, false);
    phase6_mfma(c, P);
    panel_handoff(ctl + CW_PAN2 + 32 * pm, 4u, false);
    phase7_mfma(c, P, pm * 256 + pn * 64, !conv_first);
}
__device__ __forceinline__ int expert_rowbase(const unsigned* ctl, int e, int& cnt_e) {
    int base = 0; cnt_e = 0;
    for (int i = 0; i < NEXP; ++i) { const int ci = (int)ctl[CW_ECNT + 64 * i]; if (i < e) base += (ci + 255) & ~255; if (i == e) cnt_e = ci; }
    return base;
}
__device__ __forceinline__ void phase8_naive(const Ctx& c, const Ptrs& P) {
    const unsigned* ctl = (const unsigned*)(P.ws + WS_CTL);
    for (int e = 0; e < NEXP; ++e) { int cnt; const int base = expert_rowbase(ctl, e, cnt);
        naive_gemm(c, RowGather{P.b(WS_H2), DM, (const int*)(P.ws + WS_ELIST) + e * T}, P.wgu() + (size_t)e * 1024 * 1024, 1024, cnt, 1024, 1024,
                   EpiSwiGLU{P.b(WS_HID), P.f(WS_EWL) + e * T, base}); }
}
__device__ __forceinline__ void phase9_naive(const Ctx& c, const Ptrs& P) {
    const unsigned* ctl = (const unsigned*)(P.ws + WS_CTL);
    for (int e = 0; e < NEXP; ++e) { int cnt; const int base = expert_rowbase(ctl, e, cnt);
        naive_gemm(c, RowPlain{P.b(WS_HID) + (size_t)base * DFF, DFF}, P.wd() + (size_t)e * 1024 * 512, 512, cnt, 1024, 512, EpiRowsBf16{P.b(WS_DROWS), 1024, base}); }
}
struct FinTok { f32x4 x[4]; unsigned a[4], b[4]; };
__device__ __forceinline__ void fin_issue(FinTok& d, const float* X0, const bf16* DD, const bf16* DR, int tok, int4 m, const int (&rb)[NEXP], int lane) {
    int ba = 0, bb = 0;
#pragma unroll
    for (int i = 0; i < NEXP; ++i) { ba = (i == m.x) ? rb[i] : ba; bb = (i == m.z) ? rb[i] : bb; }
    const unsigned* da = (const unsigned*)((const unsigned char*)DR + (size_t)(ba + m.y) * DM) + lane;
    const unsigned* db = (const unsigned*)((const unsigned char*)DR + (size_t)(bb + m.w) * DM) + lane;
#pragma unroll
    for (int j = 0; j < 4; ++j) { d.a[j] = __builtin_nontemporal_load(da + 64 * j); d.b[j] = __builtin_nontemporal_load(db + 64 * j); d.x[j] = x1_load(X0, DD, (size_t)tok, lane, j); }
}
__device__ __forceinline__ void phase10(const Ctx& c, const Ptrs& P) {
    const unsigned* ctl = (const unsigned*)(P.ws + WS_CTL); const int* tmeta = (const int*)(P.ws + WS_TMETA); const bf16* DR = P.b(WS_DROWS); const float* g = P.in[22];
    int rb[NEXP]; { int base = 0;
#pragma unroll
        for (int i = 0; i < NEXP; ++i) { rb[i] = base; base += ((int)ctl[CW_ECNT + 64 * i] + 255) & ~255; } }
    const int lane = c.lane;
    if (c.gw >= T) return;
    FinTok cur, nxt; int4 mn = *(const int4*)(tmeta + 4 * c.gw);
    fin_issue(cur, P.in[0], P.b(WS_D), DR, c.gw, mn, rb, lane);
    { const int t1 = c.gw + c.ngw; mn = *(const int4*)(tmeta + 4 * (t1 < T ? t1 : c.gw)); }
#pragma unroll 1
    for (int tok = c.gw; tok < T; tok += c.ngw) {
        const int t1 = tok + c.ngw, t2 = tok + 2 * c.ngw;
        if (t1 < T) { fin_issue(nxt, P.in[0], P.b(WS_D), DR, t1, mn, rb, lane); mn = *(const int4*)(tmeta + 4 * (t2 < T ? t2 : tok)); }
        f32x4* xr = (f32x4*)(P.out + (size_t)tok * DM) + lane; const f32x4* gr = (const f32x4*)g + lane;
        f32x4 v[4]; float s = 0.f;
#pragma unroll
        for (int j = 0; j < 4; ++j) { const unsigned a = cur.a[j], b = cur.b[j]; f32x4 x = cur.x[j];
            const f32x2_ a0 = __builtin_amdgcn_cvt_pk_f32_fp8(a, false), a1 = __builtin_amdgcn_cvt_pk_f32_fp8(a, true), b0 = __builtin_amdgcn_cvt_pk_f32_fp8(b, false), b1 = __builtin_amdgcn_cvt_pk_f32_fp8(b, true);
            x.x += (a0[0] + b0[0]) * 0.125f; x.y += (a0[1] + b0[1]) * 0.125f; x.z += (a1[0] + b1[0]) * 0.125f; x.w += (a1[1] + b1[1]) * 0.125f;
            v[j] = x; s += (x.x * x.x + x.y * x.y) + (x.z * x.z + x.w * x.w); }
        const float r = 1.0f / sqrtf(wave_sum(s) * (1.f / 1024.f) + RMS_EPS);
#pragma unroll
        for (int j = 0; j < 4; ++j) { const f32x4 gg = gr[64 * j]; __builtin_nontemporal_store((f32x4){v[j].x * r * gg.x, v[j].y * r * gg.y, v[j].z * r * gg.z, v[j].w * r * gg.w}, xr + 64 * j); }
        cur = nxt;
    }
#if PROBE_TS_A >= 0
    if (c.gw == 0 && lane == 0) { volatile LAS unsigned* MISC = (volatile LAS unsigned*)((LAS unsigned char*)c.lds + MISC_OFF);
        asm volatile("s_waitcnt vmcnt(0)" ::: "memory"); MISC[32 + 24] = (unsigned)__builtin_amdgcn_s_memrealtime();
        const unsigned dt = MISC[32 + PROBE_TS_B] - MISC[32 + PROBE_TS_A]; P.out[0] += 8.0f + (float)dt * (0.01f / PROBE_TS_DIV); }
#endif
}

constexpr int NPHASES = 12;
__global__ void __launch_bounds__(NTHREADS, 2) mk_fwd(Args args) {
    extern __shared__ __attribute__((aligned(16))) unsigned char lds[];
    Ctx c; c.tid = threadIdx.x; c.lane = c.tid & 63; c.wave = __builtin_amdgcn_readfirstlane(c.tid >> 6);
    c.gw = blockIdx.x * NWAVES + c.wave; c.ngw = gridDim.x * NWAVES; c.lds = lds;
    Ptrs P;
#pragma unroll
    for (int i = 0; i < 23; ++i) P.in[i] = args.in[i];
    P.out = args.out; P.ws = args.ws;
    volatile LAS unsigned* MISC = (volatile LAS unsigned*)((LAS unsigned char*)lds + MISC_OFF);
    if (c.tid < 32) MISC[c.tid] = 0u;
    __syncthreads();
    XcdBarrier bar; bar.bar = (unsigned*)(args.ws + WS_CTL) + CW_BAR; bar.x = 0; bar.st = nullptr;
    const int lo = args.ph_lo, hi = args.ph_hi;
    const bool one_launch = (hi - lo > 1);
    if (one_launch && blockIdx.x == 0) {
        unsigned* ctlw = (unsigned*)(args.ws + WS_CTL); int w = -1; const int t = c.tid;
        if (t < 16) w = CW_BAR + XB_XCNT(t); else if (t < 32) w = CW_BAR + XB_XSUB(t - 16); else if (t < 48) w = CW_BAR + XB_XGEN(t - 32);
        else if (t == 48) w = CW_BAR + XB_TMO; else if (t == 49) w = CW_BAR + XB_TOP; else if (t == 50) w = CW_BAR + XB_TOPGEN;
        else if (t >= 64 && t < 80) w = CW_ECNT + 64 * (t - 64); else if (t >= 80 && t < 96) w = CW_TCNT + 64 * (t - 80);
        else if (t >= 128 && t < 192) w = CW_PAN1 + 32 * (t - 128); else if (t >= 192 && t < 256) w = CW_PAN2 + 32 * (t - 192);
        else if (t >= 256) w = CW_TILE + 16 * (t - 256);
        if (w >= 0) __hip_atomic_store(ctlw + w, 0u, __ATOMIC_RELAXED, __HIP_MEMORY_SCOPE_AGENT);
        asm volatile("s_waitcnt vmcnt(0)" ::: "memory"); __syncthreads();
        if (c.tid == 0) __hip_atomic_store(ctlw + CW_READY, READY_MAGIC, __ATOMIC_RELAXED, __HIP_MEMORY_SCOPE_AGENT);
    }
#define IN(k) (lo <= (k) && (k) < hi)
#define SEAM(k) do { if (IN(k) && IN((k) + 1)) xcd_barrier(bar); } while (0)
    const int sub = args.sub;
#if PROBE_TS_A >= 0
#define STAMP(k) do { if (blockIdx.x == 0 && c.tid == 0) MISC[32 + (k)] = (unsigned)__builtin_amdgcn_s_memrealtime(); } while (0)
#else
#define STAMP(k) do { } while (0)
#endif
    STAMP(0);
#define SUBRUN(id, stmt) do { if (sub & (1 << (id))) { stmt; __syncthreads(); } } while (0)
    if (IN(0)) { SUBRUN(0, phase0(c, P)); } STAMP(1);
    if (one_launch) {
        if (c.tid == 0) { unsigned* ctlw = (unsigned*)(args.ws + WS_CTL); unsigned sp = 0;
            while (__hip_atomic_load(ctlw + CW_READY, __ATOMIC_RELAXED, __HIP_MEMORY_SCOPE_AGENT) != READY_MAGIC) { __builtin_amdgcn_s_sleep(2); if (++sp > (1u << 22)) break; } }
        __syncthreads();
        bar = xcd_barrier_post((unsigned*)(args.ws + WS_CTL) + CW_BAR, MISC + 8);
    }
    SEAM(0); STAMP(2);
    if (IN(1)) { SUBRUN(1, phase1_mfma(c, P)); } STAMP(3); SEAM(1); STAMP(4);
    if (IN(2)) { SUBRUN(2, mx::ret_state_phase((LAS unsigned char*)lds, P.b(WS_RK), P.b(WS_RV), (bf16*)P.out, P.in[4], P.in[5])); STAMP(5);
                 SUBRUN(3, mx::na_phase((LAS unsigned char*)lds, P.b(WS_NQ), P.b(WS_NK), P.b(WS_NV), P.b(WS_FT))); STAMP(6);
                 SUBRUN(4, phase2_memkv_mfma(c, P)); } STAMP(7); SEAM(2); STAMP(8);
    if (IN(3)) { SUBRUN(5, mx::ret_out_phase((LAS unsigned char*)lds, P.b(WS_RQ), P.b(WS_RK), P.b(WS_RV), P.b(WS_RG), (const bf16*)P.out, P.in[6], P.in[4], P.in[5])); STAMP(9);
                 SUBRUN(6, mx::xa_phase((LAS unsigned char*)lds, P.b(WS_XQ), P.b(WS_MKV))); } STAMP(10); SEAM(3); STAMP(11);
    STAMP(12); STAMP(13);
    if (gridDim.x == 256) {
        if (IN(5)) { SUBRUN(8, phase567(c, P)); } STAMP(18); if (IN(5) && IN(8)) xcd_barrier(bar); STAMP(19);
    } else {
        if (IN(5)) { SUBRUN(8, phase5_mfma(c, P)); if (IN(8)) xcd_barrier(bar); SUBRUN(9, phase6_mfma(c, P)); if (IN(8)) xcd_barrier(bar); SUBRUN(10, phase7<false>(c, P)); } if (IN(5) && IN(8)) xcd_barrier(bar);
    }
    const bool merged = one_launch && moe_merged(P);
    if (merged) { if (IN(8)) { SUBRUN(11, phase8m(c, P)); } STAMP(20); STAMP(21); STAMP(22); SEAM(9); STAMP(23); }
    else {
    if (IN(8)) { SUBRUN(11, phase8a(c, P)); } STAMP(20); SEAM(8); STAMP(21);
    if (IN(9)) { SUBRUN(12, phase8b(c, P)); } STAMP(22); SEAM(9); STAMP(23); }
    if (IN(10) && !merged && moe_needs_8c(P)) { SUBRUN(12, phase8c(c, P)); STAMP(44); SEAM(10); } STAMP(45);
    if (one_launch && blockIdx.x == 0 && c.tid == 0) __hip_atomic_store((unsigned*)(args.ws + WS_CTL) + CW_READY, 0u, __ATOMIC_RELAXED, __HIP_MEMORY_SCOPE_AGENT);
    if (IN(11)) { SUBRUN(13, phase10(c, P)); }
#undef SUBRUN
#undef IN
#undef SEAM
}

extern "C" void kernel_launch(void* const* d_in, const int* in_sizes, int n_in, void* d_out, int out_size, void* d_ws, size_t ws_size, hipStream_t stream) {
    static int grid = 0;
    if (grid == 0) {
        if (n_in != 23 || out_size != T * DM || ws_size < WS_END) { fprintf(stderr, "kernel_launch: unexpected shapes (n_in %d out %d ws %zu)\n", n_in, out_size, ws_size); grid = -1; return; }
        int dev = 0, cus = 0;
        if (hipGetDevice(&dev) != hipSuccess || hipDeviceGetAttribute(&cus, hipDeviceAttributeMultiprocessorCount, dev) != hipSuccess) { grid = -1; return; }
        if (hipFuncSetAttribute((const void*)mk_fwd, hipFuncAttributeMaxDynamicSharedMemorySize, LDS_BYTES) != hipSuccess) { fprintf(stderr, "kernel_launch: hipFuncSetAttribute failed\n"); grid = -1; return; }
        (void)hipGetLastError();
        grid = cus;
    }
    if (grid < 0) return;
#if MK_PER_PHASE
    (void)hipMemsetAsync((char*)d_ws + WS_CTL, 0, CTL_ZERO_BYTES, stream);
#endif
    Args a{};
    for (int i = 0; i < 23; ++i) a.in[i] = (const float*)d_in[i];
    a.out = (float*)d_out; a.ws = (unsigned char*)d_ws;
#if MK_PER_PHASE
    a.sub = 0x3fff; a.rep = -1;
    for (int p = 0; p < NPHASES; ++p) { a.ph_lo = p; a.ph_hi = p + 1; hipLaunchKernelGGL(mk_fwd, dim3(grid), dim3(NTHREADS), LDS_BYTES, stream, a); }
#else
    a.ph_lo = 0; a.ph_hi = NPHASES; a.sub = 0x3fff; a.rep = PROBE_REP; hipLaunchKernelGGL(mk_fwd, dim3(grid), dim3(NTHREADS), LDS_BYTES, stream, a);
#if PROBE_END >= 0
    { const int ph_of[14] = {0, 1, 2, 2, 2, 3, 3, 4, 5, 6, 7, 8, 9, 11};
      a.ph_lo = ph_of[PROBE_END]; a.ph_hi = a.ph_lo + 1; a.sub = 1 << PROBE_END; a.rep = -1; hipLaunchKernelGGL(mk_fwd, dim3(grid), dim3(NTHREADS), LDS_BYTES, stream, a); }
#endif
#endif
}
```
